# Optimizing an MI355X kernel written in HIP

```python
import jax, jax.numpy as jnp
from jax import lax
import numpy as np

D_MODEL = 2048
BATCH = 2
SEQ = 4096
DEPTH = 1

GRID_W = 64
N_MEM = 256

NA_HEADS = 8
NA_HEAD_DIM = 128
NA_MAX_ROWS = 8
NA_COLS = 16

RET_HEADS = 8
RET_QK_DIM = 128
RET_V_DIM = 256
RET_CHUNK = 128
ROPE_BASE = 10000.0

XA_HEADS = 4
XA_HEAD_DIM = 256

D_FF = 4 * D_MODEL
N_BRANCH = 3
EPS = 1e-6

NA_W = NA_HEADS * NA_HEAD_DIM
RET_QK_W = RET_HEADS * RET_QK_DIM
RET_V_W = RET_HEADS * RET_V_DIM
XA_W = XA_HEADS * XA_HEAD_DIM
IN_SPLITS = (NA_W, NA_W, NA_W, RET_QK_W, RET_QK_W, RET_V_W, RET_V_W, XA_W, D_MODEL, D_MODEL, D_MODEL)
D_IN = sum(IN_SPLITS)

kernel_name = 'hybrid_na_retention_memxattn_encoder'


def rmsnorm(x, g):
    xf = x.astype(jnp.float32)
    y = xf * lax.rsqrt(jnp.mean(jnp.square(xf), axis=-1, keepdims=True) + EPS)
    return (y * g.astype(jnp.float32)).astype(x.dtype)


def split_heads(t, n_heads):
    b, s, w = t.shape
    return t.reshape(b, s, n_heads, w // n_heads).transpose(0, 2, 1, 3)


def merge_heads(t):
    b, h, s, d = t.shape
    return t.transpose(0, 2, 1, 3).reshape(b, s, h * d)


def rope(t):
    s, d = t.shape[2], t.shape[3]
    half = d // 2
    inv = jnp.power(jnp.float32(ROPE_BASE), -jnp.arange(half, dtype=jnp.float32) / half)
    ang = jnp.arange(s, dtype=jnp.float32)[:, None] * inv[None, :]
    cos = jnp.cos(ang).astype(t.dtype)
    sin = jnp.sin(ang).astype(t.dtype)
    t1, t2 = t[..., :half], t[..., half:]
    return jnp.concatenate([t1 * cos - t2 * sin, t1 * sin + t2 * cos], axis=-1)


def neighbourhood_attention(q, k, v, rpb):
    b, h, s, dh = q.shape
    rows = s // GRID_W
    kr = min(NA_MAX_ROWS, rows)
    kc = NA_COLS
    r = jnp.arange(rows)
    row_start = jnp.clip(r - kr // 2, 0, rows - kr)
    row_idx = row_start[:, None] + jnp.arange(kr)[None, :]
    c = jnp.arange(GRID_W)
    col_start = jnp.clip(c - kc // 2, 0, GRID_W - kc)
    col_ok = (c[None, :] >= col_start[:, None]) & (c[None, :] < col_start[:, None] + kc)
    qg = q.reshape(b, h, rows, GRID_W, dh)
    kg = k.reshape(b, h, rows, GRID_W, dh)[:, :, row_idx]
    vg = v.reshape(b, h, rows, GRID_W, dh)[:, :, row_idx]
    sc = jnp.einsum('bhrqd,bhrkwd->bhrqkw', qg, kg).astype(jnp.float32)
    dr = row_idx - r[:, None] + (NA_MAX_ROWS - 1)
    dc = jnp.clip(c[None, :] - c[:, None], -(kc - 1), kc - 1) + (kc - 1)
    bias = rpb[:, dr[:, None, :, None], dc[None, :, None, :]].astype(jnp.float32)
    sc = sc + bias[None]
    sc = jnp.where(col_ok[:, None, :], sc, -jnp.inf)
    p = jax.nn.softmax(sc.reshape(b, h, rows, GRID_W, kr * GRID_W), axis=-1)
    p = p.reshape(sc.shape).astype(v.dtype)
    o = jnp.einsum('bhrqkw,bhrkwd->bhrqd', p, vg)
    return o.reshape(b, h, s, dh)


def retention_one_direction(q, k, v, log_g, strict):
    b, h, s, dk = q.shape
    dv = v.shape[-1]
    c = RET_CHUNK
    n = s // c
    dt = q.dtype
    qc = q.reshape(b, h, n, c, dk)
    kc = k.reshape(b, h, n, c, dk)
    vc = v.reshape(b, h, n, c, dv)
    i = jnp.arange(c, dtype=jnp.float32)
    diff = i[:, None] - i[None, :]
    mask = (diff > 0) if strict else (diff >= 0)
    d_intra = jnp.where(mask[None], jnp.exp(log_g[:, None, None] * jnp.maximum(diff, 0.0)[None]), 0.0).astype(dt)
    sc = jnp.einsum('bhnid,bhnjd->bhnij', qc, kc) * d_intra[:, None]
    o_intra = jnp.einsum('bhnij,bhnje->bhnie', sc, vc)
    k_decay = jnp.exp(log_g[:, None] * (c - 1 - i)[None]).astype(dt)
    q_decay = jnp.exp(log_g[:, None] * (i + 1)[None]).astype(dt)
    kv = jnp.einsum('bhncd,bhnce->nbhde', kc * k_decay[:, None, :, None], vc)
    chunk_decay = jnp.exp(log_g * c).astype(dt)[:, None, None]

    def step(state, kv_n):
        return chunk_decay * state + kv_n, state

    _, states = lax.scan(step, jnp.zeros((b, h, dk, dv), kv.dtype), kv)
    o_inter = jnp.einsum('bhncd,nbhde->bhnce', qc * q_decay[:, None, :, None], states)
    return (o_intra + o_inter).reshape(b, h, s, dv)


def head_group_norm(o, g):
    of = o.astype(jnp.float32)
    mu = jnp.mean(of, axis=-1, keepdims=True)
    var = jnp.mean(jnp.square(of - mu), axis=-1, keepdims=True)
    y = (of - mu) * lax.rsqrt(var + EPS)
    return (merge_heads(y) * g.astype(jnp.float32)).astype(o.dtype)


def setup_inputs(seed: int = 0) -> dict:
    key = jax.random.key(seed)
    ks = jax.random.split(key, 24)
    f32 = jnp.float32

    def nrm(k, shape, scale):
        return jax.random.normal(k, shape, f32) * scale

    def gain(k, shape):
        return 1.0 + 0.02 * jax.random.normal(k, shape, f32)

    e = 5.0 + np.arange(RET_HEADS, dtype=np.float32)
    base_logit = jnp.asarray(np.log(np.power(2.0, e) - 1.0).astype(np.float32))
    return {
        'x': nrm(ks[0], (BATCH, SEQ, D_MODEL), 1.0),
        'mem': nrm(ks[1], (BATCH, N_MEM, D_MODEL), 1.0),
        'norm_mix_g': gain(ks[2], (DEPTH, D_MODEL)),
        'w_in': nrm(ks[3], (DEPTH, D_MODEL, D_IN), D_MODEL ** -0.5),
        'na_q_norm_g': gain(ks[4], (DEPTH, NA_HEAD_DIM)),
        'na_k_norm_g': gain(ks[5], (DEPTH, NA_HEAD_DIM)),
        'na_rpb': nrm(ks[6], (DEPTH, NA_HEADS, 2 * NA_MAX_ROWS - 1, 2 * NA_COLS - 1), 0.02),
        'ret_decay_logit_fwd': base_logit[None] + nrm(ks[7], (DEPTH, RET_HEADS), 0.01),
        'ret_decay_logit_bwd': base_logit[None] + nrm(ks[8], (DEPTH, RET_HEADS), 0.01),
        'ret_gn_g': gain(ks[9], (DEPTH, RET_V_W)),
        'mem_norm_g': gain(ks[10], (DEPTH, D_MODEL)),
        'w_mem_kv': nrm(ks[11], (DEPTH, D_MODEL, 2 * XA_W), D_MODEL ** -0.5),
        'xa_q_norm_g': gain(ks[12], (DEPTH, XA_HEAD_DIM)),
        'xa_k_norm_g': gain(ks[13], (DEPTH, XA_HEAD_DIM)),
        'w_br_na': nrm(ks[14], (DEPTH, NA_W, D_MODEL), NA_W ** -0.5),
        'w_br_ret': nrm(ks[15], (DEPTH, RET_V_W, D_MODEL), RET_V_W ** -0.5),
        'w_br_mem': nrm(ks[16], (DEPTH, XA_W, D_MODEL), XA_W ** -0.5),
        'w_out': nrm(ks[17], (DEPTH, D_MODEL, D_MODEL), D_MODEL ** -0.5),
        'norm_ffn_g': gain(ks[18], (DEPTH, D_MODEL)),
        'w_ff1': nrm(ks[19], (DEPTH, D_MODEL, D_FF), D_MODEL ** -0.5),
        'w_ff2': nrm(ks[20], (DEPTH, D_FF, D_MODEL), D_FF ** -0.5),
    }


def reference(x, mem, norm_mix_g, w_in, na_q_norm_g, na_k_norm_g, na_rpb,
              ret_decay_logit_fwd, ret_decay_logit_bwd, ret_gn_g, mem_norm_g, w_mem_kv,
              xa_q_norm_g, xa_k_norm_g, w_br_na, w_br_ret, w_br_mem, w_out,
              norm_ffn_g, w_ff1, w_ff2):
    split_at = [int(v) for v in np.cumsum(IN_SPLITS)[:-1]]
    for l in range(DEPTH):
        h = rmsnorm(x, norm_mix_g[l])
        proj = h @ w_in[l]
        (na_q, na_k, na_v, rq, rk, rv, rg, xq, g_na, g_ret, g_mem) = jnp.split(proj, split_at, axis=-1)

        qa = rmsnorm(split_heads(na_q, NA_HEADS), na_q_norm_g[l]) * (NA_HEAD_DIM ** -0.5)
        ka = rmsnorm(split_heads(na_k, NA_HEADS), na_k_norm_g[l])
        va = split_heads(na_v, NA_HEADS)
        o_na = merge_heads(neighbourhood_attention(qa, ka, va, na_rpb[l]))

        qr = rope(split_heads(rq, RET_HEADS))
        kr = rope(split_heads(rk, RET_HEADS)) * (RET_QK_DIM ** -0.5)
        vr = split_heads(rv, RET_HEADS)
        lg_f = jax.nn.log_sigmoid(ret_decay_logit_fwd[l].astype(jnp.float32))
        lg_b = jax.nn.log_sigmoid(ret_decay_logit_bwd[l].astype(jnp.float32))
        o_f = retention_one_direction(qr, kr, vr, lg_f, False)
        o_b = jnp.flip(retention_one_direction(jnp.flip(qr, 2), jnp.flip(kr, 2), jnp.flip(vr, 2), lg_b, True), 2)
        o_ret = head_group_norm(o_f + o_b, ret_gn_g[l]) * jax.nn.silu(rg)

        mkv = rmsnorm(mem, mem_norm_g[l]) @ w_mem_kv[l]
        mk, mv = jnp.split(mkv, 2, axis=-1)
        qx = rmsnorm(split_heads(xq, XA_HEADS), xa_q_norm_g[l]) * (XA_HEAD_DIM ** -0.5)
        kx = rmsnorm(split_heads(mk, XA_HEADS), xa_k_norm_g[l])
        vx = split_heads(mv, XA_HEADS)
        px = jax.nn.softmax(jnp.einsum('bhsd,bhmd->bhsm', qx, kx).astype(jnp.float32), axis=-1).astype(vx.dtype)
        o_mem = merge_heads(jnp.einsum('bhsm,bhmd->bhsd', px, vx))

        merged = (jax.nn.sigmoid(g_na) * (o_na @ w_br_na[l])
                  + jax.nn.sigmoid(g_ret) * (o_ret @ w_br_ret[l])
                  + jax.nn.sigmoid(g_mem) * (o_mem @ w_br_mem[l]))
        x = x + merged @ w_out[l]

        h2 = rmsnorm(x, norm_ffn_g[l])
        x = x + jnp.square(jax.nn.relu(h2 @ w_ff1[l])) @ w_ff2[l]
    return x
```

```cpp
#include <hip/hip_runtime.h>
#include <cstdio>
#include <cstdint>

namespace pg8 {
#define PG8_LAS __attribute__((address_space(3)))
typedef unsigned short bf16_t;
typedef short bf16x8 __attribute__((ext_vector_type(8)));
typedef float f32x4 __attribute__((ext_vector_type(4)));
typedef float f32x2 __attribute__((ext_vector_type(2)));
typedef unsigned u32x4 __attribute__((ext_vector_type(4)));
typedef unsigned u32x2 __attribute__((ext_vector_type(2)));
constexpr int BM = 256, BK = 64, HALF = 128, HTB = HALF * BK * 2, STAGE_BYTES = 8 * HTB, NXCD = 8, WGM = 8;

__host__ __device__ __forceinline__ int lds_byte(int r, int c) { const int st = (r >> 4) * 2 + (c >> 5), rr = r & 15, cc = c & 31, ob = rr * 64 + cc * 2; return st * 1024 + (ob ^ (((ob >> 9) & 1) << 5)); }
__host__ __device__ __forceinline__ void stage_rc(int b, int& R, int& C) { const int st = b / 1024, sb = b % 1024, swz = sb ^ (((sb >> 9) & 1) << 5); R = (st >> 1) * 16 + swz / 64; C = (st & 1) * 32 + (swz % 64) / 2; }
__host__ __device__ __forceinline__ int perm32(int rho) { const int n = rho >> 4, i = rho & 15; return 8 * (i >> 2) + 4 * n + (i & 3); }

struct Unit { int pm, pn, sub; };
struct Gemm { int lda, ldb, K; };

struct GridOrder {
    int nM, nN, nwg, G, c;
    __device__ void init(int M, int N, int G_, int c_) { nM = M / BM; nN = N / BM; nwg = nM * nN; G = G_; c = c_; }
    __device__ bool next(int i, Unit& u) const {
        const long L = (long)i * G + c; if (L >= nwg) return false;
        int wgid = (int)L; { const int q = nwg / NXCD, r = nwg % NXCD, xcd = wgid % NXCD, off = wgid / NXCD; wgid = (xcd < r ? xcd * (q + 1) : r * (q + 1) + (xcd - r) * q) + off; }
        const int nig = WGM * nN, gid = wgid / nig, fm = gid * WGM, gsz = (nM - fm) < WGM ? (nM - fm) : WGM;
        u.pm = fm + ((wgid % nig) % gsz); u.pn = (wgid % nig) / gsz; u.sub = 0; return true;
    }
};

__device__ __forceinline__ unsigned cvt_pk_bf16(float lo, float hi) { unsigned r; asm volatile("v_cvt_pk_bf16_f32 %0, %1, %2" : "=v"(r) : "v"(lo), "v"(hi)); return r; }
__device__ __forceinline__ void store8(bf16_t* p, f32x4 v0, f32x4 v1) { u32x4 w; w.x = cvt_pk_bf16(v0[0], v0[1]); w.y = cvt_pk_bf16(v0[2], v0[3]); w.z = cvt_pk_bf16(v1[0], v1[1]); w.w = cvt_pk_bf16(v1[2], v1[3]); *(u32x4*)p = w; }
__device__ __forceinline__ void store4(bf16_t* p, f32x4 v0) { u32x2 w; w.x = cvt_pk_bf16(v0[0], v0[1]); w.y = cvt_pk_bf16(v0[2], v0[3]); *(u32x2*)p = w; }
__device__ __forceinline__ float bf2f(unsigned short h) { return __uint_as_float((unsigned)h << 16); }
__device__ __forceinline__ void load8(const bf16_t* p, f32x4& v0, f32x4& v1) { const u32x4 w = *(const u32x4*)p;
    v0[0] = __uint_as_float(w.x << 16); v0[1] = __uint_as_float(w.x & 0xffff0000u); v0[2] = __uint_as_float(w.y << 16); v0[3] = __uint_as_float(w.y & 0xffff0000u);
    v1[0] = __uint_as_float(w.z << 16); v1[1] = __uint_as_float(w.z & 0xffff0000u); v1[2] = __uint_as_float(w.w << 16); v1[3] = __uint_as_float(w.w & 0xffff0000u); }
__device__ __forceinline__ void load8_l2(const bf16_t* p, f32x4& v0, f32x4& v1) { u32x4 w; const unsigned long long a = __hip_atomic_load((const unsigned long long*)p, __ATOMIC_RELAXED, __HIP_MEMORY_SCOPE_AGENT), b = __hip_atomic_load((const unsigned long long*)p + 1, __ATOMIC_RELAXED, __HIP_MEMORY_SCOPE_AGENT);
    w.x = (unsigned)a; w.y = (unsigned)(a >> 32); w.z = (unsigned)b; w.w = (unsigned)(b >> 32);
    v0[0] = __uint_as_float(w.x << 16); v0[1] = __uint_as_float(w.x & 0xffff0000u); v0[2] = __uint_as_float(w.y << 16); v0[3] = __uint_as_float(w.y & 0xffff0000u);
    v1[0] = __uint_as_float(w.z << 16); v1[1] = __uint_as_float(w.z & 0xffff0000u); v1[2] = __uint_as_float(w.w << 16); v1[3] = __uint_as_float(w.w & 0xffff0000u); }
__device__ __forceinline__ float fexp2(float x) { return __builtin_amdgcn_exp2f(x); }
__device__ __forceinline__ float frcp(float x) { return __builtin_amdgcn_rcpf(x); }
__device__ __forceinline__ float sigmoidf_(float x) { return frcp(1.f + fexp2(-1.4426950408889634f * x)); }

template <class Epi, class Sched, bool ALIGN_EPI>
__device__ __forceinline__ void gemm_phase(PG8_LAS unsigned char* lds, const Gemm g, const Sched& S, const Epi& E) {
    int tid_ = threadIdx.x; asm volatile("" : "+v"(tid_));
    const int tid = tid_, wid = __builtin_amdgcn_readfirstlane(tid >> 6), lane = tid & 63, wr = wid >> 2, wc = wid & 3, fr = lane & 15, fq = lane >> 4;
    unsigned voffA[2], voffB[2];
#pragma unroll
    for (int i = 0; i < 2; ++i) { int R, C; stage_rc(tid * 16 + i * 8192, R, C); const int Rb = Epi::PERM ? ((R & ~31) + perm32(R & 31)) : R;
        voffA[i] = (unsigned)(R * g.lda + C) * 2u; voffB[i] = (unsigned)(Rb * g.ldb + C) * 2u; }
    const size_t kstep = (size_t)(BK * 2);
    const size_t hstepA = (size_t)HALF * g.lda * 2, hstepB = (size_t)HALF * g.ldb * 2;
    const unsigned ldsw = (unsigned)wid * 1024u;
    const int aoff = lds_byte(wr * 64 + fr, fq * 8), boff = lds_byte(wc * 32 + fr, fq * 8);
#define PG8_SA(b, h) (((b) * 2 + (h)) * HTB)
#define PG8_SB(b, h) ((4 + (b) * 2 + (h)) * HTB)
#define PG8_STAGE(bufoff, gbase, voff) do { _Pragma("unroll") for (int _i = 0; _i < 2; ++_i) \
        __builtin_amdgcn_global_load_lds((const unsigned*)((const char*)(gbase) + (voff)[_i]), (PG8_LAS unsigned*)(lds + (bufoff) + ldsw + _i * 8192), 16, 0, 0); } while (0)
#define PG8_LDA(dst, b, h) do { _Pragma("unroll") for (int m = 0; m < 4; ++m) _Pragma("unroll") for (int k = 0; k < 2; ++k) dst[m][k] = *(const PG8_LAS bf16x8*)(lds + PG8_SA(b, h) + aoff + m * 2048 + k * 1024); } while (0)
#define PG8_LDB(dst, b, h) do { _Pragma("unroll") for (int n = 0; n < 2; ++n) _Pragma("unroll") for (int k = 0; k < 2; ++k) dst[n][k] = *(const PG8_LAS bf16x8*)(lds + PG8_SB(b, h) + boff + n * 2048 + k * 1024); } while (0)
#define PG8_MMA(ai, bj, At, Bt) do { __builtin_amdgcn_s_setprio(1); _Pragma("unroll") for (int m = 0; m < 4; ++m) _Pragma("unroll") for (int n = 0; n < 2; ++n) _Pragma("unroll") for (int k = 0; k < 2; ++k) \
        acc[ai][bj][m][n] = __builtin_amdgcn_mfma_f32_16x16x32_bf16(Bt[n][k], At[m][k], acc[ai][bj][m][n], 0, 0, 0); __builtin_amdgcn_s_setprio(0); } while (0)
#define PG8_WAIT_V(n) asm volatile("s_waitcnt vmcnt(" #n ")" ::: "memory")
#define PG8_WAIT_L(n) asm volatile("s_waitcnt lgkmcnt(" #n ")" ::: "memory")
#define PG8_BAR __builtin_amdgcn_s_barrier()
#define PG8_SCHED __builtin_amdgcn_sched_barrier(0)
    Unit cur, nxt; int ui = 0;
    if (!S.next(0, cur)) return;
    f32x4 acc[2][2][4][2];
#pragma unroll
    for (int a = 0; a < 2; ++a)
#pragma unroll
        for (int b = 0; b < 2; ++b)
#pragma unroll
            for (int m = 0; m < 4; ++m)
#pragma unroll
                for (int n = 0; n < 2; ++n) acc[a][b][m][n] = (f32x4){0.f, 0.f, 0.f, 0.f};
    bf16x8 At[4][2], B0[2][2], B1[2][2];
    const char* cA; const char* cB; S.ptrs(cur, cA, cB);
    PG8_STAGE(PG8_SB(0, 0), cB, voffB); PG8_STAGE(PG8_SB(0, 1), cB + hstepB, voffB); PG8_STAGE(PG8_SA(0, 0), cA, voffA); PG8_STAGE(PG8_SA(0, 1), cA + hstepA, voffA);
    if (wr == 1) PG8_BAR;
    PG8_WAIT_V(2); PG8_BAR;
    PG8_STAGE(PG8_SB(1, 0), cB + kstep, voffB); PG8_STAGE(PG8_SA(1, 0), cA + kstep, voffA); PG8_STAGE(PG8_SB(1, 1), cB + hstepB + kstep, voffB);
    PG8_WAIT_V(6); PG8_BAR;
    for (;;) {
        const bool has_next = S.next(ui + 1, nxt); const int nt = S.nt(cur, g.K) ;
        const char* nA = cA; const char* nB = cB; if (has_next) S.ptrs(nxt, nA, nB);
        for (int t = 0; t < nt; t += 2) {
            const bool last = (t == nt - 2);
            const char* a1 = cA + (size_t)(t + 1) * kstep;
            const char* a2 = last ? nA : cA + (size_t)(t + 2) * kstep; const char* b2 = last ? nB : cB + (size_t)(t + 2) * kstep;
            const char* a3 = a2 + kstep; const char* b3 = b2 + kstep;
            PG8_LDB(B0, 0, 0); PG8_LDB(B1, 0, 1); PG8_SCHED; PG8_LDA(At, 0, 0); PG8_STAGE(PG8_SA(1, 1), a1 + hstepA, voffA);
            PG8_WAIT_V(8); PG8_WAIT_L(0); PG8_BAR; PG8_MMA(0, 0, At, B0); PG8_MMA(0, 1, At, B1); PG8_BAR; PG8_SCHED;
            PG8_LDA(At, 0, 1); PG8_STAGE(PG8_SB(0, 0), b2, voffB); PG8_STAGE(PG8_SB(0, 1), b2 + hstepB, voffB); PG8_STAGE(PG8_SA(0, 0), a2, voffA);
            PG8_WAIT_V(8); PG8_WAIT_L(0); PG8_BAR; PG8_MMA(1, 0, At, B0); PG8_MMA(1, 1, At, B1); PG8_BAR; PG8_SCHED;
            PG8_LDB(B0, 1, 0); PG8_LDB(B1, 1, 1); PG8_SCHED; PG8_LDA(At, 1, 0); PG8_STAGE(PG8_SA(0, 1), a2 + hstepA, voffA);
            PG8_WAIT_V(8); PG8_WAIT_L(0); PG8_BAR; PG8_MMA(0, 0, At, B0); PG8_MMA(0, 1, At, B1); PG8_BAR; PG8_SCHED;
            PG8_LDA(At, 1, 1); PG8_STAGE(PG8_SB(1, 0), b3, voffB); PG8_STAGE(PG8_SB(1, 1), b3 + hstepB, voffB); PG8_STAGE(PG8_SA(1, 0), a3, voffA);
            PG8_WAIT_V(8); PG8_WAIT_L(0); PG8_BAR; PG8_MMA(1, 0, At, B0); PG8_MMA(1, 1, At, B1); PG8_BAR; PG8_SCHED;
        }
        if constexpr (ALIGN_EPI) { if (wr == 0) PG8_BAR; }
        if constexpr (!Epi::AFTER_DRAIN) { int fr2 = fr, fq2 = fq; asm volatile("" : "+v"(fr2), "+v"(fq2)); E(acc, cur, wr, wc, fr2, fq2); }
        if (!has_next) break;
#pragma unroll
        for (int a = 0; a < 2; ++a)
#pragma unroll
            for (int b = 0; b < 2; ++b)
#pragma unroll
                for (int m = 0; m < 4; ++m)
#pragma unroll
                    for (int n = 0; n < 2; ++n) acc[a][b][m][n] = (f32x4){0.f, 0.f, 0.f, 0.f};
        cur = nxt; cA = nA; cB = nB; ++ui;
        if constexpr (ALIGN_EPI) { if (wr == 1) PG8_BAR; }
    }
    PG8_WAIT_V(0);
    if constexpr (!ALIGN_EPI) { if (wr == 0) PG8_BAR; }
    PG8_BAR;
    if constexpr (Epi::AFTER_DRAIN) { int fr2 = fr, fq2 = fq; asm volatile("" : "+v"(fr2), "+v"(fq2)); E.fused(acc, cur, wr, wc, fr2, fq2, lds, wid, lane); }
#undef PG8_SA
#undef PG8_SB
#undef PG8_STAGE
#undef PG8_LDA
#undef PG8_LDB
#undef PG8_MMA
#undef PG8_WAIT_V
#undef PG8_WAIT_L
#undef PG8_BAR
#undef PG8_SCHED
}
}

namespace mk {
using pg8::bf16_t; using pg8::f32x4; using pg8::f32x2; using pg8::u32x4; using pg8::u32x2; using pg8::Unit;
constexpr int D = 2048, BATCH = 2, SEQ = 4096, M = BATCH * SEQ, D_IN = 16384, D_FF = 8192, N_MEM = 256;
constexpr float EPS = 1e-6f, LOG2E = 1.4426950408889634f;
constexpr size_t MiB = 1u << 20;
constexpr size_t WS_CTL = 0, CTL_ZERO_BYTES = 1 * MiB;
constexpr size_t WS_COS = 1 * MiB, WS_SIN = 2 * MiB;
constexpr size_t WS_SSQ_NAQ = 3 * MiB, WS_SSQ_NAK = 4 * MiB;
constexpr size_t WS_SSQ_XQ = 5 * MiB, WS_XL = 5 * MiB + 512 * 1024;
constexpr size_t WS_SSQ_X1 = 6 * MiB;
constexpr size_t WS_TAB = 6 * MiB + 512 * 1024;
constexpr int TAB_CS_NAQ = 0, TAB_CS_MK = 128, TAB_L2F = 384, TAB_L2B = 392, TAB_SSQ_MK = 1024;
constexpr size_t WS_MEMN = 8 * MiB, WS_MK = 10 * MiB, WS_MVT = 11 * MiB;
constexpr size_t WS_WIN = 16 * MiB, WS_WFF1 = 80 * MiB, WS_WFF2 = 112 * MiB, WS_WRET = 144 * MiB, WS_WOUT = 152 * MiB, WS_WNM = 160 * MiB  , WS_WMKV = 168 * MiB;
constexpr size_t WS_NAQKV = 176 * MiB, WS_K0 = 224 * MiB, WS_RG = 240 * MiB, WS_XQ = 272 * MiB, WS_GATES = 288 * MiB;
constexpr size_t WS_AR = 384 * MiB, WS_BR = 448 * MiB, WS_END = 512 * MiB;
constexpr size_t WS_KV = WS_WIN;
constexpr size_t WS_ORET = 16 * MiB;
constexpr size_t WS_MERGED = WS_NAQKV;
constexpr size_t WS_X1B = WS_AR;
constexpr size_t WS_HFF = 176 * MiB;
constexpr int LDH = 8192;
constexpr size_t DO_HN = 0, DO_KT = 0, DO_XP = 32 * MiB, DO_ONM = 0;

struct SchedGrid {
    pg8::GridOrder o; const char* A; const char* B; size_t ta, tb;
    __device__ __forceinline__ bool next(int i, Unit& u) const { return o.next(i, u); }
    __device__ __forceinline__ void ptrs(const Unit& u, const char*& a, const char*& b) const { a = A + (size_t)u.pm * ta; b = B + (size_t)u.pn * tb; }
    __device__ __forceinline__ int nt(const Unit&, int K) const { return K / 64; }
};
struct SchedProj {
    pg8::GridOrder o; const char* hn_; const char* wt_;
    __device__ __forceinline__ bool next(int i, Unit& u) const { return o.next(i, u); }
    __device__ __forceinline__ void ptrs(const Unit& u, const char*& a, const char*& b) const {
        const char* h = hn_ + (size_t)u.pm * (256u * 2048u * 2u); const char* w = wt_ + (size_t)u.pn * (256u * 2048u * 2u);
        const bool sw = (u.pn >= 20 && u.pn < 28); a = sw ? w : h; b = sw ? h : w; }
    __device__ __forceinline__ int nt(const Unit&, int K) const { return K / 64; }
};
struct SchedOne { bool has; Unit u; const char* a; const char* b;
    __device__ __forceinline__ bool next(int i, Unit& uu) const { if (i != 0 || !has) return false; uu = u; return true; }
    __device__ __forceinline__ void ptrs(const Unit&, const char*& aa, const char*& bb) const { aa = a; bb = b; }
    __device__ __forceinline__ int nt(const Unit&, int K) const { return K / 64; }
};

#define MK_ROWS_BEGIN _Pragma("unroll") for (int ai = 0; ai < 2; ++ai) { _Pragma("unroll") for (int m = 0; m < 4; ++m) { const int rl = ai * 128 + wr * 64 + m * 16 + fr;
#define MK_ROWS_END __builtin_amdgcn_sched_barrier(0); } }
#define MK_ROWS_END_NB } }
__device__ __forceinline__ float sq8(const f32x4& a, const f32x4& b) { return (a[0] * a[0] + a[1] * a[1]) + (a[2] * a[2] + a[3] * a[3]) + (b[0] * b[0] + b[1] * b[1]) + (b[2] * b[2] + b[3] * b[3]); }
__device__ __forceinline__ float red_fq(float s) { s += __shfl_xor(s, 16); s += __shfl_xor(s, 32); return s; }

struct EpiProj {
    static constexpr bool PERM = true, AFTER_DRAIN = false;
    unsigned char* ws;
    __device__ __forceinline__ void operator()(const f32x4 (&acc)[2][2][4][2], const Unit& u, int wr, int wc, int fr, int fq) const {
        bf16_t* const naqkv = (bf16_t*)(ws + WS_NAQKV); bf16_t* const k0 = (bf16_t*)(ws + WS_K0); bf16_t* const rg = (bf16_t*)(ws + WS_RG); bf16_t* const xq = (bf16_t*)(ws + WS_XQ);
        bf16_t* const gates = (bf16_t*)(ws + WS_GATES); bf16_t* const ar = (bf16_t*)(ws + WS_AR); bf16_t* const br = (bf16_t*)(ws + WS_BR);
        float* const ssq_naq = (float*)(ws + WS_SSQ_NAQ); float* const ssq_nak = (float*)(ws + WS_SSQ_NAK); float* const ssq_xq = (float*)(ws + WS_SSQ_XQ);
        const float* const cosT = (const float*)(ws + WS_COS); const float* const sinT = (const float*)(ws + WS_SIN); const float* const tab = (const float*)(ws + WS_TAB);
        const int pn = u.pn, row0 = u.pm * 256, cw = wc * 32 + 8 * fq;
        if (pn < 8) {
            const bool isq = pn < 4; float* ssq = isq ? ssq_naq : ssq_nak; const int hb = isq ? 2 * pn : 2 * (pn - 4);
            f32x4 c0 = (f32x4){1.f, 1.f, 1.f, 1.f}, c1 = c0; if (isq) { c0 = *(const f32x4*)(tab + TAB_CS_NAQ + cw); c1 = *(const f32x4*)(tab + TAB_CS_NAQ + cw + 4); }
            MK_ROWS_BEGIN  const int row = row0 + rl;
#pragma unroll
                for (int bj = 0; bj < 2; ++bj) { const f32x4 v0 = acc[ai][bj][m][0], v1 = acc[ai][bj][m][1]; const float q = red_fq(sq8(v0, v1));
                    if (fq == 0) ssq[(size_t)row * 32 + (hb + bj) * 4 + wc] = q;
                    pg8::store8(naqkv + (size_t)row * 3072 + pn * 256 + bj * 128 + cw, v0 * c0, v1 * c1); }  MK_ROWS_END
        } else if (pn < 12) {
            MK_ROWS_BEGIN  const int row = row0 + rl;
#pragma unroll
                for (int bj = 0; bj < 2; ++bj) pg8::store8(naqkv + (size_t)row * 3072 + pn * 256 + bj * 128 + cw, acc[ai][bj][m][0], acc[ai][bj][m][1]);  MK_ROWS_END
        } else if (pn < 20) {
            const bool isq = pn < 16; const int head = 2 * (pn & 3) + (wc >> 1), i0 = 32 * (wc & 1) + 8 * fq;
            const float l2f = tab[TAB_L2F + head], l2b = tab[TAB_L2B + head];
            MK_ROWS_BEGIN  const int row = row0 + rl, s = row & 4095, b = row >> 12;
                const f32x4 cs0 = *(const f32x4*)(cosT + s * 64 + i0), cs1 = *(const f32x4*)(cosT + s * 64 + i0 + 4), sn0 = *(const f32x4*)(sinT + s * 64 + i0), sn1 = *(const f32x4*)(sinT + s * 64 + i0 + 4);
                const f32x4 a0 = acc[ai][0][m][0], a1 = acc[ai][0][m][1], b0 = acc[ai][1][m][0], b1 = acc[ai][1][m][1];
                const f32x4 lo0 = a0 * cs0 - b0 * sn0, lo1 = a1 * cs1 - b1 * sn1, hi0 = a0 * sn0 + b0 * cs0, hi1 = a1 * sn1 + b1 * cs1;
                if (isq) { const int c = row & 255; const float df = pg8::fexp2(l2f * (float)(c + 1)), db = pg8::fexp2(l2b * (float)(256 - c));
                    bf16_t* d = ar + ((size_t)(b * 8 + head) * 4096 + s) * 512 + 256 + i0;
                    pg8::store8(d, lo0 * df, lo1 * df); pg8::store8(d + 64, hi0 * df, hi1 * df); pg8::store8(d + 128, lo0 * db, lo1 * db); pg8::store8(d + 192, hi0 * db, hi1 * db);
                } else { const float sc = 0.08838834764831845f; bf16_t* d = k0 + (size_t)row * 1024 + head * 128 + i0;
                    pg8::store8(d, lo0 * sc, lo1 * sc); pg8::store8(d + 64, hi0 * sc, hi1 * sc); }  MK_ROWS_END
        } else if (pn < 28) {
            const int hv = pn - 20, b = u.pm >> 4, nc = u.pm & 15;
            bf16_t* base = br + ((size_t)((b * 8 + hv) * 16 + nc) * 256) * 512;
            MK_ROWS_BEGIN
#pragma unroll
                for (int bj = 0; bj < 2; ++bj) pg8::store8(base + (size_t)rl * 512 + bj * 128 + cw, acc[ai][bj][m][0], acc[ai][bj][m][1]);  MK_ROWS_END
        } else if (pn < 36) {
            MK_ROWS_BEGIN  const int row = row0 + rl;
#pragma unroll
                for (int bj = 0; bj < 2; ++bj) { f32x4 v0 = acc[ai][bj][m][0], v1 = acc[ai][bj][m][1];
#pragma unroll
                    for (int e = 0; e < 4; ++e) { v0[e] = v0[e] * pg8::sigmoidf_(v0[e]); v1[e] = v1[e] * pg8::sigmoidf_(v1[e]); }
                    pg8::store8(rg + (size_t)row * 2048 + (pn - 28) * 256 + bj * 128 + cw, v0, v1); }  MK_ROWS_END
        } else if (pn < 40) {
            MK_ROWS_BEGIN  const int row = row0 + rl;
                const float q = red_fq(sq8(acc[ai][0][m][0], acc[ai][0][m][1]) + sq8(acc[ai][1][m][0], acc[ai][1][m][1]));
                if (fq == 0) ssq_xq[(size_t)row * 16 + (pn - 36) * 4 + wc] = q;
#pragma unroll
                for (int bj = 0; bj < 2; ++bj) pg8::store8(xq + (size_t)row * 1024 + (pn - 36) * 256 + bj * 128 + cw, acc[ai][bj][m][0], acc[ai][bj][m][1]);  MK_ROWS_END
        } else {
            MK_ROWS_BEGIN  const int row = row0 + rl;
#pragma unroll
                for (int bj = 0; bj < 2; ++bj) { f32x4 v0 = acc[ai][bj][m][0], v1 = acc[ai][bj][m][1];
#pragma unroll
                    for (int e = 0; e < 4; ++e) { v0[e] = pg8::sigmoidf_(v0[e]); v1[e] = pg8::sigmoidf_(v1[e]); }
                    pg8::store8(gates + (size_t)row * 6144 + (pn - 40) * 256 + bj * 128 + cw, v0, v1); }  MK_ROWS_END
        }
    }
};
struct EpiMKV {
    static constexpr bool PERM = true, AFTER_DRAIN = false;
    bf16_t *mk, *mvt; float* tabw; const float* tab; int mode;
    __device__ __forceinline__ void operator()(const f32x4 (&acc)[2][2][4][2], const Unit& u, int wr, int wc, int fr, int fq) const {
        const int cw = wc * 32 + 8 * fq, row0 = u.pm * 256;
        if (mode == 0) {
            MK_ROWS_BEGIN  const int row = row0 + rl;
                const float q = red_fq(sq8(acc[ai][0][m][0], acc[ai][0][m][1]) + sq8(acc[ai][1][m][0], acc[ai][1][m][1]));
                if (fq == 0) tabw[TAB_SSQ_MK + row * 16 + u.pn * 4 + wc] = q;
#pragma unroll
                for (int bj = 0; bj < 2; ++bj) { const f32x4 c0 = *(const f32x4*)(tab + TAB_CS_MK + bj * 128 + cw), c1 = *(const f32x4*)(tab + TAB_CS_MK + bj * 128 + cw + 4);
                    pg8::store8(mk + (size_t)row * 1024 + u.pn * 256 + bj * 128 + cw, acc[ai][bj][m][0] * c0, acc[ai][bj][m][1] * c1); }  MK_ROWS_END
        } else {
            MK_ROWS_BEGIN  const int row = row0 + rl;
#pragma unroll
                for (int bj = 0; bj < 2; ++bj) pg8::store8(mvt + (size_t)row * 512 + u.pn * 256 + bj * 128 + cw, acc[ai][bj][m][0], acc[ai][bj][m][1]);  MK_ROWS_END
        }
    }
};
struct EpiF32 {
    static constexpr bool PERM = false, AFTER_DRAIN = false;
    float* C;
    __device__ __forceinline__ void operator()(const f32x4 (&acc)[2][2][4][2], const Unit&, int wr, int wc, int fr, int fq) const {
        const int col0 = wc * 32 + 4 * fq;
        MK_ROWS_BEGIN  float* rowp = C + (size_t)rl * 256 + col0;
#pragma unroll
            for (int bj = 0; bj < 2; ++bj)
#pragma unroll
                for (int n = 0; n < 2; ++n) *(f32x4*)(rowp + bj * 128 + n * 16) = acc[ai][bj][m][n];  MK_ROWS_END
    }
};
struct EpiP {
    static constexpr bool PERM = true, AFTER_DRAIN = false;
    bf16_t* P; float l2f, l2b;
    __device__ __forceinline__ void operator()(const f32x4 (&acc)[2][2][4][2], const Unit&, int wr, int wc, int fr, int fq) const {
        const int cw = wc * 32 + 8 * fq;
        MK_ROWS_BEGIN  const int c = rl; const float rowf = -l2f * (float)(c + 1);
#pragma unroll
            for (int bj = 0; bj < 2; ++bj) { f32x4 v[2] = {acc[ai][bj][m][0], acc[ai][bj][m][1]};
#pragma unroll
                for (int n = 0; n < 2; ++n)
#pragma unroll
                    for (int e = 0; e < 4; ++e) { const int cp = bj * 128 + cw + 4 * n + e;
                        const float ex = (c >= cp) ? (-l2f * (float)(cp + 1)) : (l2b * (float)(cp - c) + rowf);
                        v[n][e] *= pg8::fexp2(ex); }
                pg8::store8(P + (size_t)c * 512 + bj * 128 + cw, v[0], v[1]); }  MK_ROWS_END
    }
};
struct EpiGN {
    static constexpr bool PERM = true, AFTER_DRAIN = true;
    bf16_t* oret; const bf16_t* rgv; const float* gn;
    __device__ __forceinline__ void fused(f32x4 (&acc)[2][2][4][2], const Unit&, int wr, int wc, int fr, int fq, PG8_LAS unsigned char* lds, int wid, int lane) const {
        PG8_LAS f32x2* P = (PG8_LAS f32x2*)lds;
        const int cw = wc * 32 + 8 * fq;
        MK_ROWS_BEGIN  float s = 0.f;
#pragma unroll
            for (int bj = 0; bj < 2; ++bj)
#pragma unroll
                for (int n = 0; n < 2; ++n) { const f32x4 x = acc[ai][bj][m][n]; s += (x[0] + x[1]) + (x[2] + x[3]); }
            s = red_fq(s); const float mw = s * (1.0f / 64.0f); float q = 0.f;
#pragma unroll
            for (int bj = 0; bj < 2; ++bj)
#pragma unroll
                for (int n = 0; n < 2; ++n) { const f32x4 d = acc[ai][bj][m][n] - mw; q += (d[0] * d[0] + d[1] * d[1]) + (d[2] * d[2] + d[3] * d[3]); }
            q = red_fq(q);
            if (fq == 0) P[rl * 4 + wc] = (f32x2){mw, q};  MK_ROWS_END
        asm volatile("s_waitcnt lgkmcnt(0)" ::: "memory"); __builtin_amdgcn_s_barrier(); asm volatile("" ::: "memory");
        f32x4 g0[2], g1[2];
#pragma unroll
        for (int bj = 0; bj < 2; ++bj) { g0[bj] = *(const f32x4*)(gn + bj * 128 + cw); g1[bj] = *(const f32x4*)(gn + bj * 128 + cw + 4); }
        MK_ROWS_BEGIN  const f32x2 a = P[rl * 4 + 0], b = P[rl * 4 + 1], c = P[rl * 4 + 2], d = P[rl * 4 + 3];
            const float mt = (a.x + b.x + c.x + d.x) * 0.25f;
            const float da = a.x - mt, db = b.x - mt, dc = c.x - mt, dd = d.x - mt;
            const float m2 = (a.y + b.y) + (c.y + d.y) + 64.0f * ((da * da + db * db) + (dc * dc + dd * dd));
            const float rstd = 1.0f / sqrtf(m2 * (1.0f / 256.0f) + EPS);
#pragma unroll
            for (int bj = 0; bj < 2; ++bj) { f32x4 r0, r1; pg8::load8(rgv + (size_t)rl * 2048 + bj * 128 + cw, r0, r1);
                const f32x4 o0 = (acc[ai][bj][m][0] - mt) * rstd * g0[bj] * r0, o1 = (acc[ai][bj][m][1] - mt) * rstd * g1[bj] * r1;
                pg8::store8(oret + (size_t)rl * 2048 + bj * 128 + cw, o0, o1); }  MK_ROWS_END
        asm volatile("s_waitcnt lgkmcnt(0)" ::: "memory"); __builtin_amdgcn_s_barrier(); asm volatile("" ::: "memory");
    }
};
struct EpiXS {
    static constexpr bool PERM = true, AFTER_DRAIN = false;
    bf16_t* xp; float* xl; const float* ssq_q; const float* ssq_k;
    __device__ __forceinline__ void operator()(const f32x4 (&acc)[2][2][4][2], const Unit&, int wr, int wc, int fr, int fq) const {
        const int cw = wc * 32 + 8 * fq;
        float rk[2][8];
#pragma unroll
        for (int bj = 0; bj < 2; ++bj)
#pragma unroll
            for (int j = 0; j < 8; ++j) { const f32x4 p = *(const f32x4*)(ssq_k + (size_t)(bj * 128 + cw + j) * 16); rk[bj][j] = rsqrtf(((p[0] + p[1]) + (p[2] + p[3])) * (1.0f / 256.0f) + EPS) * LOG2E; }
        MK_ROWS_BEGIN  const f32x4 pq = *(const f32x4*)(ssq_q + (size_t)rl * 16); const float rq = rsqrtf(((pq[0] + pq[1]) + (pq[2] + pq[3])) * (1.0f / 256.0f) + EPS);
            float s = 0.f;
#pragma unroll
            for (int bj = 0; bj < 2; ++bj) { f32x4 v[2] = {acc[ai][bj][m][0], acc[ai][bj][m][1]};
#pragma unroll
                for (int n = 0; n < 2; ++n)
#pragma unroll
                    for (int e = 0; e < 4; ++e) { v[n][e] = pg8::fexp2(v[n][e] * rq * rk[bj][4 * n + e]); s += v[n][e]; }
                pg8::store8(xp + (size_t)rl * 1024 + bj * 128 + cw, v[0], v[1]); }
            s = red_fq(s); if (fq == 0) xl[(size_t)rl * 16 + wc] = s;  MK_ROWS_END
    }
};
struct EpiXO {
    static constexpr bool PERM = true, AFTER_DRAIN = false;
    bf16_t* omem; const float* xl;
    __device__ __forceinline__ void operator()(const f32x4 (&acc)[2][2][4][2], const Unit&, int wr, int wc, int fr, int fq) const {
        const int cw = wc * 32 + 8 * fq;
        MK_ROWS_BEGIN  const f32x4 p = *(const f32x4*)(xl + (size_t)rl * 16); const float il = pg8::frcp((p[0] + p[1]) + (p[2] + p[3]));
#pragma unroll
            for (int bj = 0; bj < 2; ++bj) pg8::store8(omem + (size_t)rl * 2048 + bj * 128 + cw, acc[ai][bj][m][0] * il, acc[ai][bj][m][1] * il);  MK_ROWS_END
    }
};
struct EpiGate4 {
    static constexpr bool PERM = true, AFTER_DRAIN = false;
    bf16_t* merged; const bf16_t* gates;
    __device__ __forceinline__ void operator()(const f32x4 (&acc)[2][2][4][2], const Unit& u, int wr, int wc, int fr, int fq) const {
        const int cw = wc * 32 + 8 * fq; const bf16_t* gate = gates + u.sub * 2048; const bool first = u.sub == 0;
        MK_ROWS_BEGIN  const size_t row = (size_t)u.pm * 256 + rl;
#pragma unroll
            for (int bj = 0; bj < 2; ++bj) { const int col = u.pn * 256 + bj * 128 + cw; f32x4 g0, g1; pg8::load8(gate + row * 6144 + col, g0, g1);
                f32x4 v0 = acc[ai][bj][m][0] * g0, v1 = acc[ai][bj][m][1] * g1;
                if (!first) { f32x4 t0, t1; pg8::load8_l2(merged + row * 2048 + col, t0, t1); v0 += t0; v1 += t1; }
                pg8::store8(merged + row * 2048 + col, v0, v1); }  MK_ROWS_END_NB
    }
};
struct SchedBR {
    pg8::GridOrder o; const char* onm; const char* oret; const char* wnm; const char* wret;
    __device__ __forceinline__ bool next(int i, Unit& u) const { if (i >= 3) return false; const bool ok = o.next(0, u); u.sub = i; return ok; }
    __device__ __forceinline__ void ptrs(const Unit& u, const char*& a, const char*& b) const {
        const size_t ra = (size_t)u.pm * (256u * 2048u * 2u), rb = (size_t)u.pn * (256u * 2048u * 2u);
        const bool nm = (u.sub != 1); const size_t co = (u.sub == 2) ? 2048u : 0u;
        a = (nm ? onm : oret) + ra + co; b = (nm ? wnm : wret) + rb + co; }
    __device__ __forceinline__ int nt(const Unit& u, int) const { return u.sub == 1 ? 32 : 16; }
};
struct EpiWout {
    static constexpr bool PERM = false, AFTER_DRAIN = true;
    const float* x; float* x1; bf16_t* x1b; float* ssq; const float* gffn;
    __device__ __forceinline__ void fused(f32x4 (&acc)[2][2][4][2], const Unit& u, int wr, int wc, int fr, int fq, PG8_LAS unsigned char* lds, int wid, int lane) const {
        PG8_LAS float* P = (PG8_LAS float*)lds;
        const int col0 = u.pn * 256 + wc * 32 + 4 * fq;
        MK_ROWS_BEGIN  const size_t off = ((size_t)u.pm * 256 + rl) * 2048 + col0; float q = 0.f;
#pragma unroll
            for (int bj = 0; bj < 2; ++bj)
#pragma unroll
                for (int n = 0; n < 2; ++n) { const f32x4 v = *(const f32x4*)(x + off + bj * 128 + n * 16) + acc[ai][bj][m][n];
                    *(f32x4*)(x1 + off + bj * 128 + n * 16) = v; pg8::store4(x1b + off + bj * 128 + n * 16, v * *(const f32x4*)(gffn + col0 + bj * 128 + n * 16)); q += (v[0] * v[0] + v[1] * v[1]) + (v[2] * v[2] + v[3] * v[3]); }
            q = red_fq(q); if (fq == 0) P[rl * 4 + wc] = q;  MK_ROWS_END
        asm volatile("s_waitcnt lgkmcnt(0)" ::: "memory"); __builtin_amdgcn_s_barrier(); asm volatile("" ::: "memory");
        if (threadIdx.x < 256) { const int r = threadIdx.x; const f32x4 p = *(const PG8_LAS f32x4*)(P + r * 4); ssq[((size_t)u.pm * 256 + r) * 8 + u.pn] = (p[0] + p[1]) + (p[2] + p[3]); }
        asm volatile("s_waitcnt lgkmcnt(0)" ::: "memory"); __builtin_amdgcn_s_barrier(); asm volatile("" ::: "memory");
    }
};
struct EpiFF1 {
    static constexpr bool PERM = true, AFTER_DRAIN = false;
    bf16_t* hff; const float* ssq;
    __device__ __forceinline__ void operator()(const f32x4 (&acc)[2][2][4][2], const Unit& u, int wr, int wc, int fr, int fq) const {
        const int cw = wc * 32 + 8 * fq;
        MK_ROWS_BEGIN  const size_t row = (size_t)u.pm * 256 + rl; const f32x4 p0 = *(const f32x4*)(ssq + row * 8), p1 = *(const f32x4*)(ssq + row * 8 + 4);
            const float r = rsqrtf((((p0[0] + p0[1]) + (p0[2] + p0[3])) + ((p1[0] + p1[1]) + (p1[2] + p1[3]))) * (1.0f / 2048.0f) + EPS);
#pragma unroll
            for (int bj = 0; bj < 2; ++bj) { f32x4 v0 = acc[ai][bj][m][0] * r, v1 = acc[ai][bj][m][1] * r;
#pragma unroll
                for (int e = 0; e < 4; ++e) { const float a = fmaxf(v0[e], 0.f), b = fmaxf(v1[e], 0.f); v0[e] = a * a; v1[e] = b * b; }
                pg8::store8(hff + row * LDH + u.pn * 256 + bj * 128 + cw, v0, v1); }  MK_ROWS_END
    }
};
struct EpiFF2 {
    static constexpr bool PERM = false, AFTER_DRAIN = false;
    const float* src; float* out;
    __device__ __forceinline__ void operator()(const f32x4 (&acc)[2][2][4][2], const Unit& u, int wr, int wc, int fr, int fq) const {
        const int col0 = u.pn * 256 + wc * 32 + 4 * fq;
        MK_ROWS_BEGIN  const size_t off = ((size_t)u.pm * 256 + rl) * 2048 + col0;
#pragma unroll
            for (int bj = 0; bj < 2; ++bj)
#pragma unroll
                for (int n = 0; n < 2; ++n) { const size_t o2 = off + bj * 128 + n * 16; *(f32x4*)(out + o2) = *(const f32x4*)(src + o2) + acc[ai][bj][m][n]; }  MK_ROWS_END
    }
};
#undef MK_ROWS_BEGIN
#undef MK_ROWS_END
#undef MK_ROWS_END_NB
}

namespace na {
using bf16 = unsigned short;
using bf16x8 = __attribute__((ext_vector_type(8))) short;
using s16x4  = __attribute__((ext_vector_type(4))) short;
using f32x16 = __attribute__((ext_vector_type(16))) float;
using f32x4  = __attribute__((ext_vector_type(4))) float;
using u32x4  = __attribute__((ext_vector_type(4))) unsigned;
constexpr int DH = 128, NW = 8, QBLK = 32, KVBLK = 64, LDQ = 3072;
constexpr size_t SHM_V = KVBLK * DH * 2, SHM_K = KVBLK * DH * 2;
constexpr int OFF_RK = 2 * SHM_V + 2 * SHM_K;
constexpr int OFF_BIAS = OFF_RK + 768 * 4;
constexpr int BIAS_PAD = 64, BIAS_N = 64 + 15 * 31 + 79;
constexpr int OFF_LI = OFF_BIAS + ((BIAS_N * 4 + 15) / 16) * 16;
constexpr int NA_LDS_BYTES = OFF_LI + NW * 64 * 4;
#define KSWZ(row, colB) ((row) * 256 + ((colB) ^ (((row) & 7) << 4)))
#define SBAR() __builtin_amdgcn_sched_barrier(0)
__device__ __forceinline__ int crow(int r, int hi) { return (r & 3) + 8 * (r >> 2) + 4 * hi; }
__device__ __forceinline__ unsigned cvtpk(float lo, float hi) { unsigned r; asm volatile("v_cvt_pk_bf16_f32 %0, %1, %2" : "=v"(r) : "v"(lo), "v"(hi)); return r; }

__device__ __forceinline__ void procP(f32x16& p0, f32x16& p1, float& lsum, bool inwin, const float* rk_t  , const float* bias_l  ,
                                      float rqs, int cs, int hi) {
  if (!inwin) { p0 = f32x16{}; p1 = f32x16{}; return; }
#pragma unroll
  for (int g = 0; g < 4; ++g) {
    const f32x4 k0 = *(const f32x4*)(rk_t + 8 * g + 4 * hi), k1 = *(const f32x4*)(rk_t + 32 + 8 * g + 4 * hi);
#pragma unroll
    for (int e = 0; e < 4; ++e) { const int r = 4 * g + e; const int w0 = e + 8 * g + 4 * hi, w1 = w0 + 32;
      const float x0 = fmaf(p0[r], rqs * k0[e], bias_l[w0]), x1 = fmaf(p1[r], rqs * k1[e], bias_l[w1]);
      const float e0 = __builtin_amdgcn_exp2f(x0), e1 = __builtin_amdgcn_exp2f(x1);
      const float v0 = ((unsigned)(w0 - cs) < 16u) ? e0 : 0.f, v1 = ((unsigned)(w1 - cs) < 16u) ? e1 : 0.f;
      p0[r] = v0; p1[r] = v1; lsum += v0 + v1; }
  }
}
__device__ __forceinline__ void packP(const f32x16& p0, const f32x16& p1, bf16x8& pa0, bf16x8& pa1, bf16x8& pa2, bf16x8& pa3) {
#define PK4(P, BASE, OUT) do { unsigned a0 = cvtpk(P[BASE + 0], P[BASE + 1]), a1 = cvtpk(P[BASE + 2], P[BASE + 3]);   \
    unsigned b0 = cvtpk(P[BASE + 4], P[BASE + 5]), b1 = cvtpk(P[BASE + 6], P[BASE + 7]);                              \
    auto r0 = __builtin_amdgcn_permlane32_swap(a0, b0, false, false); auto r1 = __builtin_amdgcn_permlane32_swap(a1, b1, false, false); \
    u32x4 w = {r0[0], r1[0], r0[1], r1[1]}; OUT = *reinterpret_cast<bf16x8*>(&w); } while (0)
  PK4(p0, 0, pa0); PK4(p0, 8, pa1); PK4(p1, 0, pa2); PK4(p1, 8, pa3);
#undef PK4
}
__device__ __forceinline__ void qkt(f32x16& p0, f32x16& p1, const bf16* Ks, const bf16x8* qr, int r32, int hi) {
  p0 = f32x16{}; p1 = f32x16{};
#pragma unroll
  for (int d0 = 0; d0 < 8; ++d0) { int cb = (d0 * 16 + hi * 8) * 2;
    bf16x8 b0 = *reinterpret_cast<const bf16x8*>((const char*)Ks + KSWZ(r32, cb));
    bf16x8 b1 = *reinterpret_cast<const bf16x8*>((const char*)Ks + KSWZ(32 + r32, cb));
    p0 = __builtin_amdgcn_mfma_f32_32x32x16_bf16(b0, qr[d0], p0, 0, 0, 0);
    p1 = __builtin_amdgcn_mfma_f32_32x32x16_bf16(b1, qr[d0], p1, 0, 0, 0); }
}
__device__ __forceinline__ int v_st(int k, int c) { const int kk = (k & ~0xC) | ((k & 4) << 1) | ((k & 8) >> 1); return ((kk >> 3) * 4 + (c >> 5)) * 512 + ((kk & 7) * 32 + (c & 31)) * 2; }
__device__ __forceinline__ int v_rd_base(int lane) { return ((lane & 3) << 3) | (((lane >> 2) & 3) << 6) | (((lane >> 4) & 1) << 5) | (((lane >> 5) & 1) << 8); }
constexpr int v_rd_off(int d0, int ks, int half) { return d0 * 512 + ks * 4096 + half * 2048; }
template <int OFF> __device__ __forceinline__ s16x4 tr_read(int vb) {
  s16x4 r; asm volatile("ds_read_b64_tr_b16 %0, %1 offset:%2" : "=&v"(r) : "v"(vb), "i"(OFF) : "memory"); return r;
}
template <int D0> __device__ __forceinline__ void pv_one(f32x16& od, int vb, bf16x8 pa0, bf16x8 pa1, bf16x8 pa2, bf16x8 pa3) {
  const s16x4 l0 = tr_read<v_rd_off(D0, 0, 0)>(vb), h0 = tr_read<v_rd_off(D0, 0, 1)>(vb), l1 = tr_read<v_rd_off(D0, 1, 0)>(vb), h1 = tr_read<v_rd_off(D0, 1, 1)>(vb);
  const s16x4 l2 = tr_read<v_rd_off(D0, 2, 0)>(vb), h2 = tr_read<v_rd_off(D0, 2, 1)>(vb), l3 = tr_read<v_rd_off(D0, 3, 0)>(vb), h3 = tr_read<v_rd_off(D0, 3, 1)>(vb);
  asm volatile("s_waitcnt lgkmcnt(0)" ::: "memory"); SBAR();
#define PK(L, H) (bf16x8){L[0], L[1], L[2], L[3], H[0], H[1], H[2], H[3]}
  od = __builtin_amdgcn_mfma_f32_32x32x16_bf16(pa0, PK(l0, h0), od, 0, 0, 0);
  od = __builtin_amdgcn_mfma_f32_32x32x16_bf16(pa1, PK(l1, h1), od, 0, 0, 0);
  od = __builtin_amdgcn_mfma_f32_32x32x16_bf16(pa2, PK(l2, h2), od, 0, 0, 0);
  od = __builtin_amdgcn_mfma_f32_32x32x16_bf16(pa3, PK(l3, h3), od, 0, 0, 0);
#undef PK
}
__device__ __forceinline__ void pv_d0(f32x16* o, int vb, bf16x8 pa0, bf16x8 pa1, bf16x8 pa2, bf16x8 pa3) {
  pv_one<0>(o[0], vb, pa0, pa1, pa2, pa3); pv_one<1>(o[1], vb, pa0, pa1, pa2, pa3); pv_one<2>(o[2], vb, pa0, pa1, pa2, pa3); pv_one<3>(o[3], vb, pa0, pa1, pa2, pa3);
}

__device__ __forceinline__ void na_unit(int b, int h, int i4, const bf16* __restrict__ qkv, const float* __restrict__ ssq_q, const float* __restrict__ ssq_k,
                                        const float* __restrict__ rpb, bf16* __restrict__ ona, char* lds) {
  int tid_ = threadIdx.x; asm volatile("" : "+v"(tid_));
  const int tid = tid_, wid = __builtin_amdgcn_readfirstlane(tid >> 6), lane = tid & 63, r32 = lane & 31, hi = lane >> 5;
  bf16* V_lds = (bf16*)lds; bf16* K_lds = (bf16*)(lds + 2 * SHM_V);
  float* rkL = (float*)(lds + OFF_RK); float* biasL = (float*)(lds + OFF_BIAS); float* li_l = (float*)(lds + OFF_LI) + wid * 64;
  const int NT = (i4 == 0 || i4 == 15) ? 8 : 12, rbase = (i4 == 0) ? 0 : ((i4 == 15) ? 56 : 4 * i4 - 4);
  const int qrow = 4 * i4 + (wid >> 1), qc = 32 * (wid & 1) + r32;
  int rs = qrow - 4; rs = rs < 0 ? 0 : (rs > 56 ? 56 : rs);
  int cs = qc - 8; cs = cs < 0 ? 0 : (cs > 48 ? 48 : cs);
  const size_t tok_q = (size_t)b * 4096 + qrow * 64 + qc, tok_k0 = (size_t)b * 4096 + rbase * 64;
  for (int i = tid; i < NT * 64; i += 512) { const f32x4 p = *(const f32x4*)(ssq_k + (tok_k0 + i) * 32 + h * 4); rkL[i] = rsqrtf(((p[0] + p[1]) + (p[2] + p[3])) * (1.0f / 128.0f) + 1e-6f); }
  for (int i = tid; i < BIAS_N; i += 512) { const int j = i - BIAS_PAD; biasL[i] = (j >= 0 && j < 15 * 31) ? rpb[h * 465 + j] * 1.4426950408889634f : 0.f; }
  float rqs; { const f32x4 p = *(const f32x4*)(ssq_q + tok_q * 32 + h * 4); rqs = rsqrtf(((p[0] + p[1]) + (p[2] + p[3])) * (1.0f / 128.0f) + 1e-6f) * 1.4426950408889634f; }
  float l_reg = 0; f32x16 o[4] = {}; bf16x8 qr[8];
  const bf16* Qw = qkv + tok_q * LDQ + h * 128 + hi * 8;
#pragma unroll
  for (int d0 = 0; d0 < 8; ++d0) qr[d0] = *reinterpret_cast<const bf16x8*>(Qw + d0 * 16);
  const bf16* Kh = qkv + tok_k0 * LDQ + 1024 + h * 128; const bf16* Vh = qkv + tok_k0 * LDQ + 2048 + h * 128;
  const int sr = tid >> 4, sc = (tid & 15) * 8, vst0 = v_st(sr, sc), vst1 = v_st(32 + sr, sc);
  const int vb0 = (int)(uintptr_t)V_lds + v_rd_base(lane);
  struct { bf16x8 vs0, vs1, ks0, ks1; } sr_[2];
#define SLOAD(i, k0) do { sr_[i].vs0 = *(const bf16x8*)(&Vh[(long)((k0) + sr) * LDQ + sc]); sr_[i].vs1 = *(const bf16x8*)(&Vh[(long)((k0) + 32 + sr) * LDQ + sc]); \
    sr_[i].ks0 = *(const bf16x8*)(&Kh[(long)((k0) + sr) * LDQ + sc]); sr_[i].ks1 = *(const bf16x8*)(&Kh[(long)((k0) + 32 + sr) * LDQ + sc]); } while (0)
#define SWRITE(bb, i) do { *(bf16x8*)((char*)V_lds + (bb) * SHM_V + vst0) = sr_[i].vs0;          \
    *(bf16x8*)((char*)V_lds + (bb) * SHM_V + vst1) = sr_[i].vs1; int kc = sc * 2;               \
    *(bf16x8*)((char*)K_lds + (bb) * SHM_K + KSWZ(sr, kc)) = sr_[i].ks0;                       \
    *(bf16x8*)((char*)K_lds + (bb) * SHM_K + KSWZ(32 + sr, kc)) = sr_[i].ks1; } while (0)
#define SWAIT() asm volatile("s_waitcnt vmcnt(0)" ::: "memory")
#define TILE_ARGS(j) ((unsigned)(rbase + (j) - rs) < 8u), rkL + (j) * 64, biasL + BIAS_PAD + (rbase + (j) - qrow + 7) * 31 + 15 - qc, rqs, cs, hi
  f32x16 p0, p1; bf16x8 pa0, pa1, pa2, pa3;
#define NA_TILE(j, bo) do { if ((unsigned)(rbase + (j) - rs) < 8u) {     \
      SBAR(); qkt(p0, p1, (const bf16*)((const char*)K_lds + (bo) * SHM_K), qr, r32, hi); \
      procP(p0, p1, l_reg, TILE_ARGS(j)); \
      packP(p0, p1, pa0, pa1, pa2, pa3); SBAR(); \
      pv_d0(o, vb0 + (bo) * (int)SHM_V, pa0, pa1, pa2, pa3); } } while (0)
  SLOAD(0, 0); SLOAD(1, KVBLK); asm volatile("s_waitcnt vmcnt(4)" ::: "memory"); SWRITE(0, 0); SLOAD(0, 2 * KVBLK); __syncthreads();
  for (int j = 0; j < NT; j += 2) {
    NA_TILE(j, 0);
    __syncthreads();
    SWRITE(1, 1); if (j + 3 < NT) SLOAD(1, (j + 3) * KVBLK);
    __syncthreads();
    NA_TILE(j + 1, 1);
    if (j + 2 < NT) {
      __syncthreads();
      SWRITE(0, 0); if (j + 4 < NT) SLOAD(0, (j + 4) * KVBLK);
      __syncthreads();
    }
  }
#undef NA_TILE
  { auto rr = __builtin_amdgcn_permlane32_swap(__float_as_uint(l_reg), __float_as_uint(l_reg), false, false); l_reg = __uint_as_float(rr[0]) + __uint_as_float(rr[1]); }
  if (hi == 0) li_l[r32] = l_reg; asm volatile("s_waitcnt lgkmcnt(0)" ::: "memory");
  float rli[16];
#pragma unroll
  for (int r = 0; r < 16; ++r) rli[r] = __builtin_amdgcn_rcpf(li_l[crow(r, hi)]);
  bf16* Ow = ona + ((size_t)b * 4096 + qrow * 64 + 32 * (wid & 1)) * 2048 + h * 128;
#pragma unroll
  for (int r = 0; r < 16; ++r) { const int orow = crow(r, hi);
#pragma unroll
    for (int d0 = 0; d0 < 4; ++d0) { const float v = o[d0][r] * rli[r]; unsigned u = __float_as_uint(v); u += 0x7fffu + ((u >> 16) & 1u); Ow[(size_t)orow * 2048 + d0 * 32 + r32] = (bf16)(u >> 16); } }
  __syncthreads();
#undef SLOAD
#undef SWRITE
#undef SWAIT
#undef TILE_ARGS
}
#undef KSWZ
#undef SBAR
}

constexpr int NWAVES = 8;
constexpr int RING_OFF = 0, RING_BYTES = 131072;
constexpr int LDSCTL_OFF = RING_BYTES, MISC_OFF = LDSCTL_OFF + 320;
constexpr int LDS_BYTES = 147456;
static_assert(MISC_OFF + 128 <= LDS_BYTES && na::NA_LDS_BYTES <= RING_BYTES, "LDS map");
constexpr int CW_TMO = 0, CW_BAR = 4096;

#define GAS __attribute__((address_space(1)))
#define LAS __attribute__((address_space(3)))
typedef unsigned short bf16;
typedef unsigned v4u __attribute__((ext_vector_type(4)));
typedef float f32x4 __attribute__((ext_vector_type(4)));
typedef GAS unsigned gu32;
#define LDS_WAIT() asm volatile("s_waitcnt lgkmcnt(0)" ::: "memory")
#define VM_WAIT() asm volatile("s_waitcnt vmcnt(0)" ::: "memory")
__device__ __forceinline__ unsigned f2bf(float f) { unsigned u = __builtin_bit_cast(unsigned, f); return (u + 0x7fffu + ((u >> 16) & 1u)) >> 16; }
__device__ __forceinline__ unsigned pk2(float lo, float hi) { return f2bf(lo) | (f2bf(hi) << 16); }
__device__ __forceinline__ float bf2f_(unsigned h) { return __uint_as_float(h << 16); }

#define XB_TMO      128
#define XB_XCNT(j)  (256  + 64 * (j))
#define XB_XSUB(j)  (1280 + 64 * (j))
#define XB_XGEN(j)  (2304 + 64 * (j))
#define XB_TOP      3328
#define XB_TOPGEN   3392
#define XCD_BAR_WORDS 3456
#define XB_SPIN_CAP (1u << 18)
__device__ __forceinline__ unsigned xb_ld(unsigned* p)              { return __hip_atomic_load(p, __ATOMIC_RELAXED, __HIP_MEMORY_SCOPE_AGENT); }
__device__ __forceinline__ unsigned xb_add(unsigned* p, unsigned v) { return __hip_atomic_fetch_add(p, v, __ATOMIC_RELAXED, __HIP_MEMORY_SCOPE_AGENT); }
__device__ __forceinline__ unsigned xb_xcc_id() { return (unsigned)__builtin_amdgcn_s_getreg((3 << 11) | 20) & 0xFu; }
#define XB_SPIN(cond, bar) do { unsigned _sp = 0; while (cond) { __builtin_amdgcn_s_sleep(1); \
    if ((++_sp & 255u) == 0u) { if (xb_ld(&(bar)[XB_TMO])) break; if (_sp > XB_SPIN_CAP) { atomicAdd(&(bar)[XB_TMO], 1u); break; } } } } while (0)
struct XcdBarrier { unsigned* bar; unsigned x; volatile LAS unsigned* st; };
__device__ __forceinline__ XcdBarrier xcd_barrier_post(unsigned* bar, volatile LAS unsigned* st) {
    XcdBarrier b; b.bar = bar; b.x = xb_xcc_id(); b.st = st;
    if (threadIdx.x == 0) (void)xb_add(&bar[XB_XCNT(b.x)], 1u);
    return b;
}
__device__ __forceinline__ void xcd_barrier_complete(unsigned* bar, unsigned x, unsigned& nloc, unsigned& nx) {
    const unsigned G = gridDim.x * gridDim.y * gridDim.z;
    unsigned sum, cnt, mine, sp = 0u;
    for (;;) {
        sum = 0u; cnt = 0u; mine = 0u;
#pragma unroll
        for (unsigned j = 0; j < 16; ++j) { const unsigned c = xb_ld(&bar[XB_XCNT(j)]); sum += c; cnt += (c > 0u) ? 1u : 0u; mine = (j == x) ? c : mine; }
        if (sum == G) break;
        __builtin_amdgcn_s_sleep(1);
        if ((++sp & 255u) == 0u) { if (xb_ld(&bar[XB_TMO])) break; if (sp > XB_SPIN_CAP) { atomicAdd(&bar[XB_TMO], 1u); break; } }
    }
    nloc = mine > 0u ? mine : 1u; nx = cnt > 0u ? cnt : 1u;
}
__device__ __forceinline__ void xcd_barrier(const XcdBarrier& b) {
    asm volatile("s_waitcnt vmcnt(0)" ::: "memory");
    __syncthreads();
    if (threadIdx.x == 0) {
        unsigned* bar = b.bar;
        __builtin_amdgcn_s_waitcnt(0);
        unsigned nloc = b.st[0], nx = b.st[1];
        if (nloc == 0u) { xcd_barrier_complete(bar, b.x, nloc, nx); b.st[0] = nloc; b.st[1] = nx; }
        const unsigned old = xb_add(&bar[XB_XSUB(b.x)], 1u);
        const unsigned gen = old / nloc;
        if (old + 1u == (gen + 1u) * nloc) {
            __builtin_amdgcn_fence(__ATOMIC_RELEASE, "agent");
            asm volatile("s_waitcnt vmcnt(0)" ::: "memory");
            const unsigned og = xb_add(&bar[XB_TOP], 1u);
            const unsigned tg = og / nx;
            if (og + 1u == (tg + 1u) * nx) xb_add(&bar[XB_TOPGEN], 1u);
            else XB_SPIN(xb_ld(&bar[XB_TOPGEN]) == tg, bar);
            __builtin_amdgcn_fence(__ATOMIC_ACQUIRE, "agent");
            xb_add(&bar[XB_XGEN(b.x)], 1u);
            asm volatile("s_waitcnt vmcnt(0)" ::: "memory");
        } else {
            XB_SPIN(xb_ld(&bar[XB_XGEN(b.x)]) == gen, bar);
            __builtin_amdgcn_fence(__ATOMIC_ACQUIRE, "agent");
            asm volatile("s_waitcnt vmcnt(0)" ::: "memory");
        }
    }
    __syncthreads();
}

__device__ __forceinline__ float wave_sum(float v) {
#pragma unroll
    for (int o = 1; o < 64; o <<= 1) v += __shfl_xor(v, o);
    return v;
}
__device__ __forceinline__ void p0_item(const float* __restrict__ W, int ldw, int k0, int n0, bf16* __restrict__ WT, int ldt, int dA, int dB, const float* __restrict__ kscale, LAS float* scr, int lane) {
    const int c16 = lane & 15, kr = lane >> 4;
#pragma unroll
    for (int it = 0; it < 16; ++it) { const int k = 4 * it + kr;
        f32x4 v = *(const f32x4*)(W + (size_t)(k0 + k) * ldw + n0 + 4 * c16);
        if (kscale) v = v * kscale[k0 + k];
        *(LAS f32x4*)(scr + k * 64 + ((4 * c16) ^ (8 * ((k >> 3) & 7)))) = v; }
    LDS_WAIT(); asm volatile("" ::: "memory");
    const int c = lane & 7;
#pragma unroll
    for (int j = 0; j < 8; ++j) { const int n = (lane >> 3) + 8 * j; const LAS float* s = scr + (8 * c) * 64 + (n ^ (8 * c));
        v4u o; o.x = pk2(s[0 * 64], s[1 * 64]); o.y = pk2(s[2 * 64], s[3 * 64]); o.z = pk2(s[4 * 64], s[5 * 64]); o.w = pk2(s[6 * 64], s[7 * 64]);
        const int drow = (n < 32) ? dA + n : dB + n - 32;
        *(GAS v4u*)(WT + (size_t)drow * ldt + k0 + 8 * c) = o; }
    LDS_WAIT(); asm volatile("" ::: "memory");
}
struct P0Desc { const float* src; bf16* dst; int ldw, ldt, dA, dB; };
__device__ __forceinline__ void p0_load(const P0Desc& d, f32x4 (&R)[16], int lane) {
    const int c16 = lane & 15, kr = lane >> 4;
#pragma unroll
    for (int it = 0; it < 16; ++it) R[it] = *(const f32x4*)(d.src + (size_t)(4 * it + kr) * d.ldw + 4 * c16);
}
__device__ __forceinline__ void p0_to_lds(const f32x4 (&R)[16], LAS float* scr, int lane) {
    const int c16 = lane & 15, kr = lane >> 4;
#pragma unroll
    for (int it = 0; it < 16; ++it) { const int k = 4 * it + kr; *(LAS f32x4*)(scr + k * 64 + ((4 * c16) ^ (8 * ((k >> 3) & 7)))) = R[it]; }
}
__device__ __forceinline__ void p0_store(const P0Desc& d, LAS float* scr, int lane) {
    const int c = lane & 7;
#pragma unroll
    for (int j = 0; j < 8; ++j) { const int n = (lane >> 3) + 8 * j; const LAS float* s = scr + (8 * c) * 64 + (n ^ (8 * c));
        v4u o; o.x = pk2(s[0 * 64], s[1 * 64]); o.y = pk2(s[2 * 64], s[3 * 64]); o.z = pk2(s[4 * 64], s[5 * 64]); o.w = pk2(s[6 * 64], s[7 * 64]);
        const int drow = (n < 32) ? d.dA + n : d.dB + n - 32;
        *(GAS v4u*)(d.dst + (size_t)drow * d.ldt + 8 * c) = o; }
}
__device__ __forceinline__ void rms_row_to_bf16(const float* __restrict__ xrow, const float* __restrict__ g, bf16* __restrict__ orow, int lane) {
    const f32x4* xr = (const f32x4*)xrow + lane; const f32x4* gr = (const f32x4*)g + lane;
    f32x4 v[8]; float s = 0.f;
#pragma unroll
    for (int j = 0; j < 8; ++j) { v[j] = xr[64 * j]; s += (v[j].x * v[j].x + v[j].y * v[j].y) + (v[j].z * v[j].z + v[j].w * v[j].w); }
    const float r = rsqrtf(wave_sum(s) * (1.f / 2048.f) + mk::EPS);
    unsigned long long* o8 = (unsigned long long*)orow + lane;
#pragma unroll
    for (int j = 0; j < 8; ++j) { const f32x4 gg = gr[64 * j]; o8[64 * j] = (unsigned long long)pk2(v[j].x * r * gg.x, v[j].y * r * gg.y) | ((unsigned long long)pk2(v[j].z * r * gg.z, v[j].w * r * gg.w) << 32); }
}
__device__ __forceinline__ int win_dest_row(int n32  ) {
    const int pn = n32 >> 3, ga = n32 & 7;
    if (pn < 12 || pn >= 20) return n32 * 32;
    const int gs = 4 * ((ga >> 1) & 1) + 2 * (ga >> 2) + (ga & 1);
    return (pn * 8 + gs) * 32;
}

struct Args { const float* in[21]; float* out; unsigned char* ws; };

__global__ void __launch_bounds__(NWAVES * 64, 2) mk_fwd(Args args) {
    extern __shared__ __attribute__((aligned(16))) unsigned char lds[];
    LAS unsigned char* ldsl = (LAS unsigned char*)lds;
    volatile LAS unsigned* MISC = (volatile LAS unsigned*)(ldsl + MISC_OFF);
    const int tid = threadIdx.x, lane = tid & 63, wave = __builtin_amdgcn_readfirstlane(tid >> 6);
    const int G = gridDim.x, bx = blockIdx.x;
    const int vcu = (G % 8 == 0) ? (bx % 8) * (G / 8) + bx / 8 : bx;
    unsigned char* ws = args.ws; unsigned char* dob = (unsigned char*)args.out;
    gu32* ctl = (gu32*)(ws + mk::WS_CTL);
#define I_x args.in[0]
#define I_mem args.in[1]
#define I_g_mix args.in[2]
#define I_w_in args.in[3]
#define I_gq args.in[4]
#define I_gk args.in[5]
#define I_rpb args.in[6]
#define I_lgf_in args.in[7]
#define I_lgb_in args.in[8]
#define I_gn args.in[9]
#define I_g_mem args.in[10]
#define I_w_mkv args.in[11]
#define I_gxq args.in[12]
#define I_gxk args.in[13]
#define I_w_na args.in[14]
#define I_w_ret args.in[15]
#define I_w_memb args.in[16]
#define I_w_out args.in[17]
#define I_g_ffn args.in[18]
#define I_w_ff1 args.in[19]
#define I_w_ff2 args.in[20]
#define I_out args.out
#define cosT ((float*)(ws + mk::WS_COS))
#define sinT ((float*)(ws + mk::WS_SIN))
#define ssq_naq ((float*)(ws + mk::WS_SSQ_NAQ))
#define ssq_nak ((float*)(ws + mk::WS_SSQ_NAK))
#define ssq_xq ((float*)(ws + mk::WS_SSQ_XQ))
#define xl ((float*)(ws + mk::WS_XL))
#define ssq_x1 ((float*)(ws + mk::WS_SSQ_X1))
#define tab ((float*)(ws + mk::WS_TAB))
#define MEMN ((bf16*)(ws + mk::WS_MEMN))
#define MKb ((bf16*)(ws + mk::WS_MK))
#define MVT ((bf16*)(ws + mk::WS_MVT))
#define WinT ((bf16*)(ws + mk::WS_WIN))
#define Wff1T ((bf16*)(ws + mk::WS_WFF1))
#define Wff2T ((bf16*)(ws + mk::WS_WFF2))
#define WretT ((bf16*)(ws + mk::WS_WRET))
#define WoutT ((bf16*)(ws + mk::WS_WOUT))
#define WnmT ((bf16*)(ws + mk::WS_WNM))
#define WmkvT ((bf16*)(ws + mk::WS_WMKV))
#define NAQKV ((bf16*)(ws + mk::WS_NAQKV))
#define K0 ((bf16*)(ws + mk::WS_K0))
#define RG ((bf16*)(ws + mk::WS_RG))
#define XQ ((bf16*)(ws + mk::WS_XQ))
#define GATES ((bf16*)(ws + mk::WS_GATES))
#define AR ((bf16*)(ws + mk::WS_AR))
#define BR ((bf16*)(ws + mk::WS_BR))
#define KV ((float*)(ws + mk::WS_KV))
#define ORET ((bf16*)(ws + mk::WS_ORET))
#define MERGED ((bf16*)(ws + mk::WS_MERGED))
#define X1B ((bf16*)(ws + mk::WS_X1B))
#define HFF ((bf16*)(ws + mk::WS_HFF))
#define HN ((bf16*)(dob + mk::DO_HN))
#define KT ((bf16*)(dob + mk::DO_KT))
#define XP ((bf16*)(dob + mk::DO_XP))
#define ONM ((bf16*)(dob + mk::DO_ONM))
    for (int u = tid; u < (LDS_BYTES - LDSCTL_OFF) / 4; u += NWAVES * 64) ((LAS unsigned*)(ldsl + LDSCTL_OFF))[u] = 0u;
    __syncthreads();
    XcdBarrier bar = xcd_barrier_post((unsigned*)(ctl + CW_BAR), MISC + 8);
#define GRID_BAR() xcd_barrier(bar)
    LAS float* scr = (LAS float*)(ldsl + RING_OFF + wave * 16384);
    const int gw = vcu * NWAVES + wave, NGW = G * NWAVES;

    {
    {
        for (int i = gw * 64 + lane; i < 4096 * 64; i += NGW * 64) { const int s = i >> 6, f = i & 63;
            const float inv = powf(10000.0f, -(float)f / 64.0f), ang = (float)s * inv; cosT[i] = cosf(ang); sinT[i] = sinf(ang); }
        if (bx == 0) {
            if (tid < 128) tab[mk::TAB_CS_NAQ + tid] = I_gq[tid] * I_gk[tid] * 0.08838834764831845f;
            if (tid < 256) tab[mk::TAB_CS_MK + tid] = I_gxq[tid] * I_gxk[tid] * 0.0625f;
            if (tid < 8) { tab[mk::TAB_L2F + tid] = -log1pf(expf(-I_lgf_in[tid])) * mk::LOG2E; tab[mk::TAB_L2B + tid] = -log1pf(expf(-I_lgb_in[tid])) * mk::LOG2E; }
        }
        for (int m = gw; m < 512; m += NGW) rms_row_to_bf16(I_mem + (size_t)m * 2048, I_g_mem, MEMN + (size_t)m * 2048, lane);
        for (int it = gw; it < 32 * 32; it += NGW) { const int kb = it >> 5, nb = it & 31; p0_item(I_w_mkv, 2048, 64 * kb, 64 * nb, WmkvT, 2048, 64 * nb, 64 * nb + 32, nullptr, scr, lane); }
    }
    GRID_BAR();
    }
    {
    if (vcu < 16) {
        mk::SchedOne S; S.has = true; const pg8::Gemm g{2048, 2048, 2048};
        mk::EpiMKV E{MKb, MVT, tab, tab, 0};
        if (vcu < 8) { S.u.pm = vcu >> 2; S.u.pn = vcu & 3; S.a = (const char*)(MEMN + (size_t)S.u.pm * 256 * 2048); S.b = (const char*)(WmkvT + (size_t)S.u.pn * 256 * 2048); E.mode = 0; }
        else { const int c = vcu - 8; S.u.pm = c >> 1; S.u.pn = c & 1; S.a = (const char*)(WmkvT + (size_t)(1024 + S.u.pm * 256) * 2048); S.b = (const char*)(MEMN + (size_t)S.u.pn * 256 * 2048); E.mode = 1; }
        pg8::gemm_phase<mk::EpiMKV, mk::SchedOne, false>(ldsl + RING_OFF, g, S, E);
    } else {
        const int gw2 = (vcu - 16) * NWAVES + wave, NGW2 = (G - 16) * NWAVES;
        constexpr int I_IN = 32 * 256, I_FF1 = 32 * 128, I_FF2 = 128 * 32, I_RET = 32 * 32, I_OUT = 32 * 32, I_NA = 16 * 32, I_MEM = 16 * 32;
        constexpr int NITEMS = I_IN + I_FF1 + I_FF2 + I_RET + I_OUT + I_NA + I_MEM;
#define P0_DECODE(d, item) do { int r = (item); \
            if (r < I_IN) { const int kb = r >> 8, nb = r & 255; d.src = I_w_in + (size_t)(64 * kb) * 16384 + 64 * nb; d.ldw = 16384; d.dst = WinT + 64 * kb; d.ldt = 2048; d.dA = win_dest_row(2 * nb); d.dB = win_dest_row(2 * nb + 1); break; } r -= I_IN; \
            if (r < I_FF1) { const int kb = r >> 7, nb = r & 127; d.src = I_w_ff1 + (size_t)(64 * kb) * 8192 + 64 * nb; d.ldw = 8192; d.dst = Wff1T + 64 * kb; d.ldt = 2048; d.dA = 64 * nb; d.dB = 64 * nb + 32; break; } r -= I_FF1; \
            if (r < I_FF2) { const int kb = r >> 5, nb = r & 31; d.src = I_w_ff2 + (size_t)(64 * kb) * 2048 + 64 * nb; d.ldw = 2048; d.dst = Wff2T + 64 * kb; d.ldt = 8192; d.dA = 64 * nb; d.dB = 64 * nb + 32; break; } r -= I_FF2; \
            if (r < I_RET) { const int kb = r >> 5, nb = r & 31; d.src = I_w_ret + (size_t)(64 * kb) * 2048 + 64 * nb; d.ldw = 2048; d.dst = WretT + 64 * kb; d.ldt = 2048; d.dA = 64 * nb; d.dB = 64 * nb + 32; break; } r -= I_RET; \
            if (r < I_OUT) { const int kb = r >> 5, nb = r & 31; d.src = I_w_out + (size_t)(64 * kb) * 2048 + 64 * nb; d.ldw = 2048; d.dst = WoutT + 64 * kb; d.ldt = 2048; d.dA = 64 * nb; d.dB = 64 * nb + 32; break; } r -= I_OUT; \
            if (r < I_NA) { const int kb = r >> 5, nb = r & 31; d.src = I_w_na + (size_t)(64 * kb) * 2048 + 64 * nb; d.ldw = 2048; d.dst = WnmT + 64 * kb; d.ldt = 2048; d.dA = 64 * nb; d.dB = 64 * nb + 32; break; } r -= I_NA; \
            { const int kb = r >> 5, nb = r & 31; d.src = I_w_memb + (size_t)(64 * kb) * 2048 + 64 * nb; d.ldw = 2048; d.dst = WnmT + 1024 + 64 * kb; d.ldt = 2048; d.dA = 64 * nb; d.dB = 64 * nb + 32; } } while (0)
        {
            f32x4 R0[16], R1[16]; P0Desc d0, d1; int it = gw2;
            if (it < NITEMS) { P0_DECODE(d0, it); p0_load(d0, R0, lane); }
            if (it + NGW2 < NITEMS) { P0_DECODE(d1, it + NGW2); p0_load(d1, R1, lane); }
            for (; it < NITEMS; it += 2 * NGW2) {
                p0_to_lds(R0, scr, lane); const P0Desc c0 = d0;
                if (it + 2 * NGW2 < NITEMS) { P0_DECODE(d0, it + 2 * NGW2); p0_load(d0, R0, lane); }
                LDS_WAIT(); asm volatile("" ::: "memory"); p0_store(c0, scr, lane); LDS_WAIT(); asm volatile("" ::: "memory");
                if (it + NGW2 < NITEMS) {
                    p0_to_lds(R1, scr, lane); const P0Desc c1 = d1;
                    if (it + 3 * NGW2 < NITEMS) { P0_DECODE(d1, it + 3 * NGW2); p0_load(d1, R1, lane); }
                    LDS_WAIT(); asm volatile("" ::: "memory"); p0_store(c1, scr, lane); LDS_WAIT(); asm volatile("" ::: "memory");
                }
            }
        }
#undef P0_DECODE
        for (int m = gw2; m < mk::M; m += NGW2) rms_row_to_bf16(I_x + (size_t)m * 2048, I_g_mix, HN + (size_t)m * 2048, lane);
    }
    GRID_BAR();
    }
    {
    {
        mk::SchedProj S; S.o.init(mk::M, mk::D_IN, G, bx); S.hn_ = (const char*)HN; S.wt_ = (const char*)WinT;
        const pg8::Gemm g{2048, 2048, 2048};
        mk::EpiProj E{ws};
        pg8::gemm_phase<mk::EpiProj, mk::SchedProj, true>(ldsl + RING_OFF, g, S, E);
    }
    GRID_BAR();
    }
    {
    {
        const int c = bx, bh = c >> 4, nc = c & 15, b = bh >> 3, h = bh & 7;
        const float l2f = tab[mk::TAB_L2F + h], l2b = tab[mk::TAB_L2B + h];
        {
            bf16* kt = KT + (size_t)c * 65536; const bf16* ksrc = K0 + ((size_t)b * 4096 + nc * 256) * 1024 + h * 128;
            LAS float* t = scr;
            const int tok0 = wave * 32;
#pragma unroll
            for (int it = 0; it < 8; ++it) { const int tr = 4 * it + (lane >> 4), c8 = (lane & 15) * 8; const v4u w = *(const v4u*)(ksrc + (size_t)(tok0 + tr) * 1024 + c8);
                LAS float* d = t + tr * 128 + (c8 ^ (8 * (tr >> 3))); d[0] = bf2f_(w.x & 0xffffu); d[1] = bf2f_(w.x >> 16); d[2] = bf2f_(w.y & 0xffffu); d[3] = bf2f_(w.y >> 16);
                d[4] = bf2f_(w.z & 0xffffu); d[5] = bf2f_(w.z >> 16); d[6] = bf2f_(w.w & 0xffffu); d[7] = bf2f_(w.w >> 16); }
            LDS_WAIT(); asm volatile("" ::: "memory");
            const int q = lane & 3;
            float df[8], db[8];
#pragma unroll
            for (int i = 0; i < 8; ++i) { const int tk = tok0 + 8 * q + i; df[i] = pg8::fexp2(l2f * (float)(255 - tk)); db[i] = pg8::fexp2(l2b * (float)tk); }
#pragma unroll
            for (int j = 0; j < 8; ++j) { const int dk = (lane >> 2) + 16 * j; const LAS float* s = t + (8 * q) * 128 + (dk ^ (8 * q));
                float v[8];
#pragma unroll
                for (int i = 0; i < 8; ++i) v[i] = s[i * 128];
                v4u o; o.x = pk2(v[0] * df[0], v[1] * df[1]); o.y = pk2(v[2] * df[2], v[3] * df[3]); o.z = pk2(v[4] * df[4], v[5] * df[5]); o.w = pk2(v[6] * df[6], v[7] * df[7]);
                *(GAS v4u*)(kt + (size_t)dk * 256 + tok0 + 8 * q) = o;
                o.x = pk2(v[0] * db[0], v[1] * db[1]); o.y = pk2(v[2] * db[2], v[3] * db[3]); o.z = pk2(v[4] * db[4], v[5] * db[5]); o.w = pk2(v[6] * db[6], v[7] * db[7]);
                *(GAS v4u*)(kt + (size_t)(128 + dk) * 256 + tok0 + 8 * q) = o; }
            VM_WAIT(); LDS_WAIT(); __syncthreads();
        }
        {
            mk::SchedOne S; S.has = true; S.u.pm = 0; S.u.pn = 0; S.a = (const char*)(BR + (size_t)c * 256 * 512); S.b = (const char*)(KT + (size_t)c * 65536);
            const pg8::Gemm g{512, 256, 256}; mk::EpiF32 E{KV + (size_t)c * 65536};
            pg8::gemm_phase<mk::EpiF32, mk::SchedOne, false>(ldsl + RING_OFF, g, S, E);
        }
        {
            mk::SchedOne S; S.has = true; S.u.pm = 0; S.u.pn = 0;
            bf16* arc = AR + ((size_t)bh * 4096 + nc * 256) * 512;
            S.a = (const char*)(arc + 256); S.b = (const char*)(K0 + ((size_t)b * 4096 + nc * 256) * 1024 + h * 128);
            const pg8::Gemm g{512, 1024, 128}; mk::EpiP E{arc, l2f, l2b};
            pg8::gemm_phase<mk::EpiP, mk::SchedOne, false>(ldsl + RING_OFF, g, S, E);
        }
        if (bx < 128) {
            const int xb = bx >> 6, xh = (bx >> 4) & 3, qt = bx & 15; const size_t tok0 = (size_t)xb * 4096 + qt * 256;
            mk::SchedOne S; S.has = true; S.u.pm = 0; S.u.pn = 0;
            S.a = (const char*)(XQ + tok0 * 1024 + xh * 256); S.b = (const char*)(MKb + (size_t)xb * 256 * 1024 + xh * 256);
            const pg8::Gemm g{1024, 1024, 256};
            mk::EpiXS E{XP + tok0 * 1024 + xh * 256, xl + tok0 * 16 + xh * 4, ssq_xq + tok0 * 16 + xh * 4, tab + mk::TAB_SSQ_MK + (size_t)xb * 256 * 16 + xh * 4};
            pg8::gemm_phase<mk::EpiXS, mk::SchedOne, false>(ldsl + RING_OFF, g, S, E);
        }
    }
    GRID_BAR();
    }
    {
    {
        for (int e = (vcu * 512 + tid); e < 16 * 65536; e += G * 512) {
            const int bh = e >> 16, r = e & 65535, col = r & 255, h = bh & 7;
            const bool fwd = col < 128; const float dec = pg8::fexp2((fwd ? tab[mk::TAB_L2F + h] : tab[mk::TAB_L2B + h]) * 256.0f);
            const float* kvp = KV + (size_t)bh * 16 * 65536 + r; bf16* brp = BR + ((size_t)bh * 16 * 256 + (r >> 8)) * 512 + 256 + col;
            float kvv[16];
#pragma unroll
            for (int n = 0; n < 16; ++n) kvv[n] = kvp[(size_t)n * 65536];
            float s = 0.f;
            if (fwd) {
#pragma unroll
                for (int n = 0; n < 16; ++n) { brp[(size_t)n * 256 * 512] = (bf16)f2bf(s); s = dec * s + kvv[n]; }
            } else {
#pragma unroll
                for (int n = 15; n >= 0; --n) { brp[(size_t)n * 256 * 512] = (bf16)f2bf(s); s = dec * s + kvv[n]; }
            }
        }
        __syncthreads();
        { const int b = bx >> 7, h = (bx >> 4) & 7, i4 = bx & 15;
        na::na_unit(b, h, i4, NAQKV, ssq_naq, ssq_nak, I_rpb, ONM, (char*)lds); }
    }
    GRID_BAR();
    }
    {
    {
        const int c = bx, bh = c >> 4, nc = c & 15, b = bh >> 3, h = bh & 7;
        {
            mk::SchedOne S; S.has = true; S.u.pm = 0; S.u.pn = 0;
            S.a = (const char*)(AR + ((size_t)bh * 4096 + nc * 256) * 512); S.b = (const char*)(BR + (size_t)c * 256 * 512);
            const pg8::Gemm g{512, 512, 512};
            const size_t o0 = ((size_t)b * 4096 + nc * 256) * 2048 + h * 256;
            mk::EpiGN E{ORET + o0, RG + o0, I_gn + h * 256};
            pg8::gemm_phase<mk::EpiGN, mk::SchedOne, false>(ldsl + RING_OFF, g, S, E);
        }
        if (bx < 128) {
            const int xb = bx >> 6, xh = (bx >> 4) & 3, qt = bx & 15; const size_t tok0 = (size_t)xb * 4096 + qt * 256;
            mk::SchedOne S; S.has = true; S.u.pm = 0; S.u.pn = 0;
            S.a = (const char*)(XP + tok0 * 1024 + xh * 256); S.b = (const char*)(MVT + (size_t)xh * 256 * 512 + xb * 256);
            const pg8::Gemm g{1024, 512, 256};
            mk::EpiXO E{ONM + tok0 * 2048 + 1024 + xh * 256, xl + tok0 * 16 + xh * 4};
            pg8::gemm_phase<mk::EpiXO, mk::SchedOne, false>(ldsl + RING_OFF, g, S, E);
        }
    }
    GRID_BAR();
    }
    {
    {
        mk::SchedBR S; S.o.init(mk::M, 2048, G, bx); S.onm = (const char*)ONM; S.oret = (const char*)ORET; S.wnm = (const char*)WnmT; S.wret = (const char*)WretT;
        const pg8::Gemm g{2048, 2048, 1024}; mk::EpiGate4 E{MERGED, GATES};
        pg8::gemm_phase<mk::EpiGate4, mk::SchedBR, true>(ldsl + RING_OFF, g, S, E);
    }
    GRID_BAR();
    }
    {
    {
        mk::SchedGrid S; S.o.init(mk::M, 2048, G, bx); S.A = (const char*)MERGED; S.B = (const char*)WoutT; S.ta = 256u * 2048u * 2u; S.tb = 256u * 2048u * 2u;
        const pg8::Gemm g{2048, 2048, 2048}; mk::EpiWout E{I_x, I_out, X1B, ssq_x1, I_g_ffn};
        pg8::gemm_phase<mk::EpiWout, mk::SchedGrid, false>(ldsl + RING_OFF, g, S, E);
    }
    GRID_BAR();
    }
    {
    {
        mk::SchedGrid S; S.o.init(mk::M, 8192, G, bx); S.A = (const char*)X1B; S.B = (const char*)Wff1T; S.ta = 256u * 2048u * 2u; S.tb = 256u * 2048u * 2u;
        const pg8::Gemm g{2048, 2048, 2048}; mk::EpiFF1 E{HFF, ssq_x1};
        pg8::gemm_phase<mk::EpiFF1, mk::SchedGrid, true>(ldsl + RING_OFF, g, S, E);
    }
    GRID_BAR();
    }
    if (false) {
        mk::SchedGrid S; S.o.init(mk::M, 2048, G, bx); S.A = (const char*)HFF; S.B = (const char*)Wff2T; S.ta = 256u * (unsigned)mk::LDH * 2u; S.tb = 256u * 8192u * 2u;
        const pg8::Gemm g{mk::LDH, 8192, 8192}; mk::EpiFF2 E{I_out, KV};
        pg8::gemm_phase<mk::EpiFF2, mk::SchedGrid, false>(ldsl + RING_OFF, g, S, E);
        GRID_BAR();
    }
    {
        mk::SchedGrid S; S.o.init(mk::M, 2048, G, bx); S.A = (const char*)HFF; S.B = (const char*)Wff2T; S.ta = 256u * (unsigned)mk::LDH * 2u; S.tb = 256u * 8192u * 2u;
        const pg8::Gemm g{mk::LDH, 8192, 8192}; mk::EpiFF2 E{I_out, I_out};
        pg8::gemm_phase<mk::EpiFF2, mk::SchedGrid, false>(ldsl + RING_OFF, g, S, E);
    }
}

extern "C" void kernel_launch(void* const* d_in, const int* in_sizes, int n_in, void* d_out, int out_size, void* d_ws, size_t ws_size, hipStream_t stream) {
    static int grid = 0;
    if (grid == 0) {
        if (n_in != 21 || out_size != mk::M * mk::D || ws_size < mk::WS_END) { fprintf(stderr, "kernel_launch: unexpected shapes (n_in %d out %d ws %zu); nothing launched\n", n_in, out_size, ws_size); grid = -1; return; }
        int dev = 0, cus = 0;
        if (hipGetDevice(&dev) != hipSuccess || hipDeviceGetAttribute(&cus, hipDeviceAttributeMultiprocessorCount, dev) != hipSuccess) { grid = -1; return; }
        if (hipFuncSetAttribute((const void*)mk_fwd, hipFuncAttributeMaxDynamicSharedMemorySize, LDS_BYTES) != hipSuccess) { fprintf(stderr, "kernel_launch: hipFuncSetAttribute failed\n"); grid = -1; return; }
        (void)hipGetLastError();
        grid = cus;
        if (grid != 256) fprintf(stderr, "kernel_launch: %d CUs; this kernel's unit maps assume 256\n", grid);
    }
    if (grid < 0) return;
    if (hipMemsetAsync((char*)d_ws + mk::WS_CTL, 0, mk::CTL_ZERO_BYTES, stream) != hipSuccess) return;
    Args a{};
    for (int i = 0; i < 21; ++i) a.in[i] = (const float*)d_in[i];
    a.out = (float*)d_out; a.ws = (unsigned char*)d_ws;
    hipLaunchKernelGGL(mk_fwd, dim3(grid), dim3(NWAVES * 64), LDS_BYTES, stream, a);
}
```

```cpp
#include <hip/hip_runtime.h>
#include <cstdio>
#include <cstdint>

namespace pg8 {
#define PG8_LAS __attribute__((address_space(3)))
typedef unsigned short bf16_t;
typedef short bf16x8 __attribute__((ext_vector_type(8)));
typedef float f32x4 __attribute__((ext_vector_type(4)));
typedef float f32x2 __attribute__((ext_vector_type(2)));
typedef unsigned u32x4 __attribute__((ext_vector_type(4)));
typedef unsigned u32x2 __attribute__((ext_vector_type(2)));
constexpr int BM = 256, BK = 64, HALF = 128, HTB = HALF * BK * 2, STAGE_BYTES = 8 * HTB, NXCD = 8, WGM = 8;

__host__ __device__ __forceinline__ int lds_byte(int r, int c) { const int st = (r >> 4) * 2 + (c >> 5), rr = r & 15, cc = c & 31, ob = rr * 64 + cc * 2; return st * 1024 + (ob ^ (((ob >> 9) & 1) << 5)); }
__host__ __device__ __forceinline__ void stage_rc(int b, int& R, int& C) { const int st = b / 1024, sb = b % 1024, swz = sb ^ (((sb >> 9) & 1) << 5); R = (st >> 1) * 16 + swz / 64; C = (st & 1) * 32 + (swz % 64) / 2; }
__host__ __device__ __forceinline__ int perm32(int rho) { const int n = rho >> 4, i = rho & 15; return 8 * (i >> 2) + 4 * n + (i & 3); }

struct Unit { int pm, pn, sub; };
struct Gemm { int lda, ldb, K; };

struct GridOrder {
    int nM, nN, nwg, G, c;
    __device__ void init(int M, int N, int G_, int c_) { nM = M / BM; nN = N / BM; nwg = nM * nN; G = G_; c = c_; }
    __device__ bool next(int i, Unit& u) const {
        const long L = (long)i * G + c; if (L >= nwg) return false;
        int wgid = (int)L; { const int q = nwg / NXCD, r = nwg % NXCD, xcd = wgid % NXCD, off = wgid / NXCD; wgid = (xcd < r ? xcd * (q + 1) : r * (q + 1) + (xcd - r) * q) + off; }
        const int nig = WGM * nN, gid = wgid / nig, fm = gid * WGM, gsz = (nM - fm) < WGM ? (nM - fm) : WGM;
        u.pm = fm + ((wgid % nig) % gsz); u.pn = (wgid % nig) / gsz; u.sub = 0; return true;
    }
};

typedef float f32x2_cv __attribute__((ext_vector_type(2))); typedef __bf16 bf16x2_cv __attribute__((ext_vector_type(2)));
__device__ __forceinline__ unsigned cvt_pk_bf16(float lo, float hi) { const f32x2_cv v = {lo, hi}; const bf16x2_cv b = __builtin_convertvector(v, bf16x2_cv); return __builtin_bit_cast(unsigned, b); }
__device__ __forceinline__ void store8(bf16_t* p, f32x4 v0, f32x4 v1) { u32x4 w; w.x = cvt_pk_bf16(v0[0], v0[1]); w.y = cvt_pk_bf16(v0[2], v0[3]); w.z = cvt_pk_bf16(v1[0], v1[1]); w.w = cvt_pk_bf16(v1[2], v1[3]); *(u32x4*)p = w; }
__device__ __forceinline__ void store4(bf16_t* p, f32x4 v0) { u32x2 w; w.x = cvt_pk_bf16(v0[0], v0[1]); w.y = cvt_pk_bf16(v0[2], v0[3]); *(u32x2*)p = w; }
__device__ __forceinline__ float bf2f(unsigned short h) { return __uint_as_float((unsigned)h << 16); }
__device__ __forceinline__ void load8(const bf16_t* p, f32x4& v0, f32x4& v1) { const u32x4 w = *(const u32x4*)p;
    v0[0] = __uint_as_float(w.x << 16); v0[1] = __uint_as_float(w.x & 0xffff0000u); v0[2] = __uint_as_float(w.y << 16); v0[3] = __uint_as_float(w.y & 0xffff0000u);
    v1[0] = __uint_as_float(w.z << 16); v1[1] = __uint_as_float(w.z & 0xffff0000u); v1[2] = __uint_as_float(w.w << 16); v1[3] = __uint_as_float(w.w & 0xffff0000u); }
__device__ __forceinline__ void load8_l2(const bf16_t* p, f32x4& v0, f32x4& v1) { u32x4 w; const unsigned long long a = __hip_atomic_load((const unsigned long long*)p, __ATOMIC_RELAXED, __HIP_MEMORY_SCOPE_AGENT), b = __hip_atomic_load((const unsigned long long*)p + 1, __ATOMIC_RELAXED, __HIP_MEMORY_SCOPE_AGENT);
    w.x = (unsigned)a; w.y = (unsigned)(a >> 32); w.z = (unsigned)b; w.w = (unsigned)(b >> 32);
    v0[0] = __uint_as_float(w.x << 16); v0[1] = __uint_as_float(w.x & 0xffff0000u); v0[2] = __uint_as_float(w.y << 16); v0[3] = __uint_as_float(w.y & 0xffff0000u);
    v1[0] = __uint_as_float(w.z << 16); v1[1] = __uint_as_float(w.z & 0xffff0000u); v1[2] = __uint_as_float(w.w << 16); v1[3] = __uint_as_float(w.w & 0xffff0000u); }
__device__ __forceinline__ float fexp2(float x) { return __builtin_amdgcn_exp2f(x); }
__device__ __forceinline__ float frcp(float x) { return __builtin_amdgcn_rcpf(x); }
__device__ __forceinline__ float sigmoidf_(float x) { return frcp(1.f + fexp2(-1.4426950408889634f * x)); }

template <class Epi, class Sched, bool ALIGN_EPI>
__device__ __forceinline__ void gemm_phase(PG8_LAS unsigned char* lds, const Gemm g, const Sched& S, const Epi& E) {
    int tid_ = threadIdx.x; asm volatile("" : "+v"(tid_));
    const int tid = tid_, wid = __builtin_amdgcn_readfirstlane(tid >> 6), lane = tid & 63, wr = wid >> 2, wc = wid & 3, fr = lane & 15, fq = lane >> 4;
    unsigned voffA[2], voffB[2];
#pragma unroll
    for (int i = 0; i < 2; ++i) { int R, C; stage_rc(tid * 16 + i * 8192, R, C); const int Rb = Epi::PERM ? ((R & ~31) + perm32(R & 31)) : R;
        voffA[i] = (unsigned)(R * g.lda + C) * 2u; voffB[i] = (unsigned)(Rb * g.ldb + C) * 2u; }
    const size_t kstep = (size_t)(BK * 2);
    const size_t hstepA = (size_t)HALF * g.lda * 2, hstepB = (size_t)HALF * g.ldb * 2;
    const unsigned ldsw = (unsigned)wid * 1024u;
    const int aoff = lds_byte(wr * 64 + fr, fq * 8), boff = lds_byte(wc * 32 + fr, fq * 8);
#define PG8_SA(b, h) (((b) * 2 + (h)) * HTB)
#define PG8_SB(b, h) ((4 + (b) * 2 + (h)) * HTB)
#define PG8_STAGE(bufoff, gbase, voff) do { _Pragma("unroll") for (int _i = 0; _i < 2; ++_i) \
        __builtin_amdgcn_global_load_lds((const unsigned*)((const char*)(gbase) + (voff)[_i]), (PG8_LAS unsigned*)(lds + (bufoff) + ldsw + _i * 8192), 16, 0, 0); } while (0)
#define PG8_LDA(dst, b, h) do { _Pragma("unroll") for (int m = 0; m < 4; ++m) _Pragma("unroll") for (int k = 0; k < 2; ++k) dst[m][k] = *(const PG8_LAS bf16x8*)(lds + PG8_SA(b, h) + aoff + m * 2048 + k * 1024); } while (0)
#define PG8_LDB(dst, b, h) do { _Pragma("unroll") for (int n = 0; n < 2; ++n) _Pragma("unroll") for (int k = 0; k < 2; ++k) dst[n][k] = *(const PG8_LAS bf16x8*)(lds + PG8_SB(b, h) + boff + n * 2048 + k * 1024); } while (0)
#define PG8_MMA(ai, bj, At, Bt) do { __builtin_amdgcn_s_setprio(1); _Pragma("unroll") for (int m = 0; m < 4; ++m) _Pragma("unroll") for (int n = 0; n < 2; ++n) _Pragma("unroll") for (int k = 0; k < 2; ++k) \
        acc[ai][bj][m][n] = __builtin_amdgcn_mfma_f32_16x16x32_bf16(Bt[n][k], At[m][k], acc[ai][bj][m][n], 0, 0, 0); __builtin_amdgcn_s_setprio(0); } while (0)
#define PG8_WAIT_V(n) asm volatile("s_waitcnt vmcnt(" #n ")" ::: "memory")
#define PG8_WAIT_L(n) asm volatile("s_waitcnt lgkmcnt(" #n ")" ::: "memory")
#define PG8_BAR __builtin_amdgcn_s_barrier()
#define PG8_SCHED __builtin_amdgcn_sched_barrier(0)
    Unit cur, nxt; int ui = 0;
    if (!S.next(0, cur)) return;
    f32x4 acc[2][2][4][2];
#pragma unroll
    for (int a = 0; a < 2; ++a)
#pragma unroll
        for (int b = 0; b < 2; ++b)
#pragma unroll
            for (int m = 0; m < 4; ++m)
#pragma unroll
                for (int n = 0; n < 2; ++n) acc[a][b][m][n] = (f32x4){0.f, 0.f, 0.f, 0.f};
    bf16x8 At[4][2], B0[2][2], B1[2][2];
    const char* cA; const char* cB; S.ptrs(cur, cA, cB);
    PG8_STAGE(PG8_SB(0, 0), cB, voffB); PG8_STAGE(PG8_SB(0, 1), cB + hstepB, voffB); PG8_STAGE(PG8_SA(0, 0), cA, voffA); PG8_STAGE(PG8_SA(0, 1), cA + hstepA, voffA);
    if (wr == 1) PG8_BAR;
    PG8_WAIT_V(2); PG8_BAR;
    PG8_STAGE(PG8_SB(1, 0), cB + kstep, voffB); PG8_STAGE(PG8_SA(1, 0), cA + kstep, voffA); PG8_STAGE(PG8_SB(1, 1), cB + hstepB + kstep, voffB);
    PG8_WAIT_V(6); PG8_BAR;
    for (;;) {
        const bool has_next = S.next(ui + 1, nxt); const int nt = S.nt(cur, g.K) ;
        const char* nA = cA; const char* nB = cB; if (has_next) S.ptrs(nxt, nA, nB);
        for (int t = 0; t < nt; t += 2) {
            const bool last = (t == nt - 2);
            const char* a1 = cA + (size_t)(t + 1) * kstep;
            const char* a2 = last ? nA : cA + (size_t)(t + 2) * kstep; const char* b2 = last ? nB : cB + (size_t)(t + 2) * kstep;
            const char* a3 = a2 + kstep; const char* b3 = b2 + kstep;
            PG8_LDB(B0, 0, 0); PG8_LDB(B1, 0, 1); PG8_SCHED; PG8_LDA(At, 0, 0); PG8_STAGE(PG8_SA(1, 1), a1 + hstepA, voffA);
            PG8_WAIT_V(8); PG8_WAIT_L(0); PG8_BAR; PG8_MMA(0, 0, At, B0); PG8_MMA(0, 1, At, B1); PG8_BAR; PG8_SCHED;
            PG8_LDA(At, 0, 1); PG8_STAGE(PG8_SB(0, 0), b2, voffB); PG8_STAGE(PG8_SB(0, 1), b2 + hstepB, voffB); PG8_STAGE(PG8_SA(0, 0), a2, voffA);
            PG8_WAIT_V(8); PG8_WAIT_L(0); PG8_BAR; PG8_MMA(1, 0, At, B0); PG8_MMA(1, 1, At, B1); PG8_BAR; PG8_SCHED;
            PG8_LDB(B0, 1, 0); PG8_LDB(B1, 1, 1); PG8_SCHED; PG8_LDA(At, 1, 0); PG8_STAGE(PG8_SA(0, 1), a2 + hstepA, voffA);
            PG8_WAIT_V(8); PG8_WAIT_L(0); PG8_BAR; PG8_MMA(0, 0, At, B0); PG8_MMA(0, 1, At, B1); PG8_BAR; PG8_SCHED;
            PG8_LDA(At, 1, 1); PG8_STAGE(PG8_SB(1, 0), b3, voffB); PG8_STAGE(PG8_SB(1, 1), b3 + hstepB, voffB); PG8_STAGE(PG8_SA(1, 0), a3, voffA);
            PG8_WAIT_V(8); PG8_WAIT_L(0); PG8_BAR; PG8_MMA(1, 0, At, B0); PG8_MMA(1, 1, At, B1); PG8_BAR; PG8_SCHED;
        }
        if constexpr (ALIGN_EPI) { if (wr == 0) PG8_BAR; }
        if constexpr (!Epi::AFTER_DRAIN) { int fr2 = fr, fq2 = fq; asm volatile("" : "+v"(fr2), "+v"(fq2)); E(acc, cur, wr, wc, fr2, fq2); }
        if (!has_next) break;
#pragma unroll
        for (int a = 0; a < 2; ++a)
#pragma unroll
            for (int b = 0; b < 2; ++b)
#pragma unroll
                for (int m = 0; m < 4; ++m)
#pragma unroll
                    for (int n = 0; n < 2; ++n) acc[a][b][m][n] = (f32x4){0.f, 0.f, 0.f, 0.f};
        cur = nxt; cA = nA; cB = nB; ++ui;
        if constexpr (ALIGN_EPI) { if (wr == 1) PG8_BAR; }
    }
    PG8_WAIT_V(0);
    if constexpr (!ALIGN_EPI) { if (wr == 0) PG8_BAR; }
    PG8_BAR;
    if constexpr (Epi::AFTER_DRAIN) { int fr2 = fr, fq2 = fq; asm volatile("" : "+v"(fr2), "+v"(fq2)); E.fused(acc, cur, wr, wc, fr2, fq2, lds, wid, lane); }
#undef PG8_SA
#undef PG8_SB
#undef PG8_STAGE
#undef PG8_LDA
#undef PG8_LDB
#undef PG8_MMA
#undef PG8_WAIT_V
#undef PG8_WAIT_L
#undef PG8_BAR
#undef PG8_SCHED
}
struct UnitG { const char* a; const char* b; int lda, ldb, nt, kind, perm; };
template <class Epi, class Sched, bool ALIGN_EPI>
__device__ __forceinline__ void gemm_stream(PG8_LAS unsigned char* lds, const Sched& S, const Epi& E) {
    int tid_ = threadIdx.x; asm volatile("" : "+v"(tid_));
    const int tid = tid_, wid = __builtin_amdgcn_readfirstlane(tid >> 6), lane = tid & 63, wr = wid >> 2, wc = wid & 3, fr = lane & 15, fq = lane >> 4;
#define PG8_VOFF(u, vA, vB) do { _Pragma("unroll") for (int i_ = 0; i_ < 2; ++i_) { int R_, C_; stage_rc(tid * 16 + i_ * 8192, R_, C_); const int Rb_ = (u).perm ? ((R_ & ~31) + perm32(R_ & 31)) : R_; \
        vA[i_] = (unsigned)(R_ * (u).lda + C_) * 2u; vB[i_] = (unsigned)(Rb_ * (u).ldb + C_) * 2u; } } while (0)
    const size_t kstep = (size_t)(BK * 2);
    const unsigned ldsw = (unsigned)wid * 1024u;
    const int aoff = lds_byte(wr * 64 + fr, fq * 8), boff = lds_byte(wc * 32 + fr, fq * 8);
#undef PG8_SA
#undef PG8_SB
#undef PG8_STAGE
#undef PG8_LDA
#undef PG8_LDB
#undef PG8_MMA
#undef PG8_WAIT_V
#undef PG8_WAIT_L
#undef PG8_BAR
#undef PG8_SCHED
#define PG8_SA(b, h) (((b) * 2 + (h)) * HTB)
#define PG8_SB(b, h) ((4 + (b) * 2 + (h)) * HTB)
#define PG8_STAGE(bufoff, gbase, voff) do { _Pragma("unroll") for (int _i = 0; _i < 2; ++_i) \
        __builtin_amdgcn_global_load_lds((const unsigned*)((const char*)(gbase) + (voff)[_i]), (PG8_LAS unsigned*)(lds + (bufoff) + ldsw + _i * 8192), 16, 0, 0); } while (0)
#define PG8_LDA(dst, b, h) do { _Pragma("unroll") for (int m = 0; m < 4; ++m) _Pragma("unroll") for (int k = 0; k < 2; ++k) dst[m][k] = *(const PG8_LAS bf16x8*)(lds + PG8_SA(b, h) + aoff + m * 2048 + k * 1024); } while (0)
#define PG8_LDB(dst, b, h) do { _Pragma("unroll") for (int n = 0; n < 2; ++n) _Pragma("unroll") for (int k = 0; k < 2; ++k) dst[n][k] = *(const PG8_LAS bf16x8*)(lds + PG8_SB(b, h) + boff + n * 2048 + k * 1024); } while (0)
#define PG8_MMA(ai, bj, At, Bt) do { __builtin_amdgcn_s_setprio(1); _Pragma("unroll") for (int m = 0; m < 4; ++m) _Pragma("unroll") for (int n = 0; n < 2; ++n) _Pragma("unroll") for (int k = 0; k < 2; ++k) \
        acc[ai][bj][m][n] = __builtin_amdgcn_mfma_f32_16x16x32_bf16(Bt[n][k], At[m][k], acc[ai][bj][m][n], 0, 0, 0); __builtin_amdgcn_s_setprio(0); } while (0)
#define PG8_WAIT_V(n) asm volatile("s_waitcnt vmcnt(" #n ")" ::: "memory")
#define PG8_WAIT_L(n) asm volatile("s_waitcnt lgkmcnt(" #n ")" ::: "memory")
#define PG8_BAR __builtin_amdgcn_s_barrier()
#define PG8_SCHED __builtin_amdgcn_sched_barrier(0)
    UnitG cur, nxt; int ui = 0;
    if (!S.next(0, cur)) return;
    unsigned voffA[2], voffB[2]; PG8_VOFF(cur, voffA, voffB);
    size_t hstepA = (size_t)HALF * cur.lda * 2, hstepB = (size_t)HALF * cur.ldb * 2;
    f32x4 acc[2][2][4][2];
#pragma unroll
    for (int a = 0; a < 2; ++a)
#pragma unroll
        for (int b = 0; b < 2; ++b)
#pragma unroll
            for (int m = 0; m < 4; ++m)
#pragma unroll
                for (int n = 0; n < 2; ++n) acc[a][b][m][n] = (f32x4){0.f, 0.f, 0.f, 0.f};
    bf16x8 At[4][2], B0[2][2], B1[2][2];
    const char* cA = cur.a; const char* cB = cur.b;
    PG8_STAGE(PG8_SB(0, 0), cB, voffB); PG8_STAGE(PG8_SB(0, 1), cB + hstepB, voffB); PG8_STAGE(PG8_SA(0, 0), cA, voffA); PG8_STAGE(PG8_SA(0, 1), cA + hstepA, voffA);
    if (wr == 1) PG8_BAR;
    PG8_WAIT_V(2); PG8_BAR;
    PG8_STAGE(PG8_SB(1, 0), cB + kstep, voffB); PG8_STAGE(PG8_SA(1, 0), cA + kstep, voffA); PG8_STAGE(PG8_SB(1, 1), cB + hstepB + kstep, voffB);
    PG8_WAIT_V(6); PG8_BAR;
    for (;;) {
        const bool has_next = S.next(ui + 1, nxt); const int nt = cur.nt; if (!has_next) nxt = cur;
        const char* nA = nxt.a; const char* nB = nxt.b;
        const size_t nhA = (size_t)HALF * nxt.lda * 2, nhB = (size_t)HALF * nxt.ldb * 2;
        for (int t = 0; t < nt; t += 2) {
            const bool last = (t == nt - 2);
            const char* a1 = cA + (size_t)(t + 1) * kstep;
            const char* a2 = last ? nA : cA + (size_t)(t + 2) * kstep; const char* b2 = last ? nB : cB + (size_t)(t + 2) * kstep;
            const char* a3 = a2 + kstep; const char* b3 = b2 + kstep;
            unsigned xvA[2], xvB[2]; if (last) { PG8_VOFF(nxt, xvA, xvB); } else { xvA[0] = voffA[0]; xvA[1] = voffA[1]; xvB[0] = voffB[0]; xvB[1] = voffB[1]; }
            const size_t xhA = last ? nhA : hstepA, xhB = last ? nhB : hstepB;
            PG8_LDB(B0, 0, 0); PG8_LDB(B1, 0, 1); PG8_SCHED; PG8_LDA(At, 0, 0); PG8_STAGE(PG8_SA(1, 1), a1 + hstepA, voffA);
            PG8_WAIT_V(8); PG8_WAIT_L(0); PG8_BAR; PG8_MMA(0, 0, At, B0); PG8_MMA(0, 1, At, B1); PG8_BAR; PG8_SCHED;
            PG8_LDA(At, 0, 1); PG8_STAGE(PG8_SB(0, 0), b2, xvB); PG8_STAGE(PG8_SB(0, 1), b2 + xhB, xvB); PG8_STAGE(PG8_SA(0, 0), a2, xvA);
            PG8_WAIT_V(8); PG8_WAIT_L(0); PG8_BAR; PG8_MMA(1, 0, At, B0); PG8_MMA(1, 1, At, B1); PG8_BAR; PG8_SCHED;
            PG8_LDB(B0, 1, 0); PG8_LDB(B1, 1, 1); PG8_SCHED; PG8_LDA(At, 1, 0); PG8_STAGE(PG8_SA(0, 1), a2 + xhA, xvA);
            PG8_WAIT_V(8); PG8_WAIT_L(0); PG8_BAR; PG8_MMA(0, 0, At, B0); PG8_MMA(0, 1, At, B1); PG8_BAR; PG8_SCHED;
            PG8_LDA(At, 1, 1); PG8_STAGE(PG8_SB(1, 0), b3, xvB); PG8_STAGE(PG8_SB(1, 1), b3 + xhB, xvB); PG8_STAGE(PG8_SA(1, 0), a3, xvA);
            PG8_WAIT_V(8); PG8_WAIT_L(0); PG8_BAR; PG8_MMA(1, 0, At, B0); PG8_MMA(1, 1, At, B1); PG8_BAR; PG8_SCHED;
        }
        if constexpr (ALIGN_EPI) { if (wr == 0) PG8_BAR; }
        if (!E.after_drain(cur)) { int fr2 = fr, fq2 = fq; asm volatile("" : "+v"(fr2), "+v"(fq2)); E(acc, cur, wr, wc, fr2, fq2); }
        if (!has_next) break;
#pragma unroll
        for (int a = 0; a < 2; ++a)
#pragma unroll
            for (int b = 0; b < 2; ++b)
#pragma unroll
                for (int m = 0; m < 4; ++m)
#pragma unroll
                    for (int n = 0; n < 2; ++n) acc[a][b][m][n] = (f32x4){0.f, 0.f, 0.f, 0.f};
        cur = nxt; cA = nA; cB = nB; ++ui; PG8_VOFF(cur, voffA, voffB); hstepA = nhA; hstepB = nhB;
        if constexpr (ALIGN_EPI) { if (wr == 1) PG8_BAR; }
    }
    PG8_WAIT_V(0);
    if constexpr (!ALIGN_EPI) { if (wr == 0) PG8_BAR; }
    PG8_BAR;
    if (E.after_drain(cur)) { int fr2 = fr, fq2 = fq; asm volatile("" : "+v"(fr2), "+v"(fq2)); E.fused(acc, cur, wr, wc, fr2, fq2, lds, wid, lane); }
#undef PG8_SA
#undef PG8_SB
#undef PG8_STAGE
#undef PG8_LDA
#undef PG8_LDB
#undef PG8_MMA
#undef PG8_WAIT_V
#undef PG8_WAIT_L
#undef PG8_BAR
#undef PG8_SCHED
#undef PG8_VOFF
}
}

namespace mk {
using pg8::bf16_t; using pg8::f32x4; using pg8::f32x2; using pg8::u32x4; using pg8::u32x2; using pg8::Unit;
constexpr int D = 2048, BATCH = 2, SEQ = 4096, M = BATCH * SEQ, D_IN = 16384, D_FF = 8192, N_MEM = 256;
constexpr float EPS = 1e-6f, LOG2E = 1.4426950408889634f;
constexpr size_t MiB = 1u << 20;
constexpr size_t WS_CTL = 0, CTL_ZERO_BYTES = 1 * MiB;
constexpr size_t WS_COS = 1 * MiB, WS_SIN = 2 * MiB;
constexpr size_t WS_SSQ_NAQ = 3 * MiB, WS_SSQ_NAK = 4 * MiB;
constexpr size_t WS_SSQ_XQ = 5 * MiB, WS_XL = 5 * MiB + 512 * 1024;
constexpr size_t WS_SSQ_X1 = 6 * MiB;
constexpr size_t WS_TAB = 6 * MiB + 512 * 1024;
constexpr int TAB_CS_NAQ = 0, TAB_CS_MK = 128, TAB_L2F = 384, TAB_L2B = 392, TAB_SSQ_MK = 1024;
constexpr size_t WS_MEMN = 8 * MiB, WS_MK = 10 * MiB, WS_MVT = 11 * MiB;
constexpr size_t WS_WIN = 16 * MiB, WS_WFF1 = 80 * MiB, WS_WFF2 = 112 * MiB, WS_WRET = 144 * MiB, WS_WOUT = 152 * MiB, WS_WNM = 160 * MiB  , WS_WMKV = 168 * MiB;
constexpr size_t WS_NAQKV = 176 * MiB, WS_K0 = 224 * MiB, WS_RG = 240 * MiB, WS_XQ = 272 * MiB, WS_GATES = 288 * MiB;
constexpr size_t WS_AR = 384 * MiB, WS_BR = 448 * MiB, WS_END = 512 * MiB;
constexpr size_t WS_KV = WS_WIN;
constexpr size_t WS_ORET = 16 * MiB;
constexpr size_t WS_MERGED = WS_NAQKV;
constexpr size_t WS_X1B = WS_AR;
constexpr size_t WS_HFF = 176 * MiB;
constexpr int LDH = 8192;
constexpr size_t DO_HN = 0, DO_KT = 0, DO_XP = 32 * MiB, DO_ONM = 0;

struct SchedGrid {
    pg8::GridOrder o; const char* A; const char* B; size_t ta, tb;
    __device__ __forceinline__ bool next(int i, Unit& u) const { return o.next(i, u); }
    __device__ __forceinline__ void ptrs(const Unit& u, const char*& a, const char*& b) const { a = A + (size_t)u.pm * ta; b = B + (size_t)u.pn * tb; }
    __device__ __forceinline__ int nt(const Unit&, int K) const { return K / 64; }
};
struct SchedProj {
    pg8::GridOrder o; const char* hn_; const char* wt_;
    __device__ __forceinline__ bool next(int i, Unit& u) const { return o.next(i, u); }
    __device__ __forceinline__ void ptrs(const Unit& u, const char*& a, const char*& b) const {
        const char* h = hn_ + (size_t)u.pm * (256u * 2048u * 2u); const char* w = wt_ + (size_t)u.pn * (256u * 2048u * 2u);
        const bool sw = (u.pn >= 20 && u.pn < 28); a = sw ? w : h; b = sw ? h : w; }
    __device__ __forceinline__ int nt(const Unit&, int K) const { return K / 64; }
};
struct SchedOne { bool has; Unit u; const char* a; const char* b;
    __device__ __forceinline__ bool next(int i, Unit& uu) const { if (i != 0 || !has) return false; uu = u; return true; }
    __device__ __forceinline__ void ptrs(const Unit&, const char*& aa, const char*& bb) const { aa = a; bb = b; }
    __device__ __forceinline__ int nt(const Unit&, int K) const { return K / 64; }
};

#define MK_ROWS_BEGIN _Pragma("unroll") for (int ai = 0; ai < 2; ++ai) { _Pragma("unroll") for (int m = 0; m < 4; ++m) { const int rl = ai * 128 + wr * 64 + m * 16 + fr;
#define MK_ROWS_END } }
#define MK_ROWS_END_NB } }
__device__ __forceinline__ float sq8(const f32x4& a, const f32x4& b) { return (a[0] * a[0] + a[1] * a[1]) + (a[2] * a[2] + a[3] * a[3]) + (b[0] * b[0] + b[1] * b[1]) + (b[2] * b[2] + b[3] * b[3]); }
__device__ __forceinline__ float red_fq(float s) {
    { auto r = __builtin_amdgcn_permlane16_swap(__float_as_uint(s), __float_as_uint(s), false, false); s = __uint_as_float(r[0]) + __uint_as_float(r[1]); }
    { auto r = __builtin_amdgcn_permlane32_swap(__float_as_uint(s), __float_as_uint(s), false, false); s = __uint_as_float(r[0]) + __uint_as_float(r[1]); }
    return s; }

struct EpiProj {
    static constexpr bool PERM = true, AFTER_DRAIN = false;
    unsigned char* ws;
    __device__ __forceinline__ void operator()(const f32x4 (&acc)[2][2][4][2], const Unit& u, int wr, int wc, int fr, int fq) const {
        bf16_t* const naqkv = (bf16_t*)(ws + WS_NAQKV); bf16_t* const k0 = (bf16_t*)(ws + WS_K0); bf16_t* const rg = (bf16_t*)(ws + WS_RG); bf16_t* const xq = (bf16_t*)(ws + WS_XQ);
        bf16_t* const gates = (bf16_t*)(ws + WS_GATES); bf16_t* const ar = (bf16_t*)(ws + WS_AR); bf16_t* const br = (bf16_t*)(ws + WS_BR);
        float* const ssq_naq = (float*)(ws + WS_SSQ_NAQ); float* const ssq_nak = (float*)(ws + WS_SSQ_NAK); float* const ssq_xq = (float*)(ws + WS_SSQ_XQ);
        const float* const cosT = (const float*)(ws + WS_COS); const float* const sinT = (const float*)(ws + WS_SIN); const float* const tab = (const float*)(ws + WS_TAB);
        const int pn = u.pn, row0 = u.pm * 256, cw = wc * 32 + 8 * fq;
        if (pn < 8) {
            const bool isq = pn < 4; float* ssq = isq ? ssq_naq : ssq_nak; const int hb = isq ? 2 * pn : 2 * (pn - 4);
            f32x4 c0 = (f32x4){1.f, 1.f, 1.f, 1.f}, c1 = c0; if (isq) { c0 = *(const f32x4*)(tab + TAB_CS_NAQ + cw); c1 = *(const f32x4*)(tab + TAB_CS_NAQ + cw + 4); }
            MK_ROWS_BEGIN  const int row = row0 + rl;
#pragma unroll
                for (int bj = 0; bj < 2; ++bj) { const f32x4 v0 = acc[ai][bj][m][0], v1 = acc[ai][bj][m][1]; const float q = red_fq(sq8(v0, v1));
                    if (fq == 0) ssq[(size_t)row * 32 + (hb + bj) * 4 + wc] = q;
                    pg8::store8(naqkv + (size_t)row * 3072 + pn * 256 + bj * 128 + cw, v0 * c0, v1 * c1); }  MK_ROWS_END
        } else if (pn < 12) {
            MK_ROWS_BEGIN  const int row = row0 + rl;
#pragma unroll
                for (int bj = 0; bj < 2; ++bj) pg8::store8(naqkv + (size_t)row * 3072 + pn * 256 + bj * 128 + cw, acc[ai][bj][m][0], acc[ai][bj][m][1]);  MK_ROWS_END
        } else if (pn < 20) {
            const bool isq = pn < 16; const int head = 2 * (pn & 3) + (wc >> 1), i0 = 32 * (wc & 1) + 8 * fq;
            const float l2f = tab[TAB_L2F + head], l2b = tab[TAB_L2B + head];
            MK_ROWS_BEGIN  const int row = row0 + rl, s = row & 4095, b = row >> 12;
                const f32x4 cs0 = *(const f32x4*)(cosT + s * 64 + i0), cs1 = *(const f32x4*)(cosT + s * 64 + i0 + 4), sn0 = *(const f32x4*)(sinT + s * 64 + i0), sn1 = *(const f32x4*)(sinT + s * 64 + i0 + 4);
                const f32x4 a0 = acc[ai][0][m][0], a1 = acc[ai][0][m][1], b0 = acc[ai][1][m][0], b1 = acc[ai][1][m][1];
                const f32x4 lo0 = a0 * cs0 - b0 * sn0, lo1 = a1 * cs1 - b1 * sn1, hi0 = a0 * sn0 + b0 * cs0, hi1 = a1 * sn1 + b1 * cs1;
                if (isq) { const int c = row & 255; const float df = pg8::fexp2(l2f * (float)(c + 1)), db = pg8::fexp2(l2b * (float)(256 - c));
                    bf16_t* d = ar + ((size_t)(b * 8 + head) * 4096 + s) * 512 + 256 + i0;
                    pg8::store8(d, lo0 * df, lo1 * df); pg8::store8(d + 64, hi0 * df, hi1 * df); pg8::store8(d + 128, lo0 * db, lo1 * db); pg8::store8(d + 192, hi0 * db, hi1 * db);
                } else { const float sc = 0.08838834764831845f; bf16_t* d = k0 + (size_t)row * 1024 + head * 128 + i0;
                    pg8::store8(d, lo0 * sc, lo1 * sc); pg8::store8(d + 64, hi0 * sc, hi1 * sc); }  MK_ROWS_END
        } else if (pn < 28) {
            const int hv = pn - 20, b = u.pm >> 4, nc = u.pm & 15;
            bf16_t* base = br + ((size_t)((b * 8 + hv) * 16 + nc) * 256) * 512;
            MK_ROWS_BEGIN
#pragma unroll
                for (int bj = 0; bj < 2; ++bj) pg8::store8(base + (size_t)rl * 512 + bj * 128 + cw, acc[ai][bj][m][0], acc[ai][bj][m][1]);  MK_ROWS_END
        } else if (pn < 36) {
            MK_ROWS_BEGIN  const int row = row0 + rl;
#pragma unroll
                for (int bj = 0; bj < 2; ++bj) { f32x4 v0 = acc[ai][bj][m][0], v1 = acc[ai][bj][m][1];
#pragma unroll
                    for (int e = 0; e < 4; ++e) { v0[e] = v0[e] * pg8::sigmoidf_(v0[e]); v1[e] = v1[e] * pg8::sigmoidf_(v1[e]); }
                    pg8::store8(rg + (size_t)row * 2048 + (pn - 28) * 256 + bj * 128 + cw, v0, v1); }  MK_ROWS_END
        } else if (pn < 40) {
            MK_ROWS_BEGIN  const int row = row0 + rl;
                const float q = red_fq(sq8(acc[ai][0][m][0], acc[ai][0][m][1]) + sq8(acc[ai][1][m][0], acc[ai][1][m][1]));
                if (fq == 0) ssq_xq[(size_t)row * 16 + (pn - 36) * 4 + wc] = q;
#pragma unroll
                for (int bj = 0; bj < 2; ++bj) pg8::store8(xq + (size_t)row * 1024 + (pn - 36) * 256 + bj * 128 + cw, acc[ai][bj][m][0], acc[ai][bj][m][1]);  MK_ROWS_END
        } else {
            MK_ROWS_BEGIN  const int row = row0 + rl;
#pragma unroll
                for (int bj = 0; bj < 2; ++bj) { f32x4 v0 = acc[ai][bj][m][0], v1 = acc[ai][bj][m][1];
#pragma unroll
                    for (int e = 0; e < 4; ++e) { v0[e] = pg8::sigmoidf_(v0[e]); v1[e] = pg8::sigmoidf_(v1[e]); }
                    pg8::store8(gates + (size_t)row * 6144 + (pn - 40) * 256 + bj * 128 + cw, v0, v1); }  MK_ROWS_END
        }
    }
};
struct EpiMKV {
    static constexpr bool PERM = true, AFTER_DRAIN = false;
    bf16_t *mk, *mvt; float* tabw; const float* tab; int mode;
    __device__ __forceinline__ void operator()(const f32x4 (&acc)[2][2][4][2], const Unit& u, int wr, int wc, int fr, int fq) const {
        const int cw = wc * 32 + 8 * fq, row0 = u.pm * 256;
        if (mode == 0) {
            MK_ROWS_BEGIN  const int row = row0 + rl;
                const float q = red_fq(sq8(acc[ai][0][m][0], acc[ai][0][m][1]) + sq8(acc[ai][1][m][0], acc[ai][1][m][1]));
                if (fq == 0) tabw[TAB_SSQ_MK + row * 16 + u.pn * 4 + wc] = q;
#pragma unroll
                for (int bj = 0; bj < 2; ++bj) { const f32x4 c0 = *(const f32x4*)(tab + TAB_CS_MK + bj * 128 + cw), c1 = *(const f32x4*)(tab + TAB_CS_MK + bj * 128 + cw + 4);
                    pg8::store8(mk + (size_t)row * 1024 + u.pn * 256 + bj * 128 + cw, acc[ai][bj][m][0] * c0, acc[ai][bj][m][1] * c1); }  MK_ROWS_END
        } else {
            MK_ROWS_BEGIN  const int row = row0 + rl;
#pragma unroll
                for (int bj = 0; bj < 2; ++bj) pg8::store8(mvt + (size_t)row * 512 + u.pn * 256 + bj * 128 + cw, acc[ai][bj][m][0], acc[ai][bj][m][1]);  MK_ROWS_END
        }
    }
};
struct EpiF32 {
    static constexpr bool PERM = false, AFTER_DRAIN = false;
    float* C;
    __device__ __forceinline__ void operator()(const f32x4 (&acc)[2][2][4][2], const Unit&, int wr, int wc, int fr, int fq) const {
        const int col0 = wc * 32 + 4 * fq;
        MK_ROWS_BEGIN  float* rowp = C + (size_t)rl * 256 + col0;
#pragma unroll
            for (int bj = 0; bj < 2; ++bj)
#pragma unroll
                for (int n = 0; n < 2; ++n) *(f32x4*)(rowp + bj * 128 + n * 16) = acc[ai][bj][m][n];  MK_ROWS_END
    }
};
struct EpiP {
    static constexpr bool PERM = true, AFTER_DRAIN = false;
    bf16_t* P; float l2f, l2b;
    __device__ __forceinline__ void operator()(const f32x4 (&acc)[2][2][4][2], const Unit&, int wr, int wc, int fr, int fq) const {
        const int cw = wc * 32 + 8 * fq;
        MK_ROWS_BEGIN  const int c = rl; const float rowf = -l2f * (float)(c + 1);
#pragma unroll
            for (int bj = 0; bj < 2; ++bj) { f32x4 v[2] = {acc[ai][bj][m][0], acc[ai][bj][m][1]};
#pragma unroll
                for (int n = 0; n < 2; ++n)
#pragma unroll
                    for (int e = 0; e < 4; ++e) { const int cp = bj * 128 + cw + 4 * n + e;
                        const float ex = (c >= cp) ? (-l2f * (float)(cp + 1)) : (l2b * (float)(cp - c) + rowf);
                        v[n][e] *= pg8::fexp2(ex); }
                pg8::store8(P + (size_t)c * 512 + bj * 128 + cw, v[0], v[1]); }  MK_ROWS_END
    }
};
struct EpiGN {
    static constexpr bool PERM = true, AFTER_DRAIN = true;
    bf16_t* oret; const bf16_t* rgv; const float* gn;
    __device__ __forceinline__ void fused(f32x4 (&acc)[2][2][4][2], const Unit&, int wr, int wc, int fr, int fq, PG8_LAS unsigned char* lds, int wid, int lane) const {
        PG8_LAS f32x2* P = (PG8_LAS f32x2*)lds;
        const int cw = wc * 32 + 8 * fq;
        MK_ROWS_BEGIN  float s = 0.f;
#pragma unroll
            for (int bj = 0; bj < 2; ++bj)
#pragma unroll
                for (int n = 0; n < 2; ++n) { const f32x4 x = acc[ai][bj][m][n]; s += (x[0] + x[1]) + (x[2] + x[3]); }
            s = red_fq(s); const float mw = s * (1.0f / 64.0f); float q = 0.f;
#pragma unroll
            for (int bj = 0; bj < 2; ++bj)
#pragma unroll
                for (int n = 0; n < 2; ++n) { const f32x4 d = acc[ai][bj][m][n] - mw; q += (d[0] * d[0] + d[1] * d[1]) + (d[2] * d[2] + d[3] * d[3]); }
            q = red_fq(q);
            if (fq == 0) P[rl * 4 + wc] = (f32x2){mw, q};  MK_ROWS_END
        asm volatile("s_waitcnt lgkmcnt(0)" ::: "memory"); __builtin_amdgcn_s_barrier(); asm volatile("" ::: "memory");
        f32x4 g0[2], g1[2];
#pragma unroll
        for (int bj = 0; bj < 2; ++bj) { g0[bj] = *(const f32x4*)(gn + bj * 128 + cw); g1[bj] = *(const f32x4*)(gn + bj * 128 + cw + 4); }
        MK_ROWS_BEGIN  const f32x2 a = P[rl * 4 + 0], b = P[rl * 4 + 1], c = P[rl * 4 + 2], d = P[rl * 4 + 3];
            const float mt = (a.x + b.x + c.x + d.x) * 0.25f;
            const float da = a.x - mt, db = b.x - mt, dc = c.x - mt, dd = d.x - mt;
            const float m2 = (a.y + b.y) + (c.y + d.y) + 64.0f * ((da * da + db * db) + (dc * dc + dd * dd));
            const float rstd = 1.0f / sqrtf(m2 * (1.0f / 256.0f) + EPS);
#pragma unroll
            for (int bj = 0; bj < 2; ++bj) { f32x4 r0, r1; pg8::load8(rgv + (size_t)rl * 2048 + bj * 128 + cw, r0, r1);
                const f32x4 o0 = (acc[ai][bj][m][0] - mt) * rstd * g0[bj] * r0, o1 = (acc[ai][bj][m][1] - mt) * rstd * g1[bj] * r1;
                pg8::store8(oret + (size_t)rl * 2048 + bj * 128 + cw, o0, o1); }  MK_ROWS_END
        asm volatile("s_waitcnt lgkmcnt(0)" ::: "memory"); __builtin_amdgcn_s_barrier(); asm volatile("" ::: "memory");
    }
};
struct EpiXS {
    static constexpr bool PERM = true, AFTER_DRAIN = false;
    bf16_t* xp; float* xl; const float* ssq_q; const float* ssq_k;
    __device__ __forceinline__ void operator()(const f32x4 (&acc)[2][2][4][2], const Unit&, int wr, int wc, int fr, int fq) const {
        const int cw = wc * 32 + 8 * fq;
        float rk[2][8];
#pragma unroll
        for (int bj = 0; bj < 2; ++bj)
#pragma unroll
            for (int j = 0; j < 8; ++j) { const f32x4 p = *(const f32x4*)(ssq_k + (size_t)(bj * 128 + cw + j) * 16); rk[bj][j] = rsqrtf(((p[0] + p[1]) + (p[2] + p[3])) * (1.0f / 256.0f) + EPS) * LOG2E; }
        MK_ROWS_BEGIN  const f32x4 pq = *(const f32x4*)(ssq_q + (size_t)rl * 16); const float rq = rsqrtf(((pq[0] + pq[1]) + (pq[2] + pq[3])) * (1.0f / 256.0f) + EPS);
            float s = 0.f;
#pragma unroll
            for (int bj = 0; bj < 2; ++bj) { f32x4 v[2] = {acc[ai][bj][m][0], acc[ai][bj][m][1]};
#pragma unroll
                for (int n = 0; n < 2; ++n)
#pragma unroll
                    for (int e = 0; e < 4; ++e) { v[n][e] = pg8::fexp2(v[n][e] * rq * rk[bj][4 * n + e]); s += v[n][e]; }
                pg8::store8(xp + (size_t)rl * 1024 + bj * 128 + cw, v[0], v[1]); }
            s = red_fq(s); if (fq == 0) xl[(size_t)rl * 16 + wc] = s;  MK_ROWS_END
    }
};
struct EpiXO {
    static constexpr bool PERM = true, AFTER_DRAIN = false;
    bf16_t* omem; const float* xl;
    __device__ __forceinline__ void operator()(const f32x4 (&acc)[2][2][4][2], const Unit&, int wr, int wc, int fr, int fq) const {
        const int cw = wc * 32 + 8 * fq;
        MK_ROWS_BEGIN  const f32x4 p = *(const f32x4*)(xl + (size_t)rl * 16); const float il = pg8::frcp((p[0] + p[1]) + (p[2] + p[3]));
#pragma unroll
            for (int bj = 0; bj < 2; ++bj) pg8::store8(omem + (size_t)rl * 2048 + bj * 128 + cw, acc[ai][bj][m][0] * il, acc[ai][bj][m][1] * il);  MK_ROWS_END
    }
};
struct EpiGate4 {
    static constexpr bool PERM = true, AFTER_DRAIN = false;
    bf16_t* merged; const bf16_t* gates;
    __device__ __forceinline__ void operator()(const f32x4 (&acc)[2][2][4][2], const Unit& u, int wr, int wc, int fr, int fq) const {
        const int cw = wc * 32 + 8 * fq; const bf16_t* gate = gates + u.sub * 2048; const bool first = u.sub == 0;
        MK_ROWS_BEGIN  const size_t row = (size_t)u.pm * 256 + rl;
#pragma unroll
            for (int bj = 0; bj < 2; ++bj) { const int col = u.pn * 256 + bj * 128 + cw; f32x4 g0, g1; pg8::load8(gate + row * 6144 + col, g0, g1);
                f32x4 v0 = acc[ai][bj][m][0] * g0, v1 = acc[ai][bj][m][1] * g1;
                if (!first) { f32x4 t0, t1; pg8::load8_l2(merged + row * 2048 + col, t0, t1); v0 += t0; v1 += t1; }
                pg8::store8(merged + row * 2048 + col, v0, v1); }  MK_ROWS_END_NB
    }
};
struct SchedBR {
    pg8::GridOrder o; const char* onm; const char* oret; const char* wnm; const char* wret;
    __device__ __forceinline__ bool next(int i, Unit& u) const { if (i >= 3) return false; const bool ok = o.next(0, u); u.sub = i; return ok; }
    __device__ __forceinline__ void ptrs(const Unit& u, const char*& a, const char*& b) const {
        const size_t ra = (size_t)u.pm * (256u * 2048u * 2u), rb = (size_t)u.pn * (256u * 2048u * 2u);
        const bool nm = (u.sub != 1); const size_t co = (u.sub == 2) ? 2048u : 0u;
        a = (nm ? onm : oret) + ra + co; b = (nm ? wnm : wret) + rb + co; }
    __device__ __forceinline__ int nt(const Unit& u, int) const { return u.sub == 1 ? 32 : 16; }
};
struct EpiWout {
    static constexpr bool PERM = false, AFTER_DRAIN = true;
    const float* x; float* x1; bf16_t* x1b; float* ssq; const float* gffn;
    __device__ __forceinline__ void fused(f32x4 (&acc)[2][2][4][2], const Unit& u, int wr, int wc, int fr, int fq, PG8_LAS unsigned char* lds, int wid, int lane) const {
        PG8_LAS float* P = (PG8_LAS float*)lds;
        const int col0 = u.pn * 256 + wc * 32 + 4 * fq;
        MK_ROWS_BEGIN  const size_t off = ((size_t)u.pm * 256 + rl) * 2048 + col0; float q = 0.f;
#pragma unroll
            for (int bj = 0; bj < 2; ++bj)
#pragma unroll
                for (int n = 0; n < 2; ++n) { const f32x4 v = *(const f32x4*)(x + off + bj * 128 + n * 16) + acc[ai][bj][m][n];
                    *(f32x4*)(x1 + off + bj * 128 + n * 16) = v; pg8::store4(x1b + off + bj * 128 + n * 16, v * *(const f32x4*)(gffn + col0 + bj * 128 + n * 16)); q += (v[0] * v[0] + v[1] * v[1]) + (v[2] * v[2] + v[3] * v[3]); }
            q = red_fq(q); if (fq == 0) P[rl * 4 + wc] = q;  MK_ROWS_END
        asm volatile("s_waitcnt lgkmcnt(0)" ::: "memory"); __builtin_amdgcn_s_barrier(); asm volatile("" ::: "memory");
        if (threadIdx.x < 256) { const int r = threadIdx.x; const f32x4 p = *(const PG8_LAS f32x4*)(P + r * 4); ssq[((size_t)u.pm * 256 + r) * 8 + u.pn] = (p[0] + p[1]) + (p[2] + p[3]); }
        asm volatile("s_waitcnt lgkmcnt(0)" ::: "memory"); __builtin_amdgcn_s_barrier(); asm volatile("" ::: "memory");
    }
};
struct EpiFF1 {
    static constexpr bool PERM = true, AFTER_DRAIN = false;
    bf16_t* hff; const float* ssq;
    __device__ __forceinline__ void operator()(const f32x4 (&acc)[2][2][4][2], const Unit& u, int wr, int wc, int fr, int fq) const {
        const int cw = wc * 32 + 8 * fq;
        MK_ROWS_BEGIN  const size_t row = (size_t)u.pm * 256 + rl; const f32x4 p0 = *(const f32x4*)(ssq + row * 8), p1 = *(const f32x4*)(ssq + row * 8 + 4);
            const float r = rsqrtf((((p0[0] + p0[1]) + (p0[2] + p0[3])) + ((p1[0] + p1[1]) + (p1[2] + p1[3]))) * (1.0f / 2048.0f) + EPS);
#pragma unroll
            for (int bj = 0; bj < 2; ++bj) { f32x4 v0 = acc[ai][bj][m][0] * r, v1 = acc[ai][bj][m][1] * r;
#pragma unroll
                for (int e = 0; e < 4; ++e) { const float a = fmaxf(v0[e], 0.f), b = fmaxf(v1[e], 0.f); v0[e] = a * a; v1[e] = b * b; }
                pg8::store8(hff + row * LDH + u.pn * 256 + bj * 128 + cw, v0, v1); }  MK_ROWS_END
    }
};
struct EpiFF2 {
    static constexpr bool PERM = false, AFTER_DRAIN = false;
    const float* src; float* out;
    __device__ __forceinline__ void operator()(const f32x4 (&acc)[2][2][4][2], const Unit& u, int wr, int wc, int fr, int fq) const {
        const int col0 = u.pn * 256 + wc * 32 + 4 * fq;
        MK_ROWS_BEGIN  const size_t off = ((size_t)u.pm * 256 + rl) * 2048 + col0;
#pragma unroll
            for (int bj = 0; bj < 2; ++bj)
#pragma unroll
                for (int n = 0; n < 2; ++n) { const size_t o2 = off + bj * 128 + n * 16; *(f32x4*)(out + o2) = *(const f32x4*)(src + o2) + acc[ai][bj][m][n]; }  MK_ROWS_END
    }
};

struct SchedList3 {
    pg8::UnitG u0, u1, u2; int n;
    __device__ __forceinline__ bool next(int i, pg8::UnitG& u) const { if (i >= n) return false;
        u.a = (i == 0) ? u0.a : ((i == 1) ? u1.a : u2.a); u.b = (i == 0) ? u0.b : ((i == 1) ? u1.b : u2.b);
        u.lda = (i == 0) ? u0.lda : ((i == 1) ? u1.lda : u2.lda); u.ldb = (i == 0) ? u0.ldb : ((i == 1) ? u1.ldb : u2.ldb);
        u.nt = (i == 0) ? u0.nt : ((i == 1) ? u1.nt : u2.nt); u.kind = (i == 0) ? u0.kind : ((i == 1) ? u1.kind : u2.kind); u.perm = (i == 0) ? u0.perm : ((i == 1) ? u1.perm : u2.perm);
        return true; }
};
struct EpiM1 {
    EpiF32 e0; EpiP e1; EpiXS e2;
    __device__ __forceinline__ bool after_drain(const pg8::UnitG&) const { return false; }
    __device__ __forceinline__ void operator()(const f32x4 (&acc)[2][2][4][2], const pg8::UnitG& u, int wr, int wc, int fr, int fq) const {
        Unit d; d.pm = 0; d.pn = 0; d.sub = 0;
        if (u.kind == 0) e0(acc, d, wr, wc, fr, fq); else if (u.kind == 1) e1(acc, d, wr, wc, fr, fq); else e2(acc, d, wr, wc, fr, fq); }
    __device__ __forceinline__ void fused(f32x4 (&)[2][2][4][2], const pg8::UnitG&, int, int, int, int, PG8_LAS unsigned char*, int, int) const {}
};
struct EpiM3 {
    EpiXO e0; EpiGN e1;
    __device__ __forceinline__ bool after_drain(const pg8::UnitG& u) const { return u.kind == 1; }
    __device__ __forceinline__ void operator()(const f32x4 (&acc)[2][2][4][2], const pg8::UnitG& u, int wr, int wc, int fr, int fq) const { Unit d; d.pm = 0; d.pn = 0; d.sub = 0; e0(acc, d, wr, wc, fr, fq); }
    __device__ __forceinline__ void fused(f32x4 (&acc)[2][2][4][2], const pg8::UnitG&, int wr, int wc, int fr, int fq, PG8_LAS unsigned char* lds, int wid, int lane) const {
        Unit d; d.pm = 0; d.pn = 0; d.sub = 0; e1.fused(acc, d, wr, wc, fr, fq, lds, wid, lane); }
};
#undef MK_ROWS_BEGIN
#undef MK_ROWS_END
#undef MK_ROWS_END_NB
}

namespace na {
using bf16 = unsigned short;
using bf16x8 = __attribute__((ext_vector_type(8))) short;
using s16x4  = __attribute__((ext_vector_type(4))) short;
using f32x16 = __attribute__((ext_vector_type(16))) float;
using f32x4  = __attribute__((ext_vector_type(4))) float;
using u32x4  = __attribute__((ext_vector_type(4))) unsigned;
constexpr int DH = 128, NW = 8, QBLK = 32, KVBLK = 64, LDQ = 3072;
constexpr size_t SHM_V = KVBLK * DH * 2, SHM_K = KVBLK * DH * 2;
constexpr int OFF_RK = 2 * SHM_V + 2 * SHM_K;
constexpr int OFF_BIAS = OFF_RK + 768 * 4;
constexpr int BIAS_PAD = 64, BIAS_N = 64 + 15 * 31 + 79;
constexpr int OFF_LI = OFF_BIAS + ((BIAS_N * 4 + 15) / 16) * 16;
constexpr int NA_LDS_BYTES = OFF_LI + NW * 64 * 4;
#define KSWZ(row, colB) ((row) * 256 + ((colB) ^ (((row) & 7) << 4)))
#define SBAR() __builtin_amdgcn_sched_barrier(0)
__device__ __forceinline__ int crow(int r, int hi) { return (r & 3) + 8 * (r >> 2) + 4 * hi; }
__device__ __forceinline__ unsigned cvtpk(float lo, float hi) { return pg8::cvt_pk_bf16(lo, hi); }

__device__ __forceinline__ void procP(f32x16& p0, f32x16& p1, float& lsum, bool inwin, const float* rk_t  , const float* bias_l  ,
                                      float rqs, int cs, int hi) {
  if (!inwin) { p0 = f32x16{}; p1 = f32x16{}; return; }
#pragma unroll
  for (int g = 0; g < 4; ++g) {
    const f32x4 k0 = *(const f32x4*)(rk_t + 8 * g + 4 * hi), k1 = *(const f32x4*)(rk_t + 32 + 8 * g + 4 * hi);
#pragma unroll
    for (int e = 0; e < 4; ++e) { const int r = 4 * g + e; const int w0 = e + 8 * g + 4 * hi, w1 = w0 + 32;
      const float x0 = fmaf(p0[r], rqs * k0[e], bias_l[w0]), x1 = fmaf(p1[r], rqs * k1[e], bias_l[w1]);
      const float e0 = __builtin_amdgcn_exp2f(x0), e1 = __builtin_amdgcn_exp2f(x1);
      const float v0 = ((unsigned)(w0 - cs) < 16u) ? e0 : 0.f, v1 = ((unsigned)(w1 - cs) < 16u) ? e1 : 0.f;
      p0[r] = v0; p1[r] = v1; lsum += v0 + v1; }
  }
}
__device__ __forceinline__ void packP(const f32x16& p0, const f32x16& p1, bf16x8& pa0, bf16x8& pa1, bf16x8& pa2, bf16x8& pa3) {
#define PK4(P, BASE, OUT) do { unsigned a0 = cvtpk(P[BASE + 0], P[BASE + 1]), a1 = cvtpk(P[BASE + 2], P[BASE + 3]);   \
    unsigned b0 = cvtpk(P[BASE + 4], P[BASE + 5]), b1 = cvtpk(P[BASE + 6], P[BASE + 7]);                              \
    auto r0 = __builtin_amdgcn_permlane32_swap(a0, b0, false, false); auto r1 = __builtin_amdgcn_permlane32_swap(a1, b1, false, false); \
    u32x4 w = {r0[0], r1[0], r0[1], r1[1]}; OUT = *reinterpret_cast<bf16x8*>(&w); } while (0)
  PK4(p0, 0, pa0); PK4(p0, 8, pa1); PK4(p1, 0, pa2); PK4(p1, 8, pa3);
#undef PK4
}
__device__ __forceinline__ void qkt(f32x16& p0, f32x16& p1, const bf16* Ks, const bf16x8* qr, int r32, int hi) {
  p0 = f32x16{}; p1 = f32x16{};
#pragma unroll
  for (int d0 = 0; d0 < 8; ++d0) { int cb = (d0 * 16 + hi * 8) * 2;
    bf16x8 b0 = *reinterpret_cast<const bf16x8*>((const char*)Ks + KSWZ(r32, cb));
    bf16x8 b1 = *reinterpret_cast<const bf16x8*>((const char*)Ks + KSWZ(32 + r32, cb));
    p0 = __builtin_amdgcn_mfma_f32_32x32x16_bf16(b0, qr[d0], p0, 0, 0, 0);
    p1 = __builtin_amdgcn_mfma_f32_32x32x16_bf16(b1, qr[d0], p1, 0, 0, 0); }
}
__device__ __forceinline__ int v_st(int k, int c) { const int kk = (k & ~0xC) | ((k & 4) << 1) | ((k & 8) >> 1); return ((kk >> 3) * 4 + (c >> 5)) * 512 + ((kk & 7) * 32 + (c & 31)) * 2; }
__device__ __forceinline__ int v_rd_base(int lane) { return ((lane & 3) << 3) | (((lane >> 2) & 3) << 6) | (((lane >> 4) & 1) << 5) | (((lane >> 5) & 1) << 8); }
constexpr int v_rd_off(int d0, int ks, int half) { return d0 * 512 + ks * 4096 + half * 2048; }
template <int OFF> __device__ __forceinline__ s16x4 tr_read(int vb) {
  s16x4 r; asm volatile("ds_read_b64_tr_b16 %0, %1 offset:%2" : "=&v"(r) : "v"(vb), "i"(OFF) : "memory"); return r;
}
template <int D0> __device__ __forceinline__ void pv_one(f32x16& od, int vb, bf16x8 pa0, bf16x8 pa1, bf16x8 pa2, bf16x8 pa3) {
  const s16x4 l0 = tr_read<v_rd_off(D0, 0, 0)>(vb), h0 = tr_read<v_rd_off(D0, 0, 1)>(vb), l1 = tr_read<v_rd_off(D0, 1, 0)>(vb), h1 = tr_read<v_rd_off(D0, 1, 1)>(vb);
  const s16x4 l2 = tr_read<v_rd_off(D0, 2, 0)>(vb), h2 = tr_read<v_rd_off(D0, 2, 1)>(vb), l3 = tr_read<v_rd_off(D0, 3, 0)>(vb), h3 = tr_read<v_rd_off(D0, 3, 1)>(vb);
  asm volatile("s_waitcnt lgkmcnt(0)" ::: "memory"); SBAR();
#define PK(L, H) (bf16x8){L[0], L[1], L[2], L[3], H[0], H[1], H[2], H[3]}
  od = __builtin_amdgcn_mfma_f32_32x32x16_bf16(pa0, PK(l0, h0), od, 0, 0, 0);
  od = __builtin_amdgcn_mfma_f32_32x32x16_bf16(pa1, PK(l1, h1), od, 0, 0, 0);
  od = __builtin_amdgcn_mfma_f32_32x32x16_bf16(pa2, PK(l2, h2), od, 0, 0, 0);
  od = __builtin_amdgcn_mfma_f32_32x32x16_bf16(pa3, PK(l3, h3), od, 0, 0, 0);
#undef PK
}
__device__ __forceinline__ void pv_d0(f32x16* o, int vb, bf16x8 pa0, bf16x8 pa1, bf16x8 pa2, bf16x8 pa3) {
  pv_one<0>(o[0], vb, pa0, pa1, pa2, pa3); pv_one<1>(o[1], vb, pa0, pa1, pa2, pa3); pv_one<2>(o[2], vb, pa0, pa1, pa2, pa3); pv_one<3>(o[3], vb, pa0, pa1, pa2, pa3);
}

__device__ __forceinline__ void na_unit(int b, int h, int i4, const bf16* __restrict__ qkv, const float* __restrict__ ssq_q, const float* __restrict__ ssq_k,
                                        const float* __restrict__ rpb, bf16* __restrict__ ona, char* lds) {
  int tid_ = threadIdx.x; asm volatile("" : "+v"(tid_));
  const int tid = tid_, wid = __builtin_amdgcn_readfirstlane(tid >> 6), lane = tid & 63, r32 = lane & 31, hi = lane >> 5;
  bf16* V_lds = (bf16*)lds; bf16* K_lds = (bf16*)(lds + 2 * SHM_V);
  float* rkL = (float*)(lds + OFF_RK); float* biasL = (float*)(lds + OFF_BIAS); float* li_l = (float*)(lds + OFF_LI) + wid * 64;
  const int NT = (i4 == 0 || i4 == 15) ? 8 : 12, rbase = (i4 == 0) ? 0 : ((i4 == 15) ? 56 : 4 * i4 - 4);
  const int qrow = 4 * i4 + (wid >> 1), qc = 32 * (wid & 1) + r32;
  int rs = qrow - 4; rs = rs < 0 ? 0 : (rs > 56 ? 56 : rs);
  int cs = qc - 8; cs = cs < 0 ? 0 : (cs > 48 ? 48 : cs);
  const size_t tok_q = (size_t)b * 4096 + qrow * 64 + qc, tok_k0 = (size_t)b * 4096 + rbase * 64;
  for (int i = tid; i < NT * 64; i += 512) { const f32x4 p = *(const f32x4*)(ssq_k + (tok_k0 + i) * 32 + h * 4); rkL[i] = rsqrtf(((p[0] + p[1]) + (p[2] + p[3])) * (1.0f / 128.0f) + 1e-6f); }
  for (int i = tid; i < BIAS_N; i += 512) { const int j = i - BIAS_PAD; biasL[i] = (j >= 0 && j < 15 * 31) ? rpb[h * 465 + j] * 1.4426950408889634f : 0.f; }
  float rqs; { const f32x4 p = *(const f32x4*)(ssq_q + tok_q * 32 + h * 4); rqs = rsqrtf(((p[0] + p[1]) + (p[2] + p[3])) * (1.0f / 128.0f) + 1e-6f) * 1.4426950408889634f; }
  float l_reg = 0; f32x16 o[4] = {}; bf16x8 qr[8];
  const bf16* Qw = qkv + tok_q * LDQ + h * 128 + hi * 8;
#pragma unroll
  for (int d0 = 0; d0 < 8; ++d0) qr[d0] = *reinterpret_cast<const bf16x8*>(Qw + d0 * 16);
  const bf16* Kh = qkv + tok_k0 * LDQ + 1024 + h * 128; const bf16* Vh = qkv + tok_k0 * LDQ + 2048 + h * 128;
  const int sr = tid >> 4, sc = (tid & 15) * 8, vst0 = v_st(sr, sc), vst1 = v_st(32 + sr, sc);
  const int vb0 = (int)(uintptr_t)V_lds + v_rd_base(lane);
  struct { bf16x8 vs0, vs1, ks0, ks1; } sr_[2];
#define SLOAD(i, k0) do { sr_[i].vs0 = *(const bf16x8*)(&Vh[(long)((k0) + sr) * LDQ + sc]); sr_[i].vs1 = *(const bf16x8*)(&Vh[(long)((k0) + 32 + sr) * LDQ + sc]); \
    sr_[i].ks0 = *(const bf16x8*)(&Kh[(long)((k0) + sr) * LDQ + sc]); sr_[i].ks1 = *(const bf16x8*)(&Kh[(long)((k0) + 32 + sr) * LDQ + sc]); } while (0)
#define SWRITE(bb, i) do { *(bf16x8*)((char*)V_lds + (bb) * SHM_V + vst0) = sr_[i].vs0;          \
    *(bf16x8*)((char*)V_lds + (bb) * SHM_V + vst1) = sr_[i].vs1; int kc = sc * 2;               \
    *(bf16x8*)((char*)K_lds + (bb) * SHM_K + KSWZ(sr, kc)) = sr_[i].ks0;                       \
    *(bf16x8*)((char*)K_lds + (bb) * SHM_K + KSWZ(32 + sr, kc)) = sr_[i].ks1; } while (0)
#define SWAIT() asm volatile("s_waitcnt vmcnt(0)" ::: "memory")
#define TILE_ARGS(j) ((unsigned)(rbase + (j) - rs) < 8u), rkL + (j) * 64, biasL + BIAS_PAD + (rbase + (j) - qrow + 7) * 31 + 15 - qc, rqs, cs, hi
  f32x16 p0, p1; bf16x8 pa0, pa1, pa2, pa3;
#define NA_TILE(j, bo) do { if ((unsigned)(rbase + (j) - rs) < 8u) {     \
      SBAR(); qkt(p0, p1, (const bf16*)((const char*)K_lds + (bo) * SHM_K), qr, r32, hi); \
      procP(p0, p1, l_reg, TILE_ARGS(j)); \
      packP(p0, p1, pa0, pa1, pa2, pa3); SBAR(); \
      pv_d0(o, vb0 + (bo) * (int)SHM_V, pa0, pa1, pa2, pa3); } } while (0)
  SLOAD(0, 0); SLOAD(1, KVBLK); asm volatile("s_waitcnt vmcnt(4)" ::: "memory"); SWRITE(0, 0); SLOAD(0, 2 * KVBLK); __syncthreads();
  for (int j = 0; j < NT; j += 2) {
    NA_TILE(j, 0);
    __syncthreads();
    SWRITE(1, 1); if (j + 3 < NT) SLOAD(1, (j + 3) * KVBLK);
    __syncthreads();
    NA_TILE(j + 1, 1);
    if (j + 2 < NT) {
      __syncthreads();
      SWRITE(0, 0); if (j + 4 < NT) SLOAD(0, (j + 4) * KVBLK);
      __syncthreads();
    }
  }
#undef NA_TILE
  { auto rr = __builtin_amdgcn_permlane32_swap(__float_as_uint(l_reg), __float_as_uint(l_reg), false, false); l_reg = __uint_as_float(rr[0]) + __uint_as_float(rr[1]); }
  if (hi == 0) li_l[r32] = l_reg; asm volatile("s_waitcnt lgkmcnt(0)" ::: "memory");
  float rli[16];
#pragma unroll
  for (int r = 0; r < 16; ++r) rli[r] = __builtin_amdgcn_rcpf(li_l[crow(r, hi)]);
  bf16* Ow = ona + ((size_t)b * 4096 + qrow * 64 + 32 * (wid & 1)) * 2048 + h * 128;
#pragma unroll
  for (int r = 0; r < 16; ++r) { const int orow = crow(r, hi);
#pragma unroll
    for (int d0 = 0; d0 < 4; ++d0) { const float v = o[d0][r] * rli[r]; unsigned u = __float_as_uint(v); u += 0x7fffu + ((u >> 16) & 1u); Ow[(size_t)orow * 2048 + d0 * 32 + r32] = (bf16)(u >> 16); } }
  __syncthreads();
#undef SLOAD
#undef SWRITE
#undef SWAIT
#undef TILE_ARGS
}
#undef KSWZ
#undef SBAR
}

constexpr int NWAVES = 8;
constexpr int RING_OFF = 0, RING_BYTES = 131072;
constexpr int LDSCTL_OFF = RING_BYTES, MISC_OFF = LDSCTL_OFF + 320;
constexpr int LDS_BYTES = 147456;
static_assert(MISC_OFF + 128 <= LDS_BYTES && na::NA_LDS_BYTES <= RING_BYTES, "LDS map");
constexpr int CW_TMO = 0, CW_BAR = 4096;

#define GAS __attribute__((address_space(1)))
#define LAS __attribute__((address_space(3)))
typedef unsigned short bf16;
typedef unsigned v4u __attribute__((ext_vector_type(4)));
typedef float f32x4 __attribute__((ext_vector_type(4)));
typedef GAS unsigned gu32;
#define LDS_WAIT() asm volatile("s_waitcnt lgkmcnt(0)" ::: "memory")
#define VM_WAIT() asm volatile("s_waitcnt vmcnt(0)" ::: "memory")
__device__ __forceinline__ unsigned f2bf(float f) { unsigned u = __builtin_bit_cast(unsigned, f); return (u + 0x7fffu + ((u >> 16) & 1u)) >> 16; }
__device__ __forceinline__ unsigned pk2(float lo, float hi) { return f2bf(lo) | (f2bf(hi) << 16); }
__device__ __forceinline__ float bf2f_(unsigned h) { return __uint_as_float(h << 16); }

#define XB_TMO      128
#define XB_XCNT(j)  (256  + 64 * (j))
#define XB_XSUB(j)  (1280 + 64 * (j))
#define XB_XGEN(j)  (2304 + 64 * (j))
#define XB_TOP      3328
#define XB_TOPGEN   3392
#define XCD_BAR_WORDS 3456
#define XB_SPIN_CAP (1u << 18)
__device__ __forceinline__ unsigned xb_ld(unsigned* p)              { return __hip_atomic_load(p, __ATOMIC_RELAXED, __HIP_MEMORY_SCOPE_AGENT); }
__device__ __forceinline__ unsigned xb_add(unsigned* p, unsigned v) { return __hip_atomic_fetch_add(p, v, __ATOMIC_RELAXED, __HIP_MEMORY_SCOPE_AGENT); }
__device__ __forceinline__ unsigned xb_xcc_id() { return (unsigned)__builtin_amdgcn_s_getreg((3 << 11) | 20) & 0xFu; }
#define XB_SPIN(cond, bar) do { unsigned _sp = 0; while (cond) { __builtin_amdgcn_s_sleep(1); \
    if ((++_sp & 255u) == 0u) { if (xb_ld(&(bar)[XB_TMO])) break; if (_sp > XB_SPIN_CAP) { atomicAdd(&(bar)[XB_TMO], 1u); break; } } } } while (0)
struct XcdBarrier { unsigned* bar; unsigned x; volatile LAS unsigned* st; };
__device__ __forceinline__ XcdBarrier xcd_barrier_post(unsigned* bar, volatile LAS unsigned* st) {
    XcdBarrier b; b.bar = bar; b.x = xb_xcc_id(); b.st = st;
    if (threadIdx.x == 0) (void)xb_add(&bar[XB_XCNT(b.x)], 1u);
    return b;
}
__device__ __forceinline__ void xcd_barrier_complete(unsigned* bar, unsigned x, unsigned& nloc, unsigned& nx) {
    const unsigned G = gridDim.x * gridDim.y * gridDim.z;
    unsigned sum, cnt, mine, sp = 0u;
    for (;;) {
        sum = 0u; cnt = 0u; mine = 0u;
#pragma unroll
        for (unsigned j = 0; j < 16; ++j) { const unsigned c = xb_ld(&bar[XB_XCNT(j)]); sum += c; cnt += (c > 0u) ? 1u : 0u; mine = (j == x) ? c : mine; }
        if (sum == G) break;
        __builtin_amdgcn_s_sleep(1);
        if ((++sp & 255u) == 0u) { if (xb_ld(&bar[XB_TMO])) break; if (sp > XB_SPIN_CAP) { atomicAdd(&bar[XB_TMO], 1u); break; } }
    }
    nloc = mine > 0u ? mine : 1u; nx = cnt > 0u ? cnt : 1u;
}
__device__ __forceinline__ void xcd_barrier(const XcdBarrier& b) {
    asm volatile("s_waitcnt vmcnt(0)" ::: "memory");
    __syncthreads();
    if (threadIdx.x == 0) {
        unsigned* bar = b.bar;
        __builtin_amdgcn_s_waitcnt(0);
        unsigned nloc = b.st[0], nx = b.st[1];
        if (nloc == 0u) { xcd_barrier_complete(bar, b.x, nloc, nx); b.st[0] = nloc; b.st[1] = nx; }
        const unsigned old = xb_add(&bar[XB_XSUB(b.x)], 1u);
        const unsigned gen = old / nloc;
        if (old + 1u == (gen + 1u) * nloc) {
            __builtin_amdgcn_fence(__ATOMIC_RELEASE, "agent");
            asm volatile("s_waitcnt vmcnt(0)" ::: "memory");
            const unsigned og = xb_add(&bar[XB_TOP], 1u);
            const unsigned tg = og / nx;
            if (og + 1u == (tg + 1u) * nx) xb_add(&bar[XB_TOPGEN], 1u);
            else XB_SPIN(xb_ld(&bar[XB_TOPGEN]) == tg, bar);
            __builtin_amdgcn_fence(__ATOMIC_ACQUIRE, "agent");
            xb_add(&bar[XB_XGEN(b.x)], 1u);
            asm volatile("s_waitcnt vmcnt(0)" ::: "memory");
        } else {
            XB_SPIN(xb_ld(&bar[XB_XGEN(b.x)]) == gen, bar);
            __builtin_amdgcn_fence(__ATOMIC_ACQUIRE, "agent");
            asm volatile("s_waitcnt vmcnt(0)" ::: "memory");
        }
    }
    __syncthreads();
}

__device__ __forceinline__ float wave_sum(float v) {
#pragma unroll
    for (int o = 1; o < 64; o <<= 1) v += __shfl_xor(v, o);
    return v;
}
__device__ __forceinline__ void p0_item(const float* __restrict__ W, int ldw, int k0, int n0, bf16* __restrict__ WT, int ldt, int dA, int dB, const float* __restrict__ kscale, LAS float* scr, int lane) {
    const int c16 = lane & 15, kr = lane >> 4;
#pragma unroll
    for (int it = 0; it < 16; ++it) { const int k = 4 * it + kr;
        f32x4 v = *(const f32x4*)(W + (size_t)(k0 + k) * ldw + n0 + 4 * c16);
        if (kscale) v = v * kscale[k0 + k];
        *(LAS f32x4*)(scr + k * 64 + ((4 * c16) ^ (8 * ((k >> 3) & 7)))) = v; }
    LDS_WAIT(); asm volatile("" ::: "memory");
    const int c = lane & 7;
#pragma unroll
    for (int j = 0; j < 8; ++j) { const int n = (lane >> 3) + 8 * j; const LAS float* s = scr + (8 * c) * 64 + (n ^ (8 * c));
        v4u o; o.x = pk2(s[0 * 64], s[1 * 64]); o.y = pk2(s[2 * 64], s[3 * 64]); o.z = pk2(s[4 * 64], s[5 * 64]); o.w = pk2(s[6 * 64], s[7 * 64]);
        const int drow = (n < 32) ? dA + n : dB + n - 32;
        *(GAS v4u*)(WT + (size_t)drow * ldt + k0 + 8 * c) = o; }
    LDS_WAIT(); asm volatile("" ::: "memory");
}
struct P0Desc { const float* src; bf16* dst; int ldw, ldt, dA, dB; };
__device__ __forceinline__ void p0_load(const P0Desc& d, f32x4 (&R)[16], int lane) {
    const int c16 = lane & 15, kr = lane >> 4;
#pragma unroll
    for (int it = 0; it < 16; ++it) R[it] = *(const f32x4*)(d.src + (size_t)(4 * it + kr) * d.ldw + 4 * c16);
}
__device__ __forceinline__ void p0_to_lds(const f32x4 (&R)[16], LAS float* scr, int lane) {
    const int c16 = lane & 15, kr = lane >> 4;
#pragma unroll
    for (int it = 0; it < 16; ++it) { const int k = 4 * it + kr; *(LAS f32x4*)(scr + k * 64 + ((4 * c16) ^ (8 * ((k >> 3) & 7)))) = R[it]; }
}
__device__ __forceinline__ void p0_store(const P0Desc& d, LAS float* scr, int lane) {
    const int c = lane & 7;
#pragma unroll
    for (int j = 0; j < 8; ++j) { const int n = (lane >> 3) + 8 * j; const LAS float* s = scr + (8 * c) * 64 + (n ^ (8 * c));
        v4u o; o.x = pk2(s[0 * 64], s[1 * 64]); o.y = pk2(s[2 * 64], s[3 * 64]); o.z = pk2(s[4 * 64], s[5 * 64]); o.w = pk2(s[6 * 64], s[7 * 64]);
        const int drow = (n < 32) ? d.dA + n : d.dB + n - 32;
        *(GAS v4u*)(d.dst + (size_t)drow * d.ldt + 8 * c) = o; }
}
__device__ __forceinline__ void rms_row_to_bf16(const float* __restrict__ xrow, const float* __restrict__ g, bf16* __restrict__ orow, int lane) {
    const f32x4* xr = (const f32x4*)xrow + lane; const f32x4* gr = (const f32x4*)g + lane;
    f32x4 v[8]; float s = 0.f;
#pragma unroll
    for (int j = 0; j < 8; ++j) { v[j] = xr[64 * j]; s += (v[j].x * v[j].x + v[j].y * v[j].y) + (v[j].z * v[j].z + v[j].w * v[j].w); }
    const float r = rsqrtf(wave_sum(s) * (1.f / 2048.f) + mk::EPS);
    unsigned long long* o8 = (unsigned long long*)orow + lane;
#pragma unroll
    for (int j = 0; j < 8; ++j) { const f32x4 gg = gr[64 * j]; o8[64 * j] = (unsigned long long)pk2(v[j].x * r * gg.x, v[j].y * r * gg.y) | ((unsigned long long)pk2(v[j].z * r * gg.z, v[j].w * r * gg.w) << 32); }
}
__device__ __forceinline__ int win_dest_row(int n32  ) {
    const int pn = n32 >> 3, ga = n32 & 7;
    if (pn < 12 || pn >= 20) return n32 * 32;
    const int gs = 4 * ((ga >> 1) & 1) + 2 * (ga >> 2) + (ga & 1);
    return (pn * 8 + gs) * 32;
}

#ifndef MK_TS
#define MK_TS -1
#endif
struct Args { const float* in[21]; float* out; unsigned char* ws; };

__global__ void __launch_bounds__(NWAVES * 64, 2) mk_fwd(Args args) {
    extern __shared__ __attribute__((aligned(16))) unsigned char lds[];
    LAS unsigned char* ldsl = (LAS unsigned char*)lds;
    volatile LAS unsigned* MISC = (volatile LAS unsigned*)(ldsl + MISC_OFF);
    const int tid = threadIdx.x, lane = tid & 63, wave = __builtin_amdgcn_readfirstlane(tid >> 6);
    const int G = gridDim.x, bx = blockIdx.x;
    const int vcu = (G % 8 == 0) ? (bx % 8) * (G / 8) + bx / 8 : bx;
    unsigned char* ws = args.ws; unsigned char* dob = (unsigned char*)args.out;
    gu32* ctl = (gu32*)(ws + mk::WS_CTL);
#define I_x args.in[0]
#define I_mem args.in[1]
#define I_g_mix args.in[2]
#define I_w_in args.in[3]
#define I_gq args.in[4]
#define I_gk args.in[5]
#define I_rpb args.in[6]
#define I_lgf_in args.in[7]
#define I_lgb_in args.in[8]
#define I_gn args.in[9]
#define I_g_mem args.in[10]
#define I_w_mkv args.in[11]
#define I_gxq args.in[12]
#define I_gxk args.in[13]
#define I_w_na args.in[14]
#define I_w_ret args.in[15]
#define I_w_memb args.in[16]
#define I_w_out args.in[17]
#define I_g_ffn args.in[18]
#define I_w_ff1 args.in[19]
#define I_w_ff2 args.in[20]
#define I_out args.out
#define cosT ((float*)(ws + mk::WS_COS))
#define sinT ((float*)(ws + mk::WS_SIN))
#define ssq_naq ((float*)(ws + mk::WS_SSQ_NAQ))
#define ssq_nak ((float*)(ws + mk::WS_SSQ_NAK))
#define ssq_xq ((float*)(ws + mk::WS_SSQ_XQ))
#define xl ((float*)(ws + mk::WS_XL))
#define ssq_x1 ((float*)(ws + mk::WS_SSQ_X1))
#define tab ((float*)(ws + mk::WS_TAB))
#define MEMN ((bf16*)(ws + mk::WS_MEMN))
#define MKb ((bf16*)(ws + mk::WS_MK))
#define MVT ((bf16*)(ws + mk::WS_MVT))
#define WinT ((bf16*)(ws + mk::WS_WIN))
#define Wff1T ((bf16*)(ws + mk::WS_WFF1))
#define Wff2T ((bf16*)(ws + mk::WS_WFF2))
#define WretT ((bf16*)(ws + mk::WS_WRET))
#define WoutT ((bf16*)(ws + mk::WS_WOUT))
#define WnmT ((bf16*)(ws + mk::WS_WNM))
#define WmkvT ((bf16*)(ws + mk::WS_WMKV))
#define NAQKV ((bf16*)(ws + mk::WS_NAQKV))
#define K0 ((bf16*)(ws + mk::WS_K0))
#define RG ((bf16*)(ws + mk::WS_RG))
#define XQ ((bf16*)(ws + mk::WS_XQ))
#define GATES ((bf16*)(ws + mk::WS_GATES))
#define AR ((bf16*)(ws + mk::WS_AR))
#define BR ((bf16*)(ws + mk::WS_BR))
#define KV ((float*)(ws + mk::WS_KV))
#define ORET ((bf16*)(ws + mk::WS_ORET))
#define MERGED ((bf16*)(ws + mk::WS_MERGED))
#define X1B ((bf16*)(ws + mk::WS_X1B))
#define HFF ((bf16*)(ws + mk::WS_HFF))
#define HN ((bf16*)(dob + mk::DO_HN))
#define KT ((bf16*)(dob + mk::DO_KT))
#define XP ((bf16*)(dob + mk::DO_XP))
#define ONM ((bf16*)(dob + mk::DO_ONM))
    for (int u = tid; u < (LDS_BYTES - LDSCTL_OFF) / 4; u += NWAVES * 64) ((LAS unsigned*)(ldsl + LDSCTL_OFF))[u] = 0u;
    __syncthreads();
    XcdBarrier bar = xcd_barrier_post((unsigned*)(ctl + CW_BAR), MISC + 8);
#define GRID_BAR() do { xcd_barrier(bar); MK_STAMP(); } while (0)
    int n_stamp_ = 0;
#define MK_STAMP() do { if (MK_TS >= 0) { if (bx == 0 && tid == 0) MISC[16 + n_stamp_] = (unsigned)__builtin_amdgcn_s_memrealtime(); ++n_stamp_; } } while (0)
    MK_STAMP();
    LAS float* scr = (LAS float*)(ldsl + RING_OFF + wave * 16384);
    const int gw = vcu * NWAVES + wave, NGW = G * NWAVES;

    {
    {
        for (int i = gw * 64 + lane; i < 4096 * 64; i += NGW * 64) { const int s = i >> 6, f = i & 63;
            const float inv = powf(10000.0f, -(float)f / 64.0f), ang = (float)s * inv; cosT[i] = cosf(ang); sinT[i] = sinf(ang); }
        if (bx == 0) {
            if (tid < 128) tab[mk::TAB_CS_NAQ + tid] = I_gq[tid] * I_gk[tid] * 0.08838834764831845f;
            if (tid < 256) tab[mk::TAB_CS_MK + tid] = I_gxq[tid] * I_gxk[tid] * 0.0625f;
            if (tid < 8) { tab[mk::TAB_L2F + tid] = -log1pf(expf(-I_lgf_in[tid])) * mk::LOG2E; tab[mk::TAB_L2B + tid] = -log1pf(expf(-I_lgb_in[tid])) * mk::LOG2E; }
        }
        for (int m = gw; m < 512; m += NGW) rms_row_to_bf16(I_mem + (size_t)m * 2048, I_g_mem, MEMN + (size_t)m * 2048, lane);
        for (int it = gw; it < 32 * 32; it += NGW) { const int kb = it >> 5, nb = it & 31; p0_item(I_w_mkv, 2048, 64 * kb, 64 * nb, WmkvT, 2048, 64 * nb, 64 * nb + 32, nullptr, scr, lane); }
    }
    GRID_BAR();
    }
    {
    if (vcu < 16) {
        mk::SchedOne S; S.has = true; const pg8::Gemm g{2048, 2048, 2048};
        mk::EpiMKV E{MKb, MVT, tab, tab, 0};
        if (vcu < 8) { S.u.pm = vcu >> 2; S.u.pn = vcu & 3; S.a = (const char*)(MEMN + (size_t)S.u.pm * 256 * 2048); S.b = (const char*)(WmkvT + (size_t)S.u.pn * 256 * 2048); E.mode = 0; }
        else { const int c = vcu - 8; S.u.pm = c >> 1; S.u.pn = c & 1; S.a = (const char*)(WmkvT + (size_t)(1024 + S.u.pm * 256) * 2048); S.b = (const char*)(MEMN + (size_t)S.u.pn * 256 * 2048); E.mode = 1; }
        pg8::gemm_phase<mk::EpiMKV, mk::SchedOne, false>(ldsl + RING_OFF, g, S, E);
    } else {
        const int gw2 = (vcu - 16) * NWAVES + wave, NGW2 = (G - 16) * NWAVES;
        constexpr int I_IN = 32 * 256, I_FF1 = 32 * 128, I_FF2 = 128 * 32, I_RET = 32 * 32, I_OUT = 32 * 32, I_NA = 16 * 32, I_MEM = 16 * 32;
        constexpr int NITEMS = I_IN + I_FF1 + I_FF2 + I_RET + I_OUT + I_NA + I_MEM;
#define P0_DECODE(d, item) do { int r = (item); \
            if (r < I_IN) { const int kb = r >> 8, nb = r & 255; d.src = I_w_in + (size_t)(64 * kb) * 16384 + 64 * nb; d.ldw = 16384; d.dst = WinT + 64 * kb; d.ldt = 2048; d.dA = win_dest_row(2 * nb); d.dB = win_dest_row(2 * nb + 1); break; } r -= I_IN; \
            if (r < I_FF1) { const int kb = r >> 7, nb = r & 127; d.src = I_w_ff1 + (size_t)(64 * kb) * 8192 + 64 * nb; d.ldw = 8192; d.dst = Wff1T + 64 * kb; d.ldt = 2048; d.dA = 64 * nb; d.dB = 64 * nb + 32; break; } r -= I_FF1; \
            if (r < I_FF2) { const int kb = r >> 5, nb = r & 31; d.src = I_w_ff2 + (size_t)(64 * kb) * 2048 + 64 * nb; d.ldw = 2048; d.dst = Wff2T + 64 * kb; d.ldt = 8192; d.dA = 64 * nb; d.dB = 64 * nb + 32; break; } r -= I_FF2; \
            if (r < I_RET) { const int kb = r >> 5, nb = r & 31; d.src = I_w_ret + (size_t)(64 * kb) * 2048 + 64 * nb; d.ldw = 2048; d.dst = WretT + 64 * kb; d.ldt = 2048; d.dA = 64 * nb; d.dB = 64 * nb + 32; break; } r -= I_RET; \
            if (r < I_OUT) { const int kb = r >> 5, nb = r & 31; d.src = I_w_out + (size_t)(64 * kb) * 2048 + 64 * nb; d.ldw = 2048; d.dst = WoutT + 64 * kb; d.ldt = 2048; d.dA = 64 * nb; d.dB = 64 * nb + 32; break; } r -= I_OUT; \
            if (r < I_NA) { const int kb = r >> 5, nb = r & 31; d.src = I_w_na + (size_t)(64 * kb) * 2048 + 64 * nb; d.ldw = 2048; d.dst = WnmT + 64 * kb; d.ldt = 2048; d.dA = 64 * nb; d.dB = 64 * nb + 32; break; } r -= I_NA; \
            { const int kb = r >> 5, nb = r & 31; d.src = I_w_memb + (size_t)(64 * kb) * 2048 + 64 * nb; d.ldw = 2048; d.dst = WnmT + 1024 + 64 * kb; d.ldt = 2048; d.dA = 64 * nb; d.dB = 64 * nb + 32; } } while (0)
        {
            f32x4 R0[16], R1[16]; P0Desc d0, d1; int it = gw2;
            if (it < NITEMS) { P0_DECODE(d0, it); p0_load(d0, R0, lane); }
            if (it + NGW2 < NITEMS) { P0_DECODE(d1, it + NGW2); p0_load(d1, R1, lane); }
            for (; it < NITEMS; it += 2 * NGW2) {
                p0_to_lds(R0, scr, lane); const P0Desc c0 = d0;
                if (it + 2 * NGW2 < NITEMS) { P0_DECODE(d0, it + 2 * NGW2); p0_load(d0, R0, lane); }
                LDS_WAIT(); asm volatile("" ::: "memory"); p0_store(c0, scr, lane); LDS_WAIT(); asm volatile("" ::: "memory");
                if (it + NGW2 < NITEMS) {
                    p0_to_lds(R1, scr, lane); const P0Desc c1 = d1;
                    if (it + 3 * NGW2 < NITEMS) { P0_DECODE(d1, it + 3 * NGW2); p0_load(d1, R1, lane); }
                    LDS_WAIT(); asm volatile("" ::: "memory"); p0_store(c1, scr, lane); LDS_WAIT(); asm volatile("" ::: "memory");
                }
            }
        }
#undef P0_DECODE
        for (int m = gw2; m < mk::M; m += NGW2) rms_row_to_bf16(I_x + (size_t)m * 2048, I_g_mix, HN + (size_t)m * 2048, lane);
    }
    GRID_BAR();
    }
    {
    {
        mk::SchedProj S; S.o.init(mk::M, mk::D_IN, G, bx); S.hn_ = (const char*)HN; S.wt_ = (const char*)WinT;
        const pg8::Gemm g{2048, 2048, 2048};
        mk::EpiProj E{ws};
        pg8::gemm_phase<mk::EpiProj, mk::SchedProj, true>(ldsl + RING_OFF, g, S, E);
    }
    GRID_BAR();
    }
    {
    {
        const int c = bx, bh = c >> 4, nc = c & 15, b = bh >> 3, h = bh & 7;
        const float l2f = tab[mk::TAB_L2F + h], l2b = tab[mk::TAB_L2B + h];
        {
            bf16* kt = KT + (size_t)c * 65536; const bf16* ksrc = K0 + ((size_t)b * 4096 + nc * 256) * 1024 + h * 128;
            LAS float* t = scr;
            const int tok0 = wave * 32;
#pragma unroll
            for (int it = 0; it < 8; ++it) { const int tr = 4 * it + (lane >> 4), c8 = (lane & 15) * 8; const v4u w = *(const v4u*)(ksrc + (size_t)(tok0 + tr) * 1024 + c8);
                LAS float* d = t + tr * 128 + (c8 ^ (8 * (tr >> 3))); d[0] = bf2f_(w.x & 0xffffu); d[1] = bf2f_(w.x >> 16); d[2] = bf2f_(w.y & 0xffffu); d[3] = bf2f_(w.y >> 16);
                d[4] = bf2f_(w.z & 0xffffu); d[5] = bf2f_(w.z >> 16); d[6] = bf2f_(w.w & 0xffffu); d[7] = bf2f_(w.w >> 16); }
            LDS_WAIT(); asm volatile("" ::: "memory");
            const int q = lane & 3;
            float df[8], db[8];
#pragma unroll
            for (int i = 0; i < 8; ++i) { const int tk = tok0 + 8 * q + i; df[i] = pg8::fexp2(l2f * (float)(255 - tk)); db[i] = pg8::fexp2(l2b * (float)tk); }
#pragma unroll
            for (int j = 0; j < 8; ++j) { const int dk = (lane >> 2) + 16 * j; const LAS float* s = t + (8 * q) * 128 + (dk ^ (8 * q));
                float v[8];
#pragma unroll
                for (int i = 0; i < 8; ++i) v[i] = s[i * 128];
                v4u o; o.x = pk2(v[0] * df[0], v[1] * df[1]); o.y = pk2(v[2] * df[2], v[3] * df[3]); o.z = pk2(v[4] * df[4], v[5] * df[5]); o.w = pk2(v[6] * df[6], v[7] * df[7]);
                *(GAS v4u*)(kt + (size_t)dk * 256 + tok0 + 8 * q) = o;
                o.x = pk2(v[0] * db[0], v[1] * db[1]); o.y = pk2(v[2] * db[2], v[3] * db[3]); o.z = pk2(v[4] * db[4], v[5] * db[5]); o.w = pk2(v[6] * db[6], v[7] * db[7]);
                *(GAS v4u*)(kt + (size_t)(128 + dk) * 256 + tok0 + 8 * q) = o; }
            VM_WAIT(); LDS_WAIT(); __syncthreads();
        }
        MK_STAMP();
        {
            bf16* arc = AR + ((size_t)bh * 4096 + nc * 256) * 512;
            mk::SchedList3 S; S.n = (bx < 128) ? 3 : 2;
            S.u0.a = (const char*)(BR + (size_t)c * 256 * 512); S.u0.b = (const char*)(KT + (size_t)c * 65536); S.u0.lda = 512; S.u0.ldb = 256; S.u0.nt = 4; S.u0.kind = 0; S.u0.perm = 0;
            S.u1.a = (const char*)(arc + 256); S.u1.b = (const char*)(K0 + ((size_t)b * 4096 + nc * 256) * 1024 + h * 128); S.u1.lda = 512; S.u1.ldb = 1024; S.u1.nt = 2; S.u1.kind = 1; S.u1.perm = 1;
            const int xb = (bx >> 6) & 1, xh = (bx >> 4) & 3, qt = bx & 15; const size_t tok0 = (size_t)xb * 4096 + qt * 256;
            S.u2.a = (const char*)(XQ + tok0 * 1024 + xh * 256); S.u2.b = (const char*)(MKb + (size_t)xb * 256 * 1024 + xh * 256); S.u2.lda = 1024; S.u2.ldb = 1024; S.u2.nt = 4; S.u2.kind = 2; S.u2.perm = 1;
            mk::EpiM1 E{mk::EpiF32{KV + (size_t)c * 65536}, mk::EpiP{arc, l2f, l2b},
                        mk::EpiXS{XP + tok0 * 1024 + xh * 256, xl + tok0 * 16 + xh * 4, ssq_xq + tok0 * 16 + xh * 4, tab + mk::TAB_SSQ_MK + (size_t)xb * 256 * 16 + xh * 4}};
            pg8::gemm_stream<mk::EpiM1, mk::SchedList3, true>(ldsl + RING_OFF, S, E);
        }
        MK_STAMP();
    }
    GRID_BAR();
    }
    {
    {
        for (int e = (vcu * 512 + tid); e < 16 * 65536; e += G * 512) {
            const int bh = e >> 16, r = e & 65535, col = r & 255, h = bh & 7;
            const bool fwd = col < 128; const float dec = pg8::fexp2((fwd ? tab[mk::TAB_L2F + h] : tab[mk::TAB_L2B + h]) * 256.0f);
            const float* kvp = KV + (size_t)bh * 16 * 65536 + r; bf16* brp = BR + ((size_t)bh * 16 * 256 + (r >> 8)) * 512 + 256 + col;
            float kvv[16];
#pragma unroll
            for (int n = 0; n < 16; ++n) kvv[n] = kvp[(size_t)n * 65536];
            float s = 0.f;
            if (fwd) {
#pragma unroll
                for (int n = 0; n < 16; ++n) { brp[(size_t)n * 256 * 512] = (bf16)f2bf(s); s = dec * s + kvv[n]; }
            } else {
#pragma unroll
                for (int n = 15; n >= 0; --n) { brp[(size_t)n * 256 * 512] = (bf16)f2bf(s); s = dec * s + kvv[n]; }
            }
        }
        __syncthreads();
        MK_STAMP();
        { const int b = bx >> 7, h = (bx >> 4) & 7, i4 = bx & 15;
        na::na_unit(b, h, i4, NAQKV, ssq_naq, ssq_nak, I_rpb, ONM, (char*)lds); }
        MK_STAMP();
    }
    GRID_BAR();
    }
    {
    {
        const int c = bx, bh = c >> 4, nc = c & 15, b = bh >> 3, h = bh & 7;
        {
            const int xb = (bx >> 6) & 1, xh = (bx >> 4) & 3, qt = bx & 15; const size_t tok0 = (size_t)xb * 4096 + qt * 256;
            const size_t o0 = ((size_t)b * 4096 + nc * 256) * 2048 + h * 256;
            const bool hx = bx < 128;
            mk::SchedList3 S; S.n = hx ? 2 : 1;
            const char* const ra = (const char*)(AR + ((size_t)bh * 4096 + nc * 256) * 512); const char* const rb = (const char*)(BR + (size_t)c * 256 * 512);
            S.u0.a = hx ? (const char*)(XP + tok0 * 1024 + xh * 256) : ra; S.u0.b = hx ? (const char*)(MVT + (size_t)xh * 256 * 512 + xb * 256) : rb;
            S.u0.lda = hx ? 1024 : 512; S.u0.ldb = 512; S.u0.nt = hx ? 4 : 8; S.u0.kind = hx ? 0 : 1; S.u0.perm = 1;
            S.u1.a = ra; S.u1.b = rb; S.u1.lda = 512; S.u1.ldb = 512; S.u1.nt = 8; S.u1.kind = 1; S.u1.perm = 1;
            S.u2.a = ra; S.u2.b = rb; S.u2.lda = 512; S.u2.ldb = 512; S.u2.nt = 8; S.u2.kind = 1; S.u2.perm = 1;
            mk::EpiM3 E{mk::EpiXO{ONM + tok0 * 2048 + 1024 + xh * 256, xl + tok0 * 16 + xh * 4}, mk::EpiGN{ORET + o0, RG + o0, I_gn + h * 256}};
            pg8::gemm_stream<mk::EpiM3, mk::SchedList3, true>(ldsl + RING_OFF, S, E);
        }
        MK_STAMP();
    }
    GRID_BAR();
    }
    {
    {
        mk::SchedBR S; S.o.init(mk::M, 2048, G, bx); S.onm = (const char*)ONM; S.oret = (const char*)ORET; S.wnm = (const char*)WnmT; S.wret = (const char*)WretT;
        const pg8::Gemm g{2048, 2048, 1024}; mk::EpiGate4 E{MERGED, GATES};
        pg8::gemm_phase<mk::EpiGate4, mk::SchedBR, true>(ldsl + RING_OFF, g, S, E);
    }
    GRID_BAR();
    }
    {
    {
        mk::SchedGrid S; S.o.init(mk::M, 2048, G, bx); S.A = (const char*)MERGED; S.B = (const char*)WoutT; S.ta = 256u * 2048u * 2u; S.tb = 256u * 2048u * 2u;
        const pg8::Gemm g{2048, 2048, 2048}; mk::EpiWout E{I_x, I_out, X1B, ssq_x1, I_g_ffn};
        pg8::gemm_phase<mk::EpiWout, mk::SchedGrid, false>(ldsl + RING_OFF, g, S, E);
    }
    GRID_BAR();
    }
    {
    {
        mk::SchedGrid S; S.o.init(mk::M, 8192, G, bx); S.A = (const char*)X1B; S.B = (const char*)Wff1T; S.ta = 256u * 2048u * 2u; S.tb = 256u * 2048u * 2u;
        const pg8::Gemm g{2048, 2048, 2048}; mk::EpiFF1 E{HFF, ssq_x1};
        pg8::gemm_phase<mk::EpiFF1, mk::SchedGrid, true>(ldsl + RING_OFF, g, S, E);
    }
    GRID_BAR();
    }
    if (false) {
        mk::SchedGrid S; S.o.init(mk::M, 2048, G, bx); S.A = (const char*)HFF; S.B = (const char*)Wff2T; S.ta = 256u * (unsigned)mk::LDH * 2u; S.tb = 256u * 8192u * 2u;
        const pg8::Gemm g{mk::LDH, 8192, 8192}; mk::EpiFF2 E{I_out, KV};
        pg8::gemm_phase<mk::EpiFF2, mk::SchedGrid, false>(ldsl + RING_OFF, g, S, E);
        GRID_BAR();
    }
    {
        mk::SchedGrid S; S.o.init(mk::M, 2048, G, bx); S.A = (const char*)HFF; S.B = (const char*)Wff2T; S.ta = 256u * (unsigned)mk::LDH * 2u; S.tb = 256u * 8192u * 2u;
        const pg8::Gemm g{mk::LDH, 8192, 8192}; mk::EpiFF2 E{I_out, I_out};
        pg8::gemm_phase<mk::EpiFF2, mk::SchedGrid, false>(ldsl + RING_OFF, g, S, E);
    }
    MK_STAMP();
    if (MK_TS >= 0 && bx == 0 && tid == 0) {
        const unsigned dt = MISC[16 + MK_TS + 1] - MISC[16 + MK_TS]; const unsigned long long t0 = __builtin_amdgcn_s_memrealtime();
        while (__builtin_amdgcn_s_memrealtime() - t0 < 8ull * dt) __builtin_amdgcn_s_sleep(8);
    }
}

extern "C" void kernel_launch(void* const* d_in, const int* in_sizes, int n_in, void* d_out, int out_size, void* d_ws, size_t ws_size, hipStream_t stream) {
    static int grid = 0;
    if (grid == 0) {
        if (n_in != 21 || out_size != mk::M * mk::D || ws_size < mk::WS_END) { fprintf(stderr, "kernel_launch: unexpected shapes (n_in %d out %d ws %zu); nothing launched\n", n_in, out_size, ws_size); grid = -1; return; }
        int dev = 0, cus = 0;
        if (hipGetDevice(&dev) != hipSuccess || hipDeviceGetAttribute(&cus, hipDeviceAttributeMultiprocessorCount, dev) != hipSuccess) { grid = -1; return; }
        if (hipFuncSetAttribute((const void*)mk_fwd, hipFuncAttributeMaxDynamicSharedMemorySize, LDS_BYTES) != hipSuccess) { fprintf(stderr, "kernel_launch: hipFuncSetAttribute failed\n"); grid = -1; return; }
        (void)hipGetLastError();
        grid = cus;
        if (grid != 256) fprintf(stderr, "kernel_launch: %d CUs; this kernel's unit maps assume 256\n", grid);
    }
    if (grid < 0) return;
    if (hipMemsetAsync((char*)d_ws + mk::WS_CTL, 0, mk::CTL_ZERO_BYTES, stream) != hipSuccess) return;
    Args a{};
    for (int i = 0; i < 21; ++i) a.in[i] = (const float*)d_in[i];
    a.out = (float*)d_out; a.ws = (unsigned char*)d_ws;
    hipLaunchKernelGGL(mk_fwd, dim3(grid), dim3(NWAVES * 64), LDS_BYTES, stream, a);
}
```

```cpp
#include <hip/hip_runtime.h>
#include <cstdio>
#include <cstdint>

namespace pg8 {
#define PG8_LAS __attribute__((address_space(3)))
typedef unsigned short bf16_t;
typedef short bf16x8 __attribute__((ext_vector_type(8)));
typedef float f32x4 __attribute__((ext_vector_type(4)));
typedef float f32x2 __attribute__((ext_vector_type(2)));
typedef unsigned u32x4 __attribute__((ext_vector_type(4)));
typedef unsigned u32x2 __attribute__((ext_vector_type(2)));
constexpr int BM = 256, BK = 64, HALF = 128, HTB = HALF * BK * 2, STAGE_BYTES = 8 * HTB, NXCD = 8, WGM = 8;

__host__ __device__ __forceinline__ int lds_byte(int r, int c) { const int st = (r >> 4) * 2 + (c >> 5), rr = r & 15, cc = c & 31, ob = rr * 64 + cc * 2; return st * 1024 + (ob ^ (((ob >> 9) & 1) << 5)); }
__host__ __device__ __forceinline__ void stage_rc(int b, int& R, int& C) { const int st = b / 1024, sb = b % 1024, swz = sb ^ (((sb >> 9) & 1) << 5); R = (st >> 1) * 16 + swz / 64; C = (st & 1) * 32 + (swz % 64) / 2; }
__host__ __device__ __forceinline__ int perm32(int rho) { const int n = rho >> 4, i = rho & 15; return 8 * (i >> 2) + 4 * n + (i & 3); }

struct Unit { int pm, pn, sub; };
struct Gemm { int lda, ldb, K; };

struct GridOrder {
    int nM, nN, nwg, G, c;
    __device__ void init(int M, int N, int G_, int c_) { nM = M / BM; nN = N / BM; nwg = nM * nN; G = G_; c = c_; }
    __device__ bool next(int i, Unit& u) const {
        const long L = (long)i * G + c; if (L >= nwg) return false;
        int wgid = (int)L; { const int q = nwg / NXCD, r = nwg % NXCD, xcd = wgid % NXCD, off = wgid / NXCD; wgid = (xcd < r ? xcd * (q + 1) : r * (q + 1) + (xcd - r) * q) + off; }
        const int nig = WGM * nN, gid = wgid / nig, fm = gid * WGM, gsz = (nM - fm) < WGM ? (nM - fm) : WGM;
        u.pm = fm + ((wgid % nig) % gsz); u.pn = (wgid % nig) / gsz; u.sub = 0; return true;
    }
};

typedef float f32x2_cv __attribute__((ext_vector_type(2))); typedef __bf16 bf16x2_cv __attribute__((ext_vector_type(2)));
__device__ __forceinline__ unsigned cvt_pk_bf16(float lo, float hi) { const f32x2_cv v = {lo, hi}; const bf16x2_cv b = __builtin_convertvector(v, bf16x2_cv); return __builtin_bit_cast(unsigned, b); }
__device__ __forceinline__ void store8(bf16_t* p, f32x4 v0, f32x4 v1) { u32x4 w; w.x = cvt_pk_bf16(v0[0], v0[1]); w.y = cvt_pk_bf16(v0[2], v0[3]); w.z = cvt_pk_bf16(v1[0], v1[1]); w.w = cvt_pk_bf16(v1[2], v1[3]); *(u32x4*)p = w; }
__device__ __forceinline__ void store4(bf16_t* p, f32x4 v0) { u32x2 w; w.x = cvt_pk_bf16(v0[0], v0[1]); w.y = cvt_pk_bf16(v0[2], v0[3]); *(u32x2*)p = w; }
__device__ __forceinline__ float bf2f(unsigned short h) { return __uint_as_float((unsigned)h << 16); }
__device__ __forceinline__ void load8(const bf16_t* p, f32x4& v0, f32x4& v1) { const u32x4 w = *(const u32x4*)p;
    v0[0] = __uint_as_float(w.x << 16); v0[1] = __uint_as_float(w.x & 0xffff0000u); v0[2] = __uint_as_float(w.y << 16); v0[3] = __uint_as_float(w.y & 0xffff0000u);
    v1[0] = __uint_as_float(w.z << 16); v1[1] = __uint_as_float(w.z & 0xffff0000u); v1[2] = __uint_as_float(w.w << 16); v1[3] = __uint_as_float(w.w & 0xffff0000u); }
__device__ __forceinline__ void load8_l2(const bf16_t* p, f32x4& v0, f32x4& v1) { u32x4 w; const unsigned long long a = __hip_atomic_load((const unsigned long long*)p, __ATOMIC_RELAXED, __HIP_MEMORY_SCOPE_AGENT), b = __hip_atomic_load((const unsigned long long*)p + 1, __ATOMIC_RELAXED, __HIP_MEMORY_SCOPE_AGENT);
    w.x = (unsigned)a; w.y = (unsigned)(a >> 32); w.z = (unsigned)b; w.w = (unsigned)(b >> 32);
    v0[0] = __uint_as_float(w.x << 16); v0[1] = __uint_as_float(w.x & 0xffff0000u); v0[2] = __uint_as_float(w.y << 16); v0[3] = __uint_as_float(w.y & 0xffff0000u);
    v1[0] = __uint_as_float(w.z << 16); v1[1] = __uint_as_float(w.z & 0xffff0000u); v1[2] = __uint_as_float(w.w << 16); v1[3] = __uint_as_float(w.w & 0xffff0000u); }
__device__ __forceinline__ float fexp2(float x) { return __builtin_amdgcn_exp2f(x); }
__device__ __forceinline__ float frcp(float x) { return __builtin_amdgcn_rcpf(x); }
__device__ __forceinline__ float sigmoidf_(float x) { return frcp(1.f + fexp2(-1.4426950408889634f * x)); }

template <class Epi, class Sched, bool ALIGN_EPI>
__device__ __forceinline__ void gemm_phase(PG8_LAS unsigned char* lds, const Gemm g, const Sched& S, const Epi& E) {
    int tid_ = threadIdx.x; asm volatile("" : "+v"(tid_));
    const int tid = tid_, wid = __builtin_amdgcn_readfirstlane(tid >> 6), lane = tid & 63, wr = wid >> 2, wc = wid & 3, fr = lane & 15, fq = lane >> 4;
    unsigned voffA[2], voffB[2];
#pragma unroll
    for (int i = 0; i < 2; ++i) { int R, C; stage_rc(tid * 16 + i * 8192, R, C); const int Rb = Epi::PERM ? ((R & ~31) + perm32(R & 31)) : R;
        voffA[i] = (unsigned)(R * g.lda + C) * 2u; voffB[i] = (unsigned)(Rb * g.ldb + C) * 2u; }
    const size_t kstep = (size_t)(BK * 2);
    const size_t hstepA = (size_t)HALF * g.lda * 2, hstepB = (size_t)HALF * g.ldb * 2;
    const unsigned ldsw = (unsigned)wid * 1024u;
    const int aoff = lds_byte(wr * 64 + fr, fq * 8), boff = lds_byte(wc * 32 + fr, fq * 8);
#define PG8_SA(b, h) (((b) * 2 + (h)) * HTB)
#define PG8_SB(b, h) ((4 + (b) * 2 + (h)) * HTB)
#define PG8_STAGE(bufoff, gbase, voff) do { _Pragma("unroll") for (int _i = 0; _i < 2; ++_i) \
        __builtin_amdgcn_global_load_lds((const unsigned*)((const char*)(gbase) + (voff)[_i]), (PG8_LAS unsigned*)(lds + (bufoff) + ldsw + _i * 8192), 16, 0, 0); } while (0)
#define PG8_LDA(dst, b, h) do { _Pragma("unroll") for (int m = 0; m < 4; ++m) _Pragma("unroll") for (int k = 0; k < 2; ++k) dst[m][k] = *(const PG8_LAS bf16x8*)(lds + PG8_SA(b, h) + aoff + m * 2048 + k * 1024); } while (0)
#define PG8_LDB(dst, b, h) do { _Pragma("unroll") for (int n = 0; n < 2; ++n) _Pragma("unroll") for (int k = 0; k < 2; ++k) dst[n][k] = *(const PG8_LAS bf16x8*)(lds + PG8_SB(b, h) + boff + n * 2048 + k * 1024); } while (0)
#define PG8_MMA(ai, bj, At, Bt) do { __builtin_amdgcn_s_setprio(1); _Pragma("unroll") for (int m = 0; m < 4; ++m) _Pragma("unroll") for (int n = 0; n < 2; ++n) _Pragma("unroll") for (int k = 0; k < 2; ++k) \
        acc[ai][bj][m][n] = __builtin_amdgcn_mfma_f32_16x16x32_bf16(Bt[n][k], At[m][k], acc[ai][bj][m][n], 0, 0, 0); __builtin_amdgcn_s_setprio(0); } while (0)
#define PG8_WAIT_V(n) asm volatile("s_waitcnt vmcnt(" #n ")" ::: "memory")
#define PG8_WAIT_L(n) asm volatile("s_waitcnt lgkmcnt(" #n ")" ::: "memory")
#define PG8_BAR __builtin_amdgcn_s_barrier()
#define PG8_SCHED __builtin_amdgcn_sched_barrier(0)
    Unit cur, nxt; int ui = 0;
    if (!S.next(0, cur)) return;
    f32x4 acc[2][2][4][2];
#pragma unroll
    for (int a = 0; a < 2; ++a)
#pragma unroll
        for (int b = 0; b < 2; ++b)
#pragma unroll
            for (int m = 0; m < 4; ++m)
#pragma unroll
                for (int n = 0; n < 2; ++n) acc[a][b][m][n] = (f32x4){0.f, 0.f, 0.f, 0.f};
    bf16x8 At[4][2], B0[2][2], B1[2][2];
    const char* cA; const char* cB; S.ptrs(cur, cA, cB);
    PG8_STAGE(PG8_SB(0, 0), cB, voffB); PG8_STAGE(PG8_SB(0, 1), cB + hstepB, voffB); PG8_STAGE(PG8_SA(0, 0), cA, voffA); PG8_STAGE(PG8_SA(0, 1), cA + hstepA, voffA);
    if (wr == 1) PG8_BAR;
    PG8_WAIT_V(2); PG8_BAR;
    PG8_STAGE(PG8_SB(1, 0), cB + kstep, voffB); PG8_STAGE(PG8_SA(1, 0), cA + kstep, voffA); PG8_STAGE(PG8_SB(1, 1), cB + hstepB + kstep, voffB);
    PG8_WAIT_V(6); PG8_BAR;
    for (;;) {
        const bool has_next = S.next(ui + 1, nxt); const int nt = S.nt(cur, g.K) ;
        const char* nA = cA; const char* nB = cB; if (has_next) S.ptrs(nxt, nA, nB);
        for (int t = 0; t < nt; t += 2) {
            const bool last = (t == nt - 2);
            const char* a1 = cA + (size_t)(t + 1) * kstep;
            const char* a2 = last ? nA : cA + (size_t)(t + 2) * kstep; const char* b2 = last ? nB : cB + (size_t)(t + 2) * kstep;
            const char* a3 = a2 + kstep; const char* b3 = b2 + kstep;
            PG8_LDB(B0, 0, 0); PG8_LDB(B1, 0, 1); PG8_SCHED; PG8_LDA(At, 0, 0); PG8_STAGE(PG8_SA(1, 1), a1 + hstepA, voffA);
            PG8_WAIT_V(8); PG8_WAIT_L(0); PG8_BAR; PG8_MMA(0, 0, At, B0); PG8_MMA(0, 1, At, B1); PG8_BAR; PG8_SCHED;
            PG8_LDA(At, 0, 1); PG8_STAGE(PG8_SB(0, 0), b2, voffB); PG8_STAGE(PG8_SB(0, 1), b2 + hstepB, voffB); PG8_STAGE(PG8_SA(0, 0), a2, voffA);
            PG8_WAIT_V(8); PG8_WAIT_L(0); PG8_BAR; PG8_MMA(1, 0, At, B0); PG8_MMA(1, 1, At, B1); PG8_BAR; PG8_SCHED;
            PG8_LDB(B0, 1, 0); PG8_LDB(B1, 1, 1); PG8_SCHED; PG8_LDA(At, 1, 0); PG8_STAGE(PG8_SA(0, 1), a2 + hstepA, voffA);
            PG8_WAIT_V(8); PG8_WAIT_L(0); PG8_BAR; PG8_MMA(0, 0, At, B0); PG8_MMA(0, 1, At, B1); PG8_BAR; PG8_SCHED;
            PG8_LDA(At, 1, 1); PG8_STAGE(PG8_SB(1, 0), b3, voffB); PG8_STAGE(PG8_SB(1, 1), b3 + hstepB, voffB); PG8_STAGE(PG8_SA(1, 0), a3, voffA);
            PG8_WAIT_V(8); PG8_WAIT_L(0); PG8_BAR; PG8_MMA(1, 0, At, B0); PG8_MMA(1, 1, At, B1); PG8_BAR; PG8_SCHED;
        }
        if constexpr (ALIGN_EPI) { if (wr == 0) PG8_BAR; }
        if constexpr (!Epi::AFTER_DRAIN) { int fr2 = fr, fq2 = fq; asm volatile("" : "+v"(fr2), "+v"(fq2)); E(acc, cur, wr, wc, fr2, fq2); }
        if (!has_next) break;
#pragma unroll
        for (int a = 0; a < 2; ++a)
#pragma unroll
            for (int b = 0; b < 2; ++b)
#pragma unroll
                for (int m = 0; m < 4; ++m)
#pragma unroll
                    for (int n = 0; n < 2; ++n) acc[a][b][m][n] = (f32x4){0.f, 0.f, 0.f, 0.f};
        cur = nxt; cA = nA; cB = nB; ++ui;
        if constexpr (ALIGN_EPI) { if (wr == 1) PG8_BAR; }
    }
    PG8_WAIT_V(0);
    if constexpr (!ALIGN_EPI) { if (wr == 0) PG8_BAR; }
    PG8_BAR;
    if constexpr (Epi::AFTER_DRAIN) { int fr2 = fr, fq2 = fq; asm volatile("" : "+v"(fr2), "+v"(fq2)); E.fused(acc, cur, wr, wc, fr2, fq2, lds, wid, lane); }
#undef PG8_SA
#undef PG8_SB
#undef PG8_STAGE
#undef PG8_LDA
#undef PG8_LDB
#undef PG8_MMA
#undef PG8_WAIT_V
#undef PG8_WAIT_L
#undef PG8_BAR
#undef PG8_SCHED
}
struct UnitG { const char* a; const char* b; int lda, ldb, nt, kind, perm; };
template <class Epi, class Sched, bool ALIGN_EPI>
__device__ __forceinline__ void gemm_stream(PG8_LAS unsigned char* lds, const Sched& S, const Epi& E) {
    int tid_ = threadIdx.x; asm volatile("" : "+v"(tid_));
    const int tid = tid_, wid = __builtin_amdgcn_readfirstlane(tid >> 6), lane = tid & 63, wr = wid >> 2, wc = wid & 3, fr = lane & 15, fq = lane >> 4;
#define PG8_VOFF(u, vA, vB) do { _Pragma("unroll") for (int i_ = 0; i_ < 2; ++i_) { int R_, C_; stage_rc(tid * 16 + i_ * 8192, R_, C_); const int Rb_ = (u).perm ? ((R_ & ~31) + perm32(R_ & 31)) : R_; \
        vA[i_] = (unsigned)(R_ * (u).lda + C_) * 2u; vB[i_] = (unsigned)(Rb_ * (u).ldb + C_) * 2u; } } while (0)
    const size_t kstep = (size_t)(BK * 2);
    const unsigned ldsw = (unsigned)wid * 1024u;
    const int aoff = lds_byte(wr * 64 + fr, fq * 8), boff = lds_byte(wc * 32 + fr, fq * 8);
#undef PG8_SA
#undef PG8_SB
#undef PG8_STAGE
#undef PG8_LDA
#undef PG8_LDB
#undef PG8_MMA
#undef PG8_WAIT_V
#undef PG8_WAIT_L
#undef PG8_BAR
#undef PG8_SCHED
#define PG8_SA(b, h) (((b) * 2 + (h)) * HTB)
#define PG8_SB(b, h) ((4 + (b) * 2 + (h)) * HTB)
#define PG8_STAGE(bufoff, gbase, voff) do { _Pragma("unroll") for (int _i = 0; _i < 2; ++_i) \
        __builtin_amdgcn_global_load_lds((const unsigned*)((const char*)(gbase) + (voff)[_i]), (PG8_LAS unsigned*)(lds + (bufoff) + ldsw + _i * 8192), 16, 0, 0); } while (0)
#define PG8_LDA(dst, b, h) do { _Pragma("unroll") for (int m = 0; m < 4; ++m) _Pragma("unroll") for (int k = 0; k < 2; ++k) dst[m][k] = *(const PG8_LAS bf16x8*)(lds + PG8_SA(b, h) + aoff + m * 2048 + k * 1024); } while (0)
#define PG8_LDB(dst, b, h) do { _Pragma("unroll") for (int n = 0; n < 2; ++n) _Pragma("unroll") for (int k = 0; k < 2; ++k) dst[n][k] = *(const PG8_LAS bf16x8*)(lds + PG8_SB(b, h) + boff + n * 2048 + k * 1024); } while (0)
#define PG8_MMA(ai, bj, At, Bt) do { __builtin_amdgcn_s_setprio(1); _Pragma("unroll") for (int m = 0; m < 4; ++m) _Pragma("unroll") for (int n = 0; n < 2; ++n) _Pragma("unroll") for (int k = 0; k < 2; ++k) \
        acc[ai][bj][m][n] = __builtin_amdgcn_mfma_f32_16x16x32_bf16(Bt[n][k], At[m][k], acc[ai][bj][m][n], 0, 0, 0); __builtin_amdgcn_s_setprio(0); } while (0)
#define PG8_WAIT_V(n) asm volatile("s_waitcnt vmcnt(" #n ")" ::: "memory")
#define PG8_WAIT_L(n) asm volatile("s_waitcnt lgkmcnt(" #n ")" ::: "memory")
#define PG8_BAR __builtin_amdgcn_s_barrier()
#define PG8_SCHED __builtin_amdgcn_sched_barrier(0)
    UnitG cur, nxt; int ui = 0;
    if (!S.next(0, cur)) return;
    unsigned voffA[2], voffB[2]; PG8_VOFF(cur, voffA, voffB);
    size_t hstepA = (size_t)HALF * cur.lda * 2, hstepB = (size_t)HALF * cur.ldb * 2;
    f32x4 acc[2][2][4][2];
#pragma unroll
    for (int a = 0; a < 2; ++a)
#pragma unroll
        for (int b = 0; b < 2; ++b)
#pragma unroll
            for (int m = 0; m < 4; ++m)
#pragma unroll
                for (int n = 0; n < 2; ++n) acc[a][b][m][n] = (f32x4){0.f, 0.f, 0.f, 0.f};
    bf16x8 At[4][2], B0[2][2], B1[2][2];
    const char* cA = cur.a; const char* cB = cur.b;
    PG8_STAGE(PG8_SB(0, 0), cB, voffB); PG8_STAGE(PG8_SB(0, 1), cB + hstepB, voffB); PG8_STAGE(PG8_SA(0, 0), cA, voffA); PG8_STAGE(PG8_SA(0, 1), cA + hstepA, voffA);
    if (wr == 1) PG8_BAR;
    PG8_WAIT_V(2); PG8_BAR;
    PG8_STAGE(PG8_SB(1, 0), cB + kstep, voffB); PG8_STAGE(PG8_SA(1, 0), cA + kstep, voffA); PG8_STAGE(PG8_SB(1, 1), cB + hstepB + kstep, voffB);
    PG8_WAIT_V(6); PG8_BAR;
    for (;;) {
        const bool has_next = S.next(ui + 1, nxt); const int nt = cur.nt; if (!has_next) nxt = cur;
        const char* nA = nxt.a; const char* nB = nxt.b;
        const size_t nhA = (size_t)HALF * nxt.lda * 2, nhB = (size_t)HALF * nxt.ldb * 2;
        for (int t = 0; t < nt; t += 2) {
            const bool last = (t == nt - 2);
            const char* a1 = cA + (size_t)(t + 1) * kstep;
            const char* a2 = last ? nA : cA + (size_t)(t + 2) * kstep; const char* b2 = last ? nB : cB + (size_t)(t + 2) * kstep;
            const char* a3 = a2 + kstep; const char* b3 = b2 + kstep;
            unsigned xvA[2], xvB[2]; if (last) { PG8_VOFF(nxt, xvA, xvB); } else { xvA[0] = voffA[0]; xvA[1] = voffA[1]; xvB[0] = voffB[0]; xvB[1] = voffB[1]; }
            const size_t xhA = last ? nhA : hstepA, xhB = last ? nhB : hstepB;
            PG8_LDB(B0, 0, 0); PG8_LDB(B1, 0, 1); PG8_SCHED; PG8_LDA(At, 0, 0); PG8_STAGE(PG8_SA(1, 1), a1 + hstepA, voffA);
            PG8_WAIT_V(8); PG8_WAIT_L(0); PG8_BAR; PG8_MMA(0, 0, At, B0); PG8_MMA(0, 1, At, B1); PG8_BAR; PG8_SCHED;
            PG8_LDA(At, 0, 1); PG8_STAGE(PG8_SB(0, 0), b2, xvB); PG8_STAGE(PG8_SB(0, 1), b2 + xhB, xvB); PG8_STAGE(PG8_SA(0, 0), a2, xvA);
            PG8_WAIT_V(8); PG8_WAIT_L(0); PG8_BAR; PG8_MMA(1, 0, At, B0); PG8_MMA(1, 1, At, B1); PG8_BAR; PG8_SCHED;
            PG8_LDB(B0, 1, 0); PG8_LDB(B1, 1, 1); PG8_SCHED; PG8_LDA(At, 1, 0); PG8_STAGE(PG8_SA(0, 1), a2 + xhA, xvA);
            PG8_WAIT_V(8); PG8_WAIT_L(0); PG8_BAR; PG8_MMA(0, 0, At, B0); PG8_MMA(0, 1, At, B1); PG8_BAR; PG8_SCHED;
            PG8_LDA(At, 1, 1); PG8_STAGE(PG8_SB(1, 0), b3, xvB); PG8_STAGE(PG8_SB(1, 1), b3 + xhB, xvB); PG8_STAGE(PG8_SA(1, 0), a3, xvA);
            PG8_WAIT_V(8); PG8_WAIT_L(0); PG8_BAR; PG8_MMA(1, 0, At, B0); PG8_MMA(1, 1, At, B1); PG8_BAR; PG8_SCHED;
        }
        if constexpr (ALIGN_EPI) { if (wr == 0) PG8_BAR; }
        if (!E.after_drain(cur)) { int fr2 = fr, fq2 = fq; asm volatile("" : "+v"(fr2), "+v"(fq2)); E(acc, cur, wr, wc, fr2, fq2); }
        if (!has_next) break;
#pragma unroll
        for (int a = 0; a < 2; ++a)
#pragma unroll
            for (int b = 0; b < 2; ++b)
#pragma unroll
                for (int m = 0; m < 4; ++m)
#pragma unroll
                    for (int n = 0; n < 2; ++n) acc[a][b][m][n] = (f32x4){0.f, 0.f, 0.f, 0.f};
        cur = nxt; cA = nA; cB = nB; ++ui; PG8_VOFF(cur, voffA, voffB); hstepA = nhA; hstepB = nhB;
        if constexpr (ALIGN_EPI) { if (wr == 1) PG8_BAR; }
    }
    PG8_WAIT_V(0);
    if constexpr (!ALIGN_EPI) { if (wr == 0) PG8_BAR; }
    PG8_BAR;
    if (E.after_drain(cur)) { int fr2 = fr, fq2 = fq; asm volatile("" : "+v"(fr2), "+v"(fq2)); E.fused(acc, cur, wr, wc, fr2, fq2, lds, wid, lane); }
#undef PG8_SA
#undef PG8_SB
#undef PG8_STAGE
#undef PG8_LDA
#undef PG8_LDB
#undef PG8_MMA
#undef PG8_WAIT_V
#undef PG8_WAIT_L
#undef PG8_BAR
#undef PG8_SCHED
#undef PG8_VOFF
}
}

namespace mk {
using pg8::bf16_t; using pg8::f32x4; using pg8::f32x2; using pg8::u32x4; using pg8::u32x2; using pg8::Unit;
constexpr int D = 2048, BATCH = 2, SEQ = 4096, M = BATCH * SEQ, D_IN = 16384, D_FF = 8192, N_MEM = 256;
constexpr float EPS = 1e-6f, LOG2E = 1.4426950408889634f;
constexpr size_t MiB = 1u << 20;
constexpr size_t WS_CTL = 0, CTL_ZERO_BYTES = 1 * MiB;
constexpr size_t WS_COS = 1 * MiB, WS_SIN = 2 * MiB;
constexpr size_t WS_SSQ_NAQ = 3 * MiB, WS_SSQ_NAK = 4 * MiB;
constexpr size_t WS_SSQ_XQ = 5 * MiB, WS_XL = 5 * MiB + 512 * 1024;
constexpr size_t WS_SSQ_X1 = 6 * MiB;
constexpr size_t WS_TAB = 6 * MiB + 512 * 1024;
constexpr int TAB_CS_NAQ = 0, TAB_CS_MK = 128, TAB_L2F = 384, TAB_L2B = 392, TAB_SSQ_MK = 1024;
constexpr size_t WS_MEMN = 8 * MiB, WS_MK = 10 * MiB, WS_MVT = 11 * MiB;
constexpr size_t WS_WIN = 16 * MiB, WS_WFF1 = 80 * MiB, WS_WFF2 = 112 * MiB, WS_WRET = 144 * MiB, WS_WOUT = 152 * MiB, WS_WNM = 160 * MiB  , WS_WMKV = 168 * MiB;
constexpr size_t WS_NAQKV = 176 * MiB, WS_K0 = 224 * MiB, WS_RG = 240 * MiB, WS_XQ = 272 * MiB, WS_GATES = 288 * MiB;
constexpr size_t WS_AR = 384 * MiB, WS_BR = 448 * MiB, WS_END = 512 * MiB;
constexpr size_t WS_KV = WS_WIN;
constexpr size_t WS_ORET = 16 * MiB;
constexpr size_t WS_MERGED = WS_NAQKV;
constexpr size_t WS_X1B = WS_AR;
constexpr size_t WS_HFF = 176 * MiB;
constexpr int LDH = 8192;
constexpr size_t DO_HN = 0, DO_KT = 0, DO_XP = 32 * MiB, DO_ONM = 0;

struct SchedGrid {
    pg8::GridOrder o; const char* A; const char* B; size_t ta, tb;
    __device__ __forceinline__ bool next(int i, Unit& u) const { return o.next(i, u); }
    __device__ __forceinline__ void ptrs(const Unit& u, const char*& a, const char*& b) const { a = A + (size_t)u.pm * ta; b = B + (size_t)u.pn * tb; }
    __device__ __forceinline__ int nt(const Unit&, int K) const { return K / 64; }
};
struct SchedProj {
    pg8::GridOrder o; const char* hn_; const char* wt_;
    __device__ __forceinline__ bool next(int i, Unit& u) const { return o.next(i, u); }
    __device__ __forceinline__ void ptrs(const Unit& u, const char*& a, const char*& b) const {
        const char* h = hn_ + (size_t)u.pm * (256u * 2048u * 2u); const char* w = wt_ + (size_t)u.pn * (256u * 2048u * 2u);
        const bool sw = (u.pn >= 20 && u.pn < 28); a = sw ? w : h; b = sw ? h : w; }
    __device__ __forceinline__ int nt(const Unit&, int K) const { return K / 64; }
};
struct SchedOne { bool has; Unit u; const char* a; const char* b;
    __device__ __forceinline__ bool next(int i, Unit& uu) const { if (i != 0 || !has) return false; uu = u; return true; }
    __device__ __forceinline__ void ptrs(const Unit&, const char*& aa, const char*& bb) const { aa = a; bb = b; }
    __device__ __forceinline__ int nt(const Unit&, int K) const { return K / 64; }
};

#define MK_ROWS_BEGIN _Pragma("unroll") for (int ai = 0; ai < 2; ++ai) { _Pragma("unroll") for (int m = 0; m < 4; ++m) { const int rl = ai * 128 + wr * 64 + m * 16 + fr;
#define MK_ROWS_END __builtin_amdgcn_sched_barrier(0); } }
#define MK_ROWS_END_NB } }
#define MK_ROWS_END2 if (m & 1) __builtin_amdgcn_sched_barrier(0); } }
#define MK_RL(ai, m) ((ai) * 128 + wr * 64 + (m) * 16 + fr)
__device__ __forceinline__ float sq8(const f32x4& a, const f32x4& b) { return (a[0] * a[0] + a[1] * a[1]) + (a[2] * a[2] + a[3] * a[3]) + (b[0] * b[0] + b[1] * b[1]) + (b[2] * b[2] + b[3] * b[3]); }
__device__ __forceinline__ float red_fq(float s) {
    { auto r = __builtin_amdgcn_permlane16_swap(__float_as_uint(s), __float_as_uint(s), false, false); s = __uint_as_float(r[0]) + __uint_as_float(r[1]); }
    { auto r = __builtin_amdgcn_permlane32_swap(__float_as_uint(s), __float_as_uint(s), false, false); s = __uint_as_float(r[0]) + __uint_as_float(r[1]); }
    return s; }

struct EpiProj {
    static constexpr bool PERM = true, AFTER_DRAIN = false;
    unsigned char* ws;
    __device__ __forceinline__ void operator()(const f32x4 (&acc)[2][2][4][2], const Unit& u, int wr, int wc, int fr, int fq) const {
        bf16_t* const naqkv = (bf16_t*)(ws + WS_NAQKV); bf16_t* const k0 = (bf16_t*)(ws + WS_K0); bf16_t* const rg = (bf16_t*)(ws + WS_RG); bf16_t* const xq = (bf16_t*)(ws + WS_XQ);
        bf16_t* const gates = (bf16_t*)(ws + WS_GATES); bf16_t* const ar = (bf16_t*)(ws + WS_AR); bf16_t* const br = (bf16_t*)(ws + WS_BR);
        float* const ssq_naq = (float*)(ws + WS_SSQ_NAQ); float* const ssq_nak = (float*)(ws + WS_SSQ_NAK); float* const ssq_xq = (float*)(ws + WS_SSQ_XQ);
        const float* const cosT = (const float*)(ws + WS_COS); const float* const sinT = (const float*)(ws + WS_SIN); const float* const tab = (const float*)(ws + WS_TAB);
        const int pn = u.pn, row0 = u.pm * 256, cw = wc * 32 + 8 * fq;
        if (pn < 8) {
            const bool isq = pn < 4; float* ssq = isq ? ssq_naq : ssq_nak; const int hb = isq ? 2 * pn : 2 * (pn - 4);
            f32x4 c0 = (f32x4){1.f, 1.f, 1.f, 1.f}, c1 = c0; if (isq) { c0 = *(const f32x4*)(tab + TAB_CS_NAQ + cw); c1 = *(const f32x4*)(tab + TAB_CS_NAQ + cw + 4); }
            MK_ROWS_BEGIN  const int row = row0 + rl;
#pragma unroll
                for (int bj = 0; bj < 2; ++bj) { const f32x4 v0 = acc[ai][bj][m][0], v1 = acc[ai][bj][m][1]; const float q = red_fq(sq8(v0, v1));
                    if (fq == 0) ssq[(size_t)row * 32 + (hb + bj) * 4 + wc] = q;
                    pg8::store8(naqkv + (size_t)row * 3072 + pn * 256 + bj * 128 + cw, v0 * c0, v1 * c1); }  MK_ROWS_END
        } else if (pn < 12) {
            MK_ROWS_BEGIN  const int row = row0 + rl;
#pragma unroll
                for (int bj = 0; bj < 2; ++bj) pg8::store8(naqkv + (size_t)row * 3072 + pn * 256 + bj * 128 + cw, acc[ai][bj][m][0], acc[ai][bj][m][1]);  MK_ROWS_END
        } else if (pn < 20) {
            const bool isq = pn < 16; const int head = 2 * (pn & 3) + (wc >> 1), i0 = 32 * (wc & 1) + 8 * fq;
            const float l2f = tab[TAB_L2F + head], l2b = tab[TAB_L2B + head];
            MK_ROWS_BEGIN  const int row = row0 + rl, s = row & 4095, b = row >> 12;
                const f32x4 cs0 = *(const f32x4*)(cosT + s * 64 + i0), cs1 = *(const f32x4*)(cosT + s * 64 + i0 + 4), sn0 = *(const f32x4*)(sinT + s * 64 + i0), sn1 = *(const f32x4*)(sinT + s * 64 + i0 + 4);
                const f32x4 a0 = acc[ai][0][m][0], a1 = acc[ai][0][m][1], b0 = acc[ai][1][m][0], b1 = acc[ai][1][m][1];
                const f32x4 lo0 = a0 * cs0 - b0 * sn0, lo1 = a1 * cs1 - b1 * sn1, hi0 = a0 * sn0 + b0 * cs0, hi1 = a1 * sn1 + b1 * cs1;
                if (isq) { const int c = row & 255; const float df = pg8::fexp2(l2f * (float)(c + 1)), db = pg8::fexp2(l2b * (float)(256 - c));
                    bf16_t* d = ar + ((size_t)(b * 8 + head) * 4096 + s) * 512 + 256 + i0;
                    pg8::store8(d, lo0 * df, lo1 * df); pg8::store8(d + 64, hi0 * df, hi1 * df); pg8::store8(d + 128, lo0 * db, lo1 * db); pg8::store8(d + 192, hi0 * db, hi1 * db);
                } else { const float sc = 0.08838834764831845f; bf16_t* d = k0 + (size_t)row * 1024 + head * 128 + i0;
                    pg8::store8(d, lo0 * sc, lo1 * sc); pg8::store8(d + 64, hi0 * sc, hi1 * sc); }  MK_ROWS_END2
        } else if (pn < 28) {
            const int hv = pn - 20, b = u.pm >> 4, nc = u.pm & 15;
            bf16_t* base = br + ((size_t)((b * 8 + hv) * 16 + nc) * 256) * 512;
            MK_ROWS_BEGIN
#pragma unroll
                for (int bj = 0; bj < 2; ++bj) pg8::store8(base + (size_t)rl * 512 + bj * 128 + cw, acc[ai][bj][m][0], acc[ai][bj][m][1]);  MK_ROWS_END
        } else if (pn < 36) {
            MK_ROWS_BEGIN  const int row = row0 + rl;
#pragma unroll
                for (int bj = 0; bj < 2; ++bj) { f32x4 v0 = acc[ai][bj][m][0], v1 = acc[ai][bj][m][1];
#pragma unroll
                    for (int e = 0; e < 4; ++e) { v0[e] = v0[e] * pg8::sigmoidf_(v0[e]); v1[e] = v1[e] * pg8::sigmoidf_(v1[e]); }
                    pg8::store8(rg + (size_t)row * 2048 + (pn - 28) * 256 + bj * 128 + cw, v0, v1); }  MK_ROWS_END
        } else if (pn < 40) {
            MK_ROWS_BEGIN  const int row = row0 + rl;
                const float q = red_fq(sq8(acc[ai][0][m][0], acc[ai][0][m][1]) + sq8(acc[ai][1][m][0], acc[ai][1][m][1]));
                if (fq == 0) ssq_xq[(size_t)row * 16 + (pn - 36) * 4 + wc] = q;
#pragma unroll
                for (int bj = 0; bj < 2; ++bj) pg8::store8(xq + (size_t)row * 1024 + (pn - 36) * 256 + bj * 128 + cw, acc[ai][bj][m][0], acc[ai][bj][m][1]);  MK_ROWS_END
        } else {
            MK_ROWS_BEGIN  const int row = row0 + rl;
#pragma unroll
                for (int bj = 0; bj < 2; ++bj) { f32x4 v0 = acc[ai][bj][m][0], v1 = acc[ai][bj][m][1];
#pragma unroll
                    for (int e = 0; e < 4; ++e) { v0[e] = pg8::sigmoidf_(v0[e]); v1[e] = pg8::sigmoidf_(v1[e]); }
                    pg8::store8(gates + (size_t)row * 6144 + (pn - 40) * 256 + bj * 128 + cw, v0, v1); }  MK_ROWS_END
        }
    }
};
struct EpiMKV {
    static constexpr bool PERM = true, AFTER_DRAIN = false;
    bf16_t *mk, *mvt; float* tabw; const float* tab; int mode;
    __device__ __forceinline__ void operator()(const f32x4 (&acc)[2][2][4][2], const Unit& u, int wr, int wc, int fr, int fq) const {
        const int cw = wc * 32 + 8 * fq, row0 = u.pm * 256;
        if (mode == 0) {
            MK_ROWS_BEGIN  const int row = row0 + rl;
                const float q = red_fq(sq8(acc[ai][0][m][0], acc[ai][0][m][1]) + sq8(acc[ai][1][m][0], acc[ai][1][m][1]));
                if (fq == 0) tabw[TAB_SSQ_MK + row * 16 + u.pn * 4 + wc] = q;
#pragma unroll
                for (int bj = 0; bj < 2; ++bj) { const f32x4 c0 = *(const f32x4*)(tab + TAB_CS_MK + bj * 128 + cw), c1 = *(const f32x4*)(tab + TAB_CS_MK + bj * 128 + cw + 4);
                    pg8::store8(mk + (size_t)row * 1024 + u.pn * 256 + bj * 128 + cw, acc[ai][bj][m][0] * c0, acc[ai][bj][m][1] * c1); }  MK_ROWS_END
        } else {
            MK_ROWS_BEGIN  const int row = row0 + rl;
#pragma unroll
                for (int bj = 0; bj < 2; ++bj) pg8::store8(mvt + (size_t)row * 512 + u.pn * 256 + bj * 128 + cw, acc[ai][bj][m][0], acc[ai][bj][m][1]);  MK_ROWS_END
        }
    }
};
struct EpiF32 {
    static constexpr bool PERM = true, AFTER_DRAIN = false;
    bf16_t* C;
    __device__ __forceinline__ void operator()(const f32x4 (&acc)[2][2][4][2], const Unit&, int wr, int wc, int fr, int fq) const {
        const int cw = wc * 32 + 8 * fq;
        MK_ROWS_BEGIN
#pragma unroll
            for (int bj = 0; bj < 2; ++bj) pg8::store8(C + (size_t)rl * 256 + bj * 128 + cw, acc[ai][bj][m][0], acc[ai][bj][m][1]);  MK_ROWS_END
    }
};
struct EpiP {
    static constexpr bool PERM = true, AFTER_DRAIN = false;
    bf16_t* P; float l2f, l2b;
    __device__ __forceinline__ void operator()(const f32x4 (&acc)[2][2][4][2], const Unit&, int wr, int wc, int fr, int fq) const {
        const int cw = wc * 32 + 8 * fq;
        MK_ROWS_BEGIN  const int c = rl; const float rowf = -l2f * (float)(c + 1);
#pragma unroll
            for (int bj = 0; bj < 2; ++bj) { f32x4 v[2] = {acc[ai][bj][m][0], acc[ai][bj][m][1]};
#pragma unroll
                for (int n = 0; n < 2; ++n)
#pragma unroll
                    for (int e = 0; e < 4; ++e) { const int cp = bj * 128 + cw + 4 * n + e;
                        const float ex = (c >= cp) ? (-l2f * (float)(cp + 1)) : (l2b * (float)(cp - c) + rowf);
                        v[n][e] *= pg8::fexp2(ex); }
                pg8::store8(P + (size_t)c * 512 + bj * 128 + cw, v[0], v[1]); }  MK_ROWS_END
    }
};
struct EpiGN {
    static constexpr bool PERM = true, AFTER_DRAIN = true;
    bf16_t* oret; const bf16_t* rgv; const float* gn;
    __device__ __forceinline__ void fused(f32x4 (&acc)[2][2][4][2], const Unit&, int wr, int wc, int fr, int fq, PG8_LAS unsigned char* lds, int wid, int lane) const {
        PG8_LAS f32x2* P = (PG8_LAS f32x2*)lds;
        const int cw = wc * 32 + 8 * fq;
        MK_ROWS_BEGIN  float s = 0.f;
#pragma unroll
            for (int bj = 0; bj < 2; ++bj)
#pragma unroll
                for (int n = 0; n < 2; ++n) { const f32x4 x = acc[ai][bj][m][n]; s += (x[0] + x[1]) + (x[2] + x[3]); }
            s = red_fq(s); const float mw = s * (1.0f / 64.0f); float q = 0.f;
#pragma unroll
            for (int bj = 0; bj < 2; ++bj)
#pragma unroll
                for (int n = 0; n < 2; ++n) { const f32x4 d = acc[ai][bj][m][n] - mw; q += (d[0] * d[0] + d[1] * d[1]) + (d[2] * d[2] + d[3] * d[3]); }
            q = red_fq(q);
            if (fq == 0) P[rl * 4 + wc] = (f32x2){mw, q};  MK_ROWS_END
        asm volatile("s_waitcnt lgkmcnt(0)" ::: "memory"); __builtin_amdgcn_s_barrier(); asm volatile("" ::: "memory");
        f32x4 g0[2], g1[2];
#pragma unroll
        for (int bj = 0; bj < 2; ++bj) { g0[bj] = *(const f32x4*)(gn + bj * 128 + cw); g1[bj] = *(const f32x4*)(gn + bj * 128 + cw + 4); }
        MK_ROWS_BEGIN  const f32x2 a = P[rl * 4 + 0], b = P[rl * 4 + 1], c = P[rl * 4 + 2], d = P[rl * 4 + 3];
            const float mt = (a.x + b.x + c.x + d.x) * 0.25f;
            const float da = a.x - mt, db = b.x - mt, dc = c.x - mt, dd = d.x - mt;
            const float m2 = (a.y + b.y) + (c.y + d.y) + 64.0f * ((da * da + db * db) + (dc * dc + dd * dd));
            const float rstd = 1.0f / sqrtf(m2 * (1.0f / 256.0f) + EPS);
#pragma unroll
            for (int bj = 0; bj < 2; ++bj) { f32x4 r0, r1; pg8::load8(rgv + (size_t)rl * 2048 + bj * 128 + cw, r0, r1);
                const f32x4 o0 = (acc[ai][bj][m][0] - mt) * rstd * g0[bj] * r0, o1 = (acc[ai][bj][m][1] - mt) * rstd * g1[bj] * r1;
                pg8::store8(oret + (size_t)rl * 2048 + bj * 128 + cw, o0, o1); }  MK_ROWS_END_NB
        asm volatile("s_waitcnt lgkmcnt(0)" ::: "memory"); __builtin_amdgcn_s_barrier(); asm volatile("" ::: "memory");
    }
};
struct EpiXS {
    static constexpr bool PERM = true, AFTER_DRAIN = false;
    bf16_t* xp; float* xl; const float* ssq_q; const float* ssq_k;
    __device__ __forceinline__ void operator()(const f32x4 (&acc)[2][2][4][2], const Unit&, int wr, int wc, int fr, int fq) const {
        const int cw = wc * 32 + 8 * fq;
        float rk[2][8];
#pragma unroll
        for (int bj = 0; bj < 2; ++bj)
#pragma unroll
            for (int j = 0; j < 8; ++j) { const f32x4 p = *(const f32x4*)(ssq_k + (size_t)(bj * 128 + cw + j) * 16); rk[bj][j] = rsqrtf(((p[0] + p[1]) + (p[2] + p[3])) * (1.0f / 256.0f) + EPS) * LOG2E; }
#pragma unroll
        for (int ai = 0; ai < 2; ++ai) {
            float rqa[4];
#pragma unroll
            for (int m = 0; m < 4; ++m) { const f32x4 pq = *(const f32x4*)(ssq_q + (size_t)MK_RL(ai, m) * 16); rqa[m] = rsqrtf(((pq[0] + pq[1]) + (pq[2] + pq[3])) * (1.0f / 256.0f) + EPS); }
#pragma unroll
            for (int m = 0; m < 4; ++m) { const int rl = MK_RL(ai, m); const float rq = rqa[m];
                float s = 0.f;
#pragma unroll
                for (int bj = 0; bj < 2; ++bj) { f32x4 v[2] = {acc[ai][bj][m][0], acc[ai][bj][m][1]};
#pragma unroll
                    for (int n = 0; n < 2; ++n)
#pragma unroll
                        for (int e = 0; e < 4; ++e) { v[n][e] = pg8::fexp2(v[n][e] * rq * rk[bj][4 * n + e]); s += v[n][e]; }
                    pg8::store8(xp + (size_t)rl * 1024 + bj * 128 + cw, v[0], v[1]); }
                s = red_fq(s); if (fq == 0) xl[(size_t)rl * 16 + wc] = s;
                __builtin_amdgcn_sched_barrier(0); }
        }
    }
};
struct EpiXO {
    static constexpr bool PERM = true, AFTER_DRAIN = false;
    bf16_t* omem; const float* xl;
    __device__ __forceinline__ void operator()(const f32x4 (&acc)[2][2][4][2], const Unit&, int wr, int wc, int fr, int fq) const {
        const int cw = wc * 32 + 8 * fq;
        float ila[2][4];
#pragma unroll
        for (int ai = 0; ai < 2; ++ai)
#pragma unroll
            for (int m = 0; m < 4; ++m) { const f32x4 p = *(const f32x4*)(xl + (size_t)MK_RL(ai, m) * 16); ila[ai][m] = pg8::frcp((p[0] + p[1]) + (p[2] + p[3])); }
        MK_ROWS_BEGIN  const float il = ila[ai][m];
#pragma unroll
            for (int bj = 0; bj < 2; ++bj) pg8::store8(omem + (size_t)rl * 2048 + bj * 128 + cw, acc[ai][bj][m][0] * il, acc[ai][bj][m][1] * il);  MK_ROWS_END
    }
};
struct EpiGate4 {
    static constexpr bool PERM = true, AFTER_DRAIN = false;
    bf16_t* merged; const bf16_t* gates;
    __device__ __forceinline__ void operator()(const f32x4 (&acc)[2][2][4][2], const Unit& u, int wr, int wc, int fr, int fq) const {
        const int cw = wc * 32 + 8 * fq; const bf16_t* gate = gates + u.sub * 2048; const bool first = u.sub == 0;
        MK_ROWS_BEGIN  const size_t row = (size_t)u.pm * 256 + rl;
#pragma unroll
            for (int bj = 0; bj < 2; ++bj) { const int col = u.pn * 256 + bj * 128 + cw; f32x4 g0, g1; pg8::load8(gate + row * 6144 + col, g0, g1);
                f32x4 v0 = acc[ai][bj][m][0] * g0, v1 = acc[ai][bj][m][1] * g1;
                if (!first) { f32x4 t0, t1; pg8::load8(merged + row * 2048 + col, t0, t1); v0 += t0; v1 += t1; }
                pg8::store8(merged + row * 2048 + col, v0, v1); }  MK_ROWS_END_NB
    }
};
struct SchedBR {
    pg8::GridOrder o; const char* onm; const char* oret; const char* wnm; const char* wret;
    __device__ __forceinline__ bool next(int i, Unit& u) const { if (i >= 3) return false; const bool ok = o.next(0, u); u.sub = i; return ok; }
    __device__ __forceinline__ void ptrs(const Unit& u, const char*& a, const char*& b) const {
        const size_t ra = (size_t)u.pm * (256u * 2048u * 2u), rb = (size_t)u.pn * (256u * 2048u * 2u);
        const bool nm = (u.sub != 1); const size_t co = (u.sub == 2) ? 2048u : 0u;
        a = (nm ? onm : oret) + ra + co; b = (nm ? wnm : wret) + rb + co; }
    __device__ __forceinline__ int nt(const Unit& u, int) const { return u.sub == 1 ? 32 : 16; }
};
struct EpiWout {
    static constexpr bool PERM = false, AFTER_DRAIN = true;
    const float* x; float* x1; bf16_t* x1b; float* ssq; const float* gffn;
    __device__ __forceinline__ void fused(f32x4 (&acc)[2][2][4][2], const Unit& u, int wr, int wc, int fr, int fq, PG8_LAS unsigned char* lds, int wid, int lane) const {
        PG8_LAS float* P = (PG8_LAS float*)lds;
        const int col0 = u.pn * 256 + wc * 32 + 4 * fq;
        MK_ROWS_BEGIN  const size_t off = ((size_t)u.pm * 256 + rl) * 2048 + col0; float q = 0.f;
#pragma unroll
            for (int bj = 0; bj < 2; ++bj)
#pragma unroll
                for (int n = 0; n < 2; ++n) { const f32x4 v = *(const f32x4*)(x + off + bj * 128 + n * 16) + acc[ai][bj][m][n];
                    *(f32x4*)(x1 + off + bj * 128 + n * 16) = v; pg8::store4(x1b + off + bj * 128 + n * 16, v * *(const f32x4*)(gffn + col0 + bj * 128 + n * 16)); q += (v[0] * v[0] + v[1] * v[1]) + (v[2] * v[2] + v[3] * v[3]); }
            q = red_fq(q); if (fq == 0) P[rl * 4 + wc] = q;  MK_ROWS_END_NB
        asm volatile("s_waitcnt lgkmcnt(0)" ::: "memory"); __builtin_amdgcn_s_barrier(); asm volatile("" ::: "memory");
        if (threadIdx.x < 256) { const int r = threadIdx.x; const f32x4 p = *(const PG8_LAS f32x4*)(P + r * 4); ssq[((size_t)u.pm * 256 + r) * 8 + u.pn] = (p[0] + p[1]) + (p[2] + p[3]); }
        asm volatile("s_waitcnt lgkmcnt(0)" ::: "memory"); __builtin_amdgcn_s_barrier(); asm volatile("" ::: "memory");
    }
};
struct EpiFF1 {
    static constexpr bool PERM = true, AFTER_DRAIN = false;
    bf16_t* hff; const float* ssq;
    __device__ __forceinline__ void operator()(const f32x4 (&acc)[2][2][4][2], const Unit& u, int wr, int wc, int fr, int fq) const {
        const int cw = wc * 32 + 8 * fq;
        float ra[2][4];
#pragma unroll
        for (int ai = 0; ai < 2; ++ai)
#pragma unroll
            for (int m = 0; m < 4; ++m) { const size_t row = (size_t)u.pm * 256 + MK_RL(ai, m); const f32x4 p0 = *(const f32x4*)(ssq + row * 8), p1 = *(const f32x4*)(ssq + row * 8 + 4);
                ra[ai][m] = rsqrtf((((p0[0] + p0[1]) + (p0[2] + p0[3])) + ((p1[0] + p1[1]) + (p1[2] + p1[3]))) * (1.0f / 2048.0f) + EPS); }
        MK_ROWS_BEGIN  const size_t row = (size_t)u.pm * 256 + rl; const float r = ra[ai][m];
#pragma unroll
            for (int bj = 0; bj < 2; ++bj) { f32x4 v0 = acc[ai][bj][m][0] * r, v1 = acc[ai][bj][m][1] * r;
#pragma unroll
                for (int e = 0; e < 4; ++e) { const float a = fmaxf(v0[e], 0.f), b = fmaxf(v1[e], 0.f); v0[e] = a * a; v1[e] = b * b; }
                pg8::store8(hff + row * LDH + u.pn * 256 + bj * 128 + cw, v0, v1); }  MK_ROWS_END
    }
};
struct EpiFF2 {
    static constexpr bool PERM = false, AFTER_DRAIN = false;
    const float* src; float* out;
    __device__ __forceinline__ void operator()(const f32x4 (&acc)[2][2][4][2], const Unit& u, int wr, int wc, int fr, int fq) const {
        const int col0 = u.pn * 256 + wc * 32 + 4 * fq;
        MK_ROWS_BEGIN  const size_t off = ((size_t)u.pm * 256 + rl) * 2048 + col0;
#pragma unroll
            for (int bj = 0; bj < 2; ++bj)
#pragma unroll
                for (int n = 0; n < 2; ++n) { const size_t o2 = off + bj * 128 + n * 16; *(f32x4*)(out + o2) = *(const f32x4*)(src + o2) + acc[ai][bj][m][n]; }  MK_ROWS_END_NB
    }
};

struct SchedList3 {
    pg8::UnitG u0, u1, u2; int n;
    __device__ __forceinline__ bool next(int i, pg8::UnitG& u) const { if (i >= n) return false;
        u.a = (i == 0) ? u0.a : ((i == 1) ? u1.a : u2.a); u.b = (i == 0) ? u0.b : ((i == 1) ? u1.b : u2.b);
        u.lda = (i == 0) ? u0.lda : ((i == 1) ? u1.lda : u2.lda); u.ldb = (i == 0) ? u0.ldb : ((i == 1) ? u1.ldb : u2.ldb);
        u.nt = (i == 0) ? u0.nt : ((i == 1) ? u1.nt : u2.nt); u.kind = (i == 0) ? u0.kind : ((i == 1) ? u1.kind : u2.kind); u.perm = (i == 0) ? u0.perm : ((i == 1) ? u1.perm : u2.perm);
        return true; }
};
struct EpiM1 {
    EpiF32 e0; EpiP e1; EpiXS e2;
    __device__ __forceinline__ bool after_drain(const pg8::UnitG&) const { return false; }
    __device__ __forceinline__ void operator()(const f32x4 (&acc)[2][2][4][2], const pg8::UnitG& u, int wr, int wc, int fr, int fq) const {
        Unit d; d.pm = 0; d.pn = 0; d.sub = 0;
        if (u.kind == 0) e0(acc, d, wr, wc, fr, fq); else if (u.kind == 1) e1(acc, d, wr, wc, fr, fq); else e2(acc, d, wr, wc, fr, fq); }
    __device__ __forceinline__ void fused(f32x4 (&)[2][2][4][2], const pg8::UnitG&, int, int, int, int, PG8_LAS unsigned char*, int, int) const {}
};
struct EpiM3 {
    EpiXO e0; EpiGN e1;
    __device__ __forceinline__ bool after_drain(const pg8::UnitG& u) const { return u.kind == 1; }
    __device__ __forceinline__ void operator()(const f32x4 (&acc)[2][2][4][2], const pg8::UnitG& u, int wr, int wc, int fr, int fq) const { Unit d; d.pm = 0; d.pn = 0; d.sub = 0; e0(acc, d, wr, wc, fr, fq); }
    __device__ __forceinline__ void fused(f32x4 (&acc)[2][2][4][2], const pg8::UnitG&, int wr, int wc, int fr, int fq, PG8_LAS unsigned char* lds, int wid, int lane) const {
        Unit d; d.pm = 0; d.pn = 0; d.sub = 0; e1.fused(acc, d, wr, wc, fr, fq, lds, wid, lane); }
};
#undef MK_ROWS_BEGIN
#undef MK_ROWS_END
#undef MK_ROWS_END_NB
#undef MK_ROWS_END2
#undef MK_RL
}

namespace na {
using bf16 = unsigned short;
using bf16x8 = __attribute__((ext_vector_type(8))) short;
using s16x4  = __attribute__((ext_vector_type(4))) short;
using f32x16 = __attribute__((ext_vector_type(16))) float;
using f32x4  = __attribute__((ext_vector_type(4))) float;
using u32x4  = __attribute__((ext_vector_type(4))) unsigned;
constexpr int DH = 128, NW = 8, QBLK = 32, KVBLK = 64, LDQ = 3072;
constexpr size_t SHM_V = KVBLK * DH * 2, SHM_K = KVBLK * DH * 2;
constexpr int NBUF = 3;
constexpr int OFF_RK = NBUF * SHM_V + NBUF * SHM_K;
constexpr int OFF_BIAS = OFF_RK + 768 * 4;
constexpr int BIAS_PAD = 64, BIAS_N = 64 + 15 * 31 + 79;
constexpr int OFF_LI = OFF_BIAS + ((BIAS_N * 4 + 15) / 16) * 16;
constexpr int NA_LDS_BYTES = OFF_LI + NW * 64 * 4;
#define KSWZ(row, colB) ((row) * 256 + ((colB) ^ (((row) & 7) << 4)))
#define SBAR() __builtin_amdgcn_sched_barrier(0)
__device__ __forceinline__ int crow(int r, int hi) { return (r & 3) + 8 * (r >> 2) + 4 * hi; }
__device__ __forceinline__ unsigned cvtpk(float lo, float hi) { return pg8::cvt_pk_bf16(lo, hi); }

__device__ __forceinline__ void procP(f32x16& p0, f32x16& p1, float& lsum, bool inwin, const float* rk_t  , const float* bias_l  ,
                                      float rqs, int cs, int hi) {
  if (!inwin) { p0 = f32x16{}; p1 = f32x16{}; return; }
#pragma unroll
  for (int g = 0; g < 4; ++g) {
    const f32x4 k0 = *(const f32x4*)(rk_t + 8 * g + 4 * hi), k1 = *(const f32x4*)(rk_t + 32 + 8 * g + 4 * hi);
#pragma unroll
    for (int e = 0; e < 4; ++e) { const int r = 4 * g + e; const int w0 = e + 8 * g + 4 * hi, w1 = w0 + 32;
      const float x0 = fmaf(p0[r], rqs * k0[e], bias_l[w0]), x1 = fmaf(p1[r], rqs * k1[e], bias_l[w1]);
      const float e0 = __builtin_amdgcn_exp2f(x0), e1 = __builtin_amdgcn_exp2f(x1);
      const float v0 = ((unsigned)(w0 - cs) < 16u) ? e0 : 0.f, v1 = ((unsigned)(w1 - cs) < 16u) ? e1 : 0.f;
      p0[r] = v0; p1[r] = v1; lsum += v0 + v1; }
  }
}
__device__ __forceinline__ void packP(const f32x16& p0, const f32x16& p1, bf16x8& pa0, bf16x8& pa1, bf16x8& pa2, bf16x8& pa3) {
#define PK4(P, BASE, OUT) do { unsigned a0 = cvtpk(P[BASE + 0], P[BASE + 1]), a1 = cvtpk(P[BASE + 2], P[BASE + 3]);   \
    unsigned b0 = cvtpk(P[BASE + 4], P[BASE + 5]), b1 = cvtpk(P[BASE + 6], P[BASE + 7]);                              \
    auto r0 = __builtin_amdgcn_permlane32_swap(a0, b0, false, false); auto r1 = __builtin_amdgcn_permlane32_swap(a1, b1, false, false); \
    u32x4 w = {r0[0], r1[0], r0[1], r1[1]}; OUT = *reinterpret_cast<bf16x8*>(&w); } while (0)
  PK4(p0, 0, pa0); PK4(p0, 8, pa1); PK4(p1, 0, pa2); PK4(p1, 8, pa3);
#undef PK4
}
__device__ __forceinline__ void qkt(f32x16& p0, f32x16& p1, const bf16* Ks, const bf16x8* qr, int r32, int hi) {
  p0 = f32x16{}; p1 = f32x16{};
#pragma unroll
  for (int d0 = 0; d0 < 8; ++d0) { int cb = (d0 * 16 + hi * 8) * 2;
    bf16x8 b0 = *reinterpret_cast<const bf16x8*>((const char*)Ks + KSWZ(r32, cb));
    bf16x8 b1 = *reinterpret_cast<const bf16x8*>((const char*)Ks + KSWZ(32 + r32, cb));
    p0 = __builtin_amdgcn_mfma_f32_32x32x16_bf16(b0, qr[d0], p0, 0, 0, 0);
    p1 = __builtin_amdgcn_mfma_f32_32x32x16_bf16(b1, qr[d0], p1, 0, 0, 0); }
}
__device__ __forceinline__ int v_st(int k, int c) { const int kk = (k & ~0xC) | ((k & 4) << 1) | ((k & 8) >> 1); return ((kk >> 3) * 4 + (c >> 5)) * 512 + ((kk & 7) * 32 + (c & 31)) * 2; }
__device__ __forceinline__ int v_rd_base(int lane) { return ((lane & 3) << 3) | (((lane >> 2) & 3) << 6) | (((lane >> 4) & 1) << 5) | (((lane >> 5) & 1) << 8); }
constexpr int v_rd_off(int d0, int ks, int half) { return d0 * 512 + ks * 4096 + half * 2048; }
template <int OFF> __device__ __forceinline__ s16x4 tr_read(int vb) {
  s16x4 r; asm volatile("ds_read_b64_tr_b16 %0, %1 offset:%2" : "=&v"(r) : "v"(vb), "i"(OFF) : "memory"); return r;
}
template <int D0> __device__ __forceinline__ void pv_one(f32x16& od, int vb, bf16x8 pa0, bf16x8 pa1, bf16x8 pa2, bf16x8 pa3) {
  const s16x4 l0 = tr_read<v_rd_off(D0, 0, 0)>(vb), h0 = tr_read<v_rd_off(D0, 0, 1)>(vb), l1 = tr_read<v_rd_off(D0, 1, 0)>(vb), h1 = tr_read<v_rd_off(D0, 1, 1)>(vb);
  const s16x4 l2 = tr_read<v_rd_off(D0, 2, 0)>(vb), h2 = tr_read<v_rd_off(D0, 2, 1)>(vb), l3 = tr_read<v_rd_off(D0, 3, 0)>(vb), h3 = tr_read<v_rd_off(D0, 3, 1)>(vb);
  asm volatile("s_waitcnt lgkmcnt(0)" ::: "memory"); SBAR();
#define PK(L, H) (bf16x8){L[0], L[1], L[2], L[3], H[0], H[1], H[2], H[3]}
  od = __builtin_amdgcn_mfma_f32_32x32x16_bf16(pa0, PK(l0, h0), od, 0, 0, 0);
  od = __builtin_amdgcn_mfma_f32_32x32x16_bf16(pa1, PK(l1, h1), od, 0, 0, 0);
  od = __builtin_amdgcn_mfma_f32_32x32x16_bf16(pa2, PK(l2, h2), od, 0, 0, 0);
  od = __builtin_amdgcn_mfma_f32_32x32x16_bf16(pa3, PK(l3, h3), od, 0, 0, 0);
#undef PK
}
__device__ __forceinline__ void pv_d0(f32x16* o, int vb, bf16x8 pa0, bf16x8 pa1, bf16x8 pa2, bf16x8 pa3) {
  pv_one<0>(o[0], vb, pa0, pa1, pa2, pa3); pv_one<1>(o[1], vb, pa0, pa1, pa2, pa3); pv_one<2>(o[2], vb, pa0, pa1, pa2, pa3); pv_one<3>(o[3], vb, pa0, pa1, pa2, pa3);
}

__device__ __forceinline__ void na_unit(int b, int h, int i4, const bf16* __restrict__ qkv, const float* __restrict__ ssq_q, const float* __restrict__ ssq_k,
                                        const float* __restrict__ rpb, bf16* __restrict__ ona, char* lds) {
  int tid_ = threadIdx.x; asm volatile("" : "+v"(tid_));
  const int tid = tid_, wid = __builtin_amdgcn_readfirstlane(tid >> 6), lane = tid & 63, r32 = lane & 31, hi = lane >> 5;
  bf16* V_lds = (bf16*)lds; bf16* K_lds = (bf16*)(lds + NBUF * SHM_V);
  float* rkL = (float*)(lds + OFF_RK); float* biasL = (float*)(lds + OFF_BIAS); float* li_l = (float*)(lds + OFF_LI) + wid * 64;
  const int NT = (i4 == 0 || i4 == 15) ? 8 : 11, rbase = (i4 == 0) ? 0 : ((i4 == 15) ? 56 : 4 * i4 - 4);
  const int qrow = 4 * i4 + (wid >> 1), qc = 32 * (wid & 1) + r32;
  int rs = qrow - 4; rs = rs < 0 ? 0 : (rs > 56 ? 56 : rs);
  int cs = qc - 8; cs = cs < 0 ? 0 : (cs > 48 ? 48 : cs);
  const size_t tok_q = (size_t)b * 4096 + qrow * 64 + qc, tok_k0 = (size_t)b * 4096 + rbase * 64;
  for (int i = tid; i < NT * 64; i += 512) { const f32x4 p = *(const f32x4*)(ssq_k + (tok_k0 + i) * 32 + h * 4); rkL[i] = rsqrtf(((p[0] + p[1]) + (p[2] + p[3])) * (1.0f / 128.0f) + 1e-6f); }
  for (int i = tid; i < BIAS_N; i += 512) { const int j = i - BIAS_PAD; biasL[i] = (j >= 0 && j < 15 * 31) ? rpb[h * 465 + j] * 1.4426950408889634f : 0.f; }
  float rqs; { const f32x4 p = *(const f32x4*)(ssq_q + tok_q * 32 + h * 4); rqs = rsqrtf(((p[0] + p[1]) + (p[2] + p[3])) * (1.0f / 128.0f) + 1e-6f) * 1.4426950408889634f; }
  float l_reg = 0; f32x16 o[4] = {}; bf16x8 qr[8];
  const bf16* Qw = qkv + tok_q * LDQ + h * 128 + hi * 8;
#pragma unroll
  for (int d0 = 0; d0 < 8; ++d0) qr[d0] = *reinterpret_cast<const bf16x8*>(Qw + d0 * 16);
  const bf16* Kh = qkv + tok_k0 * LDQ + 1024 + h * 128; const bf16* Vh = qkv + tok_k0 * LDQ + 2048 + h * 128;
  const int sr = tid >> 4, sc = (tid & 15) * 8, vst0 = v_st(sr, sc), vst1 = v_st(32 + sr, sc);
  const int vb0 = (int)(uintptr_t)V_lds + v_rd_base(lane);
  struct { bf16x8 vs0, vs1, ks0, ks1; } sr_[2];
#define SLOAD(i, k0) do { sr_[i].vs0 = *(const bf16x8*)(&Vh[(long)((k0) + sr) * LDQ + sc]); sr_[i].vs1 = *(const bf16x8*)(&Vh[(long)((k0) + 32 + sr) * LDQ + sc]); \
    sr_[i].ks0 = *(const bf16x8*)(&Kh[(long)((k0) + sr) * LDQ + sc]); sr_[i].ks1 = *(const bf16x8*)(&Kh[(long)((k0) + 32 + sr) * LDQ + sc]); } while (0)
#define SWRITE(bb, i) do { *(bf16x8*)((char*)V_lds + (bb) * SHM_V + vst0) = sr_[i].vs0;          \
    *(bf16x8*)((char*)V_lds + (bb) * SHM_V + vst1) = sr_[i].vs1; int kc = sc * 2;               \
    *(bf16x8*)((char*)K_lds + (bb) * SHM_K + KSWZ(sr, kc)) = sr_[i].ks0;                       \
    *(bf16x8*)((char*)K_lds + (bb) * SHM_K + KSWZ(32 + sr, kc)) = sr_[i].ks1; } while (0)
#define SWAIT() asm volatile("s_waitcnt vmcnt(0)" ::: "memory")
#define TILE_ARGS(j) ((unsigned)(rbase + (j) - rs) < 8u), rkL + (j) * 64, biasL + BIAS_PAD + (rbase + (j) - qrow + 7) * 31 + 15 - qc, rqs, cs, hi
  f32x16 p0, p1; bf16x8 pa0, pa1, pa2, pa3;
#define NA_TILE(j, bo) do { if ((unsigned)(rbase + (j) - rs) < 8u) {     \
      SBAR(); qkt(p0, p1, (const bf16*)((const char*)K_lds + (bo) * SHM_K), qr, r32, hi); \
      procP(p0, p1, l_reg, TILE_ARGS(j)); \
      packP(p0, p1, pa0, pa1, pa2, pa3); SBAR(); \
      pv_d0(o, vb0 + (bo) * (int)SHM_V, pa0, pa1, pa2, pa3); } } while (0)
  SLOAD(0, 0); SLOAD(1, KVBLK); SWRITE(0, 0); SLOAD(0, 2 * KVBLK); SWRITE(1, 1); SLOAD(1, 3 * KVBLK); __syncthreads();
  int b0 = 0;
  for (int j = 0; j < NT; j += 2) {
    const int b1 = (b0 == 2) ? 0 : b0 + 1, b2 = (b1 == 2) ? 0 : b1 + 1;
    NA_TILE(j, b0);
    if (j + 2 < NT) { SWRITE(b2, 0); if (j + 4 < NT) SLOAD(0, (j + 4) * KVBLK); }
    __syncthreads();
    if (j + 1 < NT) NA_TILE(j + 1, b1);
    if (j + 3 < NT) { SWRITE(b0, 1); if (j + 5 < NT) SLOAD(1, (j + 5) * KVBLK); }
    __syncthreads();
    b0 = b2;
  }
#undef NA_TILE
  { auto rr = __builtin_amdgcn_permlane32_swap(__float_as_uint(l_reg), __float_as_uint(l_reg), false, false); l_reg = __uint_as_float(rr[0]) + __uint_as_float(rr[1]); }
  if (hi == 0) li_l[r32] = l_reg; asm volatile("s_waitcnt lgkmcnt(0)" ::: "memory");
  float rli[16];
#pragma unroll
  for (int r = 0; r < 16; ++r) rli[r] = __builtin_amdgcn_rcpf(li_l[crow(r, hi)]);
  bf16* Ow = ona + ((size_t)b * 4096 + qrow * 64 + 32 * (wid & 1)) * 2048 + h * 128;
#pragma unroll
  for (int r = 0; r < 16; ++r) { const int orow = crow(r, hi);
#pragma unroll
    for (int d0 = 0; d0 < 4; ++d0) { const float v = o[d0][r] * rli[r]; unsigned u = __float_as_uint(v); u += 0x7fffu + ((u >> 16) & 1u); Ow[(size_t)orow * 2048 + d0 * 32 + r32] = (bf16)(u >> 16); } }
  __syncthreads();
#undef SLOAD
#undef SWRITE
#undef SWAIT
#undef TILE_ARGS
}
#undef KSWZ
#undef SBAR
}

constexpr int NWAVES = 8;
constexpr int RING_OFF = 0, RING_BYTES = 131072;
constexpr int LDSCTL_OFF = RING_BYTES, MISC_OFF = LDSCTL_OFF + 320;
constexpr int LDS_BYTES = 147456;
static_assert(MISC_OFF + 128 <= LDS_BYTES && na::NA_LDS_BYTES <= RING_BYTES, "LDS map");
constexpr int CW_TMO = 0, CW_BAR = 4096;

#define GAS __attribute__((address_space(1)))
#define LAS __attribute__((address_space(3)))
typedef unsigned short bf16;
typedef unsigned v4u __attribute__((ext_vector_type(4)));
typedef float f32x4 __attribute__((ext_vector_type(4)));
typedef GAS unsigned gu32;
#define LDS_WAIT() asm volatile("s_waitcnt lgkmcnt(0)" ::: "memory")
#define VM_WAIT() asm volatile("s_waitcnt vmcnt(0)" ::: "memory")
__device__ __forceinline__ unsigned f2bf(float f) { unsigned u = __builtin_bit_cast(unsigned, f); return (u + 0x7fffu + ((u >> 16) & 1u)) >> 16; }
__device__ __forceinline__ unsigned pk2(float lo, float hi) { return f2bf(lo) | (f2bf(hi) << 16); }
__device__ __forceinline__ float bf2f_(unsigned h) { return __uint_as_float(h << 16); }

#define XB_TMO      128
#define XB_XCNT(j)  (256  + 64 * (j))
#define XB_XSUB(j)  (1280 + 64 * (j))
#define XB_XGEN(j)  (2304 + 64 * (j))
#define XB_TOP      3328
#define XB_TOPGEN   3392
#define XCD_BAR_WORDS 3456
#define XB_SPIN_CAP (1u << 18)
__device__ __forceinline__ unsigned xb_ld(unsigned* p)              { return __hip_atomic_load(p, __ATOMIC_RELAXED, __HIP_MEMORY_SCOPE_AGENT); }
__device__ __forceinline__ unsigned xb_add(unsigned* p, unsigned v) { return __hip_atomic_fetch_add(p, v, __ATOMIC_RELAXED, __HIP_MEMORY_SCOPE_AGENT); }
__device__ __forceinline__ unsigned xb_xcc_id() { return (unsigned)__builtin_amdgcn_s_getreg((3 << 11) | 20) & 0xFu; }
#define XB_SPIN(cond, bar) do { unsigned _sp = 0; while (cond) { __builtin_amdgcn_s_sleep(1); \
    if ((++_sp & 255u) == 0u) { if (xb_ld(&(bar)[XB_TMO])) break; if (_sp > XB_SPIN_CAP) { atomicAdd(&(bar)[XB_TMO], 1u); break; } } } } while (0)
struct XcdBarrier { unsigned* bar; unsigned x; volatile LAS unsigned* st; };
__device__ __forceinline__ XcdBarrier xcd_barrier_post(unsigned* bar, volatile LAS unsigned* st) {
    XcdBarrier b; b.bar = bar; b.x = xb_xcc_id(); b.st = st;
    if (threadIdx.x == 0) (void)xb_add(&bar[XB_XCNT(b.x)], 1u);
    return b;
}
__device__ __forceinline__ void xcd_barrier_complete(unsigned* bar, unsigned x, unsigned& nloc, unsigned& nx) {
    const unsigned G = gridDim.x * gridDim.y * gridDim.z;
    unsigned sum, cnt, mine, sp = 0u;
    for (;;) {
        sum = 0u; cnt = 0u; mine = 0u;
#pragma unroll
        for (unsigned j = 0; j < 16; ++j) { const unsigned c = xb_ld(&bar[XB_XCNT(j)]); sum += c; cnt += (c > 0u) ? 1u : 0u; mine = (j == x) ? c : mine; }
        if (sum == G) break;
        __builtin_amdgcn_s_sleep(1);
        if ((++sp & 255u) == 0u) { if (xb_ld(&bar[XB_TMO])) break; if (sp > XB_SPIN_CAP) { atomicAdd(&bar[XB_TMO], 1u); break; } }
    }
    nloc = mine > 0u ? mine : 1u; nx = cnt > 0u ? cnt : 1u;
}
__device__ __forceinline__ void xcd_barrier(const XcdBarrier& b) {
    asm volatile("s_waitcnt vmcnt(0)" ::: "memory");
    __syncthreads();
    if (threadIdx.x == 0) {
        unsigned* bar = b.bar;
        __builtin_amdgcn_s_waitcnt(0);
        unsigned nloc = b.st[0], nx = b.st[1];
        if (nloc == 0u) { xcd_barrier_complete(bar, b.x, nloc, nx); b.st[0] = nloc; b.st[1] = nx; }
        const unsigned old = xb_add(&bar[XB_XSUB(b.x)], 1u);
        const unsigned gen = old / nloc;
        if (old + 1u == (gen + 1u) * nloc) {
            __builtin_amdgcn_fence(__ATOMIC_RELEASE, "agent");
            asm volatile("s_waitcnt vmcnt(0)" ::: "memory");
            const unsigned og = xb_add(&bar[XB_TOP], 1u);
            const unsigned tg = og / nx;
            if (og + 1u == (tg + 1u) * nx) xb_add(&bar[XB_TOPGEN], 1u);
            else XB_SPIN(xb_ld(&bar[XB_TOPGEN]) == tg, bar);
            __builtin_amdgcn_fence(__ATOMIC_ACQUIRE, "agent");
            xb_add(&bar[XB_XGEN(b.x)], 1u);
            asm volatile("s_waitcnt vmcnt(0)" ::: "memory");
        } else {
            XB_SPIN(xb_ld(&bar[XB_XGEN(b.x)]) == gen, bar);
            __builtin_amdgcn_fence(__ATOMIC_ACQUIRE, "agent");
            asm volatile("s_waitcnt vmcnt(0)" ::: "memory");
        }
    }
    __syncthreads();
}

__device__ __forceinline__ float wave_sum(float v) {
#pragma unroll
    for (int o = 1; o < 64; o <<= 1) v += __shfl_xor(v, o);
    return v;
}
__device__ __forceinline__ void p0_item(const float* __restrict__ W, int ldw, int k0, int n0, bf16* __restrict__ WT, int ldt, int dA, int dB, const float* __restrict__ kscale, LAS float* scr, int lane) {
    const int c16 = lane & 15, kr = lane >> 4;
#pragma unroll
    for (int it = 0; it < 16; ++it) { const int k = 4 * it + kr;
        f32x4 v = *(const f32x4*)(W + (size_t)(k0 + k) * ldw + n0 + 4 * c16);
        if (kscale) v = v * kscale[k0 + k];
        *(LAS f32x4*)(scr + k * 64 + ((4 * c16) ^ (8 * ((k >> 3) & 7)))) = v; }
    LDS_WAIT(); asm volatile("" ::: "memory");
    const int c = lane & 7;
#pragma unroll
    for (int j = 0; j < 8; ++j) { const int n = (lane >> 3) + 8 * j; const LAS float* s = scr + (8 * c) * 64 + (n ^ (8 * c));
        v4u o; o.x = pk2(s[0 * 64], s[1 * 64]); o.y = pk2(s[2 * 64], s[3 * 64]); o.z = pk2(s[4 * 64], s[5 * 64]); o.w = pk2(s[6 * 64], s[7 * 64]);
        const int drow = (n < 32) ? dA + n : dB + n - 32;
        *(GAS v4u*)(WT + (size_t)drow * ldt + k0 + 8 * c) = o; }
    LDS_WAIT(); asm volatile("" ::: "memory");
}
struct P0Desc { const float* src; bf16* dst; int ldw, ldt, dA, dB; };
__device__ __forceinline__ void p0_load(const P0Desc& d, f32x4 (&R)[16], int lane) {
    const int c16 = lane & 15, kr = lane >> 4;
#pragma unroll
    for (int it = 0; it < 16; ++it) R[it] = *(const f32x4*)(d.src + (size_t)(4 * it + kr) * d.ldw + 4 * c16);
}
__device__ __forceinline__ void p0_to_lds(const f32x4 (&R)[16], LAS float* scr, int lane) {
    const int c16 = lane & 15, kr = lane >> 4;
#pragma unroll
    for (int it = 0; it < 16; ++it) { const int k = 4 * it + kr; *(LAS f32x4*)(scr + k * 64 + ((4 * c16) ^ (8 * ((k >> 3) & 7)))) = R[it]; }
}
__device__ __forceinline__ void p0_store(const P0Desc& d, LAS float* scr, int lane) {
    const int c = lane & 7;
#pragma unroll
    for (int j = 0; j < 8; ++j) { const int n = (lane >> 3) + 8 * j; const LAS float* s = scr + (8 * c) * 64 + (n ^ (8 * c));
        v4u o; o.x = pk2(s[0 * 64], s[1 * 64]); o.y = pk2(s[2 * 64], s[3 * 64]); o.z = pk2(s[4 * 64], s[5 * 64]); o.w = pk2(s[6 * 64], s[7 * 64]);
        const int drow = (n < 32) ? d.dA + n : d.dB + n - 32;
        *(GAS v4u*)(d.dst + (size_t)drow * d.ldt + 8 * c) = o; }
}
__device__ __forceinline__ void rms_row_to_bf16(const float* __restrict__ xrow, const float* __restrict__ g, bf16* __restrict__ orow, int lane) {
    const f32x4* xr = (const f32x4*)xrow + lane; const f32x4* gr = (const f32x4*)g + lane;
    f32x4 v[8]; float s = 0.f;
#pragma unroll
    for (int j = 0; j < 8; ++j) { v[j] = xr[64 * j]; s += (v[j].x * v[j].x + v[j].y * v[j].y) + (v[j].z * v[j].z + v[j].w * v[j].w); }
    const float r = rsqrtf(wave_sum(s) * (1.f / 2048.f) + mk::EPS);
    unsigned long long* o8 = (unsigned long long*)orow + lane;
#pragma unroll
    for (int j = 0; j < 8; ++j) { const f32x4 gg = gr[64 * j]; o8[64 * j] = (unsigned long long)pk2(v[j].x * r * gg.x, v[j].y * r * gg.y) | ((unsigned long long)pk2(v[j].z * r * gg.z, v[j].w * r * gg.w) << 32); }
}
__device__ __forceinline__ int win_dest_row(int n32  ) {
    const int pn = n32 >> 3, ga = n32 & 7;
    if (pn < 12 || pn >= 20) return n32 * 32;
    const int gs = 4 * ((ga >> 1) & 1) + 2 * (ga >> 2) + (ga & 1);
    return (pn * 8 + gs) * 32;
}

#ifndef MK_TS
#define MK_TS -1
#endif
struct Args { const float* in[21]; float* out; unsigned char* ws; };

__global__ void __launch_bounds__(NWAVES * 64, 2) mk_fwd(Args args) {
    extern __shared__ __attribute__((aligned(16))) unsigned char lds[];
    LAS unsigned char* ldsl = (LAS unsigned char*)lds;
    volatile LAS unsigned* MISC = (volatile LAS unsigned*)(ldsl + MISC_OFF);
    const int tid = threadIdx.x, lane = tid & 63, wave = __builtin_amdgcn_readfirstlane(tid >> 6);
    const int G = gridDim.x, bx = blockIdx.x;
    const int vcu = (G % 8 == 0) ? (bx % 8) * (G / 8) + bx / 8 : bx;
    unsigned char* ws = args.ws; unsigned char* dob = (unsigned char*)args.out;
    gu32* ctl = (gu32*)(ws + mk::WS_CTL);
#define I_x args.in[0]
#define I_mem args.in[1]
#define I_g_mix args.in[2]
#define I_w_in args.in[3]
#define I_gq args.in[4]
#define I_gk args.in[5]
#define I_rpb args.in[6]
#define I_lgf_in args.in[7]
#define I_lgb_in args.in[8]
#define I_gn args.in[9]
#define I_g_mem args.in[10]
#define I_w_mkv args.in[11]
#define I_gxq args.in[12]
#define I_gxk args.in[13]
#define I_w_na args.in[14]
#define I_w_ret args.in[15]
#define I_w_memb args.in[16]
#define I_w_out args.in[17]
#define I_g_ffn args.in[18]
#define I_w_ff1 args.in[19]
#define I_w_ff2 args.in[20]
#define I_out args.out
#define cosT ((float*)(ws + mk::WS_COS))
#define sinT ((float*)(ws + mk::WS_SIN))
#define ssq_naq ((float*)(ws + mk::WS_SSQ_NAQ))
#define ssq_nak ((float*)(ws + mk::WS_SSQ_NAK))
#define ssq_xq ((float*)(ws + mk::WS_SSQ_XQ))
#define xl ((float*)(ws + mk::WS_XL))
#define ssq_x1 ((float*)(ws + mk::WS_SSQ_X1))
#define tab ((float*)(ws + mk::WS_TAB))
#define MEMN ((bf16*)(ws + mk::WS_MEMN))
#define MKb ((bf16*)(ws + mk::WS_MK))
#define MVT ((bf16*)(ws + mk::WS_MVT))
#define WinT ((bf16*)(ws + mk::WS_WIN))
#define Wff1T ((bf16*)(ws + mk::WS_WFF1))
#define Wff2T ((bf16*)(ws + mk::WS_WFF2))
#define WretT ((bf16*)(ws + mk::WS_WRET))
#define WoutT ((bf16*)(ws + mk::WS_WOUT))
#define WnmT ((bf16*)(ws + mk::WS_WNM))
#define WmkvT ((bf16*)(ws + mk::WS_WMKV))
#define NAQKV ((bf16*)(ws + mk::WS_NAQKV))
#define K0 ((bf16*)(ws + mk::WS_K0))
#define RG ((bf16*)(ws + mk::WS_RG))
#define XQ ((bf16*)(ws + mk::WS_XQ))
#define GATES ((bf16*)(ws + mk::WS_GATES))
#define AR ((bf16*)(ws + mk::WS_AR))
#define BR ((bf16*)(ws + mk::WS_BR))
#define KV ((bf16*)(ws + mk::WS_KV))
#define ORET ((bf16*)(ws + mk::WS_ORET))
#define MERGED ((bf16*)(ws + mk::WS_MERGED))
#define X1B ((bf16*)(ws + mk::WS_X1B))
#define HFF ((bf16*)(ws + mk::WS_HFF))
#define HN ((bf16*)(dob + mk::DO_HN))
#define KT ((bf16*)(dob + mk::DO_KT))
#define XP ((bf16*)(dob + mk::DO_XP))
#define ONM ((bf16*)(dob + mk::DO_ONM))
    for (int u = tid; u < (LDS_BYTES - LDSCTL_OFF) / 4; u += NWAVES * 64) ((LAS unsigned*)(ldsl + LDSCTL_OFF))[u] = 0u;
    __syncthreads();
    XcdBarrier bar = xcd_barrier_post((unsigned*)(ctl + CW_BAR), MISC + 8);
#define GRID_BAR() do { xcd_barrier(bar); MK_STAMP(); } while (0)
    int n_stamp_ = 0;
#define MK_STAMP() do { if (MK_TS >= 0) { if (bx == 0 && tid == 0) MISC[16 + n_stamp_] = (unsigned)__builtin_amdgcn_s_memrealtime(); ++n_stamp_; } } while (0)
    MK_STAMP();
    LAS float* scr = (LAS float*)(ldsl + RING_OFF + wave * 16384);
    const int gw = vcu * NWAVES + wave, NGW = G * NWAVES;

    {
    {
        for (int i = gw * 64 + lane; i < 4096 * 64; i += NGW * 64) { const int s = i >> 6, f = i & 63;
            const float inv = powf(10000.0f, -(float)f / 64.0f), ang = (float)s * inv; cosT[i] = cosf(ang); sinT[i] = sinf(ang); }
        if (bx == 0) {
            if (tid < 128) tab[mk::TAB_CS_NAQ + tid] = I_gq[tid] * I_gk[tid] * 0.08838834764831845f;
            if (tid < 256) tab[mk::TAB_CS_MK + tid] = I_gxq[tid] * I_gxk[tid] * 0.0625f;
            if (tid < 8) { tab[mk::TAB_L2F + tid] = -log1pf(expf(-I_lgf_in[tid])) * mk::LOG2E; tab[mk::TAB_L2B + tid] = -log1pf(expf(-I_lgb_in[tid])) * mk::LOG2E; }
        }
        for (int m = gw; m < 512; m += NGW) rms_row_to_bf16(I_mem + (size_t)m * 2048, I_g_mem, MEMN + (size_t)m * 2048, lane);
        for (int it = gw; it < 32 * 32; it += NGW) { const int kb = it >> 5, nb = it & 31; p0_item(I_w_mkv, 2048, 64 * kb, 64 * nb, WmkvT, 2048, 64 * nb, 64 * nb + 32, nullptr, scr, lane); }
    }
    GRID_BAR();
    }
    {
    if (vcu < 16) {
        mk::SchedOne S; S.has = true; const pg8::Gemm g{2048, 2048, 2048};
        mk::EpiMKV E{MKb, MVT, tab, tab, 0};
        if (vcu < 8) { S.u.pm = vcu >> 2; S.u.pn = vcu & 3; S.a = (const char*)(MEMN + (size_t)S.u.pm * 256 * 2048); S.b = (const char*)(WmkvT + (size_t)S.u.pn * 256 * 2048); E.mode = 0; }
        else { const int c = vcu - 8; S.u.pm = c >> 1; S.u.pn = c & 1; S.a = (const char*)(WmkvT + (size_t)(1024 + S.u.pm * 256) * 2048); S.b = (const char*)(MEMN + (size_t)S.u.pn * 256 * 2048); E.mode = 1; }
        pg8::gemm_phase<mk::EpiMKV, mk::SchedOne, false>(ldsl + RING_OFF, g, S, E);
    } else {
        const int gw2 = (vcu - 16) * NWAVES + wave, NGW2 = (G - 16) * NWAVES;
        constexpr int I_IN = 32 * 256, I_FF1 = 32 * 128, I_FF2 = 128 * 32, I_RET = 32 * 32, I_OUT = 32 * 32, I_NA = 16 * 32, I_MEM = 16 * 32;
        constexpr int NITEMS = I_IN + I_FF1 + I_FF2 + I_RET + I_OUT + I_NA + I_MEM;
#define P0_DECODE(d, item) do { int r = (item); \
            if (r < I_IN) { const int kb = r >> 8, nb = r & 255; d.src = I_w_in + (size_t)(64 * kb) * 16384 + 64 * nb; d.ldw = 16384; d.dst = WinT + 64 * kb; d.ldt = 2048; d.dA = win_dest_row(2 * nb); d.dB = win_dest_row(2 * nb + 1); break; } r -= I_IN; \
            if (r < I_FF1) { const int kb = r >> 7, nb = r & 127; d.src = I_w_ff1 + (size_t)(64 * kb) * 8192 + 64 * nb; d.ldw = 8192; d.dst = Wff1T + 64 * kb; d.ldt = 2048; d.dA = 64 * nb; d.dB = 64 * nb + 32; break; } r -= I_FF1; \
            if (r < I_FF2) { const int kb = r >> 5, nb = r & 31; d.src = I_w_ff2 + (size_t)(64 * kb) * 2048 + 64 * nb; d.ldw = 2048; d.dst = Wff2T + 64 * kb; d.ldt = 8192; d.dA = 64 * nb; d.dB = 64 * nb + 32; break; } r -= I_FF2; \
            if (r < I_RET) { const int kb = r >> 5, nb = r & 31; d.src = I_w_ret + (size_t)(64 * kb) * 2048 + 64 * nb; d.ldw = 2048; d.dst = WretT + 64 * kb; d.ldt = 2048; d.dA = 64 * nb; d.dB = 64 * nb + 32; break; } r -= I_RET; \
            if (r < I_OUT) { const int kb = r >> 5, nb = r & 31; d.src = I_w_out + (size_t)(64 * kb) * 2048 + 64 * nb; d.ldw = 2048; d.dst = WoutT + 64 * kb; d.ldt = 2048; d.dA = 64 * nb; d.dB = 64 * nb + 32; break; } r -= I_OUT; \
            if (r < I_NA) { const int kb = r >> 5, nb = r & 31; d.src = I_w_na + (size_t)(64 * kb) * 2048 + 64 * nb; d.ldw = 2048; d.dst = WnmT + 64 * kb; d.ldt = 2048; d.dA = 64 * nb; d.dB = 64 * nb + 32; break; } r -= I_NA; \
            { const int kb = r >> 5, nb = r & 31; d.src = I_w_memb + (size_t)(64 * kb) * 2048 + 64 * nb; d.ldw = 2048; d.dst = WnmT + 1024 + 64 * kb; d.ldt = 2048; d.dA = 64 * nb; d.dB = 64 * nb + 32; } } while (0)
        {
            f32x4 R0[16], R1[16]; P0Desc d0, d1; int it = gw2;
            if (it < NITEMS) { P0_DECODE(d0, it); p0_load(d0, R0, lane); }
            if (it + NGW2 < NITEMS) { P0_DECODE(d1, it + NGW2); p0_load(d1, R1, lane); }
            for (; it < NITEMS; it += 2 * NGW2) {
                p0_to_lds(R0, scr, lane); const P0Desc c0 = d0;
                if (it + 2 * NGW2 < NITEMS) { P0_DECODE(d0, it + 2 * NGW2); p0_load(d0, R0, lane); }
                LDS_WAIT(); asm volatile("" ::: "memory"); p0_store(c0, scr, lane); LDS_WAIT(); asm volatile("" ::: "memory");
                if (it + NGW2 < NITEMS) {
                    p0_to_lds(R1, scr, lane); const P0Desc c1 = d1;
                    if (it + 3 * NGW2 < NITEMS) { P0_DECODE(d1, it + 3 * NGW2); p0_load(d1, R1, lane); }
                    LDS_WAIT(); asm volatile("" ::: "memory"); p0_store(c1, scr, lane); LDS_WAIT(); asm volatile("" ::: "memory");
                }
            }
        }
#undef P0_DECODE
        for (int m = gw2; m < mk::M; m += NGW2) rms_row_to_bf16(I_x + (size_t)m * 2048, I_g_mix, HN + (size_t)m * 2048, lane);
    }
    GRID_BAR();
    }
    {
    {
        mk::SchedProj S; S.o.init(mk::M, mk::D_IN, G, bx); S.hn_ = (const char*)HN; S.wt_ = (const char*)WinT;
        const pg8::Gemm g{2048, 2048, 2048};
        mk::EpiProj E{ws};
        pg8::gemm_phase<mk::EpiProj, mk::SchedProj, true>(ldsl + RING_OFF, g, S, E);
    }
    GRID_BAR();
    }
    {
    {
        const int c = bx, bh = c >> 4, nc = c & 15, b = bh >> 3, h = bh & 7;
        const float l2f = tab[mk::TAB_L2F + h], l2b = tab[mk::TAB_L2B + h];
        {
            bf16* kt = KT + (size_t)c * 65536; const bf16* ksrc = K0 + ((size_t)b * 4096 + nc * 256) * 1024 + h * 128;
            LAS float* t = scr;
            const int tok0 = wave * 32;
#pragma unroll
            for (int it = 0; it < 8; ++it) { const int tr = 4 * it + (lane >> 4), c8 = (lane & 15) * 8; const v4u w = *(const v4u*)(ksrc + (size_t)(tok0 + tr) * 1024 + c8);
                LAS float* d = t + tr * 128 + (c8 ^ (8 * (tr >> 3))); d[0] = bf2f_(w.x & 0xffffu); d[1] = bf2f_(w.x >> 16); d[2] = bf2f_(w.y & 0xffffu); d[3] = bf2f_(w.y >> 16);
                d[4] = bf2f_(w.z & 0xffffu); d[5] = bf2f_(w.z >> 16); d[6] = bf2f_(w.w & 0xffffu); d[7] = bf2f_(w.w >> 16); }
            LDS_WAIT(); asm volatile("" ::: "memory");
            const int q = lane & 3;
            float df[8], db[8];
#pragma unroll
            for (int i = 0; i < 8; ++i) { const int tk = tok0 + 8 * q + i; df[i] = pg8::fexp2(l2f * (float)(255 - tk)); db[i] = pg8::fexp2(l2b * (float)tk); }
#pragma unroll
            for (int j = 0; j < 8; ++j) { const int dk = (lane >> 2) + 16 * j; const LAS float* s = t + (8 * q) * 128 + (dk ^ (8 * q));
                float v[8];
#pragma unroll
                for (int i = 0; i < 8; ++i) v[i] = s[i * 128];
                v4u o; o.x = pk2(v[0] * df[0], v[1] * df[1]); o.y = pk2(v[2] * df[2], v[3] * df[3]); o.z = pk2(v[4] * df[4], v[5] * df[5]); o.w = pk2(v[6] * df[6], v[7] * df[7]);
                *(GAS v4u*)(kt + (size_t)dk * 256 + tok0 + 8 * q) = o;
                o.x = pk2(v[0] * db[0], v[1] * db[1]); o.y = pk2(v[2] * db[2], v[3] * db[3]); o.z = pk2(v[4] * db[4], v[5] * db[5]); o.w = pk2(v[6] * db[6], v[7] * db[7]);
                *(GAS v4u*)(kt + (size_t)(128 + dk) * 256 + tok0 + 8 * q) = o; }
            VM_WAIT(); LDS_WAIT(); __syncthreads();
        }
        MK_STAMP();
        {
            bf16* arc = AR + ((size_t)bh * 4096 + nc * 256) * 512;
            mk::SchedList3 S; S.n = (bx < 128) ? 3 : 2;
            S.u0.a = (const char*)(BR + (size_t)c * 256 * 512); S.u0.b = (const char*)(KT + (size_t)c * 65536); S.u0.lda = 512; S.u0.ldb = 256; S.u0.nt = 4; S.u0.kind = 0; S.u0.perm = 1;
            S.u1.a = (const char*)(arc + 256); S.u1.b = (const char*)(K0 + ((size_t)b * 4096 + nc * 256) * 1024 + h * 128); S.u1.lda = 512; S.u1.ldb = 1024; S.u1.nt = 2; S.u1.kind = 1; S.u1.perm = 1;
            const int xb = (bx >> 6) & 1, xh = (bx >> 4) & 3, qt = bx & 15; const size_t tok0 = (size_t)xb * 4096 + qt * 256;
            S.u2.a = (const char*)(XQ + tok0 * 1024 + xh * 256); S.u2.b = (const char*)(MKb + (size_t)xb * 256 * 1024 + xh * 256); S.u2.lda = 1024; S.u2.ldb = 1024; S.u2.nt = 4; S.u2.kind = 2; S.u2.perm = 1;
            mk::EpiM1 E{mk::EpiF32{KV + (size_t)c * 65536}, mk::EpiP{arc, l2f, l2b},
                        mk::EpiXS{XP + tok0 * 1024 + xh * 256, xl + tok0 * 16 + xh * 4, ssq_xq + tok0 * 16 + xh * 4, tab + mk::TAB_SSQ_MK + (size_t)xb * 256 * 16 + xh * 4}};
            pg8::gemm_stream<mk::EpiM1, mk::SchedList3, true>(ldsl + RING_OFF, S, E);
        }
        MK_STAMP();
    }
    GRID_BAR();
    }
    {
    {
        for (int e = (vcu * 512 + tid); e < 16 * 65536; e += G * 512) {
            const int bh = e >> 16, r = e & 65535, col = r & 255, h = bh & 7;
            const bool fwd = col < 128; const float dec = pg8::fexp2((fwd ? tab[mk::TAB_L2F + h] : tab[mk::TAB_L2B + h]) * 256.0f);
            const bf16* kvp = KV + (size_t)bh * 16 * 65536 + r; bf16* brp = BR + ((size_t)bh * 16 * 256 + (r >> 8)) * 512 + 256 + col;
            float kvv[16];
#pragma unroll
            for (int n = 0; n < 16; ++n) kvv[n] = bf2f_(kvp[(size_t)n * 65536]);
            float s = 0.f;
            if (fwd) {
#pragma unroll
                for (int n = 0; n < 16; ++n) { brp[(size_t)n * 256 * 512] = (bf16)f2bf(s); s = dec * s + kvv[n]; }
            } else {
#pragma unroll
                for (int n = 15; n >= 0; --n) { brp[(size_t)n * 256 * 512] = (bf16)f2bf(s); s = dec * s + kvv[n]; }
            }
        }
        __syncthreads();
        MK_STAMP();
        { const int b = bx >> 7, h = (bx >> 4) & 7, i4 = bx & 15;
        na::na_unit(b, h, i4, NAQKV, ssq_naq, ssq_nak, I_rpb, ONM, (char*)lds); }
        MK_STAMP();
    }
    GRID_BAR();
    }
    {
    {
        const int c = bx, bh = c >> 4, nc = c & 15, b = bh >> 3, h = bh & 7;
        {
            const int xb = (bx >> 6) & 1, xh = (bx >> 4) & 3, qt = bx & 15; const size_t tok0 = (size_t)xb * 4096 + qt * 256;
            const size_t o0 = ((size_t)b * 4096 + nc * 256) * 2048 + h * 256;
            const bool hx = bx < 128;
            mk::SchedList3 S; S.n = hx ? 2 : 1;
            const char* const ra = (const char*)(AR + ((size_t)bh * 4096 + nc * 256) * 512); const char* const rb = (const char*)(BR + (size_t)c * 256 * 512);
            S.u0.a = hx ? (const char*)(XP + tok0 * 1024 + xh * 256) : ra; S.u0.b = hx ? (const char*)(MVT + (size_t)xh * 256 * 512 + xb * 256) : rb;
            S.u0.lda = hx ? 1024 : 512; S.u0.ldb = 512; S.u0.nt = hx ? 4 : 8; S.u0.kind = hx ? 0 : 1; S.u0.perm = 1;
            S.u1.a = ra; S.u1.b = rb; S.u1.lda = 512; S.u1.ldb = 512; S.u1.nt = 8; S.u1.kind = 1; S.u1.perm = 1;
            S.u2.a = ra; S.u2.b = rb; S.u2.lda = 512; S.u2.ldb = 512; S.u2.nt = 8; S.u2.kind = 1; S.u2.perm = 1;
            mk::EpiM3 E{mk::EpiXO{ONM + tok0 * 2048 + 1024 + xh * 256, xl + tok0 * 16 + xh * 4}, mk::EpiGN{ORET + o0, RG + o0, I_gn + h * 256}};
            pg8::gemm_stream<mk::EpiM3, mk::SchedList3, true>(ldsl + RING_OFF, S, E);
        }
        MK_STAMP();
    }
    GRID_BAR();
    }
    {
    {
        mk::SchedBR S; S.o.init(mk::M, 2048, G, bx); S.onm = (const char*)ONM; S.oret = (const char*)ORET; S.wnm = (const char*)WnmT; S.wret = (const char*)WretT;
        const pg8::Gemm g{2048, 2048, 1024}; mk::EpiGate4 E{MERGED, GATES};
        pg8::gemm_phase<mk::EpiGate4, mk::SchedBR, true>(ldsl + RING_OFF, g, S, E);
    }
    GRID_BAR();
    }
    {
    {
        mk::SchedGrid S; S.o.init(mk::M, 2048, G, bx); S.A = (const char*)MERGED; S.B = (const char*)WoutT; S.ta = 256u * 2048u * 2u; S.tb = 256u * 2048u * 2u;
        const pg8::Gemm g{2048, 2048, 2048}; mk::EpiWout E{I_x, I_out, X1B, ssq_x1, I_g_ffn};
        pg8::gemm_phase<mk::EpiWout, mk::SchedGrid, false>(ldsl + RING_OFF, g, S, E);
    }
    GRID_BAR();
    }
    {
    {
        mk::SchedGrid S; S.o.init(mk::M, 8192, G, bx); S.A = (const char*)X1B; S.B = (const char*)Wff1T; S.ta = 256u * 2048u * 2u; S.tb = 256u * 2048u * 2u;
        const pg8::Gemm g{2048, 2048, 2048}; mk::EpiFF1 E{HFF, ssq_x1};
        pg8::gemm_phase<mk::EpiFF1, mk::SchedGrid, true>(ldsl + RING_OFF, g, S, E);
    }
    GRID_BAR();
    }
    if (false) {
        mk::SchedGrid S; S.o.init(mk::M, 2048, G, bx); S.A = (const char*)HFF; S.B = (const char*)Wff2T; S.ta = 256u * (unsigned)mk::LDH * 2u; S.tb = 256u * 8192u * 2u;
        const pg8::Gemm g{mk::LDH, 8192, 8192}; mk::EpiFF2 E{I_out, (float*)AR};
        pg8::gemm_phase<mk::EpiFF2, mk::SchedGrid, false>(ldsl + RING_OFF, g, S, E);
        GRID_BAR();
    }
    {
        mk::SchedGrid S; S.o.init(mk::M, 2048, G, bx); S.A = (const char*)HFF; S.B = (const char*)Wff2T; S.ta = 256u * (unsigned)mk::LDH * 2u; S.tb = 256u * 8192u * 2u;
        const pg8::Gemm g{mk::LDH, 8192, 8192}; mk::EpiFF2 E{I_out, I_out};
        pg8::gemm_phase<mk::EpiFF2, mk::SchedGrid, false>(ldsl + RING_OFF, g, S, E);
    }
    MK_STAMP();
    if (MK_TS >= 0 && bx == 0 && tid == 0) {
        const unsigned dt = MISC[16 + MK_TS + 1] - MISC[16 + MK_TS]; const unsigned long long t0 = __builtin_amdgcn_s_memrealtime();
        while (__builtin_amdgcn_s_memrealtime() - t0 < 8ull * dt) __builtin_amdgcn_s_sleep(8);
    }
}

extern "C" void kernel_launch(void* const* d_in, const int* in_sizes, int n_in, void* d_out, int out_size, void* d_ws, size_t ws_size, hipStream_t stream) {
    static int grid = 0;
    if (grid == 0) {
        if (n_in != 21 || out_size != mk::M * mk::D || ws_size < mk::WS_END) { fprintf(stderr, "kernel_launch: unexpected shapes (n_in %d out %d ws %zu); nothing launched\n", n_in, out_size, ws_size); grid = -1; return; }
        int dev = 0, cus = 0;
        if (hipGetDevice(&dev) != hipSuccess || hipDeviceGetAttribute(&cus, hipDeviceAttributeMultiprocessorCount, dev) != hipSuccess) { grid = -1; return; }
        if (hipFuncSetAttribute((const void*)mk_fwd, hipFuncAttributeMaxDynamicSharedMemorySize, LDS_BYTES) != hipSuccess) { fprintf(stderr, "kernel_launch: hipFuncSetAttribute failed\n"); grid = -1; return; }
        (void)hipGetLastError();
        grid = cus;
        if (grid != 256) fprintf(stderr, "kernel_launch: %d CUs; this kernel's unit maps assume 256\n", grid);
    }
    if (grid < 0) return;
    if (hipMemsetAsync((char*)d_ws + mk::WS_CTL, 0, mk::CTL_ZERO_BYTES, stream) != hipSuccess) return;
    Args a{};
    for (int i = 0; i < 21; ++i) a.in[i] = (const float*)d_in[i];
    a.out = (float*)d_out; a.ws = (unsigned char*)d_ws;
    hipLaunchKernelGGL(mk_fwd, dim3(grid), dim3(NWAVES * 64), LDS_BYTES, stream, a);
}
```

```cpp
#include <hip/hip_runtime.h>
#include <cstdio>
#include <cstdint>

namespace pg8 {
#define PG8_LAS __attribute__((address_space(3)))
typedef unsigned short bf16_t;
typedef short bf16x8 __attribute__((ext_vector_type(8)));
typedef float f32x4 __attribute__((ext_vector_type(4)));
typedef float f32x2 __attribute__((ext_vector_type(2)));
typedef unsigned u32x4 __attribute__((ext_vector_type(4)));
typedef unsigned u32x2 __attribute__((ext_vector_type(2)));
constexpr int BM = 256, BK = 64, HALF = 128, HTB = HALF * BK * 2, STAGE_BYTES = 8 * HTB, NXCD = 8, WGM = 8;

__host__ __device__ __forceinline__ int lds_byte(int r, int c) { const int st = (r >> 4) * 2 + (c >> 5), rr = r & 15, cc = c & 31, ob = rr * 64 + cc * 2; return st * 1024 + (ob ^ (((ob >> 9) & 1) << 5)); }
__host__ __device__ __forceinline__ void stage_rc(int b, int& R, int& C) { const int st = b / 1024, sb = b % 1024, swz = sb ^ (((sb >> 9) & 1) << 5); R = (st >> 1) * 16 + swz / 64; C = (st & 1) * 32 + (swz % 64) / 2; }
__host__ __device__ __forceinline__ int perm32(int rho) { const int n = rho >> 4, i = rho & 15; return 8 * (i >> 2) + 4 * n + (i & 3); }

struct Unit { int pm, pn, sub; };
struct Gemm { int lda, ldb, K; };

struct GridOrder {
    int nM, nN, nwg, G, c;
    __device__ void init(int M, int N, int G_, int c_) { nM = M / BM; nN = N / BM; nwg = nM * nN; G = G_; c = c_; }
    __device__ bool next(int i, Unit& u) const {
        const long L = (long)i * G + c; if (L >= nwg) return false;
        int wgid = (int)L; { const int q = nwg / NXCD, r = nwg % NXCD, xcd = wgid % NXCD, off = wgid / NXCD; wgid = (xcd < r ? xcd * (q + 1) : r * (q + 1) + (xcd - r) * q) + off; }
        const int nig = WGM * nN, gid = wgid / nig, fm = gid * WGM, gsz = (nM - fm) < WGM ? (nM - fm) : WGM;
        u.pm = fm + ((wgid % nig) % gsz); u.pn = (wgid % nig) / gsz; u.sub = 0; return true;
    }
};

typedef float f32x2_cv __attribute__((ext_vector_type(2))); typedef __bf16 bf16x2_cv __attribute__((ext_vector_type(2)));
__device__ __forceinline__ unsigned cvt_pk_bf16(float lo, float hi) { const f32x2_cv v = {lo, hi}; const bf16x2_cv b = __builtin_convertvector(v, bf16x2_cv); return __builtin_bit_cast(unsigned, b); }
__device__ __forceinline__ void store8(bf16_t* p, f32x4 v0, f32x4 v1) { u32x4 w; w.x = cvt_pk_bf16(v0[0], v0[1]); w.y = cvt_pk_bf16(v0[2], v0[3]); w.z = cvt_pk_bf16(v1[0], v1[1]); w.w = cvt_pk_bf16(v1[2], v1[3]); *(u32x4*)p = w; }
__device__ __forceinline__ void store4(bf16_t* p, f32x4 v0) { u32x2 w; w.x = cvt_pk_bf16(v0[0], v0[1]); w.y = cvt_pk_bf16(v0[2], v0[3]); *(u32x2*)p = w; }
__device__ __forceinline__ float bf2f(unsigned short h) { return __uint_as_float((unsigned)h << 16); }
__device__ __forceinline__ void load8(const bf16_t* p, f32x4& v0, f32x4& v1) { const u32x4 w = *(const u32x4*)p;
    v0[0] = __uint_as_float(w.x << 16); v0[1] = __uint_as_float(w.x & 0xffff0000u); v0[2] = __uint_as_float(w.y << 16); v0[3] = __uint_as_float(w.y & 0xffff0000u);
    v1[0] = __uint_as_float(w.z << 16); v1[1] = __uint_as_float(w.z & 0xffff0000u); v1[2] = __uint_as_float(w.w << 16); v1[3] = __uint_as_float(w.w & 0xffff0000u); }
__device__ __forceinline__ void load8_nt(const bf16_t* p, f32x4& v0, f32x4& v1) { const u32x4 w = __builtin_nontemporal_load((const u32x4*)p);
    v0[0] = __uint_as_float(w.x << 16); v0[1] = __uint_as_float(w.x & 0xffff0000u); v0[2] = __uint_as_float(w.y << 16); v0[3] = __uint_as_float(w.y & 0xffff0000u);
    v1[0] = __uint_as_float(w.z << 16); v1[1] = __uint_as_float(w.z & 0xffff0000u); v1[2] = __uint_as_float(w.w << 16); v1[3] = __uint_as_float(w.w & 0xffff0000u); }
__device__ __forceinline__ void load8_l2(const bf16_t* p, f32x4& v0, f32x4& v1) { u32x4 w; const unsigned long long a = __hip_atomic_load((const unsigned long long*)p, __ATOMIC_RELAXED, __HIP_MEMORY_SCOPE_AGENT), b = __hip_atomic_load((const unsigned long long*)p + 1, __ATOMIC_RELAXED, __HIP_MEMORY_SCOPE_AGENT);
    w.x = (unsigned)a; w.y = (unsigned)(a >> 32); w.z = (unsigned)b; w.w = (unsigned)(b >> 32);
    v0[0] = __uint_as_float(w.x << 16); v0[1] = __uint_as_float(w.x & 0xffff0000u); v0[2] = __uint_as_float(w.y << 16); v0[3] = __uint_as_float(w.y & 0xffff0000u);
    v1[0] = __uint_as_float(w.z << 16); v1[1] = __uint_as_float(w.z & 0xffff0000u); v1[2] = __uint_as_float(w.w << 16); v1[3] = __uint_as_float(w.w & 0xffff0000u); }
__device__ __forceinline__ float fexp2(float x) { return __builtin_amdgcn_exp2f(x); }
__device__ __forceinline__ float frcp(float x) { return __builtin_amdgcn_rcpf(x); }
__device__ __forceinline__ float sigmoidf_(float x) { return frcp(1.f + fexp2(-1.4426950408889634f * x)); }

template <class Epi, class Sched, bool ALIGN_EPI>
__device__ __forceinline__ void gemm_phase(PG8_LAS unsigned char* lds, const Gemm g, const Sched& S, const Epi& E) {
    int tid_ = threadIdx.x; asm volatile("" : "+v"(tid_));
    const int tid = tid_, wid = __builtin_amdgcn_readfirstlane(tid >> 6), lane = tid & 63, wr = wid >> 2, wc = wid & 3, fr = lane & 15, fq = lane >> 4;
    unsigned voffA[2], voffB[2];
#pragma unroll
    for (int i = 0; i < 2; ++i) { int R, C; stage_rc(tid * 16 + i * 8192, R, C); const int Rb = Epi::PERM ? ((R & ~31) + perm32(R & 31)) : R;
        voffA[i] = (unsigned)(R * g.lda + C) * 2u; voffB[i] = (unsigned)(Rb * g.ldb + C) * 2u; }
    const size_t kstep = (size_t)(BK * 2);
    const size_t hstepA = (size_t)HALF * g.lda * 2, hstepB = (size_t)HALF * g.ldb * 2;
    const unsigned ldsw = (unsigned)wid * 1024u;
    const int aoff = lds_byte(wr * 64 + fr, fq * 8), boff = lds_byte(wc * 32 + fr, fq * 8);
#define PG8_SA(b, h) (((b) * 2 + (h)) * HTB)
#define PG8_SB(b, h) ((4 + (b) * 2 + (h)) * HTB)
#define PG8_STAGE(bufoff, gbase, voff) do { _Pragma("unroll") for (int _i = 0; _i < 2; ++_i) \
        __builtin_amdgcn_global_load_lds((const unsigned*)((const char*)(gbase) + (voff)[_i]), (PG8_LAS unsigned*)(lds + (bufoff) + ldsw + _i * 8192), 16, 0, 0); } while (0)
#define PG8_LDA(dst, b, h) do { _Pragma("unroll") for (int m = 0; m < 4; ++m) _Pragma("unroll") for (int k = 0; k < 2; ++k) dst[m][k] = *(const PG8_LAS bf16x8*)(lds + PG8_SA(b, h) + aoff + m * 2048 + k * 1024); } while (0)
#define PG8_LDB(dst, b, h) do { _Pragma("unroll") for (int n = 0; n < 2; ++n) _Pragma("unroll") for (int k = 0; k < 2; ++k) dst[n][k] = *(const PG8_LAS bf16x8*)(lds + PG8_SB(b, h) + boff + n * 2048 + k * 1024); } while (0)
#define PG8_MMA(ai, bj, At, Bt) do { __builtin_amdgcn_s_setprio(1); _Pragma("unroll") for (int m = 0; m < 4; ++m) _Pragma("unroll") for (int n = 0; n < 2; ++n) _Pragma("unroll") for (int k = 0; k < 2; ++k) \
        acc[ai][bj][m][n] = __builtin_amdgcn_mfma_f32_16x16x32_bf16(Bt[n][k], At[m][k], acc[ai][bj][m][n], 0, 0, 0); __builtin_amdgcn_s_setprio(0); } while (0)
#define PG8_WAIT_V(n) asm volatile("s_waitcnt vmcnt(" #n ")" ::: "memory")
#define PG8_WAIT_L(n) asm volatile("s_waitcnt lgkmcnt(" #n ")" ::: "memory")
#define PG8_BAR __builtin_amdgcn_s_barrier()
#define PG8_SCHED __builtin_amdgcn_sched_barrier(0)
    Unit cur, nxt; int ui = 0;
    if (!S.next(0, cur)) return;
    f32x4 acc[2][2][4][2];
#pragma unroll
    for (int a = 0; a < 2; ++a)
#pragma unroll
        for (int b = 0; b < 2; ++b)
#pragma unroll
            for (int m = 0; m < 4; ++m)
#pragma unroll
                for (int n = 0; n < 2; ++n) acc[a][b][m][n] = (f32x4){0.f, 0.f, 0.f, 0.f};
    bf16x8 At[4][2], B0[2][2], B1[2][2];
    const char* cA; const char* cB; S.ptrs(cur, cA, cB);
    PG8_STAGE(PG8_SB(0, 0), cB, voffB); PG8_STAGE(PG8_SB(0, 1), cB + hstepB, voffB); PG8_STAGE(PG8_SA(0, 0), cA, voffA); PG8_STAGE(PG8_SA(0, 1), cA + hstepA, voffA);
    if (wr == 1) PG8_BAR;
    PG8_WAIT_V(2); PG8_BAR;
    PG8_STAGE(PG8_SB(1, 0), cB + kstep, voffB); PG8_STAGE(PG8_SA(1, 0), cA + kstep, voffA); PG8_STAGE(PG8_SB(1, 1), cB + hstepB + kstep, voffB);
    PG8_WAIT_V(6); PG8_BAR;
    for (;;) {
        const bool has_next = S.next(ui + 1, nxt); const int nt = S.nt(cur, g.K) ;
        const char* nA = cA; const char* nB = cB; if (has_next) S.ptrs(nxt, nA, nB);
        for (int t = 0; t < nt; t += 2) {
            const bool last = (t == nt - 2);
            const char* a1 = cA + (size_t)(t + 1) * kstep;
            const char* a2 = last ? nA : cA + (size_t)(t + 2) * kstep; const char* b2 = last ? nB : cB + (size_t)(t + 2) * kstep;
            const char* a3 = a2 + kstep; const char* b3 = b2 + kstep;
            PG8_LDB(B0, 0, 0); PG8_LDB(B1, 0, 1); PG8_SCHED; PG8_LDA(At, 0, 0); PG8_STAGE(PG8_SA(1, 1), a1 + hstepA, voffA);
            PG8_WAIT_V(8); PG8_WAIT_L(0); PG8_BAR; PG8_MMA(0, 0, At, B0); PG8_MMA(0, 1, At, B1); PG8_BAR; PG8_SCHED;
            PG8_LDA(At, 0, 1); PG8_STAGE(PG8_SB(0, 0), b2, voffB); PG8_STAGE(PG8_SB(0, 1), b2 + hstepB, voffB); PG8_STAGE(PG8_SA(0, 0), a2, voffA);
            PG8_WAIT_V(8); PG8_WAIT_L(0); PG8_BAR; PG8_MMA(1, 0, At, B0); PG8_MMA(1, 1, At, B1); PG8_BAR; PG8_SCHED;
            PG8_LDB(B0, 1, 0); PG8_LDB(B1, 1, 1); PG8_SCHED; PG8_LDA(At, 1, 0); PG8_STAGE(PG8_SA(0, 1), a2 + hstepA, voffA);
            PG8_WAIT_V(8); PG8_WAIT_L(0); PG8_BAR; PG8_MMA(0, 0, At, B0); PG8_MMA(0, 1, At, B1); PG8_BAR; PG8_SCHED;
            PG8_LDA(At, 1, 1); PG8_STAGE(PG8_SB(1, 0), b3, voffB); PG8_STAGE(PG8_SB(1, 1), b3 + hstepB, voffB); PG8_STAGE(PG8_SA(1, 0), a3, voffA);
            PG8_WAIT_V(8); PG8_WAIT_L(0); PG8_BAR; PG8_MMA(1, 0, At, B0); PG8_MMA(1, 1, At, B1); PG8_BAR; PG8_SCHED;
        }
        if constexpr (ALIGN_EPI) { if (wr == 0) PG8_BAR; }
        if constexpr (!Epi::AFTER_DRAIN) { int fr2 = fr, fq2 = fq; asm volatile("" : "+v"(fr2), "+v"(fq2)); E(acc, cur, wr, wc, fr2, fq2); }
        if (!has_next) break;
#pragma unroll
        for (int a = 0; a < 2; ++a)
#pragma unroll
            for (int b = 0; b < 2; ++b)
#pragma unroll
                for (int m = 0; m < 4; ++m)
#pragma unroll
                    for (int n = 0; n < 2; ++n) acc[a][b][m][n] = (f32x4){0.f, 0.f, 0.f, 0.f};
        cur = nxt; cA = nA; cB = nB; ++ui;
        if constexpr (ALIGN_EPI) { if (wr == 1) PG8_BAR; }
    }
    PG8_WAIT_V(0);
    if constexpr (!ALIGN_EPI) { if (wr == 0) PG8_BAR; }
    PG8_BAR;
    if constexpr (Epi::AFTER_DRAIN) { int fr2 = fr, fq2 = fq; asm volatile("" : "+v"(fr2), "+v"(fq2)); E.fused(acc, cur, wr, wc, fr2, fq2, lds, wid, lane); }
#undef PG8_SA
#undef PG8_SB
#undef PG8_STAGE
#undef PG8_LDA
#undef PG8_LDB
#undef PG8_MMA
#undef PG8_WAIT_V
#undef PG8_WAIT_L
#undef PG8_BAR
#undef PG8_SCHED
}
struct UnitG { const char* a; const char* b; int lda, ldb, nt, kind, perm; };
template <class Epi, class Sched, bool ALIGN_EPI>
__device__ __forceinline__ void gemm_stream(PG8_LAS unsigned char* lds, const Sched& S, const Epi& E) {
    int tid_ = threadIdx.x; asm volatile("" : "+v"(tid_));
    const int tid = tid_, wid = __builtin_amdgcn_readfirstlane(tid >> 6), lane = tid & 63, wr = wid >> 2, wc = wid & 3, fr = lane & 15, fq = lane >> 4;
#define PG8_VOFF(u, vA, vB) do { _Pragma("unroll") for (int i_ = 0; i_ < 2; ++i_) { int R_, C_; stage_rc(tid * 16 + i_ * 8192, R_, C_); const int Rb_ = (u).perm ? ((R_ & ~31) + perm32(R_ & 31)) : R_; \
        vA[i_] = (unsigned)(R_ * (u).lda + C_) * 2u; vB[i_] = (unsigned)(Rb_ * (u).ldb + C_) * 2u; } } while (0)
    const size_t kstep = (size_t)(BK * 2);
    const unsigned ldsw = (unsigned)wid * 1024u;
    const int aoff = lds_byte(wr * 64 + fr, fq * 8), boff = lds_byte(wc * 32 + fr, fq * 8);
#undef PG8_SA
#undef PG8_SB
#undef PG8_STAGE
#undef PG8_LDA
#undef PG8_LDB
#undef PG8_MMA
#undef PG8_WAIT_V
#undef PG8_WAIT_L
#undef PG8_BAR
#undef PG8_SCHED
#define PG8_SA(b, h) (((b) * 2 + (h)) * HTB)
#define PG8_SB(b, h) ((4 + (b) * 2 + (h)) * HTB)
#define PG8_STAGE(bufoff, gbase, voff) do { _Pragma("unroll") for (int _i = 0; _i < 2; ++_i) \
        __builtin_amdgcn_global_load_lds((const unsigned*)((const char*)(gbase) + (voff)[_i]), (PG8_LAS unsigned*)(lds + (bufoff) + ldsw + _i * 8192), 16, 0, 0); } while (0)
#define PG8_LDA(dst, b, h) do { _Pragma("unroll") for (int m = 0; m < 4; ++m) _Pragma("unroll") for (int k = 0; k < 2; ++k) dst[m][k] = *(const PG8_LAS bf16x8*)(lds + PG8_SA(b, h) + aoff + m * 2048 + k * 1024); } while (0)
#define PG8_LDB(dst, b, h) do { _Pragma("unroll") for (int n = 0; n < 2; ++n) _Pragma("unroll") for (int k = 0; k < 2; ++k) dst[n][k] = *(const PG8_LAS bf16x8*)(lds + PG8_SB(b, h) + boff + n * 2048 + k * 1024); } while (0)
#define PG8_MMA(ai, bj, At, Bt) do { __builtin_amdgcn_s_setprio(1); _Pragma("unroll") for (int m = 0; m < 4; ++m) _Pragma("unroll") for (int n = 0; n < 2; ++n) _Pragma("unroll") for (int k = 0; k < 2; ++k) \
        acc[ai][bj][m][n] = __builtin_amdgcn_mfma_f32_16x16x32_bf16(Bt[n][k], At[m][k], acc[ai][bj][m][n], 0, 0, 0); __builtin_amdgcn_s_setprio(0); } while (0)
#define PG8_WAIT_V(n) asm volatile("s_waitcnt vmcnt(" #n ")" ::: "memory")
#define PG8_WAIT_L(n) asm volatile("s_waitcnt lgkmcnt(" #n ")" ::: "memory")
#define PG8_BAR __builtin_amdgcn_s_barrier()
#define PG8_SCHED __builtin_amdgcn_sched_barrier(0)
    UnitG cur, nxt; int ui = 0;
    if (!S.next(0, cur)) return;
    unsigned voffA[2], voffB[2]; PG8_VOFF(cur, voffA, voffB);
    size_t hstepA = (size_t)HALF * cur.lda * 2, hstepB = (size_t)HALF * cur.ldb * 2;
    f32x4 acc[2][2][4][2];
#pragma unroll
    for (int a = 0; a < 2; ++a)
#pragma unroll
        for (int b = 0; b < 2; ++b)
#pragma unroll
            for (int m = 0; m < 4; ++m)
#pragma unroll
                for (int n = 0; n < 2; ++n) acc[a][b][m][n] = (f32x4){0.f, 0.f, 0.f, 0.f};
    bf16x8 At[4][2], B0[2][2], B1[2][2];
    const char* cA = cur.a; const char* cB = cur.b;
    PG8_STAGE(PG8_SB(0, 0), cB, voffB); PG8_STAGE(PG8_SB(0, 1), cB + hstepB, voffB); PG8_STAGE(PG8_SA(0, 0), cA, voffA); PG8_STAGE(PG8_SA(0, 1), cA + hstepA, voffA);
    if (wr == 1) PG8_BAR;
    PG8_WAIT_V(2); PG8_BAR;
    PG8_STAGE(PG8_SB(1, 0), cB + kstep, voffB); PG8_STAGE(PG8_SA(1, 0), cA + kstep, voffA); PG8_STAGE(PG8_SB(1, 1), cB + hstepB + kstep, voffB);
    PG8_WAIT_V(6); PG8_BAR;
    for (;;) {
        const bool has_next = S.next(ui + 1, nxt); const int nt = cur.nt; if (!has_next) nxt = cur;
        const char* nA = nxt.a; const char* nB = nxt.b;
        const size_t nhA = (size_t)HALF * nxt.lda * 2, nhB = (size_t)HALF * nxt.ldb * 2;
        for (int t = 0; t < nt; t += 2) {
            const bool last = (t == nt - 2);
            const char* a1 = cA + (size_t)(t + 1) * kstep;
            const char* a2 = last ? nA : cA + (size_t)(t + 2) * kstep; const char* b2 = last ? nB : cB + (size_t)(t + 2) * kstep;
            const char* a3 = a2 + kstep; const char* b3 = b2 + kstep;
            unsigned xvA[2], xvB[2]; if (last) { PG8_VOFF(nxt, xvA, xvB); } else { xvA[0] = voffA[0]; xvA[1] = voffA[1]; xvB[0] = voffB[0]; xvB[1] = voffB[1]; }
            const size_t xhA = last ? nhA : hstepA, xhB = last ? nhB : hstepB;
            PG8_LDB(B0, 0, 0); PG8_LDB(B1, 0, 1); PG8_SCHED; PG8_LDA(At, 0, 0); PG8_STAGE(PG8_SA(1, 1), a1 + hstepA, voffA);
            PG8_WAIT_V(8); PG8_WAIT_L(0); PG8_BAR; PG8_MMA(0, 0, At, B0); PG8_MMA(0, 1, At, B1); PG8_BAR; PG8_SCHED;
            PG8_LDA(At, 0, 1); PG8_STAGE(PG8_SB(0, 0), b2, xvB); PG8_STAGE(PG8_SB(0, 1), b2 + xhB, xvB); PG8_STAGE(PG8_SA(0, 0), a2, xvA);
            PG8_WAIT_V(8); PG8_WAIT_L(0); PG8_BAR; PG8_MMA(1, 0, At, B0); PG8_MMA(1, 1, At, B1); PG8_BAR; PG8_SCHED;
            PG8_LDB(B0, 1, 0); PG8_LDB(B1, 1, 1); PG8_SCHED; PG8_LDA(At, 1, 0); PG8_STAGE(PG8_SA(0, 1), a2 + xhA, xvA);
            PG8_WAIT_V(8); PG8_WAIT_L(0); PG8_BAR; PG8_MMA(0, 0, At, B0); PG8_MMA(0, 1, At, B1); PG8_BAR; PG8_SCHED;
            PG8_LDA(At, 1, 1); PG8_STAGE(PG8_SB(1, 0), b3, xvB); PG8_STAGE(PG8_SB(1, 1), b3 + xhB, xvB); PG8_STAGE(PG8_SA(1, 0), a3, xvA);
            PG8_WAIT_V(8); PG8_WAIT_L(0); PG8_BAR; PG8_MMA(1, 0, At, B0); PG8_MMA(1, 1, At, B1); PG8_BAR; PG8_SCHED;
        }
        if constexpr (ALIGN_EPI) { if (wr == 0) PG8_BAR; }
        if (!E.after_drain(cur)) { int fr2 = fr, fq2 = fq; asm volatile("" : "+v"(fr2), "+v"(fq2)); E(acc, cur, wr, wc, fr2, fq2); }
        if (!has_next) break;
#pragma unroll
        for (int a = 0; a < 2; ++a)
#pragma unroll
            for (int b = 0; b < 2; ++b)
#pragma unroll
                for (int m = 0; m < 4; ++m)
#pragma unroll
                    for (int n = 0; n < 2; ++n) acc[a][b][m][n] = (f32x4){0.f, 0.f, 0.f, 0.f};
        cur = nxt; cA = nA; cB = nB; ++ui; PG8_VOFF(cur, voffA, voffB); hstepA = nhA; hstepB = nhB;
        if constexpr (ALIGN_EPI) { if (wr == 1) PG8_BAR; }
    }
    PG8_WAIT_V(0);
    if constexpr (!ALIGN_EPI) { if (wr == 0) PG8_BAR; }
    PG8_BAR;
    if (E.after_drain(cur)) { int fr2 = fr, fq2 = fq; asm volatile("" : "+v"(fr2), "+v"(fq2)); E.fused(acc, cur, wr, wc, fr2, fq2, lds, wid, lane); }
#undef PG8_SA
#undef PG8_SB
#undef PG8_STAGE
#undef PG8_LDA
#undef PG8_LDB
#undef PG8_MMA
#undef PG8_WAIT_V
#undef PG8_WAIT_L
#undef PG8_BAR
#undef PG8_SCHED
#undef PG8_VOFF
}
}

namespace mk {
using pg8::bf16_t; using pg8::f32x4; using pg8::f32x2; using pg8::u32x4; using pg8::u32x2; using pg8::Unit;
constexpr int D = 2048, BATCH = 2, SEQ = 4096, M = BATCH * SEQ, D_IN = 16384, D_FF = 8192, N_MEM = 256;
constexpr float EPS = 1e-6f, LOG2E = 1.4426950408889634f;
constexpr size_t MiB = 1u << 20;
constexpr size_t WS_CTL = 0, CTL_ZERO_BYTES = 1 * MiB;
constexpr size_t WS_COS = 1 * MiB, WS_SIN = 2 * MiB;
constexpr size_t WS_SSQ_NAQ = 3 * MiB, WS_SSQ_NAK = 4 * MiB;
constexpr size_t WS_SSQ_XQ = 5 * MiB, WS_XL = 5 * MiB + 512 * 1024;
constexpr size_t WS_SSQ_X1 = 6 * MiB;
constexpr size_t WS_TAB = 6 * MiB + 512 * 1024;
constexpr int TAB_CS_NAQ = 0, TAB_CS_MK = 128, TAB_L2F = 384, TAB_L2B = 392, TAB_SSQ_MK = 1024;
constexpr size_t WS_MEMN = 8 * MiB, WS_MK = 10 * MiB, WS_MVT = 11 * MiB;
constexpr size_t WS_WIN = 16 * MiB, WS_WFF1 = 80 * MiB, WS_WFF2 = 112 * MiB, WS_WRET = 144 * MiB, WS_WOUT = 152 * MiB, WS_WNM = 160 * MiB  , WS_WMKV = 168 * MiB;
constexpr size_t WS_NAQKV = 176 * MiB, WS_K0 = 224 * MiB, WS_RG = 240 * MiB, WS_XQ = 272 * MiB, WS_GATES = 288 * MiB;
constexpr size_t WS_AR = 384 * MiB, WS_BR = 448 * MiB, WS_END = 512 * MiB;
constexpr size_t WS_KV = WS_WIN;
constexpr size_t WS_ORET = 16 * MiB;
constexpr size_t WS_MERGED = WS_NAQKV;
constexpr size_t WS_X1B = WS_AR;
constexpr size_t WS_HFF = 176 * MiB;
constexpr int LDH = 8192;
constexpr size_t DO_HN = 0, DO_KT = 0, DO_XP = 32 * MiB, DO_ONM = 0;

struct SchedGrid {
    pg8::GridOrder o; const char* A; const char* B; size_t ta, tb;
    __device__ __forceinline__ bool next(int i, Unit& u) const { return o.next(i, u); }
    __device__ __forceinline__ void ptrs(const Unit& u, const char*& a, const char*& b) const { a = A + (size_t)u.pm * ta; b = B + (size_t)u.pn * tb; }
    __device__ __forceinline__ int nt(const Unit&, int K) const { return K / 64; }
};
struct SchedProj {
    pg8::GridOrder o; const char* hn_; const char* wt_;
    __device__ __forceinline__ bool next(int i, Unit& u) const { return o.next(i, u); }
    __device__ __forceinline__ void ptrs(const Unit& u, const char*& a, const char*& b) const {
        const char* h = hn_ + (size_t)u.pm * (256u * 2048u * 2u); const char* w = wt_ + (size_t)u.pn * (256u * 2048u * 2u);
        const bool sw = (u.pn >= 20 && u.pn < 28); a = sw ? w : h; b = sw ? h : w; }
    __device__ __forceinline__ int nt(const Unit&, int K) const { return K / 64; }
};
struct SchedOne { bool has; Unit u; const char* a; const char* b;
    __device__ __forceinline__ bool next(int i, Unit& uu) const { if (i != 0 || !has) return false; uu = u; return true; }
    __device__ __forceinline__ void ptrs(const Unit&, const char*& aa, const char*& bb) const { aa = a; bb = b; }
    __device__ __forceinline__ int nt(const Unit&, int K) const { return K / 64; }
};

#define MK_ROWS_BEGIN _Pragma("unroll") for (int ai = 0; ai < 2; ++ai) { _Pragma("unroll") for (int m = 0; m < 4; ++m) { const int rl = ai * 128 + wr * 64 + m * 16 + fr;
#define MK_ROWS_END __builtin_amdgcn_sched_barrier(0); } }
#define MK_ROWS_END_NB } }
#define MK_ROWS_END2 if (m & 1) __builtin_amdgcn_sched_barrier(0); } }
#define MK_RL(ai, m) ((ai) * 128 + wr * 64 + (m) * 16 + fr)
__device__ __forceinline__ float sq8(const f32x4& a, const f32x4& b) { return (a[0] * a[0] + a[1] * a[1]) + (a[2] * a[2] + a[3] * a[3]) + (b[0] * b[0] + b[1] * b[1]) + (b[2] * b[2] + b[3] * b[3]); }
__device__ __forceinline__ float red_fq(float s) {
    { auto r = __builtin_amdgcn_permlane16_swap(__float_as_uint(s), __float_as_uint(s), false, false); s = __uint_as_float(r[0]) + __uint_as_float(r[1]); }
    { auto r = __builtin_amdgcn_permlane32_swap(__float_as_uint(s), __float_as_uint(s), false, false); s = __uint_as_float(r[0]) + __uint_as_float(r[1]); }
    return s; }

struct EpiProj {
    static constexpr bool PERM = true, AFTER_DRAIN = false;
    unsigned char* ws;
    __device__ __forceinline__ void operator()(const f32x4 (&acc)[2][2][4][2], const Unit& u, int wr, int wc, int fr, int fq) const {
        bf16_t* const naqkv = (bf16_t*)(ws + WS_NAQKV); bf16_t* const k0 = (bf16_t*)(ws + WS_K0); bf16_t* const rg = (bf16_t*)(ws + WS_RG); bf16_t* const xq = (bf16_t*)(ws + WS_XQ);
        bf16_t* const gates = (bf16_t*)(ws + WS_GATES); bf16_t* const ar = (bf16_t*)(ws + WS_AR); bf16_t* const br = (bf16_t*)(ws + WS_BR);
        float* const ssq_naq = (float*)(ws + WS_SSQ_NAQ); float* const ssq_nak = (float*)(ws + WS_SSQ_NAK); float* const ssq_xq = (float*)(ws + WS_SSQ_XQ);
        const float* const cosT = (const float*)(ws + WS_COS); const float* const sinT = (const float*)(ws + WS_SIN); const float* const tab = (const float*)(ws + WS_TAB);
        const int pn = u.pn, row0 = u.pm * 256, cw = wc * 32 + 8 * fq;
        if (pn < 8) {
            const bool isq = pn < 4; float* ssq = isq ? ssq_naq : ssq_nak; const int hb = isq ? 2 * pn : 2 * (pn - 4);
            f32x4 c0 = (f32x4){1.f, 1.f, 1.f, 1.f}, c1 = c0; if (isq) { c0 = *(const f32x4*)(tab + TAB_CS_NAQ + cw); c1 = *(const f32x4*)(tab + TAB_CS_NAQ + cw + 4); }
            MK_ROWS_BEGIN  const int row = row0 + rl;
#pragma unroll
                for (int bj = 0; bj < 2; ++bj) { const f32x4 v0 = acc[ai][bj][m][0], v1 = acc[ai][bj][m][1]; const float q = red_fq(sq8(v0, v1));
                    if (fq == 0) ssq[(size_t)row * 32 + (hb + bj) * 4 + wc] = q;
                    pg8::store8(naqkv + (size_t)row * 3072 + pn * 256 + bj * 128 + cw, v0 * c0, v1 * c1); }  MK_ROWS_END
        } else if (pn < 12) {
            MK_ROWS_BEGIN  const int row = row0 + rl;
#pragma unroll
                for (int bj = 0; bj < 2; ++bj) pg8::store8(naqkv + (size_t)row * 3072 + pn * 256 + bj * 128 + cw, acc[ai][bj][m][0], acc[ai][bj][m][1]);  MK_ROWS_END
        } else if (pn < 20) {
            const bool isq = pn < 16; const int head = 2 * (pn & 3) + (wc >> 1), i0 = 32 * (wc & 1) + 8 * fq;
            const float l2f = tab[TAB_L2F + head], l2b = tab[TAB_L2B + head];
            MK_ROWS_BEGIN  const int row = row0 + rl, s = row & 4095, b = row >> 12;
                const f32x4 cs0 = *(const f32x4*)(cosT + s * 64 + i0), cs1 = *(const f32x4*)(cosT + s * 64 + i0 + 4), sn0 = *(const f32x4*)(sinT + s * 64 + i0), sn1 = *(const f32x4*)(sinT + s * 64 + i0 + 4);
                const f32x4 a0 = acc[ai][0][m][0], a1 = acc[ai][0][m][1], b0 = acc[ai][1][m][0], b1 = acc[ai][1][m][1];
                const f32x4 lo0 = a0 * cs0 - b0 * sn0, lo1 = a1 * cs1 - b1 * sn1, hi0 = a0 * sn0 + b0 * cs0, hi1 = a1 * sn1 + b1 * cs1;
                if (isq) { const int c = row & 255; const float df = pg8::fexp2(l2f * (float)(c + 1)), db = pg8::fexp2(l2b * (float)(256 - c));
                    bf16_t* d = ar + ((size_t)(b * 8 + head) * 4096 + s) * 512 + 256 + i0;
                    pg8::store8(d, lo0 * df, lo1 * df); pg8::store8(d + 64, hi0 * df, hi1 * df); pg8::store8(d + 128, lo0 * db, lo1 * db); pg8::store8(d + 192, hi0 * db, hi1 * db);
                } else { const float sc = 0.08838834764831845f; bf16_t* d = k0 + (size_t)row * 1024 + head * 128 + i0;
                    pg8::store8(d, lo0 * sc, lo1 * sc); pg8::store8(d + 64, hi0 * sc, hi1 * sc); }  MK_ROWS_END2
        } else if (pn < 28) {
            const int hv = pn - 20, b = u.pm >> 4, nc = u.pm & 15;
            bf16_t* base = br + ((size_t)((b * 8 + hv) * 16 + nc) * 256) * 512;
            MK_ROWS_BEGIN
#pragma unroll
                for (int bj = 0; bj < 2; ++bj) pg8::store8(base + (size_t)rl * 512 + bj * 128 + cw, acc[ai][bj][m][0], acc[ai][bj][m][1]);  MK_ROWS_END
        } else if (pn < 36) {
            MK_ROWS_BEGIN  const int row = row0 + rl;
#pragma unroll
                for (int bj = 0; bj < 2; ++bj) { f32x4 v0 = acc[ai][bj][m][0], v1 = acc[ai][bj][m][1];
#pragma unroll
                    for (int e = 0; e < 4; ++e) { v0[e] = v0[e] * pg8::sigmoidf_(v0[e]); v1[e] = v1[e] * pg8::sigmoidf_(v1[e]); }
                    pg8::store8(rg + (size_t)row * 2048 + (pn - 28) * 256 + bj * 128 + cw, v0, v1); }  MK_ROWS_END
        } else if (pn < 40) {
            MK_ROWS_BEGIN  const int row = row0 + rl;
                const float q = red_fq(sq8(acc[ai][0][m][0], acc[ai][0][m][1]) + sq8(acc[ai][1][m][0], acc[ai][1][m][1]));
                if (fq == 0) ssq_xq[(size_t)row * 16 + (pn - 36) * 4 + wc] = q;
#pragma unroll
                for (int bj = 0; bj < 2; ++bj) pg8::store8(xq + (size_t)row * 1024 + (pn - 36) * 256 + bj * 128 + cw, acc[ai][bj][m][0], acc[ai][bj][m][1]);  MK_ROWS_END
        } else {
            MK_ROWS_BEGIN  const int row = row0 + rl;
#pragma unroll
                for (int bj = 0; bj < 2; ++bj) { f32x4 v0 = acc[ai][bj][m][0], v1 = acc[ai][bj][m][1];
#pragma unroll
                    for (int e = 0; e < 4; ++e) { v0[e] = pg8::sigmoidf_(v0[e]); v1[e] = pg8::sigmoidf_(v1[e]); }
                    pg8::store8(gates + (size_t)row * 6144 + (pn - 40) * 256 + bj * 128 + cw, v0, v1); }  MK_ROWS_END
        }
    }
};
struct EpiMKV {
    static constexpr bool PERM = true, AFTER_DRAIN = false;
    bf16_t *mk, *mvt; float* tabw; const float* tab; int mode;
    __device__ __forceinline__ void operator()(const f32x4 (&acc)[2][2][4][2], const Unit& u, int wr, int wc, int fr, int fq) const {
        const int cw = wc * 32 + 8 * fq, row0 = u.pm * 256;
        if (mode == 0) {
            MK_ROWS_BEGIN  const int row = row0 + rl;
                const float q = red_fq(sq8(acc[ai][0][m][0], acc[ai][0][m][1]) + sq8(acc[ai][1][m][0], acc[ai][1][m][1]));
                if (fq == 0) tabw[TAB_SSQ_MK + row * 16 + u.pn * 4 + wc] = q;
#pragma unroll
                for (int bj = 0; bj < 2; ++bj) { const f32x4 c0 = *(const f32x4*)(tab + TAB_CS_MK + bj * 128 + cw), c1 = *(const f32x4*)(tab + TAB_CS_MK + bj * 128 + cw + 4);
                    pg8::store8(mk + (size_t)row * 1024 + u.pn * 256 + bj * 128 + cw, acc[ai][bj][m][0] * c0, acc[ai][bj][m][1] * c1); }  MK_ROWS_END
        } else {
            MK_ROWS_BEGIN  const int row = row0 + rl;
#pragma unroll
                for (int bj = 0; bj < 2; ++bj) pg8::store8(mvt + (size_t)row * 512 + u.pn * 256 + bj * 128 + cw, acc[ai][bj][m][0], acc[ai][bj][m][1]);  MK_ROWS_END
        }
    }
};
struct EpiF32 {
    static constexpr bool PERM = true, AFTER_DRAIN = false;
    bf16_t* C;
    __device__ __forceinline__ void operator()(const f32x4 (&acc)[2][2][4][2], const Unit&, int wr, int wc, int fr, int fq) const {
        const int cw = wc * 32 + 8 * fq;
        MK_ROWS_BEGIN
#pragma unroll
            for (int bj = 0; bj < 2; ++bj) pg8::store8(C + (size_t)rl * 256 + bj * 128 + cw, acc[ai][bj][m][0], acc[ai][bj][m][1]);  MK_ROWS_END
    }
};
struct EpiP {
    static constexpr bool PERM = true, AFTER_DRAIN = false;
    bf16_t* P; float l2f, l2b;
    __device__ __forceinline__ void operator()(const f32x4 (&acc)[2][2][4][2], const Unit&, int wr, int wc, int fr, int fq) const {
        const int cw = wc * 32 + 8 * fq;
        MK_ROWS_BEGIN  const int c = rl; const float rowf = -l2f * (float)(c + 1);
#pragma unroll
            for (int bj = 0; bj < 2; ++bj) { f32x4 v[2] = {acc[ai][bj][m][0], acc[ai][bj][m][1]};
#pragma unroll
                for (int n = 0; n < 2; ++n)
#pragma unroll
                    for (int e = 0; e < 4; ++e) { const int cp = bj * 128 + cw + 4 * n + e;
                        const float ex = (c >= cp) ? (-l2f * (float)(cp + 1)) : (l2b * (float)(cp - c) + rowf);
                        v[n][e] *= pg8::fexp2(ex); }
                pg8::store8(P + (size_t)c * 512 + bj * 128 + cw, v[0], v[1]); }  MK_ROWS_END
    }
};
struct EpiGN {
    static constexpr bool PERM = true, AFTER_DRAIN = true;
    bf16_t* oret; const bf16_t* rgv; const float* gn;
    __device__ __forceinline__ void fused(f32x4 (&acc)[2][2][4][2], const Unit&, int wr, int wc, int fr, int fq, PG8_LAS unsigned char* lds, int wid, int lane) const {
        PG8_LAS f32x2* P = (PG8_LAS f32x2*)lds;
        const int cw = wc * 32 + 8 * fq;
        MK_ROWS_BEGIN  float s = 0.f;
#pragma unroll
            for (int bj = 0; bj < 2; ++bj)
#pragma unroll
                for (int n = 0; n < 2; ++n) { const f32x4 x = acc[ai][bj][m][n]; s += (x[0] + x[1]) + (x[2] + x[3]); }
            s = red_fq(s); const float mw = s * (1.0f / 64.0f); float q = 0.f;
#pragma unroll
            for (int bj = 0; bj < 2; ++bj)
#pragma unroll
                for (int n = 0; n < 2; ++n) { const f32x4 d = acc[ai][bj][m][n] - mw; q += (d[0] * d[0] + d[1] * d[1]) + (d[2] * d[2] + d[3] * d[3]); }
            q = red_fq(q);
            if (fq == 0) P[rl * 4 + wc] = (f32x2){mw, q};  MK_ROWS_END
        asm volatile("s_waitcnt lgkmcnt(0)" ::: "memory"); __builtin_amdgcn_s_barrier(); asm volatile("" ::: "memory");
        f32x4 g0[2], g1[2];
#pragma unroll
        for (int bj = 0; bj < 2; ++bj) { g0[bj] = *(const f32x4*)(gn + bj * 128 + cw); g1[bj] = *(const f32x4*)(gn + bj * 128 + cw + 4); }
        MK_ROWS_BEGIN  const f32x2 a = P[rl * 4 + 0], b = P[rl * 4 + 1], c = P[rl * 4 + 2], d = P[rl * 4 + 3];
            const float mt = (a.x + b.x + c.x + d.x) * 0.25f;
            const float da = a.x - mt, db = b.x - mt, dc = c.x - mt, dd = d.x - mt;
            const float m2 = (a.y + b.y) + (c.y + d.y) + 64.0f * ((da * da + db * db) + (dc * dc + dd * dd));
            const float rstd = 1.0f / sqrtf(m2 * (1.0f / 256.0f) + EPS);
#pragma unroll
            for (int bj = 0; bj < 2; ++bj) { f32x4 r0, r1; pg8::load8(rgv + (size_t)rl * 2048 + bj * 128 + cw, r0, r1);
                const f32x4 o0 = (acc[ai][bj][m][0] - mt) * rstd * g0[bj] * r0, o1 = (acc[ai][bj][m][1] - mt) * rstd * g1[bj] * r1;
                pg8::store8(oret + (size_t)rl * 2048 + bj * 128 + cw, o0, o1); }  MK_ROWS_END_NB
        asm volatile("s_waitcnt lgkmcnt(0)" ::: "memory"); __builtin_amdgcn_s_barrier(); asm volatile("" ::: "memory");
    }
};
struct EpiXS {
    static constexpr bool PERM = true, AFTER_DRAIN = false;
    bf16_t* xp; float* xl; const float* ssq_q; const float* ssq_k;
    __device__ __forceinline__ void operator()(const f32x4 (&acc)[2][2][4][2], const Unit&, int wr, int wc, int fr, int fq) const {
        const int cw = wc * 32 + 8 * fq;
        float rk[2][8];
#pragma unroll
        for (int bj = 0; bj < 2; ++bj)
#pragma unroll
            for (int j = 0; j < 8; ++j) { const f32x4 p = *(const f32x4*)(ssq_k + (size_t)(bj * 128 + cw + j) * 16); rk[bj][j] = rsqrtf(((p[0] + p[1]) + (p[2] + p[3])) * (1.0f / 256.0f) + EPS) * LOG2E; }
#pragma unroll
        for (int ai = 0; ai < 2; ++ai) {
            float rqa[4];
#pragma unroll
            for (int m = 0; m < 4; ++m) { const f32x4 pq = *(const f32x4*)(ssq_q + (size_t)MK_RL(ai, m) * 16); rqa[m] = rsqrtf(((pq[0] + pq[1]) + (pq[2] + pq[3])) * (1.0f / 256.0f) + EPS); }
#pragma unroll
            for (int m = 0; m < 4; ++m) { const int rl = MK_RL(ai, m); const float rq = rqa[m];
                float s = 0.f;
#pragma unroll
                for (int bj = 0; bj < 2; ++bj) { f32x4 v[2] = {acc[ai][bj][m][0], acc[ai][bj][m][1]};
#pragma unroll
                    for (int n = 0; n < 2; ++n)
#pragma unroll
                        for (int e = 0; e < 4; ++e) { v[n][e] = pg8::fexp2(v[n][e] * rq * rk[bj][4 * n + e]); s += v[n][e]; }
                    pg8::store8(xp + (size_t)rl * 1024 + bj * 128 + cw, v[0], v[1]); }
                s = red_fq(s); if (fq == 0) xl[(size_t)rl * 16 + wc] = s;
                __builtin_amdgcn_sched_barrier(0); }
        }
    }
};
struct EpiXO {
    static constexpr bool PERM = true, AFTER_DRAIN = false;
    bf16_t* omem; const float* xl;
    __device__ __forceinline__ void operator()(const f32x4 (&acc)[2][2][4][2], const Unit&, int wr, int wc, int fr, int fq) const {
        const int cw = wc * 32 + 8 * fq;
        float ila[2][4];
#pragma unroll
        for (int ai = 0; ai < 2; ++ai)
#pragma unroll
            for (int m = 0; m < 4; ++m) { const f32x4 p = *(const f32x4*)(xl + (size_t)MK_RL(ai, m) * 16); ila[ai][m] = pg8::frcp((p[0] + p[1]) + (p[2] + p[3])); }
        MK_ROWS_BEGIN  const float il = ila[ai][m];
#pragma unroll
            for (int bj = 0; bj < 2; ++bj) pg8::store8(omem + (size_t)rl * 2048 + bj * 128 + cw, acc[ai][bj][m][0] * il, acc[ai][bj][m][1] * il);  MK_ROWS_END
    }
};
struct EpiGate4 {
    static constexpr bool PERM = true, AFTER_DRAIN = false;
    bf16_t* merged; const bf16_t* gates;
    __device__ __forceinline__ void operator()(const f32x4 (&acc)[2][2][4][2], const Unit& u, int wr, int wc, int fr, int fq) const {
        const int cw = wc * 32 + 8 * fq; const bf16_t* gate = gates + u.sub * 2048; const bool first = u.sub == 0;
        MK_ROWS_BEGIN  const size_t row = (size_t)u.pm * 256 + rl;
#pragma unroll
            for (int bj = 0; bj < 2; ++bj) { const int col = u.pn * 256 + bj * 128 + cw; f32x4 g0, g1; pg8::load8(gate + row * 6144 + col, g0, g1);
                f32x4 v0 = acc[ai][bj][m][0] * g0, v1 = acc[ai][bj][m][1] * g1;
                if (!first) { f32x4 t0, t1; pg8::load8(merged + row * 2048 + col, t0, t1); v0 += t0; v1 += t1; }
                pg8::store8(merged + row * 2048 + col, v0, v1); }  MK_ROWS_END_NB
    }
};
struct SchedBR {
    pg8::GridOrder o; const char* onm; const char* oret; const char* wnm; const char* wret;
    __device__ __forceinline__ bool next(int i, Unit& u) const { if (i >= 3) return false; const bool ok = o.next(0, u); u.sub = i; return ok; }
    __device__ __forceinline__ void ptrs(const Unit& u, const char*& a, const char*& b) const {
        const size_t ra = (size_t)u.pm * (256u * 2048u * 2u), rb = (size_t)u.pn * (256u * 2048u * 2u);
        const bool nm = (u.sub != 1); const size_t co = (u.sub == 2) ? 2048u : 0u;
        a = (nm ? onm : oret) + ra + co; b = (nm ? wnm : wret) + rb + co; }
    __device__ __forceinline__ int nt(const Unit& u, int) const { return u.sub == 1 ? 32 : 16; }
};
struct EpiWout {
    static constexpr bool PERM = false, AFTER_DRAIN = true;
    const float* x; float* x1; bf16_t* x1b; float* ssq; const float* gffn;
    __device__ __forceinline__ void fused(f32x4 (&acc)[2][2][4][2], const Unit& u, int wr, int wc, int fr, int fq, PG8_LAS unsigned char* lds, int wid, int lane) const {
        PG8_LAS float* P = (PG8_LAS float*)lds;
        const int col0 = u.pn * 256 + wc * 32 + 4 * fq;
        MK_ROWS_BEGIN  const size_t off = ((size_t)u.pm * 256 + rl) * 2048 + col0; float q = 0.f;
#pragma unroll
            for (int bj = 0; bj < 2; ++bj)
#pragma unroll
                for (int n = 0; n < 2; ++n) { const f32x4 v = *(const f32x4*)(x + off + bj * 128 + n * 16) + acc[ai][bj][m][n];
                    *(f32x4*)(x1 + off + bj * 128 + n * 16) = v; pg8::store4(x1b + off + bj * 128 + n * 16, v * *(const f32x4*)(gffn + col0 + bj * 128 + n * 16)); q += (v[0] * v[0] + v[1] * v[1]) + (v[2] * v[2] + v[3] * v[3]); }
            q = red_fq(q); if (fq == 0) P[rl * 4 + wc] = q;  MK_ROWS_END_NB
        asm volatile("s_waitcnt lgkmcnt(0)" ::: "memory"); __builtin_amdgcn_s_barrier(); asm volatile("" ::: "memory");
        if (threadIdx.x < 256) { const int r = threadIdx.x; const f32x4 p = *(const PG8_LAS f32x4*)(P + r * 4); ssq[((size_t)u.pm * 256 + r) * 8 + u.pn] = (p[0] + p[1]) + (p[2] + p[3]); }
        asm volatile("s_waitcnt lgkmcnt(0)" ::: "memory"); __builtin_amdgcn_s_barrier(); asm volatile("" ::: "memory");
    }
};
struct EpiFF1 {
    static constexpr bool PERM = true, AFTER_DRAIN = false;
    bf16_t* hff; const float* ssq;
    __device__ __forceinline__ void operator()(const f32x4 (&acc)[2][2][4][2], const Unit& u, int wr, int wc, int fr, int fq) const {
        const int cw = wc * 32 + 8 * fq;
        float ra[2][4];
#pragma unroll
        for (int ai = 0; ai < 2; ++ai)
#pragma unroll
            for (int m = 0; m < 4; ++m) { const size_t row = (size_t)u.pm * 256 + MK_RL(ai, m); const f32x4 p0 = *(const f32x4*)(ssq + row * 8), p1 = *(const f32x4*)(ssq + row * 8 + 4);
                ra[ai][m] = rsqrtf((((p0[0] + p0[1]) + (p0[2] + p0[3])) + ((p1[0] + p1[1]) + (p1[2] + p1[3]))) * (1.0f / 2048.0f) + EPS); }
        MK_ROWS_BEGIN  const size_t row = (size_t)u.pm * 256 + rl; const float r = ra[ai][m];
#pragma unroll
            for (int bj = 0; bj < 2; ++bj) { f32x4 v0 = acc[ai][bj][m][0] * r, v1 = acc[ai][bj][m][1] * r;
#pragma unroll
                for (int e = 0; e < 4; ++e) { const float a = fmaxf(v0[e], 0.f), b = fmaxf(v1[e], 0.f); v0[e] = a * a; v1[e] = b * b; }
                pg8::store8(hff + row * LDH + u.pn * 256 + bj * 128 + cw, v0, v1); }  MK_ROWS_END
    }
};
struct EpiFF2 {
    static constexpr bool PERM = false, AFTER_DRAIN = false;
    const float* src; float* out;
    __device__ __forceinline__ void operator()(const f32x4 (&acc)[2][2][4][2], const Unit& u, int wr, int wc, int fr, int fq) const {
        const int col0 = u.pn * 256 + wc * 32 + 4 * fq;
        MK_ROWS_BEGIN  const size_t off = ((size_t)u.pm * 256 + rl) * 2048 + col0;
#pragma unroll
            for (int bj = 0; bj < 2; ++bj)
#pragma unroll
                for (int n = 0; n < 2; ++n) { const size_t o2 = off + bj * 128 + n * 16; *(f32x4*)(out + o2) = *(const f32x4*)(src + o2) + acc[ai][bj][m][n]; }  MK_ROWS_END_NB
    }
};

struct SchedList3 {
    pg8::UnitG u0, u1, u2; int n;
    __device__ __forceinline__ bool next(int i, pg8::UnitG& u) const { if (i >= n) return false;
        u.a = (i == 0) ? u0.a : ((i == 1) ? u1.a : u2.a); u.b = (i == 0) ? u0.b : ((i == 1) ? u1.b : u2.b);
        u.lda = (i == 0) ? u0.lda : ((i == 1) ? u1.lda : u2.lda); u.ldb = (i == 0) ? u0.ldb : ((i == 1) ? u1.ldb : u2.ldb);
        u.nt = (i == 0) ? u0.nt : ((i == 1) ? u1.nt : u2.nt); u.kind = (i == 0) ? u0.kind : ((i == 1) ? u1.kind : u2.kind); u.perm = (i == 0) ? u0.perm : ((i == 1) ? u1.perm : u2.perm);
        return true; }
};
struct EpiM1 {
    EpiF32 e0; EpiP e1; EpiXS e2;
    __device__ __forceinline__ bool after_drain(const pg8::UnitG&) const { return false; }
    __device__ __forceinline__ void operator()(const f32x4 (&acc)[2][2][4][2], const pg8::UnitG& u, int wr, int wc, int fr, int fq) const {
        Unit d; d.pm = 0; d.pn = 0; d.sub = 0;
        if (u.kind == 0) e0(acc, d, wr, wc, fr, fq); else if (u.kind == 1) e1(acc, d, wr, wc, fr, fq); else e2(acc, d, wr, wc, fr, fq); }
    __device__ __forceinline__ void fused(f32x4 (&)[2][2][4][2], const pg8::UnitG&, int, int, int, int, PG8_LAS unsigned char*, int, int) const {}
};
struct EpiM3 {
    EpiXO e0; EpiGN e1;
    __device__ __forceinline__ bool after_drain(const pg8::UnitG& u) const { return u.kind == 1; }
    __device__ __forceinline__ void operator()(const f32x4 (&acc)[2][2][4][2], const pg8::UnitG& u, int wr, int wc, int fr, int fq) const { Unit d; d.pm = 0; d.pn = 0; d.sub = 0; e0(acc, d, wr, wc, fr, fq); }
    __device__ __forceinline__ void fused(f32x4 (&acc)[2][2][4][2], const pg8::UnitG&, int wr, int wc, int fr, int fq, PG8_LAS unsigned char* lds, int wid, int lane) const {
        Unit d; d.pm = 0; d.pn = 0; d.sub = 0; e1.fused(acc, d, wr, wc, fr, fq, lds, wid, lane); }
};
#undef MK_ROWS_BEGIN
#undef MK_ROWS_END
#undef MK_ROWS_END_NB
#undef MK_ROWS_END2
#undef MK_RL
}

namespace na {
using bf16 = unsigned short;
using bf16x8 = __attribute__((ext_vector_type(8))) short;
using s16x4  = __attribute__((ext_vector_type(4))) short;
using f32x16 = __attribute__((ext_vector_type(16))) float;
using f32x4  = __attribute__((ext_vector_type(4))) float;
using u32x4  = __attribute__((ext_vector_type(4))) unsigned;
constexpr int DH = 128, NW = 8, QBLK = 32, KVBLK = 64, LDQ = 3072;
constexpr size_t SHM_V = KVBLK * DH * 2, SHM_K = KVBLK * DH * 2;
constexpr int NBUF = 3;
constexpr int OFF_RK = NBUF * SHM_V + NBUF * SHM_K;
constexpr int OFF_BIAS = OFF_RK + 768 * 4;
constexpr int BIAS_PAD = 64, BIAS_N = 64 + 15 * 31 + 79;
constexpr int OFF_LI = OFF_BIAS + ((BIAS_N * 4 + 15) / 16) * 16;
constexpr int NA_LDS_BYTES = OFF_LI + NW * 64 * 4;
#define KSWZ(row, colB) ((row) * 256 + ((colB) ^ (((row) & 7) << 4)))
#define SBAR() __builtin_amdgcn_sched_barrier(0)
__device__ __forceinline__ int crow(int r, int hi) { return (r & 3) + 8 * (r >> 2) + 4 * hi; }
__device__ __forceinline__ unsigned cvtpk(float lo, float hi) { return pg8::cvt_pk_bf16(lo, hi); }

__device__ __forceinline__ void procP(f32x16& p0, f32x16& p1, float& lsum, bool inwin, const float* rk_t  , const float* bias_l  ,
                                      float rqs, int cs, int hi) {
  if (!inwin) { p0 = f32x16{}; p1 = f32x16{}; return; }
#pragma unroll
  for (int g = 0; g < 4; ++g) {
    const f32x4 k0 = *(const f32x4*)(rk_t + 8 * g + 4 * hi), k1 = *(const f32x4*)(rk_t + 32 + 8 * g + 4 * hi);
#pragma unroll
    for (int e = 0; e < 4; ++e) { const int r = 4 * g + e; const int w0 = e + 8 * g + 4 * hi, w1 = w0 + 32;
      const float x0 = fmaf(p0[r], rqs * k0[e], bias_l[w0]), x1 = fmaf(p1[r], rqs * k1[e], bias_l[w1]);
      const float e0 = __builtin_amdgcn_exp2f(x0), e1 = __builtin_amdgcn_exp2f(x1);
      const float v0 = ((unsigned)(w0 - cs) < 16u) ? e0 : 0.f, v1 = ((unsigned)(w1 - cs) < 16u) ? e1 : 0.f;
      p0[r] = v0; p1[r] = v1; lsum += v0 + v1; }
  }
}
__device__ __forceinline__ void packP(const f32x16& p0, const f32x16& p1, bf16x8& pa0, bf16x8& pa1, bf16x8& pa2, bf16x8& pa3) {
#define PK4(P, BASE, OUT) do { unsigned a0 = cvtpk(P[BASE + 0], P[BASE + 1]), a1 = cvtpk(P[BASE + 2], P[BASE + 3]);   \
    unsigned b0 = cvtpk(P[BASE + 4], P[BASE + 5]), b1 = cvtpk(P[BASE + 6], P[BASE + 7]);                              \
    auto r0 = __builtin_amdgcn_permlane32_swap(a0, b0, false, false); auto r1 = __builtin_amdgcn_permlane32_swap(a1, b1, false, false); \
    u32x4 w = {r0[0], r1[0], r0[1], r1[1]}; OUT = *reinterpret_cast<bf16x8*>(&w); } while (0)
  PK4(p0, 0, pa0); PK4(p0, 8, pa1); PK4(p1, 0, pa2); PK4(p1, 8, pa3);
#undef PK4
}
__device__ __forceinline__ void qkt(f32x16& p0, f32x16& p1, const bf16* Ks, const bf16x8* qr, int r32, int hi) {
  p0 = f32x16{}; p1 = f32x16{};
#pragma unroll
  for (int d0 = 0; d0 < 8; ++d0) { int cb = (d0 * 16 + hi * 8) * 2;
    bf16x8 b0 = *reinterpret_cast<const bf16x8*>((const char*)Ks + KSWZ(r32, cb));
    bf16x8 b1 = *reinterpret_cast<const bf16x8*>((const char*)Ks + KSWZ(32 + r32, cb));
    p0 = __builtin_amdgcn_mfma_f32_32x32x16_bf16(b0, qr[d0], p0, 0, 0, 0);
    p1 = __builtin_amdgcn_mfma_f32_32x32x16_bf16(b1, qr[d0], p1, 0, 0, 0); }
}
__device__ __forceinline__ int v_st(int k, int c) { const int kk = (k & ~0xC) | ((k & 4) << 1) | ((k & 8) >> 1); return ((kk >> 3) * 4 + (c >> 5)) * 512 + ((kk & 7) * 32 + (c & 31)) * 2; }
__device__ __forceinline__ int v_rd_base(int lane) { return ((lane & 3) << 3) | (((lane >> 2) & 3) << 6) | (((lane >> 4) & 1) << 5) | (((lane >> 5) & 1) << 8); }
constexpr int v_rd_off(int d0, int ks, int half) { return d0 * 512 + ks * 4096 + half * 2048; }
template <int OFF> __device__ __forceinline__ s16x4 tr_read(int vb) {
  s16x4 r; asm volatile("ds_read_b64_tr_b16 %0, %1 offset:%2" : "=&v"(r) : "v"(vb), "i"(OFF) : "memory"); return r;
}
template <int D0> __device__ __forceinline__ void pv_one(f32x16& od, int vb, bf16x8 pa0, bf16x8 pa1, bf16x8 pa2, bf16x8 pa3) {
  const s16x4 l0 = tr_read<v_rd_off(D0, 0, 0)>(vb), h0 = tr_read<v_rd_off(D0, 0, 1)>(vb), l1 = tr_read<v_rd_off(D0, 1, 0)>(vb), h1 = tr_read<v_rd_off(D0, 1, 1)>(vb);
  const s16x4 l2 = tr_read<v_rd_off(D0, 2, 0)>(vb), h2 = tr_read<v_rd_off(D0, 2, 1)>(vb), l3 = tr_read<v_rd_off(D0, 3, 0)>(vb), h3 = tr_read<v_rd_off(D0, 3, 1)>(vb);
  asm volatile("s_waitcnt lgkmcnt(0)" ::: "memory"); SBAR();
#define PK(L, H) (bf16x8){L[0], L[1], L[2], L[3], H[0], H[1], H[2], H[3]}
  od = __builtin_amdgcn_mfma_f32_32x32x16_bf16(pa0, PK(l0, h0), od, 0, 0, 0);
  od = __builtin_amdgcn_mfma_f32_32x32x16_bf16(pa1, PK(l1, h1), od, 0, 0, 0);
  od = __builtin_amdgcn_mfma_f32_32x32x16_bf16(pa2, PK(l2, h2), od, 0, 0, 0);
  od = __builtin_amdgcn_mfma_f32_32x32x16_bf16(pa3, PK(l3, h3), od, 0, 0, 0);
#undef PK
}
__device__ __forceinline__ void pv_d0(f32x16* o, int vb, bf16x8 pa0, bf16x8 pa1, bf16x8 pa2, bf16x8 pa3) {
  pv_one<0>(o[0], vb, pa0, pa1, pa2, pa3); pv_one<1>(o[1], vb, pa0, pa1, pa2, pa3); pv_one<2>(o[2], vb, pa0, pa1, pa2, pa3); pv_one<3>(o[3], vb, pa0, pa1, pa2, pa3);
}

__device__ __forceinline__ void na_unit(int b, int h, int i4, const bf16* __restrict__ qkv, const float* __restrict__ ssq_q, const float* __restrict__ ssq_k,
                                        const float* __restrict__ rpb, bf16* __restrict__ ona, char* lds) {
  int tid_ = threadIdx.x; asm volatile("" : "+v"(tid_));
  const int tid = tid_, wid = __builtin_amdgcn_readfirstlane(tid >> 6), lane = tid & 63, r32 = lane & 31, hi = lane >> 5;
  bf16* V_lds = (bf16*)lds; bf16* K_lds = (bf16*)(lds + NBUF * SHM_V);
  float* rkL = (float*)(lds + OFF_RK); float* biasL = (float*)(lds + OFF_BIAS); float* li_l = (float*)(lds + OFF_LI) + wid * 64;
  const int NT = (i4 == 0 || i4 == 15) ? 8 : 11, rbase = (i4 == 0) ? 0 : ((i4 == 15) ? 56 : 4 * i4 - 4);
  const int qrow = 4 * i4 + (wid >> 1), qc = 32 * (wid & 1) + r32;
  int rs = qrow - 4; rs = rs < 0 ? 0 : (rs > 56 ? 56 : rs);
  int cs = qc - 8; cs = cs < 0 ? 0 : (cs > 48 ? 48 : cs);
  const size_t tok_q = (size_t)b * 4096 + qrow * 64 + qc, tok_k0 = (size_t)b * 4096 + rbase * 64;
  for (int i = tid; i < NT * 64; i += 512) { const f32x4 p = *(const f32x4*)(ssq_k + (tok_k0 + i) * 32 + h * 4); rkL[i] = rsqrtf(((p[0] + p[1]) + (p[2] + p[3])) * (1.0f / 128.0f) + 1e-6f); }
  for (int i = tid; i < BIAS_N; i += 512) { const int j = i - BIAS_PAD; biasL[i] = (j >= 0 && j < 15 * 31) ? rpb[h * 465 + j] * 1.4426950408889634f : 0.f; }
  float rqs; { const f32x4 p = *(const f32x4*)(ssq_q + tok_q * 32 + h * 4); rqs = rsqrtf(((p[0] + p[1]) + (p[2] + p[3])) * (1.0f / 128.0f) + 1e-6f) * 1.4426950408889634f; }
  float l_reg = 0; f32x16 o[4] = {}; bf16x8 qr[8];
  const bf16* Qw = qkv + tok_q * LDQ + h * 128 + hi * 8;
#pragma unroll
  for (int d0 = 0; d0 < 8; ++d0) qr[d0] = *reinterpret_cast<const bf16x8*>(Qw + d0 * 16);
  const bf16* Kh = qkv + tok_k0 * LDQ + 1024 + h * 128; const bf16* Vh = qkv + tok_k0 * LDQ + 2048 + h * 128;
  const int sr = tid >> 4, sc = (tid & 15) * 8, vst0 = v_st(sr, sc), vst1 = v_st(32 + sr, sc);
  const int vb0 = (int)(uintptr_t)V_lds + v_rd_base(lane);
  struct { bf16x8 vs0, vs1, ks0, ks1; } sr_[2];
#define SLOAD(i, k0) do { sr_[i].vs0 = *(const bf16x8*)(&Vh[(long)((k0) + sr) * LDQ + sc]); sr_[i].vs1 = *(const bf16x8*)(&Vh[(long)((k0) + 32 + sr) * LDQ + sc]); \
    sr_[i].ks0 = *(const bf16x8*)(&Kh[(long)((k0) + sr) * LDQ + sc]); sr_[i].ks1 = *(const bf16x8*)(&Kh[(long)((k0) + 32 + sr) * LDQ + sc]); } while (0)
#define SWRITE(bb, i) do { *(bf16x8*)((char*)V_lds + (bb) * SHM_V + vst0) = sr_[i].vs0;          \
    *(bf16x8*)((char*)V_lds + (bb) * SHM_V + vst1) = sr_[i].vs1; int kc = sc * 2;               \
    *(bf16x8*)((char*)K_lds + (bb) * SHM_K + KSWZ(sr, kc)) = sr_[i].ks0;                       \
    *(bf16x8*)((char*)K_lds + (bb) * SHM_K + KSWZ(32 + sr, kc)) = sr_[i].ks1; } while (0)
#define SWAIT() asm volatile("s_waitcnt vmcnt(0)" ::: "memory")
#define TILE_ARGS(j) ((unsigned)(rbase + (j) - rs) < 8u), rkL + (j) * 64, biasL + BIAS_PAD + (rbase + (j) - qrow + 7) * 31 + 15 - qc, rqs, cs, hi
  f32x16 p0, p1; bf16x8 pa0, pa1, pa2, pa3;
#define NA_TILE(j, bo) do { if ((unsigned)(rbase + (j) - rs) < 8u) {     \
      SBAR(); qkt(p0, p1, (const bf16*)((const char*)K_lds + (bo) * SHM_K), qr, r32, hi); \
      procP(p0, p1, l_reg, TILE_ARGS(j)); \
      packP(p0, p1, pa0, pa1, pa2, pa3); SBAR(); \
      pv_d0(o, vb0 + (bo) * (int)SHM_V, pa0, pa1, pa2, pa3); } } while (0)
  SLOAD(0, 0); SLOAD(1, KVBLK); SWRITE(0, 0); SLOAD(0, 2 * KVBLK); SWRITE(1, 1); SLOAD(1, 3 * KVBLK); __syncthreads();
  int b0 = 0;
  for (int j = 0; j < NT; j += 2) {
    const int b1 = (b0 == 2) ? 0 : b0 + 1, b2 = (b1 == 2) ? 0 : b1 + 1;
    NA_TILE(j, b0);
    if (j + 2 < NT) { SWRITE(b2, 0); if (j + 4 < NT) SLOAD(0, (j + 4) * KVBLK); }
    __syncthreads();
    if (j + 1 < NT) NA_TILE(j + 1, b1);
    if (j + 3 < NT) { SWRITE(b0, 1); if (j + 5 < NT) SLOAD(1, (j + 5) * KVBLK); }
    __syncthreads();
    b0 = b2;
  }
#undef NA_TILE
  { auto rr = __builtin_amdgcn_permlane32_swap(__float_as_uint(l_reg), __float_as_uint(l_reg), false, false); l_reg = __uint_as_float(rr[0]) + __uint_as_float(rr[1]); }
  if (hi == 0) li_l[r32] = l_reg; asm volatile("s_waitcnt lgkmcnt(0)" ::: "memory");
  float rli[16];
#pragma unroll
  for (int r = 0; r < 16; ++r) rli[r] = __builtin_amdgcn_rcpf(li_l[crow(r, hi)]);
  bf16* Ow = ona + ((size_t)b * 4096 + qrow * 64 + 32 * (wid & 1)) * 2048 + h * 128;
#pragma unroll
  for (int r = 0; r < 16; ++r) { const int orow = crow(r, hi);
#pragma unroll
    for (int d0 = 0; d0 < 4; ++d0) { const float v = o[d0][r] * rli[r]; unsigned u = __float_as_uint(v); u += 0x7fffu + ((u >> 16) & 1u); Ow[(size_t)orow * 2048 + d0 * 32 + r32] = (bf16)(u >> 16); } }
  __syncthreads();
#undef SLOAD
#undef SWRITE
#undef SWAIT
#undef TILE_ARGS
}
#undef KSWZ
#undef SBAR
}

constexpr int NWAVES = 8;
constexpr int RING_OFF = 0, RING_BYTES = 131072;
constexpr int LDSCTL_OFF = RING_BYTES, MISC_OFF = LDSCTL_OFF + 320;
constexpr int LDS_BYTES = 147456;
static_assert(MISC_OFF + 128 <= LDS_BYTES && na::NA_LDS_BYTES <= RING_BYTES, "LDS map");
constexpr int CW_TMO = 0, CW_BAR = 4096;

#define GAS __attribute__((address_space(1)))
#define LAS __attribute__((address_space(3)))
typedef unsigned short bf16;
typedef unsigned v4u __attribute__((ext_vector_type(4)));
typedef float f32x4 __attribute__((ext_vector_type(4)));
typedef GAS unsigned gu32;
#define LDS_WAIT() asm volatile("s_waitcnt lgkmcnt(0)" ::: "memory")
#define VM_WAIT() asm volatile("s_waitcnt vmcnt(0)" ::: "memory")
__device__ __forceinline__ unsigned f2bf(float f) { unsigned u = __builtin_bit_cast(unsigned, f); return (u + 0x7fffu + ((u >> 16) & 1u)) >> 16; }
__device__ __forceinline__ unsigned pk2(float lo, float hi) { return f2bf(lo) | (f2bf(hi) << 16); }
__device__ __forceinline__ float bf2f_(unsigned h) { return __uint_as_float(h << 16); }

#define XB_TMO      128
#define XB_XCNT(j)  (256  + 64 * (j))
#define XB_XSUB(j)  (1280 + 64 * (j))
#define XB_XGEN(j)  (2304 + 64 * (j))
#define XB_TOP      3328
#define XB_TOPGEN   3392
#define XCD_BAR_WORDS 3456
#define XB_SPIN_CAP (1u << 18)
__device__ __forceinline__ unsigned xb_ld(unsigned* p)              { return __hip_atomic_load(p, __ATOMIC_RELAXED, __HIP_MEMORY_SCOPE_AGENT); }
__device__ __forceinline__ unsigned xb_add(unsigned* p, unsigned v) { return __hip_atomic_fetch_add(p, v, __ATOMIC_RELAXED, __HIP_MEMORY_SCOPE_AGENT); }
__device__ __forceinline__ unsigned xb_xcc_id() { return (unsigned)__builtin_amdgcn_s_getreg((3 << 11) | 20) & 0xFu; }
#define XB_SPIN(cond, bar) do { unsigned _sp = 0; while (cond) { __builtin_amdgcn_s_sleep(1); \
    if ((++_sp & 255u) == 0u) { if (xb_ld(&(bar)[XB_TMO])) break; if (_sp > XB_SPIN_CAP) { atomicAdd(&(bar)[XB_TMO], 1u); break; } } } } while (0)
struct XcdBarrier { unsigned* bar; unsigned x; volatile LAS unsigned* st; };
__device__ __forceinline__ XcdBarrier xcd_barrier_post(unsigned* bar, volatile LAS unsigned* st) {
    XcdBarrier b; b.bar = bar; b.x = xb_xcc_id(); b.st = st;
    if (threadIdx.x == 0) (void)xb_add(&bar[XB_XCNT(b.x)], 1u);
    return b;
}
__device__ __forceinline__ void xcd_barrier_complete(unsigned* bar, unsigned x, unsigned& nloc, unsigned& nx) {
    const unsigned G = gridDim.x * gridDim.y * gridDim.z;
    unsigned sum, cnt, mine, sp = 0u;
    for (;;) {
        sum = 0u; cnt = 0u; mine = 0u;
#pragma unroll
        for (unsigned j = 0; j < 16; ++j) { const unsigned c = xb_ld(&bar[XB_XCNT(j)]); sum += c; cnt += (c > 0u) ? 1u : 0u; mine = (j == x) ? c : mine; }
        if (sum == G) break;
        __builtin_amdgcn_s_sleep(1);
        if ((++sp & 255u) == 0u) { if (xb_ld(&bar[XB_TMO])) break; if (sp > XB_SPIN_CAP) { atomicAdd(&bar[XB_TMO], 1u); break; } }
    }
    nloc = mine > 0u ? mine : 1u; nx = cnt > 0u ? cnt : 1u;
}
__device__ __forceinline__ void xcd_barrier(const XcdBarrier& b) {
    asm volatile("s_waitcnt vmcnt(0)" ::: "memory");
    __syncthreads();
    if (threadIdx.x == 0) {
        unsigned* bar = b.bar;
        __builtin_amdgcn_s_waitcnt(0);
        unsigned nloc = b.st[0], nx = b.st[1];
        if (nloc == 0u) { xcd_barrier_complete(bar, b.x, nloc, nx); b.st[0] = nloc; b.st[1] = nx; }
        const unsigned old = xb_add(&bar[XB_XSUB(b.x)], 1u);
        const unsigned gen = old / nloc;
        if (old + 1u == (gen + 1u) * nloc) {
            __builtin_amdgcn_fence(__ATOMIC_RELEASE, "agent");
            asm volatile("s_waitcnt vmcnt(0)" ::: "memory");
            const unsigned og = xb_add(&bar[XB_TOP], 1u);
            const unsigned tg = og / nx;
            if (og + 1u == (tg + 1u) * nx) xb_add(&bar[XB_TOPGEN], 1u);
            else XB_SPIN(xb_ld(&bar[XB_TOPGEN]) == tg, bar);
            __builtin_amdgcn_fence(__ATOMIC_ACQUIRE, "agent");
            xb_add(&bar[XB_XGEN(b.x)], 1u);
            asm volatile("s_waitcnt vmcnt(0)" ::: "memory");
        } else {
            XB_SPIN(xb_ld(&bar[XB_XGEN(b.x)]) == gen, bar);
            __builtin_amdgcn_fence(__ATOMIC_ACQUIRE, "agent");
            asm volatile("s_waitcnt vmcnt(0)" ::: "memory");
        }
    }
    __syncthreads();
}

__device__ __forceinline__ float wave_sum(float v) {
#pragma unroll
    for (int o = 1; o < 64; o <<= 1) v += __shfl_xor(v, o);
    return v;
}
__device__ __forceinline__ void p0_item(const float* __restrict__ W, int ldw, int k0, int n0, bf16* __restrict__ WT, int ldt, int dA, int dB, const float* __restrict__ kscale, LAS float* scr, int lane) {
    const int c16 = lane & 15, kr = lane >> 4;
#pragma unroll
    for (int it = 0; it < 16; ++it) { const int k = 4 * it + kr;
        f32x4 v = __builtin_nontemporal_load((const f32x4*)(W + (size_t)(k0 + k) * ldw + n0 + 4 * c16));
        if (kscale) v = v * kscale[k0 + k];
        *(LAS f32x4*)(scr + k * 64 + ((4 * c16) ^ (8 * ((k >> 3) & 7)))) = v; }
    LDS_WAIT(); asm volatile("" ::: "memory");
    const int c = lane & 7;
#pragma unroll
    for (int j = 0; j < 8; ++j) { const int n = (lane >> 3) + 8 * j; const LAS float* s = scr + (8 * c) * 64 + (n ^ (8 * c));
        v4u o; o.x = pk2(s[0 * 64], s[1 * 64]); o.y = pk2(s[2 * 64], s[3 * 64]); o.z = pk2(s[4 * 64], s[5 * 64]); o.w = pk2(s[6 * 64], s[7 * 64]);
        const int drow = (n < 32) ? dA + n : dB + n - 32;
        *(GAS v4u*)(WT + (size_t)drow * ldt + k0 + 8 * c) = o; }
    LDS_WAIT(); asm volatile("" ::: "memory");
}
struct P0Desc { const float* src; bf16* dst; int ldw, ldt, dA, dB, nt; };
__device__ __forceinline__ void p0_load(const P0Desc& d, f32x4 (&R)[16], int lane) {
    const int c16 = lane & 15, kr = lane >> 4;
#pragma unroll
    for (int it = 0; it < 16; ++it) R[it] = __builtin_nontemporal_load((const f32x4*)(d.src + (size_t)(4 * it + kr) * d.ldw + 4 * c16));
}
__device__ __forceinline__ void p0_to_lds(const f32x4 (&R)[16], LAS float* scr, int lane) {
    const int c16 = lane & 15, kr = lane >> 4;
#pragma unroll
    for (int it = 0; it < 16; ++it) { const int k = 4 * it + kr; *(LAS f32x4*)(scr + k * 64 + ((4 * c16) ^ (8 * ((k >> 3) & 7)))) = R[it]; }
}
__device__ __forceinline__ void p0_store(const P0Desc& d, LAS float* scr, int lane) {
    const int c = lane & 7;
#pragma unroll
    for (int j = 0; j < 8; ++j) { const int n = (lane >> 3) + 8 * j; const LAS float* s = scr + (8 * c) * 64 + (n ^ (8 * c));
        v4u o; o.x = pk2(s[0 * 64], s[1 * 64]); o.y = pk2(s[2 * 64], s[3 * 64]); o.z = pk2(s[4 * 64], s[5 * 64]); o.w = pk2(s[6 * 64], s[7 * 64]);
        const int drow = (n < 32) ? d.dA + n : d.dB + n - 32;
        GAS v4u* q = (GAS v4u*)(d.dst + (size_t)drow * d.ldt + 8 * c); if (d.nt) __builtin_nontemporal_store(o, q); else *q = o; }
}
__device__ __forceinline__ void rms_row_to_bf16(const float* __restrict__ xrow, const float* __restrict__ g, bf16* __restrict__ orow, int lane) {
    const f32x4* xr = (const f32x4*)xrow + lane; const f32x4* gr = (const f32x4*)g + lane;
    f32x4 v[8]; float s = 0.f;
#pragma unroll
    for (int j = 0; j < 8; ++j) { v[j] = __builtin_nontemporal_load(xr + 64 * j); s += (v[j].x * v[j].x + v[j].y * v[j].y) + (v[j].z * v[j].z + v[j].w * v[j].w); }
    const float r = rsqrtf(wave_sum(s) * (1.f / 2048.f) + mk::EPS);
    unsigned long long* o8 = (unsigned long long*)orow + lane;
#pragma unroll
    for (int j = 0; j < 8; ++j) { const f32x4 gg = gr[64 * j]; o8[64 * j] = (unsigned long long)pk2(v[j].x * r * gg.x, v[j].y * r * gg.y) | ((unsigned long long)pk2(v[j].z * r * gg.z, v[j].w * r * gg.w) << 32); }
}
__device__ __forceinline__ int win_dest_row(int n32  ) {
    const int pn = n32 >> 3, ga = n32 & 7;
    if (pn < 12 || pn >= 20) return n32 * 32;
    const int gs = 4 * ((ga >> 1) & 1) + 2 * (ga >> 2) + (ga & 1);
    return (pn * 8 + gs) * 32;
}

#ifndef MK_TS
#define MK_TS -1
#endif
struct Args { const float* in[21]; float* out; unsigned char* ws; };

__global__ void __launch_bounds__(NWAVES * 64, 2) mk_fwd(Args args) {
    extern __shared__ __attribute__((aligned(16))) unsigned char lds[];
    LAS unsigned char* ldsl = (LAS unsigned char*)lds;
    volatile LAS unsigned* MISC = (volatile LAS unsigned*)(ldsl + MISC_OFF);
    const int tid = threadIdx.x, lane = tid & 63, wave = __builtin_amdgcn_readfirstlane(tid >> 6);
    const int G = gridDim.x, bx = blockIdx.x;
    const int vcu = (G % 8 == 0) ? (bx % 8) * (G / 8) + bx / 8 : bx;
    unsigned char* ws = args.ws; unsigned char* dob = (unsigned char*)args.out;
    gu32* ctl = (gu32*)(ws + mk::WS_CTL);
#define I_x args.in[0]
#define I_mem args.in[1]
#define I_g_mix args.in[2]
#define I_w_in args.in[3]
#define I_gq args.in[4]
#define I_gk args.in[5]
#define I_rpb args.in[6]
#define I_lgf_in args.in[7]
#define I_lgb_in args.in[8]
#define I_gn args.in[9]
#define I_g_mem args.in[10]
#define I_w_mkv args.in[11]
#define I_gxq args.in[12]
#define I_gxk args.in[13]
#define I_w_na args.in[14]
#define I_w_ret args.in[15]
#define I_w_memb args.in[16]
#define I_w_out args.in[17]
#define I_g_ffn args.in[18]
#define I_w_ff1 args.in[19]
#define I_w_ff2 args.in[20]
#define I_out args.out
#define cosT ((float*)(ws + mk::WS_COS))
#define sinT ((float*)(ws + mk::WS_SIN))
#define ssq_naq ((float*)(ws + mk::WS_SSQ_NAQ))
#define ssq_nak ((float*)(ws + mk::WS_SSQ_NAK))
#define ssq_xq ((float*)(ws + mk::WS_SSQ_XQ))
#define xl ((float*)(ws + mk::WS_XL))
#define ssq_x1 ((float*)(ws + mk::WS_SSQ_X1))
#define tab ((float*)(ws + mk::WS_TAB))
#define MEMN ((bf16*)(ws + mk::WS_MEMN))
#define MKb ((bf16*)(ws + mk::WS_MK))
#define MVT ((bf16*)(ws + mk::WS_MVT))
#define WinT ((bf16*)(ws + mk::WS_WIN))
#define Wff1T ((bf16*)(ws + mk::WS_WFF1))
#define Wff2T ((bf16*)(ws + mk::WS_WFF2))
#define WretT ((bf16*)(ws + mk::WS_WRET))
#define WoutT ((bf16*)(ws + mk::WS_WOUT))
#define WnmT ((bf16*)(ws + mk::WS_WNM))
#define WmkvT ((bf16*)(ws + mk::WS_WMKV))
#define NAQKV ((bf16*)(ws + mk::WS_NAQKV))
#define K0 ((bf16*)(ws + mk::WS_K0))
#define RG ((bf16*)(ws + mk::WS_RG))
#define XQ ((bf16*)(ws + mk::WS_XQ))
#define GATES ((bf16*)(ws + mk::WS_GATES))
#define AR ((bf16*)(ws + mk::WS_AR))
#define BR ((bf16*)(ws + mk::WS_BR))
#define KV ((bf16*)(ws + mk::WS_KV))
#define ORET ((bf16*)(ws + mk::WS_ORET))
#define MERGED ((bf16*)(ws + mk::WS_MERGED))
#define X1B ((bf16*)(ws + mk::WS_X1B))
#define HFF ((bf16*)(ws + mk::WS_HFF))
#define HN ((bf16*)(dob + mk::DO_HN))
#define KT ((bf16*)(dob + mk::DO_KT))
#define XP ((bf16*)(dob + mk::DO_XP))
#define ONM ((bf16*)(dob + mk::DO_ONM))
    for (int u = tid; u < (LDS_BYTES - LDSCTL_OFF) / 4; u += NWAVES * 64) ((LAS unsigned*)(ldsl + LDSCTL_OFF))[u] = 0u;
    __syncthreads();
    XcdBarrier bar = xcd_barrier_post((unsigned*)(ctl + CW_BAR), MISC + 8);
#define GRID_BAR() do { xcd_barrier(bar); MK_STAMP(); } while (0)
    int n_stamp_ = 0;
#define MK_STAMP() do { if (MK_TS >= 0) { if (bx == 0 && tid == 0) MISC[16 + n_stamp_] = (unsigned)__builtin_amdgcn_s_memrealtime(); ++n_stamp_; } } while (0)
    MK_STAMP();
    LAS float* scr = (LAS float*)(ldsl + RING_OFF + wave * 16384);
    const int gw = vcu * NWAVES + wave, NGW = G * NWAVES;

    {
    {
        for (int i = gw * 64 + lane; i < 4096 * 64; i += NGW * 64) { const int s = i >> 6, f = i & 63;
            const float inv = powf(10000.0f, -(float)f / 64.0f), ang = (float)s * inv; cosT[i] = cosf(ang); sinT[i] = sinf(ang); }
        if (bx == 0) {
            if (tid < 128) tab[mk::TAB_CS_NAQ + tid] = I_gq[tid] * I_gk[tid] * 0.08838834764831845f;
            if (tid < 256) tab[mk::TAB_CS_MK + tid] = I_gxq[tid] * I_gxk[tid] * 0.0625f;
            if (tid < 8) { tab[mk::TAB_L2F + tid] = -log1pf(expf(-I_lgf_in[tid])) * mk::LOG2E; tab[mk::TAB_L2B + tid] = -log1pf(expf(-I_lgb_in[tid])) * mk::LOG2E; }
        }
        for (int m = gw; m < 512; m += NGW) rms_row_to_bf16(I_mem + (size_t)m * 2048, I_g_mem, MEMN + (size_t)m * 2048, lane);
        for (int it = gw; it < 32 * 32; it += NGW) { const int kb = it >> 5, nb = it & 31; p0_item(I_w_mkv, 2048, 64 * kb, 64 * nb, WmkvT, 2048, 64 * nb, 64 * nb + 32, nullptr, scr, lane); }
    }
    GRID_BAR();
    }
    {
    if (vcu < 16) {
        mk::SchedOne S; S.has = true; const pg8::Gemm g{2048, 2048, 2048};
        mk::EpiMKV E{MKb, MVT, tab, tab, 0};
        if (vcu < 8) { S.u.pm = vcu >> 2; S.u.pn = vcu & 3; S.a = (const char*)(MEMN + (size_t)S.u.pm * 256 * 2048); S.b = (const char*)(WmkvT + (size_t)S.u.pn * 256 * 2048); E.mode = 0; }
        else { const int c = vcu - 8; S.u.pm = c >> 1; S.u.pn = c & 1; S.a = (const char*)(WmkvT + (size_t)(1024 + S.u.pm * 256) * 2048); S.b = (const char*)(MEMN + (size_t)S.u.pn * 256 * 2048); E.mode = 1; }
        pg8::gemm_phase<mk::EpiMKV, mk::SchedOne, false>(ldsl + RING_OFF, g, S, E);
    } else {
        const int gw2 = (vcu - 16) * NWAVES + wave, NGW2 = (G - 16) * NWAVES;
        constexpr int I_IN = 32 * 256, I_FF1 = 32 * 128, I_FF2 = 128 * 32, I_RET = 32 * 32, I_OUT = 32 * 32, I_NA = 16 * 32, I_MEM = 16 * 32;
        constexpr int NITEMS = I_IN + I_FF1 + I_FF2 + I_RET + I_OUT + I_NA + I_MEM;
#define P0_DECODE(d, item) do { int r = (item); \
            if (r < I_IN) { const int kb = r >> 8, nb = r & 255; d.src = I_w_in + (size_t)(64 * kb) * 16384 + 64 * nb; d.ldw = 16384; d.dst = WinT + 64 * kb; d.ldt = 2048; d.dA = win_dest_row(2 * nb); d.dB = win_dest_row(2 * nb + 1); d.nt = 0; break; } r -= I_IN; \
            if (r < I_FF1) { const int kb = r >> 7, nb = r & 127; d.src = I_w_ff1 + (size_t)(64 * kb) * 8192 + 64 * nb; d.ldw = 8192; d.dst = Wff1T + 64 * kb; d.ldt = 2048; d.dA = 64 * nb; d.dB = 64 * nb + 32; d.nt = 1; break; } r -= I_FF1; \
            if (r < I_FF2) { const int kb = r >> 5, nb = r & 31; d.src = I_w_ff2 + (size_t)(64 * kb) * 2048 + 64 * nb; d.ldw = 2048; d.dst = Wff2T + 64 * kb; d.ldt = 8192; d.dA = 64 * nb; d.dB = 64 * nb + 32; d.nt = 1; break; } r -= I_FF2; \
            if (r < I_RET) { const int kb = r >> 5, nb = r & 31; d.src = I_w_ret + (size_t)(64 * kb) * 2048 + 64 * nb; d.ldw = 2048; d.dst = WretT + 64 * kb; d.ldt = 2048; d.dA = 64 * nb; d.dB = 64 * nb + 32; d.nt = 1; break; } r -= I_RET; \
            if (r < I_OUT) { const int kb = r >> 5, nb = r & 31; d.src = I_w_out + (size_t)(64 * kb) * 2048 + 64 * nb; d.ldw = 2048; d.dst = WoutT + 64 * kb; d.ldt = 2048; d.dA = 64 * nb; d.dB = 64 * nb + 32; d.nt = 1; break; } r -= I_OUT; \
            if (r < I_NA) { const int kb = r >> 5, nb = r & 31; d.src = I_w_na + (size_t)(64 * kb) * 2048 + 64 * nb; d.ldw = 2048; d.dst = WnmT + 64 * kb; d.ldt = 2048; d.dA = 64 * nb; d.dB = 64 * nb + 32; d.nt = 1; break; } r -= I_NA; \
            { const int kb = r >> 5, nb = r & 31; d.src = I_w_memb + (size_t)(64 * kb) * 2048 + 64 * nb; d.ldw = 2048; d.dst = WnmT + 1024 + 64 * kb; d.ldt = 2048; d.dA = 64 * nb; d.dB = 64 * nb + 32; d.nt = 1; } } while (0)
        {
            f32x4 R0[16], R1[16]; P0Desc d0, d1; int it = gw2;
            if (it < NITEMS) { P0_DECODE(d0, it); p0_load(d0, R0, lane); }
            if (it + NGW2 < NITEMS) { P0_DECODE(d1, it + NGW2); p0_load(d1, R1, lane); }
            for (; it < NITEMS; it += 2 * NGW2) {
                p0_to_lds(R0, scr, lane); const P0Desc c0 = d0;
                if (it + 2 * NGW2 < NITEMS) { P0_DECODE(d0, it + 2 * NGW2); p0_load(d0, R0, lane); }
                LDS_WAIT(); asm volatile("" ::: "memory"); p0_store(c0, scr, lane); LDS_WAIT(); asm volatile("" ::: "memory");
                if (it + NGW2 < NITEMS) {
                    p0_to_lds(R1, scr, lane); const P0Desc c1 = d1;
                    if (it + 3 * NGW2 < NITEMS) { P0_DECODE(d1, it + 3 * NGW2); p0_load(d1, R1, lane); }
                    LDS_WAIT(); asm volatile("" ::: "memory"); p0_store(c1, scr, lane); LDS_WAIT(); asm volatile("" ::: "memory");
                }
            }
        }
#undef P0_DECODE
        for (int m = gw2; m < mk::M; m += NGW2) rms_row_to_bf16(I_x + (size_t)m * 2048, I_g_mix, HN + (size_t)m * 2048, lane);
    }
    GRID_BAR();
    }
    {
    {
        mk::SchedProj S; S.o.init(mk::M, mk::D_IN, G, bx); S.hn_ = (const char*)HN; S.wt_ = (const char*)WinT;
        const pg8::Gemm g{2048, 2048, 2048};
        mk::EpiProj E{ws};
        pg8::gemm_phase<mk::EpiProj, mk::SchedProj, true>(ldsl + RING_OFF, g, S, E);
    }
    GRID_BAR();
    }
    {
    {
        const int c = bx, bh = c >> 4, nc = c & 15, b = bh >> 3, h = bh & 7;
        const float l2f = tab[mk::TAB_L2F + h], l2b = tab[mk::TAB_L2B + h];
        {
            bf16* kt = KT + (size_t)c * 65536; const bf16* ksrc = K0 + ((size_t)b * 4096 + nc * 256) * 1024 + h * 128;
            LAS float* t = scr;
            const int tok0 = wave * 32;
#pragma unroll
            for (int it = 0; it < 8; ++it) { const int tr = 4 * it + (lane >> 4), c8 = (lane & 15) * 8; const v4u w = *(const v4u*)(ksrc + (size_t)(tok0 + tr) * 1024 + c8);
                LAS float* d = t + tr * 128 + (c8 ^ (8 * (tr >> 3))); d[0] = bf2f_(w.x & 0xffffu); d[1] = bf2f_(w.x >> 16); d[2] = bf2f_(w.y & 0xffffu); d[3] = bf2f_(w.y >> 16);
                d[4] = bf2f_(w.z & 0xffffu); d[5] = bf2f_(w.z >> 16); d[6] = bf2f_(w.w & 0xffffu); d[7] = bf2f_(w.w >> 16); }
            LDS_WAIT(); asm volatile("" ::: "memory");
            const int q = lane & 3;
            float df[8], db[8];
#pragma unroll
            for (int i = 0; i < 8; ++i) { const int tk = tok0 + 8 * q + i; df[i] = pg8::fexp2(l2f * (float)(255 - tk)); db[i] = pg8::fexp2(l2b * (float)tk); }
#pragma unroll
            for (int j = 0; j < 8; ++j) { const int dk = (lane >> 2) + 16 * j; const LAS float* s = t + (8 * q) * 128 + (dk ^ (8 * q));
                float v[8];
#pragma unroll
                for (int i = 0; i < 8; ++i) v[i] = s[i * 128];
                v4u o; o.x = pk2(v[0] * df[0], v[1] * df[1]); o.y = pk2(v[2] * df[2], v[3] * df[3]); o.z = pk2(v[4] * df[4], v[5] * df[5]); o.w = pk2(v[6] * df[6], v[7] * df[7]);
                *(GAS v4u*)(kt + (size_t)dk * 256 + tok0 + 8 * q) = o;
                o.x = pk2(v[0] * db[0], v[1] * db[1]); o.y = pk2(v[2] * db[2], v[3] * db[3]); o.z = pk2(v[4] * db[4], v[5] * db[5]); o.w = pk2(v[6] * db[6], v[7] * db[7]);
                *(GAS v4u*)(kt + (size_t)(128 + dk) * 256 + tok0 + 8 * q) = o; }
            VM_WAIT(); LDS_WAIT(); __syncthreads();
        }
        MK_STAMP();
        {
            bf16* arc = AR + ((size_t)bh * 4096 + nc * 256) * 512;
            mk::SchedList3 S; S.n = (bx < 128) ? 3 : 2;
            S.u0.a = (const char*)(BR + (size_t)c * 256 * 512); S.u0.b = (const char*)(KT + (size_t)c * 65536); S.u0.lda = 512; S.u0.ldb = 256; S.u0.nt = 4; S.u0.kind = 0; S.u0.perm = 1;
            S.u1.a = (const char*)(arc + 256); S.u1.b = (const char*)(K0 + ((size_t)b * 4096 + nc * 256) * 1024 + h * 128); S.u1.lda = 512; S.u1.ldb = 1024; S.u1.nt = 2; S.u1.kind = 1; S.u1.perm = 1;
            const int xb = (bx >> 6) & 1, xh = (bx >> 4) & 3, qt = bx & 15; const size_t tok0 = (size_t)xb * 4096 + qt * 256;
            S.u2.a = (const char*)(XQ + tok0 * 1024 + xh * 256); S.u2.b = (const char*)(MKb + (size_t)xb * 256 * 1024 + xh * 256); S.u2.lda = 1024; S.u2.ldb = 1024; S.u2.nt = 4; S.u2.kind = 2; S.u2.perm = 1;
            mk::EpiM1 E{mk::EpiF32{KV + (size_t)c * 65536}, mk::EpiP{arc, l2f, l2b},
                        mk::EpiXS{XP + tok0 * 1024 + xh * 256, xl + tok0 * 16 + xh * 4, ssq_xq + tok0 * 16 + xh * 4, tab + mk::TAB_SSQ_MK + (size_t)xb * 256 * 16 + xh * 4}};
            pg8::gemm_stream<mk::EpiM1, mk::SchedList3, true>(ldsl + RING_OFF, S, E);
        }
        MK_STAMP();
    }
    GRID_BAR();
    }
    {
    {
        for (int e = (vcu * 512 + tid); e < 16 * 65536; e += G * 512) {
            const int bh = e >> 16, r = e & 65535, col = r & 255, h = bh & 7;
            const bool fwd = col < 128; const float dec = pg8::fexp2((fwd ? tab[mk::TAB_L2F + h] : tab[mk::TAB_L2B + h]) * 256.0f);
            const bf16* kvp = KV + (size_t)bh * 16 * 65536 + r; bf16* brp = BR + ((size_t)bh * 16 * 256 + (r >> 8)) * 512 + 256 + col;
            float kvv[16];
#pragma unroll
            for (int n = 0; n < 16; ++n) kvv[n] = bf2f_(__builtin_nontemporal_load(kvp + (size_t)n * 65536));
            float s = 0.f;
            if (fwd) {
#pragma unroll
                for (int n = 0; n < 16; ++n) { brp[(size_t)n * 256 * 512] = (bf16)f2bf(s); s = dec * s + kvv[n]; }
            } else {
#pragma unroll
                for (int n = 15; n >= 0; --n) { brp[(size_t)n * 256 * 512] = (bf16)f2bf(s); s = dec * s + kvv[n]; }
            }
        }
        __syncthreads();
        MK_STAMP();
        { const int b = bx >> 7, h = (bx >> 4) & 7, i4 = bx & 15;
        na::na_unit(b, h, i4, NAQKV, ssq_naq, ssq_nak, I_rpb, ONM, (char*)lds); }
        MK_STAMP();
    }
    GRID_BAR();
    }
    {
    {
        const int c = bx, bh = c >> 4, nc = c & 15, b = bh >> 3, h = bh & 7;
        {
            const int xb = (bx >> 6) & 1, xh = (bx >> 4) & 3, qt = bx & 15; const size_t tok0 = (size_t)xb * 4096 + qt * 256;
            const size_t o0 = ((size_t)b * 4096 + nc * 256) * 2048 + h * 256;
            const bool hx = bx < 128;
            mk::SchedList3 S; S.n = hx ? 2 : 1;
            const char* const ra = (const char*)(AR + ((size_t)bh * 4096 + nc * 256) * 512); const char* const rb = (const char*)(BR + (size_t)c * 256 * 512);
            S.u0.a = hx ? (const char*)(XP + tok0 * 1024 + xh * 256) : ra; S.u0.b = hx ? (const char*)(MVT + (size_t)xh * 256 * 512 + xb * 256) : rb;
            S.u0.lda = hx ? 1024 : 512; S.u0.ldb = 512; S.u0.nt = hx ? 4 : 8; S.u0.kind = hx ? 0 : 1; S.u0.perm = 1;
            S.u1.a = ra; S.u1.b = rb; S.u1.lda = 512; S.u1.ldb = 512; S.u1.nt = 8; S.u1.kind = 1; S.u1.perm = 1;
            S.u2.a = ra; S.u2.b = rb; S.u2.lda = 512; S.u2.ldb = 512; S.u2.nt = 8; S.u2.kind = 1; S.u2.perm = 1;
            mk::EpiM3 E{mk::EpiXO{ONM + tok0 * 2048 + 1024 + xh * 256, xl + tok0 * 16 + xh * 4}, mk::EpiGN{ORET + o0, RG + o0, I_gn + h * 256}};
            pg8::gemm_stream<mk::EpiM3, mk::SchedList3, true>(ldsl + RING_OFF, S, E);
        }
        MK_STAMP();
    }
    GRID_BAR();
    }
    {
    {
        mk::SchedBR S; S.o.init(mk::M, 2048, G, bx); S.onm = (const char*)ONM; S.oret = (const char*)ORET; S.wnm = (const char*)WnmT; S.wret = (const char*)WretT;
        const pg8::Gemm g{2048, 2048, 1024}; mk::EpiGate4 E{MERGED, GATES};
        pg8::gemm_phase<mk::EpiGate4, mk::SchedBR, true>(ldsl + RING_OFF, g, S, E);
    }
    GRID_BAR();
    }
    {
    {
        mk::SchedGrid S; S.o.init(mk::M, 2048, G, bx); S.A = (const char*)MERGED; S.B = (const char*)WoutT; S.ta = 256u * 2048u * 2u; S.tb = 256u * 2048u * 2u;
        const pg8::Gemm g{2048, 2048, 2048}; mk::EpiWout E{I_x, I_out, X1B, ssq_x1, I_g_ffn};
        pg8::gemm_phase<mk::EpiWout, mk::SchedGrid, false>(ldsl + RING_OFF, g, S, E);
    }
    GRID_BAR();
    }
    {
    {
        mk::SchedGrid S; S.o.init(mk::M, 8192, G, bx); S.A = (const char*)X1B; S.B = (const char*)Wff1T; S.ta = 256u * 2048u * 2u; S.tb = 256u * 2048u * 2u;
        const pg8::Gemm g{2048, 2048, 2048}; mk::EpiFF1 E{HFF, ssq_x1};
        pg8::gemm_phase<mk::EpiFF1, mk::SchedGrid, true>(ldsl + RING_OFF, g, S, E);
    }
    GRID_BAR();
    }
    if (false) {
        mk::SchedGrid S; S.o.init(mk::M, 2048, G, bx); S.A = (const char*)HFF; S.B = (const char*)Wff2T; S.ta = 256u * (unsigned)mk::LDH * 2u; S.tb = 256u * 8192u * 2u;
        const pg8::Gemm g{mk::LDH, 8192, 8192}; mk::EpiFF2 E{I_out, (float*)AR};
        pg8::gemm_phase<mk::EpiFF2, mk::SchedGrid, false>(ldsl + RING_OFF, g, S, E);
        GRID_BAR();
    }
    {
        mk::SchedGrid S; S.o.init(mk::M, 2048, G, bx); S.A = (const char*)HFF; S.B = (const char*)Wff2T; S.ta = 256u * (unsigned)mk::LDH * 2u; S.tb = 256u * 8192u * 2u;
        const pg8::Gemm g{mk::LDH, 8192, 8192}; mk::EpiFF2 E{I_out, I_out};
        pg8::gemm_phase<mk::EpiFF2, mk::SchedGrid, false>(ldsl + RING_OFF, g, S, E);
    }
    MK_STAMP();
    if (MK_TS >= 0 && bx == 0 && tid == 0) {
        const unsigned dt = MISC[16 + MK_TS + 1] - MISC[16 + MK_TS]; const unsigned long long t0 = __builtin_amdgcn_s_memrealtime();
        while (__builtin_amdgcn_s_memrealtime() - t0 < 8ull * dt) __builtin_amdgcn_s_sleep(8);
    }
}

extern "C" void kernel_launch(void* const* d_in, const int* in_sizes, int n_in, void* d_out, int out_size, void* d_ws, size_t ws_size, hipStream_t stream) {
    static int grid = 0;
    if (grid == 0) {
        if (n_in != 21 || out_size != mk::M * mk::D || ws_size < mk::WS_END) { fprintf(stderr, "kernel_launch: unexpected shapes (n_in %d out %d ws %zu); nothing launched\n", n_in, out_size, ws_size); grid = -1; return; }
        int dev = 0, cus = 0;
        if (hipGetDevice(&dev) != hipSuccess || hipDeviceGetAttribute(&cus, hipDeviceAttributeMultiprocessorCount, dev) != hipSuccess) { grid = -1; return; }
        if (hipFuncSetAttribute((const void*)mk_fwd, hipFuncAttributeMaxDynamicSharedMemorySize, LDS_BYTES) != hipSuccess) { fprintf(stderr, "kernel_launch: hipFuncSetAttribute failed\n"); grid = -1; return; }
        (void)hipGetLastError();
        grid = cus;
        if (grid != 256) fprintf(stderr, "kernel_launch: %d CUs; this kernel's unit maps assume 256\n", grid);
    }
    if (grid < 0) return;
    if (hipMemsetAsync((char*)d_ws + mk::WS_CTL, 0, mk::CTL_ZERO_BYTES, stream) != hipSuccess) return;
    Args a{};
    for (int i = 0; i < 21; ++i) a.in[i] = (const float*)d_in[i];
    a.out = (float*)d_out; a.ws = (unsigned char*)d_ws;
    hipLaunchKernelGGL(mk_fwd, dim3(grid), dim3(NWAVES * 64), LDS_BYTES, stream, a);
}
```

```cpp
#include <hip/hip_runtime.h>
#include <cstdio>
#include <cstdint>

namespace pg8 {
#define PG8_LAS __attribute__((address_space(3)))
typedef unsigned short bf16_t;
typedef short bf16x8 __attribute__((ext_vector_type(8)));
typedef float f32x4 __attribute__((ext_vector_type(4)));
typedef float f32x2 __attribute__((ext_vector_type(2)));
typedef unsigned u32x4 __attribute__((ext_vector_type(4)));
typedef unsigned u32x2 __attribute__((ext_vector_type(2)));
constexpr int BM = 256, BK = 64, HALF = 128, HTB = HALF * BK * 2, STAGE_BYTES = 8 * HTB, NXCD = 8, WGM = 4;

__host__ __device__ __forceinline__ int lds_byte(int r, int c) { const int st = (r >> 4) * 2 + (c >> 5), rr = r & 15, cc = c & 31, ob = rr * 64 + cc * 2; return st * 1024 + (ob ^ (((ob >> 9) & 1) << 5)); }
__host__ __device__ __forceinline__ void stage_rc(int b, int& R, int& C) { const int st = b / 1024, sb = b % 1024, swz = sb ^ (((sb >> 9) & 1) << 5); R = (st >> 1) * 16 + swz / 64; C = (st & 1) * 32 + (swz % 64) / 2; }
__host__ __device__ __forceinline__ int perm32(int rho) { const int n = rho >> 4, i = rho & 15; return 8 * (i >> 2) + 4 * n + (i & 3); }

struct Unit { int pm, pn, sub; };
struct Gemm { int lda, ldb, K; };

struct GridOrder {
    int nM, nN, nwg, G, c;
    __device__ void init(int M, int N, int G_, int c_) { nM = M / BM; nN = N / BM; nwg = nM * nN; G = G_; c = c_; }
    __device__ bool next(int i, Unit& u) const {
        const long L = (long)i * G + c; if (L >= nwg) return false;
        int wgid = (int)L; { const int q = nwg / NXCD, r = nwg % NXCD, xcd = wgid % NXCD, off = wgid / NXCD; wgid = (xcd < r ? xcd * (q + 1) : r * (q + 1) + (xcd - r) * q) + off; }
        const int nig = WGM * nN, gid = wgid / nig, fm = gid * WGM, gsz = (nM - fm) < WGM ? (nM - fm) : WGM;
        u.pm = fm + ((wgid % nig) % gsz); u.pn = (wgid % nig) / gsz; u.sub = 0; return true;
    }
};

typedef float f32x2_cv __attribute__((ext_vector_type(2))); typedef __bf16 bf16x2_cv __attribute__((ext_vector_type(2)));
__device__ __forceinline__ unsigned cvt_pk_bf16(float lo, float hi) { const f32x2_cv v = {lo, hi}; const bf16x2_cv b = __builtin_convertvector(v, bf16x2_cv); return __builtin_bit_cast(unsigned, b); }
__device__ __forceinline__ void store8(bf16_t* p, f32x4 v0, f32x4 v1) { u32x4 w; w.x = cvt_pk_bf16(v0[0], v0[1]); w.y = cvt_pk_bf16(v0[2], v0[3]); w.z = cvt_pk_bf16(v1[0], v1[1]); w.w = cvt_pk_bf16(v1[2], v1[3]); *(u32x4*)p = w; }
__device__ __forceinline__ void store4(bf16_t* p, f32x4 v0) { u32x2 w; w.x = cvt_pk_bf16(v0[0], v0[1]); w.y = cvt_pk_bf16(v0[2], v0[3]); *(u32x2*)p = w; }
__device__ __forceinline__ float bf2f(unsigned short h) { return __uint_as_float((unsigned)h << 16); }
__device__ __forceinline__ void load8(const bf16_t* p, f32x4& v0, f32x4& v1) { const u32x4 w = *(const u32x4*)p;
    v0[0] = __uint_as_float(w.x << 16); v0[1] = __uint_as_float(w.x & 0xffff0000u); v0[2] = __uint_as_float(w.y << 16); v0[3] = __uint_as_float(w.y & 0xffff0000u);
    v1[0] = __uint_as_float(w.z << 16); v1[1] = __uint_as_float(w.z & 0xffff0000u); v1[2] = __uint_as_float(w.w << 16); v1[3] = __uint_as_float(w.w & 0xffff0000u); }
__device__ __forceinline__ void load8_nt(const bf16_t* p, f32x4& v0, f32x4& v1) { const u32x4 w = __builtin_nontemporal_load((const u32x4*)p);
    v0[0] = __uint_as_float(w.x << 16); v0[1] = __uint_as_float(w.x & 0xffff0000u); v0[2] = __uint_as_float(w.y << 16); v0[3] = __uint_as_float(w.y & 0xffff0000u);
    v1[0] = __uint_as_float(w.z << 16); v1[1] = __uint_as_float(w.z & 0xffff0000u); v1[2] = __uint_as_float(w.w << 16); v1[3] = __uint_as_float(w.w & 0xffff0000u); }
__device__ __forceinline__ void load8_l2(const bf16_t* p, f32x4& v0, f32x4& v1) { u32x4 w; const unsigned long long a = __hip_atomic_load((const unsigned long long*)p, __ATOMIC_RELAXED, __HIP_MEMORY_SCOPE_AGENT), b = __hip_atomic_load((const unsigned long long*)p + 1, __ATOMIC_RELAXED, __HIP_MEMORY_SCOPE_AGENT);
    w.x = (unsigned)a; w.y = (unsigned)(a >> 32); w.z = (unsigned)b; w.w = (unsigned)(b >> 32);
    v0[0] = __uint_as_float(w.x << 16); v0[1] = __uint_as_float(w.x & 0xffff0000u); v0[2] = __uint_as_float(w.y << 16); v0[3] = __uint_as_float(w.y & 0xffff0000u);
    v1[0] = __uint_as_float(w.z << 16); v1[1] = __uint_as_float(w.z & 0xffff0000u); v1[2] = __uint_as_float(w.w << 16); v1[3] = __uint_as_float(w.w & 0xffff0000u); }
__device__ __forceinline__ float fexp2(float x) { return __builtin_amdgcn_exp2f(x); }
__device__ __forceinline__ float frcp(float x) { return __builtin_amdgcn_rcpf(x); }
__device__ __forceinline__ float sigmoidf_(float x) { return frcp(1.f + fexp2(-1.4426950408889634f * x)); }

template <class Epi, class Sched, bool ALIGN_EPI>
__device__ __forceinline__ void gemm_phase(PG8_LAS unsigned char* lds, const Gemm g, const Sched& S, const Epi& E) {
    int tid_ = threadIdx.x; asm volatile("" : "+v"(tid_));
    const int tid = tid_, wid = __builtin_amdgcn_readfirstlane(tid >> 6), lane = tid & 63, wr = wid >> 2, wc = wid & 3, fr = lane & 15, fq = lane >> 4;
    unsigned voffA[2], voffB[2];
#pragma unroll
    for (int i = 0; i < 2; ++i) { int R, C; stage_rc(tid * 16 + i * 8192, R, C); const int Rb = Epi::PERM ? ((R & ~31) + perm32(R & 31)) : R;
        voffA[i] = (unsigned)(R * g.lda + C) * 2u; voffB[i] = (unsigned)(Rb * g.ldb + C) * 2u; }
    const size_t kstep = (size_t)(BK * 2);
    const size_t hstepA = (size_t)HALF * g.lda * 2, hstepB = (size_t)HALF * g.ldb * 2;
    const unsigned ldsw = (unsigned)wid * 1024u;
    const int aoff = lds_byte(wr * 64 + fr, fq * 8), boff = lds_byte(wc * 32 + fr, fq * 8);
#define PG8_SA(b, h) (((b) * 2 + (h)) * HTB)
#define PG8_SB(b, h) ((4 + (b) * 2 + (h)) * HTB)
#define PG8_STAGE(bufoff, gbase, voff) do { _Pragma("unroll") for (int _i = 0; _i < 2; ++_i) \
        __builtin_amdgcn_global_load_lds((const unsigned*)((const char*)(gbase) + (voff)[_i]), (PG8_LAS unsigned*)(lds + (bufoff) + ldsw + _i * 8192), 16, 0, 0); } while (0)
#define PG8_LDA(dst, b, h) do { _Pragma("unroll") for (int m = 0; m < 4; ++m) _Pragma("unroll") for (int k = 0; k < 2; ++k) dst[m][k] = *(const PG8_LAS bf16x8*)(lds + PG8_SA(b, h) + aoff + m * 2048 + k * 1024); } while (0)
#define PG8_LDB(dst, b, h) do { _Pragma("unroll") for (int n = 0; n < 2; ++n) _Pragma("unroll") for (int k = 0; k < 2; ++k) dst[n][k] = *(const PG8_LAS bf16x8*)(lds + PG8_SB(b, h) + boff + n * 2048 + k * 1024); } while (0)
#define PG8_MMA(ai, bj, At, Bt) do { __builtin_amdgcn_s_setprio(1); _Pragma("unroll") for (int m = 0; m < 4; ++m) _Pragma("unroll") for (int n = 0; n < 2; ++n) _Pragma("unroll") for (int k = 0; k < 2; ++k) \
        acc[ai][bj][m][n] = __builtin_amdgcn_mfma_f32_16x16x32_bf16(Bt[n][k], At[m][k], acc[ai][bj][m][n], 0, 0, 0); __builtin_amdgcn_s_setprio(0); } while (0)
#define PG8_WAIT_V(n) asm volatile("s_waitcnt vmcnt(" #n ")" ::: "memory")
#define PG8_WAIT_L(n) asm volatile("s_waitcnt lgkmcnt(" #n ")" ::: "memory")
#define PG8_BAR __builtin_amdgcn_s_barrier()
#define PG8_SCHED __builtin_amdgcn_sched_barrier(0)
    Unit cur, nxt; int ui = 0;
    if (!S.next(0, cur)) return;
    f32x4 acc[2][2][4][2];
#pragma unroll
    for (int a = 0; a < 2; ++a)
#pragma unroll
        for (int b = 0; b < 2; ++b)
#pragma unroll
            for (int m = 0; m < 4; ++m)
#pragma unroll
                for (int n = 0; n < 2; ++n) acc[a][b][m][n] = (f32x4){0.f, 0.f, 0.f, 0.f};
    bf16x8 At[4][2], B0[2][2], B1[2][2];
    const char* cA; const char* cB; S.ptrs(cur, cA, cB);
    PG8_STAGE(PG8_SB(0, 0), cB, voffB); PG8_STAGE(PG8_SB(0, 1), cB + hstepB, voffB); PG8_STAGE(PG8_SA(0, 0), cA, voffA); PG8_STAGE(PG8_SA(0, 1), cA + hstepA, voffA);
    if (wr == 1) PG8_BAR;
    PG8_WAIT_V(2); PG8_BAR;
    PG8_STAGE(PG8_SB(1, 0), cB + kstep, voffB); PG8_STAGE(PG8_SA(1, 0), cA + kstep, voffA); PG8_STAGE(PG8_SB(1, 1), cB + hstepB + kstep, voffB);
    PG8_WAIT_V(6); PG8_BAR;
    for (;;) {
        const bool has_next = S.next(ui + 1, nxt); const int nt = S.nt(cur, g.K) ;
        const char* nA = cA; const char* nB = cB; if (has_next) S.ptrs(nxt, nA, nB);
        for (int t = 0; t < nt; t += 2) {
            const bool last = (t == nt - 2);
            const char* a1 = cA + (size_t)(t + 1) * kstep;
            const char* a2 = last ? nA : cA + (size_t)(t + 2) * kstep; const char* b2 = last ? nB : cB + (size_t)(t + 2) * kstep;
            const char* a3 = a2 + kstep; const char* b3 = b2 + kstep;
            PG8_LDB(B0, 0, 0); PG8_LDB(B1, 0, 1); PG8_SCHED; PG8_LDA(At, 0, 0); PG8_STAGE(PG8_SA(1, 1), a1 + hstepA, voffA);
            PG8_WAIT_V(8); PG8_WAIT_L(0); PG8_BAR; PG8_MMA(0, 0, At, B0); PG8_MMA(0, 1, At, B1); PG8_BAR; PG8_SCHED;
            PG8_LDA(At, 0, 1); PG8_STAGE(PG8_SB(0, 0), b2, voffB); PG8_STAGE(PG8_SB(0, 1), b2 + hstepB, voffB); PG8_STAGE(PG8_SA(0, 0), a2, voffA);
            PG8_WAIT_V(8); PG8_WAIT_L(0); PG8_BAR; PG8_MMA(1, 0, At, B0); PG8_MMA(1, 1, At, B1); PG8_BAR; PG8_SCHED;
            PG8_LDB(B0, 1, 0); PG8_LDB(B1, 1, 1); PG8_SCHED; PG8_LDA(At, 1, 0); PG8_STAGE(PG8_SA(0, 1), a2 + hstepA, voffA);
            PG8_WAIT_V(8); PG8_WAIT_L(0); PG8_BAR; PG8_MMA(0, 0, At, B0); PG8_MMA(0, 1, At, B1); PG8_BAR; PG8_SCHED;
            PG8_LDA(At, 1, 1); PG8_STAGE(PG8_SB(1, 0), b3, voffB); PG8_STAGE(PG8_SB(1, 1), b3 + hstepB, voffB); PG8_STAGE(PG8_SA(1, 0), a3, voffA);
            PG8_WAIT_V(8); PG8_WAIT_L(0); PG8_BAR; PG8_MMA(1, 0, At, B0); PG8_MMA(1, 1, At, B1); PG8_BAR; PG8_SCHED;
        }
        if constexpr (ALIGN_EPI) { if (wr == 0) PG8_BAR; }
        if constexpr (!Epi::AFTER_DRAIN) { int fr2 = fr, fq2 = fq; asm volatile("" : "+v"(fr2), "+v"(fq2)); E(acc, cur, wr, wc, fr2, fq2); }
        if (!has_next) break;
#pragma unroll
        for (int a = 0; a < 2; ++a)
#pragma unroll
            for (int b = 0; b < 2; ++b)
#pragma unroll
                for (int m = 0; m < 4; ++m)
#pragma unroll
                    for (int n = 0; n < 2; ++n) acc[a][b][m][n] = (f32x4){0.f, 0.f, 0.f, 0.f};
        cur = nxt; cA = nA; cB = nB; ++ui;
        if constexpr (ALIGN_EPI) { if (wr == 1) PG8_BAR; }
    }
    PG8_WAIT_V(0);
    if constexpr (!ALIGN_EPI) { if (wr == 0) PG8_BAR; }
    PG8_BAR;
    if constexpr (Epi::AFTER_DRAIN) { int fr2 = fr, fq2 = fq; asm volatile("" : "+v"(fr2), "+v"(fq2)); E.fused(acc, cur, wr, wc, fr2, fq2, lds, wid, lane); }
#undef PG8_SA
#undef PG8_SB
#undef PG8_STAGE
#undef PG8_LDA
#undef PG8_LDB
#undef PG8_MMA
#undef PG8_WAIT_V
#undef PG8_WAIT_L
#undef PG8_BAR
#undef PG8_SCHED
}
struct UnitG { const char* a; const char* b; int lda, ldb, nt, kind, perm; };
template <class Epi, class Sched, bool ALIGN_EPI>
__device__ __forceinline__ void gemm_stream(PG8_LAS unsigned char* lds, const Sched& S, const Epi& E) {
    int tid_ = threadIdx.x; asm volatile("" : "+v"(tid_));
    const int tid = tid_, wid = __builtin_amdgcn_readfirstlane(tid >> 6), lane = tid & 63, wr = wid >> 2, wc = wid & 3, fr = lane & 15, fq = lane >> 4;
#define PG8_VOFF(u, vA, vB) do { _Pragma("unroll") for (int i_ = 0; i_ < 2; ++i_) { int R_, C_; stage_rc(tid * 16 + i_ * 8192, R_, C_); const int Rb_ = (u).perm ? ((R_ & ~31) + perm32(R_ & 31)) : R_; \
        vA[i_] = (unsigned)(R_ * (u).lda + C_) * 2u; vB[i_] = (unsigned)(Rb_ * (u).ldb + C_) * 2u; } } while (0)
    const size_t kstep = (size_t)(BK * 2);
    const unsigned ldsw = (unsigned)wid * 1024u;
    const int aoff = lds_byte(wr * 64 + fr, fq * 8), boff = lds_byte(wc * 32 + fr, fq * 8);
#undef PG8_SA
#undef PG8_SB
#undef PG8_STAGE
#undef PG8_LDA
#undef PG8_LDB
#undef PG8_MMA
#undef PG8_WAIT_V
#undef PG8_WAIT_L
#undef PG8_BAR
#undef PG8_SCHED
#define PG8_SA(b, h) (((b) * 2 + (h)) * HTB)
#define PG8_SB(b, h) ((4 + (b) * 2 + (h)) * HTB)
#define PG8_STAGE(bufoff, gbase, voff) do { _Pragma("unroll") for (int _i = 0; _i < 2; ++_i) \
        __builtin_amdgcn_global_load_lds((const unsigned*)((const char*)(gbase) + (voff)[_i]), (PG8_LAS unsigned*)(lds + (bufoff) + ldsw + _i * 8192), 16, 0, 0); } while (0)
#define PG8_LDA(dst, b, h) do { _Pragma("unroll") for (int m = 0; m < 4; ++m) _Pragma("unroll") for (int k = 0; k < 2; ++k) dst[m][k] = *(const PG8_LAS bf16x8*)(lds + PG8_SA(b, h) + aoff + m * 2048 + k * 1024); } while (0)
#define PG8_LDB(dst, b, h) do { _Pragma("unroll") for (int n = 0; n < 2; ++n) _Pragma("unroll") for (int k = 0; k < 2; ++k) dst[n][k] = *(const PG8_LAS bf16x8*)(lds + PG8_SB(b, h) + boff + n * 2048 + k * 1024); } while (0)
#define PG8_MMA(ai, bj, At, Bt) do { __builtin_amdgcn_s_setprio(1); _Pragma("unroll") for (int m = 0; m < 4; ++m) _Pragma("unroll") for (int n = 0; n < 2; ++n) _Pragma("unroll") for (int k = 0; k < 2; ++k) \
        acc[ai][bj][m][n] = __builtin_amdgcn_mfma_f32_16x16x32_bf16(Bt[n][k], At[m][k], acc[ai][bj][m][n], 0, 0, 0); __builtin_amdgcn_s_setprio(0); } while (0)
#define PG8_WAIT_V(n) asm volatile("s_waitcnt vmcnt(" #n ")" ::: "memory")
#define PG8_WAIT_L(n) asm volatile("s_waitcnt lgkmcnt(" #n ")" ::: "memory")
#define PG8_BAR __builtin_amdgcn_s_barrier()
#define PG8_SCHED __builtin_amdgcn_sched_barrier(0)
    UnitG cur, nxt; int ui = 0;
    if (!S.next(0, cur)) return;
    unsigned voffA[2], voffB[2]; PG8_VOFF(cur, voffA, voffB);
    size_t hstepA = (size_t)HALF * cur.lda * 2, hstepB = (size_t)HALF * cur.ldb * 2;
    f32x4 acc[2][2][4][2];
#pragma unroll
    for (int a = 0; a < 2; ++a)
#pragma unroll
        for (int b = 0; b < 2; ++b)
#pragma unroll
            for (int m = 0; m < 4; ++m)
#pragma unroll
                for (int n = 0; n < 2; ++n) acc[a][b][m][n] = (f32x4){0.f, 0.f, 0.f, 0.f};
    bf16x8 At[4][2], B0[2][2], B1[2][2];
    const char* cA = cur.a; const char* cB = cur.b;
    PG8_STAGE(PG8_SB(0, 0), cB, voffB); PG8_STAGE(PG8_SB(0, 1), cB + hstepB, voffB); PG8_STAGE(PG8_SA(0, 0), cA, voffA); PG8_STAGE(PG8_SA(0, 1), cA + hstepA, voffA);
    if (wr == 1) PG8_BAR;
    PG8_WAIT_V(2); PG8_BAR;
    PG8_STAGE(PG8_SB(1, 0), cB + kstep, voffB); PG8_STAGE(PG8_SA(1, 0), cA + kstep, voffA); PG8_STAGE(PG8_SB(1, 1), cB + hstepB + kstep, voffB);
    PG8_WAIT_V(6); PG8_BAR;
    for (;;) {
        const bool has_next = S.next(ui + 1, nxt); const int nt = cur.nt; if (!has_next) nxt = cur;
        const char* nA = nxt.a; const char* nB = nxt.b;
        const size_t nhA = (size_t)HALF * nxt.lda * 2, nhB = (size_t)HALF * nxt.ldb * 2;
        for (int t = 0; t < nt; t += 2) {
            const bool last = (t == nt - 2);
            const char* a1 = cA + (size_t)(t + 1) * kstep;
            const char* a2 = last ? nA : cA + (size_t)(t + 2) * kstep; const char* b2 = last ? nB : cB + (size_t)(t + 2) * kstep;
            const char* a3 = a2 + kstep; const char* b3 = b2 + kstep;
            unsigned xvA[2], xvB[2]; if (last) { PG8_VOFF(nxt, xvA, xvB); } else { xvA[0] = voffA[0]; xvA[1] = voffA[1]; xvB[0] = voffB[0]; xvB[1] = voffB[1]; }
            const size_t xhA = last ? nhA : hstepA, xhB = last ? nhB : hstepB;
            PG8_LDB(B0, 0, 0); PG8_LDB(B1, 0, 1); PG8_SCHED; PG8_LDA(At, 0, 0); PG8_STAGE(PG8_SA(1, 1), a1 + hstepA, voffA);
            PG8_WAIT_V(8); PG8_WAIT_L(0); PG8_BAR; PG8_MMA(0, 0, At, B0); PG8_MMA(0, 1, At, B1); PG8_BAR; PG8_SCHED;
            PG8_LDA(At, 0, 1); PG8_STAGE(PG8_SB(0, 0), b2, xvB); PG8_STAGE(PG8_SB(0, 1), b2 + xhB, xvB); PG8_STAGE(PG8_SA(0, 0), a2, xvA);
            PG8_WAIT_V(8); PG8_WAIT_L(0); PG8_BAR; PG8_MMA(1, 0, At, B0); PG8_MMA(1, 1, At, B1); PG8_BAR; PG8_SCHED;
            PG8_LDB(B0, 1, 0); PG8_LDB(B1, 1, 1); PG8_SCHED; PG8_LDA(At, 1, 0); PG8_STAGE(PG8_SA(0, 1), a2 + xhA, xvA);
            PG8_WAIT_V(8); PG8_WAIT_L(0); PG8_BAR; PG8_MMA(0, 0, At, B0); PG8_MMA(0, 1, At, B1); PG8_BAR; PG8_SCHED;
            PG8_LDA(At, 1, 1); PG8_STAGE(PG8_SB(1, 0), b3, xvB); PG8_STAGE(PG8_SB(1, 1), b3 + xhB, xvB); PG8_STAGE(PG8_SA(1, 0), a3, xvA);
            PG8_WAIT_V(8); PG8_WAIT_L(0); PG8_BAR; PG8_MMA(1, 0, At, B0); PG8_MMA(1, 1, At, B1); PG8_BAR; PG8_SCHED;
        }
        if constexpr (ALIGN_EPI) { if (wr == 0) PG8_BAR; }
        if (!E.after_drain(cur)) { int fr2 = fr, fq2 = fq; asm volatile("" : "+v"(fr2), "+v"(fq2)); E(acc, cur, wr, wc, fr2, fq2); }
        if (!has_next) break;
#pragma unroll
        for (int a = 0; a < 2; ++a)
#pragma unroll
            for (int b = 0; b < 2; ++b)
#pragma unroll
                for (int m = 0; m < 4; ++m)
#pragma unroll
                    for (int n = 0; n < 2; ++n) acc[a][b][m][n] = (f32x4){0.f, 0.f, 0.f, 0.f};
        cur = nxt; cA = nA; cB = nB; ++ui; PG8_VOFF(cur, voffA, voffB); hstepA = nhA; hstepB = nhB;
        if constexpr (ALIGN_EPI) { if (wr == 1) PG8_BAR; }
    }
    PG8_WAIT_V(0);
    if constexpr (!ALIGN_EPI) { if (wr == 0) PG8_BAR; }
    PG8_BAR;
    if (E.after_drain(cur)) { int fr2 = fr, fq2 = fq; asm volatile("" : "+v"(fr2), "+v"(fq2)); E.fused(acc, cur, wr, wc, fr2, fq2, lds, wid, lane); }
#undef PG8_SA
#undef PG8_SB
#undef PG8_STAGE
#undef PG8_LDA
#undef PG8_LDB
#undef PG8_MMA
#undef PG8_WAIT_V
#undef PG8_WAIT_L
#undef PG8_BAR
#undef PG8_SCHED
#undef PG8_VOFF
}
}

namespace mk {
using pg8::bf16_t; using pg8::f32x4; using pg8::f32x2; using pg8::u32x4; using pg8::u32x2; using pg8::Unit;
constexpr int D = 2048, BATCH = 2, SEQ = 4096, M = BATCH * SEQ, D_IN = 16384, D_FF = 8192, N_MEM = 256;
constexpr float EPS = 1e-6f, LOG2E = 1.4426950408889634f;
constexpr size_t MiB = 1u << 20;
constexpr size_t WS_CTL = 0, CTL_ZERO_BYTES = 1 * MiB;
constexpr size_t WS_COS = 1 * MiB, WS_SIN = 2 * MiB;
constexpr size_t WS_SSQ_NAQ = 3 * MiB, WS_SSQ_NAK = 4 * MiB;
constexpr size_t WS_SSQ_XQ = 5 * MiB, WS_XL = 5 * MiB + 512 * 1024;
constexpr size_t WS_SSQ_X1 = 6 * MiB;
constexpr size_t WS_TAB = 6 * MiB + 512 * 1024;
constexpr int TAB_CS_NAQ = 0, TAB_CS_MK = 128, TAB_L2F = 384, TAB_L2B = 392, TAB_SSQ_MK = 1024;
constexpr size_t WS_MEMN = 8 * MiB, WS_MK = 10 * MiB, WS_MVT = 11 * MiB;
constexpr size_t WS_WIN = 16 * MiB, WS_WFF1 = 80 * MiB, WS_WFF2 = 112 * MiB, WS_WRET = 144 * MiB, WS_WOUT = 152 * MiB, WS_WNM = 160 * MiB  , WS_WMKV = 168 * MiB;
constexpr size_t WS_NAQKV = 176 * MiB, WS_K0 = 224 * MiB, WS_RG = 240 * MiB, WS_XQ = 272 * MiB, WS_GATES = 288 * MiB;
constexpr size_t WS_AR = 384 * MiB, WS_BR = 448 * MiB, WS_END = 512 * MiB;
constexpr size_t WS_KV = WS_WIN;
constexpr size_t WS_ORET = 16 * MiB;
constexpr size_t WS_MERGED = WS_NAQKV;
constexpr size_t WS_X1B = WS_AR;
constexpr size_t WS_HFF = 176 * MiB;
constexpr int LDH = 8192;
constexpr size_t DO_HN = 0, DO_KT = 0, DO_XP = 32 * MiB, DO_ONM = 0;

struct SchedGrid {
    pg8::GridOrder o; const char* A; const char* B; size_t ta, tb;
    __device__ __forceinline__ bool next(int i, Unit& u) const { return o.next(i, u); }
    __device__ __forceinline__ void ptrs(const Unit& u, const char*& a, const char*& b) const { a = A + (size_t)u.pm * ta; b = B + (size_t)u.pn * tb; }
    __device__ __forceinline__ int nt(const Unit&, int K) const { return K / 64; }
};
struct SchedProj {
    pg8::GridOrder o; const char* hn_; const char* wt_;
    __device__ __forceinline__ bool next(int i, Unit& u) const { return o.next(i, u); }
    __device__ __forceinline__ void ptrs(const Unit& u, const char*& a, const char*& b) const {
        const char* h = hn_ + (size_t)u.pm * (256u * 2048u * 2u); const char* w = wt_ + (size_t)u.pn * (256u * 2048u * 2u);
        const bool sw = (u.pn >= 20 && u.pn < 28); a = sw ? w : h; b = sw ? h : w; }
    __device__ __forceinline__ int nt(const Unit&, int K) const { return K / 64; }
};
struct SchedOne { bool has; Unit u; const char* a; const char* b;
    __device__ __forceinline__ bool next(int i, Unit& uu) const { if (i != 0 || !has) return false; uu = u; return true; }
    __device__ __forceinline__ void ptrs(const Unit&, const char*& aa, const char*& bb) const { aa = a; bb = b; }
    __device__ __forceinline__ int nt(const Unit&, int K) const { return K / 64; }
};

#define MK_ROWS_BEGIN _Pragma("unroll") for (int ai = 0; ai < 2; ++ai) { _Pragma("unroll") for (int m = 0; m < 4; ++m) { const int rl = ai * 128 + wr * 64 + m * 16 + fr;
#define MK_ROWS_END __builtin_amdgcn_sched_barrier(0); } }
#define MK_ROWS_END_NB } }
#define MK_ROWS_END2 if (m & 1) __builtin_amdgcn_sched_barrier(0); } }
#define MK_RL(ai, m) ((ai) * 128 + wr * 64 + (m) * 16 + fr)
__device__ __forceinline__ float sq8(const f32x4& a, const f32x4& b) { return (a[0] * a[0] + a[1] * a[1]) + (a[2] * a[2] + a[3] * a[3]) + (b[0] * b[0] + b[1] * b[1]) + (b[2] * b[2] + b[3] * b[3]); }
__device__ __forceinline__ float red_fq(float s) {
    { auto r = __builtin_amdgcn_permlane16_swap(__float_as_uint(s), __float_as_uint(s), false, false); s = __uint_as_float(r[0]) + __uint_as_float(r[1]); }
    { auto r = __builtin_amdgcn_permlane32_swap(__float_as_uint(s), __float_as_uint(s), false, false); s = __uint_as_float(r[0]) + __uint_as_float(r[1]); }
    return s; }

struct EpiProj {
    static constexpr bool PERM = true, AFTER_DRAIN = false;
    unsigned char* ws;
    __device__ __forceinline__ void operator()(const f32x4 (&acc)[2][2][4][2], const Unit& u, int wr, int wc, int fr, int fq) const {
        bf16_t* const naqkv = (bf16_t*)(ws + WS_NAQKV); bf16_t* const k0 = (bf16_t*)(ws + WS_K0); bf16_t* const rg = (bf16_t*)(ws + WS_RG); bf16_t* const xq = (bf16_t*)(ws + WS_XQ);
        bf16_t* const gates = (bf16_t*)(ws + WS_GATES); bf16_t* const ar = (bf16_t*)(ws + WS_AR); bf16_t* const br = (bf16_t*)(ws + WS_BR);
        float* const ssq_naq = (float*)(ws + WS_SSQ_NAQ); float* const ssq_nak = (float*)(ws + WS_SSQ_NAK); float* const ssq_xq = (float*)(ws + WS_SSQ_XQ);
        const float* const cosT = (const float*)(ws + WS_COS); const float* const sinT = (const float*)(ws + WS_SIN); const float* const tab = (const float*)(ws + WS_TAB);
        const int pn = u.pn, row0 = u.pm * 256, cw = wc * 32 + 8 * fq;
        if (pn < 8) {
            const bool isq = pn < 4; float* ssq = isq ? ssq_naq : ssq_nak; const int hb = isq ? 2 * pn : 2 * (pn - 4);
            f32x4 c0 = (f32x4){1.f, 1.f, 1.f, 1.f}, c1 = c0; if (isq) { c0 = *(const f32x4*)(tab + TAB_CS_NAQ + cw); c1 = *(const f32x4*)(tab + TAB_CS_NAQ + cw + 4); }
            MK_ROWS_BEGIN  const int row = row0 + rl;
#pragma unroll
                for (int bj = 0; bj < 2; ++bj) { const f32x4 v0 = acc[ai][bj][m][0], v1 = acc[ai][bj][m][1]; const float q = red_fq(sq8(v0, v1));
                    if (fq == 0) ssq[(size_t)row * 32 + (hb + bj) * 4 + wc] = q;
                    pg8::store8(naqkv + (size_t)row * 3072 + pn * 256 + bj * 128 + cw, v0 * c0, v1 * c1); }  MK_ROWS_END
        } else if (pn < 12) {
            MK_ROWS_BEGIN  const int row = row0 + rl;
#pragma unroll
                for (int bj = 0; bj < 2; ++bj) pg8::store8(naqkv + (size_t)row * 3072 + pn * 256 + bj * 128 + cw, acc[ai][bj][m][0], acc[ai][bj][m][1]);  MK_ROWS_END
        } else if (pn < 20) {
            const bool isq = pn < 16; const int head = 2 * (pn & 3) + (wc >> 1), i0 = 32 * (wc & 1) + 8 * fq;
            const float l2f = tab[TAB_L2F + head], l2b = tab[TAB_L2B + head];
            MK_ROWS_BEGIN  const int row = row0 + rl, s = row & 4095, b = row >> 12;
                const f32x4 cs0 = *(const f32x4*)(cosT + s * 64 + i0), cs1 = *(const f32x4*)(cosT + s * 64 + i0 + 4), sn0 = *(const f32x4*)(sinT + s * 64 + i0), sn1 = *(const f32x4*)(sinT + s * 64 + i0 + 4);
                const f32x4 a0 = acc[ai][0][m][0], a1 = acc[ai][0][m][1], b0 = acc[ai][1][m][0], b1 = acc[ai][1][m][1];
                const f32x4 lo0 = a0 * cs0 - b0 * sn0, lo1 = a1 * cs1 - b1 * sn1, hi0 = a0 * sn0 + b0 * cs0, hi1 = a1 * sn1 + b1 * cs1;
                if (isq) { const int c = row & 255; const float df = pg8::fexp2(l2f * (float)(c + 1)), db = pg8::fexp2(l2b * (float)(256 - c));
                    bf16_t* d = ar + ((size_t)(b * 8 + head) * 4096 + s) * 512 + 256 + i0;
                    pg8::store8(d, lo0 * df, lo1 * df); pg8::store8(d + 64, hi0 * df, hi1 * df); pg8::store8(d + 128, lo0 * db, lo1 * db); pg8::store8(d + 192, hi0 * db, hi1 * db);
                } else { const float sc = 0.08838834764831845f; bf16_t* d = k0 + (size_t)row * 1024 + head * 128 + i0;
                    pg8::store8(d, lo0 * sc, lo1 * sc); pg8::store8(d + 64, hi0 * sc, hi1 * sc); }  MK_ROWS_END2
        } else if (pn < 28) {
            const int hv = pn - 20, b = u.pm >> 4, nc = u.pm & 15;
            bf16_t* base = br + ((size_t)((b * 8 + hv) * 16 + nc) * 256) * 512;
            MK_ROWS_BEGIN
#pragma unroll
                for (int bj = 0; bj < 2; ++bj) pg8::store8(base + (size_t)rl * 512 + bj * 128 + cw, acc[ai][bj][m][0], acc[ai][bj][m][1]);  MK_ROWS_END
        } else if (pn < 36) {
            MK_ROWS_BEGIN  const int row = row0 + rl;
#pragma unroll
                for (int bj = 0; bj < 2; ++bj) { f32x4 v0 = acc[ai][bj][m][0], v1 = acc[ai][bj][m][1];
#pragma unroll
                    for (int e = 0; e < 4; ++e) { v0[e] = v0[e] * pg8::sigmoidf_(v0[e]); v1[e] = v1[e] * pg8::sigmoidf_(v1[e]); }
                    pg8::store8(rg + (size_t)row * 2048 + (pn - 28) * 256 + bj * 128 + cw, v0, v1); }  MK_ROWS_END
        } else if (pn < 40) {
            MK_ROWS_BEGIN  const int row = row0 + rl;
                const float q = red_fq(sq8(acc[ai][0][m][0], acc[ai][0][m][1]) + sq8(acc[ai][1][m][0], acc[ai][1][m][1]));
                if (fq == 0) ssq_xq[(size_t)row * 16 + (pn - 36) * 4 + wc] = q;
#pragma unroll
                for (int bj = 0; bj < 2; ++bj) pg8::store8(xq + (size_t)row * 1024 + (pn - 36) * 256 + bj * 128 + cw, acc[ai][bj][m][0], acc[ai][bj][m][1]);  MK_ROWS_END
        } else {
            MK_ROWS_BEGIN  const int row = row0 + rl;
#pragma unroll
                for (int bj = 0; bj < 2; ++bj) { f32x4 v0 = acc[ai][bj][m][0], v1 = acc[ai][bj][m][1];
#pragma unroll
                    for (int e = 0; e < 4; ++e) { v0[e] = pg8::sigmoidf_(v0[e]); v1[e] = pg8::sigmoidf_(v1[e]); }
                    pg8::store8(gates + (size_t)row * 6144 + (pn - 40) * 256 + bj * 128 + cw, v0, v1); }  MK_ROWS_END
        }
    }
};
struct EpiMKV {
    static constexpr bool PERM = true, AFTER_DRAIN = false;
    bf16_t *mk, *mvt; float* tabw; const float* tab; int mode;
    __device__ __forceinline__ void operator()(const f32x4 (&acc)[2][2][4][2], const Unit& u, int wr, int wc, int fr, int fq) const {
        const int cw = wc * 32 + 8 * fq, row0 = u.pm * 256;
        if (mode == 0) {
            MK_ROWS_BEGIN  const int row = row0 + rl;
                const float q = red_fq(sq8(acc[ai][0][m][0], acc[ai][0][m][1]) + sq8(acc[ai][1][m][0], acc[ai][1][m][1]));
                if (fq == 0) tabw[TAB_SSQ_MK + row * 16 + u.pn * 4 + wc] = q;
#pragma unroll
                for (int bj = 0; bj < 2; ++bj) { const f32x4 c0 = *(const f32x4*)(tab + TAB_CS_MK + bj * 128 + cw), c1 = *(const f32x4*)(tab + TAB_CS_MK + bj * 128 + cw + 4);
                    pg8::store8(mk + (size_t)row * 1024 + u.pn * 256 + bj * 128 + cw, acc[ai][bj][m][0] * c0, acc[ai][bj][m][1] * c1); }  MK_ROWS_END
        } else {
            MK_ROWS_BEGIN  const int row = row0 + rl;
#pragma unroll
                for (int bj = 0; bj < 2; ++bj) pg8::store8(mvt + (size_t)row * 512 + u.pn * 256 + bj * 128 + cw, acc[ai][bj][m][0], acc[ai][bj][m][1]);  MK_ROWS_END
        }
    }
};
struct EpiF32 {
    static constexpr bool PERM = true, AFTER_DRAIN = false;
    bf16_t* C;
    __device__ __forceinline__ void operator()(const f32x4 (&acc)[2][2][4][2], const Unit&, int wr, int wc, int fr, int fq) const {
        const int cw = wc * 32 + 8 * fq;
        MK_ROWS_BEGIN
#pragma unroll
            for (int bj = 0; bj < 2; ++bj) pg8::store8(C + (size_t)rl * 256 + bj * 128 + cw, acc[ai][bj][m][0], acc[ai][bj][m][1]);  MK_ROWS_END
    }
};
struct EpiP {
    static constexpr bool PERM = true, AFTER_DRAIN = false;
    bf16_t* P; float l2f, l2b;
    __device__ __forceinline__ void operator()(const f32x4 (&acc)[2][2][4][2], const Unit&, int wr, int wc, int fr, int fq) const {
        const int cw = wc * 32 + 8 * fq;
        MK_ROWS_BEGIN  const int c = rl; const float rowf = -l2f * (float)(c + 1);
#pragma unroll
            for (int bj = 0; bj < 2; ++bj) { f32x4 v[2] = {acc[ai][bj][m][0], acc[ai][bj][m][1]};
#pragma unroll
                for (int n = 0; n < 2; ++n)
#pragma unroll
                    for (int e = 0; e < 4; ++e) { const int cp = bj * 128 + cw + 4 * n + e;
                        const float ex = (c >= cp) ? (-l2f * (float)(cp + 1)) : (l2b * (float)(cp - c) + rowf);
                        v[n][e] *= pg8::fexp2(ex); }
                pg8::store8(P + (size_t)c * 512 + bj * 128 + cw, v[0], v[1]); }  MK_ROWS_END
    }
};
struct EpiGN {
    static constexpr bool PERM = true, AFTER_DRAIN = true;
    bf16_t* oret; const bf16_t* rgv; const float* gn;
    __device__ __forceinline__ void fused(f32x4 (&acc)[2][2][4][2], const Unit&, int wr, int wc, int fr, int fq, PG8_LAS unsigned char* lds, int wid, int lane) const {
        PG8_LAS f32x2* P = (PG8_LAS f32x2*)lds;
        const int cw = wc * 32 + 8 * fq;
        MK_ROWS_BEGIN  float s = 0.f;
#pragma unroll
            for (int bj = 0; bj < 2; ++bj)
#pragma unroll
                for (int n = 0; n < 2; ++n) { const f32x4 x = acc[ai][bj][m][n]; s += (x[0] + x[1]) + (x[2] + x[3]); }
            s = red_fq(s); const float mw = s * (1.0f / 64.0f); float q = 0.f;
#pragma unroll
            for (int bj = 0; bj < 2; ++bj)
#pragma unroll
                for (int n = 0; n < 2; ++n) { const f32x4 d = acc[ai][bj][m][n] - mw; q += (d[0] * d[0] + d[1] * d[1]) + (d[2] * d[2] + d[3] * d[3]); }
            q = red_fq(q);
            if (fq == 0) P[rl * 4 + wc] = (f32x2){mw, q};  MK_ROWS_END
        asm volatile("s_waitcnt lgkmcnt(0)" ::: "memory"); __builtin_amdgcn_s_barrier(); asm volatile("" ::: "memory");
        f32x4 g0[2], g1[2];
#pragma unroll
        for (int bj = 0; bj < 2; ++bj) { g0[bj] = *(const f32x4*)(gn + bj * 128 + cw); g1[bj] = *(const f32x4*)(gn + bj * 128 + cw + 4); }
        MK_ROWS_BEGIN  const f32x2 a = P[rl * 4 + 0], b = P[rl * 4 + 1], c = P[rl * 4 + 2], d = P[rl * 4 + 3];
            const float mt = (a.x + b.x + c.x + d.x) * 0.25f;
            const float da = a.x - mt, db = b.x - mt, dc = c.x - mt, dd = d.x - mt;
            const float m2 = (a.y + b.y) + (c.y + d.y) + 64.0f * ((da * da + db * db) + (dc * dc + dd * dd));
            const float rstd = 1.0f / sqrtf(m2 * (1.0f / 256.0f) + EPS);
#pragma unroll
            for (int bj = 0; bj < 2; ++bj) { f32x4 r0, r1; pg8::load8(rgv + (size_t)rl * 2048 + bj * 128 + cw, r0, r1);
                const f32x4 o0 = (acc[ai][bj][m][0] - mt) * rstd * g0[bj] * r0, o1 = (acc[ai][bj][m][1] - mt) * rstd * g1[bj] * r1;
                pg8::store8(oret + (size_t)rl * 2048 + bj * 128 + cw, o0, o1); }  MK_ROWS_END_NB
        asm volatile("s_waitcnt lgkmcnt(0)" ::: "memory"); __builtin_amdgcn_s_barrier(); asm volatile("" ::: "memory");
    }
};
struct EpiXS {
    static constexpr bool PERM = true, AFTER_DRAIN = false;
    bf16_t* xp; float* xl; const float* ssq_q; const float* ssq_k;
    __device__ __forceinline__ void operator()(const f32x4 (&acc)[2][2][4][2], const Unit&, int wr, int wc, int fr, int fq) const {
        const int cw = wc * 32 + 8 * fq;
        float rk[2][8];
#pragma unroll
        for (int bj = 0; bj < 2; ++bj)
#pragma unroll
            for (int j = 0; j < 8; ++j) { const f32x4 p = *(const f32x4*)(ssq_k + (size_t)(bj * 128 + cw + j) * 16); rk[bj][j] = rsqrtf(((p[0] + p[1]) + (p[2] + p[3])) * (1.0f / 256.0f) + EPS) * LOG2E; }
#pragma unroll
        for (int ai = 0; ai < 2; ++ai) {
            float rqa[4];
#pragma unroll
            for (int m = 0; m < 4; ++m) { const f32x4 pq = *(const f32x4*)(ssq_q + (size_t)MK_RL(ai, m) * 16); rqa[m] = rsqrtf(((pq[0] + pq[1]) + (pq[2] + pq[3])) * (1.0f / 256.0f) + EPS); }
#pragma unroll
            for (int m = 0; m < 4; ++m) { const int rl = MK_RL(ai, m); const float rq = rqa[m];
                float s = 0.f;
#pragma unroll
                for (int bj = 0; bj < 2; ++bj) { f32x4 v[2] = {acc[ai][bj][m][0], acc[ai][bj][m][1]};
#pragma unroll
                    for (int n = 0; n < 2; ++n)
#pragma unroll
                        for (int e = 0; e < 4; ++e) { v[n][e] = pg8::fexp2(v[n][e] * rq * rk[bj][4 * n + e]); s += v[n][e]; }
                    pg8::store8(xp + (size_t)rl * 1024 + bj * 128 + cw, v[0], v[1]); }
                s = red_fq(s); if (fq == 0) xl[(size_t)rl * 16 + wc] = s;
                __builtin_amdgcn_sched_barrier(0); }
        }
    }
};
struct EpiXO {
    static constexpr bool PERM = true, AFTER_DRAIN = false;
    bf16_t* omem; const float* xl;
    __device__ __forceinline__ void operator()(const f32x4 (&acc)[2][2][4][2], const Unit&, int wr, int wc, int fr, int fq) const {
        const int cw = wc * 32 + 8 * fq;
        float ila[2][4];
#pragma unroll
        for (int ai = 0; ai < 2; ++ai)
#pragma unroll
            for (int m = 0; m < 4; ++m) { const f32x4 p = *(const f32x4*)(xl + (size_t)MK_RL(ai, m) * 16); ila[ai][m] = pg8::frcp((p[0] + p[1]) + (p[2] + p[3])); }
        MK_ROWS_BEGIN  const float il = ila[ai][m];
#pragma unroll
            for (int bj = 0; bj < 2; ++bj) pg8::store8(omem + (size_t)rl * 2048 + bj * 128 + cw, acc[ai][bj][m][0] * il, acc[ai][bj][m][1] * il);  MK_ROWS_END
    }
};
struct EpiGate4 {
    static constexpr bool PERM = true, AFTER_DRAIN = false;
    bf16_t* merged; const bf16_t* gates;
    __device__ __forceinline__ void operator()(const f32x4 (&acc)[2][2][4][2], const Unit& u, int wr, int wc, int fr, int fq) const {
        const int cw = wc * 32 + 8 * fq; const bf16_t* gate = gates + u.sub * 2048; const bool first = u.sub == 0;
        MK_ROWS_BEGIN  const size_t row = (size_t)u.pm * 256 + rl;
#pragma unroll
            for (int bj = 0; bj < 2; ++bj) { const int col = u.pn * 256 + bj * 128 + cw; f32x4 g0, g1; pg8::load8(gate + row * 6144 + col, g0, g1);
                f32x4 v0 = acc[ai][bj][m][0] * g0, v1 = acc[ai][bj][m][1] * g1;
                if (!first) { f32x4 t0, t1; pg8::load8(merged + row * 2048 + col, t0, t1); v0 += t0; v1 += t1; }
                pg8::store8(merged + row * 2048 + col, v0, v1); }  MK_ROWS_END_NB
    }
};
struct SchedBR {
    pg8::GridOrder o; const char* onm; const char* oret; const char* wnm; const char* wret;
    __device__ __forceinline__ bool next(int i, Unit& u) const { if (i >= 3) return false; const bool ok = o.next(0, u); u.sub = i; return ok; }
    __device__ __forceinline__ void ptrs(const Unit& u, const char*& a, const char*& b) const {
        const size_t ra = (size_t)u.pm * (256u * 2048u * 2u), rb = (size_t)u.pn * (256u * 2048u * 2u);
        const bool nm = (u.sub != 1); const size_t co = (u.sub == 2) ? 2048u : 0u;
        a = (nm ? onm : oret) + ra + co; b = (nm ? wnm : wret) + rb + co; }
    __device__ __forceinline__ int nt(const Unit& u, int) const { return u.sub == 1 ? 32 : 16; }
};
struct EpiWout {
    static constexpr bool PERM = false, AFTER_DRAIN = true;
    const float* x; float* x1; bf16_t* x1b; float* ssq; const float* gffn;
    __device__ __forceinline__ void fused(f32x4 (&acc)[2][2][4][2], const Unit& u, int wr, int wc, int fr, int fq, PG8_LAS unsigned char* lds, int wid, int lane) const {
        PG8_LAS float* P = (PG8_LAS float*)lds;
        const int col0 = u.pn * 256 + wc * 32 + 4 * fq;
        MK_ROWS_BEGIN  const size_t off = ((size_t)u.pm * 256 + rl) * 2048 + col0; float q = 0.f;
#pragma unroll
            for (int bj = 0; bj < 2; ++bj)
#pragma unroll
                for (int n = 0; n < 2; ++n) { const f32x4 v = *(const f32x4*)(x + off + bj * 128 + n * 16) + acc[ai][bj][m][n];
                    *(f32x4*)(x1 + off + bj * 128 + n * 16) = v; pg8::store4(x1b + off + bj * 128 + n * 16, v * *(const f32x4*)(gffn + col0 + bj * 128 + n * 16)); q += (v[0] * v[0] + v[1] * v[1]) + (v[2] * v[2] + v[3] * v[3]); }
            q = red_fq(q); if (fq == 0) P[rl * 4 + wc] = q;  MK_ROWS_END_NB
        asm volatile("s_waitcnt lgkmcnt(0)" ::: "memory"); __builtin_amdgcn_s_barrier(); asm volatile("" ::: "memory");
        if (threadIdx.x < 256) { const int r = threadIdx.x; const f32x4 p = *(const PG8_LAS f32x4*)(P + r * 4); ssq[((size_t)u.pm * 256 + r) * 8 + u.pn] = (p[0] + p[1]) + (p[2] + p[3]); }
        asm volatile("s_waitcnt lgkmcnt(0)" ::: "memory"); __builtin_amdgcn_s_barrier(); asm volatile("" ::: "memory");
    }
};
struct EpiFF1 {
    static constexpr bool PERM = true, AFTER_DRAIN = false;
    bf16_t* hff; const float* ssq;
    __device__ __forceinline__ void operator()(const f32x4 (&acc)[2][2][4][2], const Unit& u, int wr, int wc, int fr, int fq) const {
        const int cw = wc * 32 + 8 * fq;
        float ra[2][4];
#pragma unroll
        for (int ai = 0; ai < 2; ++ai)
#pragma unroll
            for (int m = 0; m < 4; ++m) { const size_t row = (size_t)u.pm * 256 + MK_RL(ai, m); const f32x4 p0 = *(const f32x4*)(ssq + row * 8), p1 = *(const f32x4*)(ssq + row * 8 + 4);
                ra[ai][m] = rsqrtf((((p0[0] + p0[1]) + (p0[2] + p0[3])) + ((p1[0] + p1[1]) + (p1[2] + p1[3]))) * (1.0f / 2048.0f) + EPS); }
        MK_ROWS_BEGIN  const size_t row = (size_t)u.pm * 256 + rl; const float r = ra[ai][m];
#pragma unroll
            for (int bj = 0; bj < 2; ++bj) { f32x4 v0 = acc[ai][bj][m][0] * r, v1 = acc[ai][bj][m][1] * r;
#pragma unroll
                for (int e = 0; e < 4; ++e) { const float a = fmaxf(v0[e], 0.f), b = fmaxf(v1[e], 0.f); v0[e] = a * a; v1[e] = b * b; }
                pg8::store8(hff + row * LDH + u.pn * 256 + bj * 128 + cw, v0, v1); }  MK_ROWS_END
    }
};
struct EpiFF2 {
    static constexpr bool PERM = false, AFTER_DRAIN = false;
    const float* src; float* out;
    __device__ __forceinline__ void operator()(const f32x4 (&acc)[2][2][4][2], const Unit& u, int wr, int wc, int fr, int fq) const {
        const int col0 = u.pn * 256 + wc * 32 + 4 * fq;
        MK_ROWS_BEGIN  const size_t off = ((size_t)u.pm * 256 + rl) * 2048 + col0;
#pragma unroll
            for (int bj = 0; bj < 2; ++bj)
#pragma unroll
                for (int n = 0; n < 2; ++n) { const size_t o2 = off + bj * 128 + n * 16; *(f32x4*)(out + o2) = *(const f32x4*)(src + o2) + acc[ai][bj][m][n]; }  MK_ROWS_END_NB
    }
};

struct SchedList3 {
    pg8::UnitG u0, u1, u2; int n;
    __device__ __forceinline__ bool next(int i, pg8::UnitG& u) const { if (i >= n) return false;
        u.a = (i == 0) ? u0.a : ((i == 1) ? u1.a : u2.a); u.b = (i == 0) ? u0.b : ((i == 1) ? u1.b : u2.b);
        u.lda = (i == 0) ? u0.lda : ((i == 1) ? u1.lda : u2.lda); u.ldb = (i == 0) ? u0.ldb : ((i == 1) ? u1.ldb : u2.ldb);
        u.nt = (i == 0) ? u0.nt : ((i == 1) ? u1.nt : u2.nt); u.kind = (i == 0) ? u0.kind : ((i == 1) ? u1.kind : u2.kind); u.perm = (i == 0) ? u0.perm : ((i == 1) ? u1.perm : u2.perm);
        return true; }
};
struct EpiM1 {
    EpiF32 e0; EpiP e1; EpiXS e2;
    __device__ __forceinline__ bool after_drain(const pg8::UnitG&) const { return false; }
    __device__ __forceinline__ void operator()(const f32x4 (&acc)[2][2][4][2], const pg8::UnitG& u, int wr, int wc, int fr, int fq) const {
        Unit d; d.pm = 0; d.pn = 0; d.sub = 0;
        if (u.kind == 0) e0(acc, d, wr, wc, fr, fq); else if (u.kind == 1) e1(acc, d, wr, wc, fr, fq); else e2(acc, d, wr, wc, fr, fq); }
    __device__ __forceinline__ void fused(f32x4 (&)[2][2][4][2], const pg8::UnitG&, int, int, int, int, PG8_LAS unsigned char*, int, int) const {}
};
struct EpiM3 {
    EpiXO e0; EpiGN e1;
    __device__ __forceinline__ bool after_drain(const pg8::UnitG& u) const { return u.kind == 1; }
    __device__ __forceinline__ void operator()(const f32x4 (&acc)[2][2][4][2], const pg8::UnitG& u, int wr, int wc, int fr, int fq) const { Unit d; d.pm = 0; d.pn = 0; d.sub = 0; e0(acc, d, wr, wc, fr, fq); }
    __device__ __forceinline__ void fused(f32x4 (&acc)[2][2][4][2], const pg8::UnitG&, int wr, int wc, int fr, int fq, PG8_LAS unsigned char* lds, int wid, int lane) const {
        Unit d; d.pm = 0; d.pn = 0; d.sub = 0; e1.fused(acc, d, wr, wc, fr, fq, lds, wid, lane); }
};
#undef MK_ROWS_BEGIN
#undef MK_ROWS_END
#undef MK_ROWS_END_NB
#undef MK_ROWS_END2
#undef MK_RL
}

namespace na {
using bf16 = unsigned short;
using bf16x8 = __attribute__((ext_vector_type(8))) short;
using s16x4  = __attribute__((ext_vector_type(4))) short;
using f32x16 = __attribute__((ext_vector_type(16))) float;
using f32x4  = __attribute__((ext_vector_type(4))) float;
using u32x4  = __attribute__((ext_vector_type(4))) unsigned;
constexpr int DH = 128, NW = 8, QBLK = 32, KVBLK = 64, LDQ = 3072;
constexpr size_t SHM_V = KVBLK * DH * 2, SHM_K = KVBLK * DH * 2;
constexpr int NBUF = 3;
constexpr int OFF_RK = NBUF * SHM_V + NBUF * SHM_K;
constexpr int OFF_BIAS = OFF_RK + 768 * 4;
constexpr int BIAS_PAD = 64, BIAS_N = 64 + 15 * 31 + 79;
constexpr int OFF_LI = OFF_BIAS + ((BIAS_N * 4 + 15) / 16) * 16;
constexpr int NA_LDS_BYTES = OFF_LI + NW * 64 * 4;
#define KSWZ(row, colB) ((row) * 256 + ((colB) ^ (((row) & 7) << 4)))
#define SBAR() __builtin_amdgcn_sched_barrier(0)
__device__ __forceinline__ int crow(int r, int hi) { return (r & 3) + 8 * (r >> 2) + 4 * hi; }
__device__ __forceinline__ unsigned cvtpk(float lo, float hi) { return pg8::cvt_pk_bf16(lo, hi); }

__device__ __forceinline__ void procP(f32x16& p0, f32x16& p1, float& lsum, bool inwin, const float* rk_t  , const float* bias_l  ,
                                      float rqs, int cs, int hi) {
  if (!inwin) { p0 = f32x16{}; p1 = f32x16{}; return; }
#pragma unroll
  for (int g = 0; g < 4; ++g) {
    const f32x4 k0 = *(const f32x4*)(rk_t + 8 * g + 4 * hi), k1 = *(const f32x4*)(rk_t + 32 + 8 * g + 4 * hi);
#pragma unroll
    for (int e = 0; e < 4; ++e) { const int r = 4 * g + e; const int w0 = e + 8 * g + 4 * hi, w1 = w0 + 32;
      const float x0 = fmaf(p0[r], rqs * k0[e], bias_l[w0]), x1 = fmaf(p1[r], rqs * k1[e], bias_l[w1]);
      const float e0 = __builtin_amdgcn_exp2f(x0), e1 = __builtin_amdgcn_exp2f(x1);
      const float v0 = ((unsigned)(w0 - cs) < 16u) ? e0 : 0.f, v1 = ((unsigned)(w1 - cs) < 16u) ? e1 : 0.f;
      p0[r] = v0; p1[r] = v1; lsum += v0 + v1; }
  }
}
__device__ __forceinline__ void packP(const f32x16& p0, const f32x16& p1, bf16x8& pa0, bf16x8& pa1, bf16x8& pa2, bf16x8& pa3) {
#define PK4(P, BASE, OUT) do { unsigned a0 = cvtpk(P[BASE + 0], P[BASE + 1]), a1 = cvtpk(P[BASE + 2], P[BASE + 3]);   \
    unsigned b0 = cvtpk(P[BASE + 4], P[BASE + 5]), b1 = cvtpk(P[BASE + 6], P[BASE + 7]);                              \
    auto r0 = __builtin_amdgcn_permlane32_swap(a0, b0, false, false); auto r1 = __builtin_amdgcn_permlane32_swap(a1, b1, false, false); \
    u32x4 w = {r0[0], r1[0], r0[1], r1[1]}; OUT = *reinterpret_cast<bf16x8*>(&w); } while (0)
  PK4(p0, 0, pa0); PK4(p0, 8, pa1); PK4(p1, 0, pa2); PK4(p1, 8, pa3);
#undef PK4
}
__device__ __forceinline__ void qkt(f32x16& p0, f32x16& p1, const bf16* Ks, const bf16x8* qr, int r32, int hi) {
  p0 = f32x16{}; p1 = f32x16{};
#pragma unroll
  for (int d0 = 0; d0 < 8; ++d0) { int cb = (d0 * 16 + hi * 8) * 2;
    bf16x8 b0 = *reinterpret_cast<const bf16x8*>((const char*)Ks + KSWZ(r32, cb));
    bf16x8 b1 = *reinterpret_cast<const bf16x8*>((const char*)Ks + KSWZ(32 + r32, cb));
    p0 = __builtin_amdgcn_mfma_f32_32x32x16_bf16(b0, qr[d0], p0, 0, 0, 0);
    p1 = __builtin_amdgcn_mfma_f32_32x32x16_bf16(b1, qr[d0], p1, 0, 0, 0); }
}
__device__ __forceinline__ int v_st(int k, int c) { const int kk = (k & ~0xC) | ((k & 4) << 1) | ((k & 8) >> 1); return ((kk >> 3) * 4 + (c >> 5)) * 512 + ((kk & 7) * 32 + (c & 31)) * 2; }
__device__ __forceinline__ int v_rd_base(int lane) { return ((lane & 3) << 3) | (((lane >> 2) & 3) << 6) | (((lane >> 4) & 1) << 5) | (((lane >> 5) & 1) << 8); }
constexpr int v_rd_off(int d0, int ks, int half) { return d0 * 512 + ks * 4096 + half * 2048; }
template <int OFF> __device__ __forceinline__ s16x4 tr_read(int vb) {
  s16x4 r; asm volatile("ds_read_b64_tr_b16 %0, %1 offset:%2" : "=&v"(r) : "v"(vb), "i"(OFF) : "memory"); return r;
}
template <int D0> __device__ __forceinline__ void pv_one(f32x16& od, int vb, bf16x8 pa0, bf16x8 pa1, bf16x8 pa2, bf16x8 pa3) {
  const s16x4 l0 = tr_read<v_rd_off(D0, 0, 0)>(vb), h0 = tr_read<v_rd_off(D0, 0, 1)>(vb), l1 = tr_read<v_rd_off(D0, 1, 0)>(vb), h1 = tr_read<v_rd_off(D0, 1, 1)>(vb);
  const s16x4 l2 = tr_read<v_rd_off(D0, 2, 0)>(vb), h2 = tr_read<v_rd_off(D0, 2, 1)>(vb), l3 = tr_read<v_rd_off(D0, 3, 0)>(vb), h3 = tr_read<v_rd_off(D0, 3, 1)>(vb);
  asm volatile("s_waitcnt lgkmcnt(0)" ::: "memory"); SBAR();
#define PK(L, H) (bf16x8){L[0], L[1], L[2], L[3], H[0], H[1], H[2], H[3]}
  od = __builtin_amdgcn_mfma_f32_32x32x16_bf16(pa0, PK(l0, h0), od, 0, 0, 0);
  od = __builtin_amdgcn_mfma_f32_32x32x16_bf16(pa1, PK(l1, h1), od, 0, 0, 0);
  od = __builtin_amdgcn_mfma_f32_32x32x16_bf16(pa2, PK(l2, h2), od, 0, 0, 0);
  od = __builtin_amdgcn_mfma_f32_32x32x16_bf16(pa3, PK(l3, h3), od, 0, 0, 0);
#undef PK
}
__device__ __forceinline__ void pv_d0(f32x16* o, int vb, bf16x8 pa0, bf16x8 pa1, bf16x8 pa2, bf16x8 pa3) {
  pv_one<0>(o[0], vb, pa0, pa1, pa2, pa3); pv_one<1>(o[1], vb, pa0, pa1, pa2, pa3); pv_one<2>(o[2], vb, pa0, pa1, pa2, pa3); pv_one<3>(o[3], vb, pa0, pa1, pa2, pa3);
}

__device__ __forceinline__ void na_unit(int b, int h, int i4, const bf16* __restrict__ qkv, const float* __restrict__ ssq_q, const float* __restrict__ ssq_k,
                                        const float* __restrict__ rpb, bf16* __restrict__ ona, char* lds) {
  int tid_ = threadIdx.x; asm volatile("" : "+v"(tid_));
  const int tid = tid_, wid = __builtin_amdgcn_readfirstlane(tid >> 6), lane = tid & 63, r32 = lane & 31, hi = lane >> 5;
  bf16* V_lds = (bf16*)lds; bf16* K_lds = (bf16*)(lds + NBUF * SHM_V);
  float* rkL = (float*)(lds + OFF_RK); float* biasL = (float*)(lds + OFF_BIAS); float* li_l = (float*)(lds + OFF_LI) + wid * 64;
  const int NT = (i4 == 0 || i4 == 15) ? 8 : 11, rbase = (i4 == 0) ? 0 : ((i4 == 15) ? 56 : 4 * i4 - 4);
  const int qrow = 4 * i4 + (wid >> 1), qc = 32 * (wid & 1) + r32;
  int rs = qrow - 4; rs = rs < 0 ? 0 : (rs > 56 ? 56 : rs);
  int cs = qc - 8; cs = cs < 0 ? 0 : (cs > 48 ? 48 : cs);
  const size_t tok_q = (size_t)b * 4096 + qrow * 64 + qc, tok_k0 = (size_t)b * 4096 + rbase * 64;
  for (int i = tid; i < NT * 64; i += 512) { const f32x4 p = *(const f32x4*)(ssq_k + (tok_k0 + i) * 32 + h * 4); rkL[i] = rsqrtf(((p[0] + p[1]) + (p[2] + p[3])) * (1.0f / 128.0f) + 1e-6f); }
  for (int i = tid; i < BIAS_N; i += 512) { const int j = i - BIAS_PAD; biasL[i] = (j >= 0 && j < 15 * 31) ? rpb[h * 465 + j] * 1.4426950408889634f : 0.f; }
  float rqs; { const f32x4 p = *(const f32x4*)(ssq_q + tok_q * 32 + h * 4); rqs = rsqrtf(((p[0] + p[1]) + (p[2] + p[3])) * (1.0f / 128.0f) + 1e-6f) * 1.4426950408889634f; }
  float l_reg = 0; f32x16 o[4] = {}; bf16x8 qr[8];
  const bf16* Qw = qkv + tok_q * LDQ + h * 128 + hi * 8;
#pragma unroll
  for (int d0 = 0; d0 < 8; ++d0) qr[d0] = *reinterpret_cast<const bf16x8*>(Qw + d0 * 16);
  const bf16* Kh = qkv + tok_k0 * LDQ + 1024 + h * 128; const bf16* Vh = qkv + tok_k0 * LDQ + 2048 + h * 128;
  const int sr = tid >> 4, sc = (tid & 15) * 8, vst0 = v_st(sr, sc), vst1 = v_st(32 + sr, sc);
  const int vb0 = (int)(uintptr_t)V_lds + v_rd_base(lane);
  struct { bf16x8 vs0, vs1, ks0, ks1; } sr_[2];
#define SLOAD(i, k0) do { sr_[i].vs0 = *(const bf16x8*)(&Vh[(long)((k0) + sr) * LDQ + sc]); sr_[i].vs1 = *(const bf16x8*)(&Vh[(long)((k0) + 32 + sr) * LDQ + sc]); \
    sr_[i].ks0 = *(const bf16x8*)(&Kh[(long)((k0) + sr) * LDQ + sc]); sr_[i].ks1 = *(const bf16x8*)(&Kh[(long)((k0) + 32 + sr) * LDQ + sc]); } while (0)
#define SWRITE(bb, i) do { *(bf16x8*)((char*)V_lds + (bb) * SHM_V + vst0) = sr_[i].vs0;          \
    *(bf16x8*)((char*)V_lds + (bb) * SHM_V + vst1) = sr_[i].vs1; int kc = sc * 2;               \
    *(bf16x8*)((char*)K_lds + (bb) * SHM_K + KSWZ(sr, kc)) = sr_[i].ks0;                       \
    *(bf16x8*)((char*)K_lds + (bb) * SHM_K + KSWZ(32 + sr, kc)) = sr_[i].ks1; } while (0)
#define SWAIT() asm volatile("s_waitcnt vmcnt(0)" ::: "memory")
#define TILE_ARGS(j) ((unsigned)(rbase + (j) - rs) < 8u), rkL + (j) * 64, biasL + BIAS_PAD + (rbase + (j) - qrow + 7) * 31 + 15 - qc, rqs, cs, hi
  f32x16 p0, p1; bf16x8 pa0, pa1, pa2, pa3;
#define NA_TILE(j, bo) do { if ((unsigned)(rbase + (j) - rs) < 8u) {     \
      SBAR(); qkt(p0, p1, (const bf16*)((const char*)K_lds + (bo) * SHM_K), qr, r32, hi); \
      procP(p0, p1, l_reg, TILE_ARGS(j)); \
      packP(p0, p1, pa0, pa1, pa2, pa3); SBAR(); \
      pv_d0(o, vb0 + (bo) * (int)SHM_V, pa0, pa1, pa2, pa3); } } while (0)
  SLOAD(0, 0); SLOAD(1, KVBLK); SWRITE(0, 0); SLOAD(0, 2 * KVBLK); SWRITE(1, 1); SLOAD(1, 3 * KVBLK); __syncthreads();
  int b0 = 0;
  for (int j = 0; j < NT; j += 2) {
    const int b1 = (b0 == 2) ? 0 : b0 + 1, b2 = (b1 == 2) ? 0 : b1 + 1;
    NA_TILE(j, b0);
    if (j + 2 < NT) { SWRITE(b2, 0); if (j + 4 < NT) SLOAD(0, (j + 4) * KVBLK); }
    __syncthreads();
    if (j + 1 < NT) NA_TILE(j + 1, b1);
    if (j + 3 < NT) { SWRITE(b0, 1); if (j + 5 < NT) SLOAD(1, (j + 5) * KVBLK); }
    __syncthreads();
    b0 = b2;
  }
#undef NA_TILE
  { auto rr = __builtin_amdgcn_permlane32_swap(__float_as_uint(l_reg), __float_as_uint(l_reg), false, false); l_reg = __uint_as_float(rr[0]) + __uint_as_float(rr[1]); }
  if (hi == 0) li_l[r32] = l_reg; asm volatile("s_waitcnt lgkmcnt(0)" ::: "memory");
  float rli[16];
#pragma unroll
  for (int r = 0; r < 16; ++r) rli[r] = __builtin_amdgcn_rcpf(li_l[crow(r, hi)]);
  bf16* Ow = ona + ((size_t)b * 4096 + qrow * 64 + 32 * (wid & 1)) * 2048 + h * 128;
#pragma unroll
  for (int r = 0; r < 16; ++r) { const int orow = crow(r, hi);
#pragma unroll
    for (int d0 = 0; d0 < 4; ++d0) { const float v = o[d0][r] * rli[r]; unsigned u = __float_as_uint(v); u += 0x7fffu + ((u >> 16) & 1u); Ow[(size_t)orow * 2048 + d0 * 32 + r32] = (bf16)(u >> 16); } }
  __syncthreads();
#undef SLOAD
#undef SWRITE
#undef SWAIT
#undef TILE_ARGS
}
#undef KSWZ
#undef SBAR
}

constexpr int NWAVES = 8;
constexpr int RING_OFF = 0, RING_BYTES = 131072;
constexpr int LDSCTL_OFF = RING_BYTES, MISC_OFF = LDSCTL_OFF + 320;
constexpr int LDS_BYTES = 147456;
static_assert(MISC_OFF + 128 <= LDS_BYTES && na::NA_LDS_BYTES <= RING_BYTES, "LDS map");
constexpr int CW_TMO = 0, CW_P0A = 64, CW_BAR = 4096;

#define GAS __attribute__((address_space(1)))
#define LAS __attribute__((address_space(3)))
typedef unsigned short bf16;
typedef unsigned v4u __attribute__((ext_vector_type(4)));
typedef float f32x4 __attribute__((ext_vector_type(4)));
typedef GAS unsigned gu32;
#define LDS_WAIT() asm volatile("s_waitcnt lgkmcnt(0)" ::: "memory")
#define VM_WAIT() asm volatile("s_waitcnt vmcnt(0)" ::: "memory")
__device__ __forceinline__ unsigned f2bf(float f) { unsigned u = __builtin_bit_cast(unsigned, f); return (u + 0x7fffu + ((u >> 16) & 1u)) >> 16; }
__device__ __forceinline__ unsigned pk2(float lo, float hi) { return f2bf(lo) | (f2bf(hi) << 16); }
__device__ __forceinline__ float bf2f_(unsigned h) { return __uint_as_float(h << 16); }

#define XB_TMO      128
#define XB_XCNT(j)  (256  + 64 * (j))
#define XB_XSUB(j)  (1280 + 64 * (j))
#define XB_XGEN(j)  (2304 + 64 * (j))
#define XB_TOP      3328
#define XB_TOPGEN   3392
#define XCD_BAR_WORDS 3456
#define XB_SPIN_CAP (1u << 18)
__device__ __forceinline__ unsigned xb_ld(unsigned* p)              { return __hip_atomic_load(p, __ATOMIC_RELAXED, __HIP_MEMORY_SCOPE_AGENT); }
__device__ __forceinline__ unsigned xb_add(unsigned* p, unsigned v) { return __hip_atomic_fetch_add(p, v, __ATOMIC_RELAXED, __HIP_MEMORY_SCOPE_AGENT); }
__device__ __forceinline__ unsigned xb_xcc_id() { return (unsigned)__builtin_amdgcn_s_getreg((3 << 11) | 20) & 0xFu; }
#define XB_SPIN(cond, bar) do { unsigned _sp = 0; while (cond) { __builtin_amdgcn_s_sleep(1); \
    if ((++_sp & 255u) == 0u) { if (xb_ld(&(bar)[XB_TMO])) break; if (_sp > XB_SPIN_CAP) { atomicAdd(&(bar)[XB_TMO], 1u); break; } } } } while (0)
struct XcdBarrier { unsigned* bar; unsigned x; volatile LAS unsigned* st; };
__device__ __forceinline__ XcdBarrier xcd_barrier_post(unsigned* bar, volatile LAS unsigned* st) {
    XcdBarrier b; b.bar = bar; b.x = xb_xcc_id(); b.st = st;
    if (threadIdx.x == 0) (void)xb_add(&bar[XB_XCNT(b.x)], 1u);
    return b;
}
__device__ __forceinline__ void xcd_barrier_complete(unsigned* bar, unsigned x, unsigned& nloc, unsigned& nx) {
    const unsigned G = gridDim.x * gridDim.y * gridDim.z;
    unsigned sum, cnt, mine, sp = 0u;
    for (;;) {
        sum = 0u; cnt = 0u; mine = 0u;
#pragma unroll
        for (unsigned j = 0; j < 16; ++j) { const unsigned c = xb_ld(&bar[XB_XCNT(j)]); sum += c; cnt += (c > 0u) ? 1u : 0u; mine = (j == x) ? c : mine; }
        if (sum == G) break;
        __builtin_amdgcn_s_sleep(1);
        if ((++sp & 255u) == 0u) { if (xb_ld(&bar[XB_TMO])) break; if (sp > XB_SPIN_CAP) { atomicAdd(&bar[XB_TMO], 1u); break; } }
    }
    nloc = mine > 0u ? mine : 1u; nx = cnt > 0u ? cnt : 1u;
}
__device__ __forceinline__ void xcd_barrier(const XcdBarrier& b) {
    asm volatile("s_waitcnt vmcnt(0)" ::: "memory");
    __syncthreads();
    if (threadIdx.x == 0) {
        unsigned* bar = b.bar;
        __builtin_amdgcn_s_waitcnt(0);
        unsigned nloc = b.st[0], nx = b.st[1];
        if (nloc == 0u) { xcd_barrier_complete(bar, b.x, nloc, nx); b.st[0] = nloc; b.st[1] = nx; }
        const unsigned old = xb_add(&bar[XB_XSUB(b.x)], 1u);
        const unsigned gen = old / nloc;
        if (old + 1u == (gen + 1u) * nloc) {
            __builtin_amdgcn_fence(__ATOMIC_RELEASE, "agent");
            asm volatile("s_waitcnt vmcnt(0)" ::: "memory");
            const unsigned og = xb_add(&bar[XB_TOP], 1u);
            const unsigned tg = og / nx;
            if (og + 1u == (tg + 1u) * nx) xb_add(&bar[XB_TOPGEN], 1u);
            else XB_SPIN(xb_ld(&bar[XB_TOPGEN]) == tg, bar);
            __builtin_amdgcn_fence(__ATOMIC_ACQUIRE, "agent");
            xb_add(&bar[XB_XGEN(b.x)], 1u);
            asm volatile("s_waitcnt vmcnt(0)" ::: "memory");
        } else {
            XB_SPIN(xb_ld(&bar[XB_XGEN(b.x)]) == gen, bar);
            __builtin_amdgcn_fence(__ATOMIC_ACQUIRE, "agent");
            asm volatile("s_waitcnt vmcnt(0)" ::: "memory");
        }
    }
    __syncthreads();
}

__device__ __forceinline__ float wave_sum(float v) {
#pragma unroll
    for (int o = 1; o < 64; o <<= 1) v += __shfl_xor(v, o);
    return v;
}
__device__ __forceinline__ void p0_item(const float* __restrict__ W, int ldw, int k0, int n0, bf16* __restrict__ WT, int ldt, int dA, int dB, const float* __restrict__ kscale, LAS float* scr, int lane) {
    const int c16 = lane & 15, kr = lane >> 4;
#pragma unroll
    for (int it = 0; it < 16; ++it) { const int k = 4 * it + kr;
        f32x4 v = __builtin_nontemporal_load((const f32x4*)(W + (size_t)(k0 + k) * ldw + n0 + 4 * c16));
        if (kscale) v = v * kscale[k0 + k];
        *(LAS f32x4*)(scr + k * 64 + ((4 * c16) ^ (8 * ((k >> 3) & 7)))) = v; }
    LDS_WAIT(); asm volatile("" ::: "memory");
    const int c = lane & 7;
#pragma unroll
    for (int j = 0; j < 8; ++j) { const int n = (lane >> 3) + 8 * j; const LAS float* s = scr + (8 * c) * 64 + (n ^ (8 * c));
        v4u o; o.x = pk2(s[0 * 64], s[1 * 64]); o.y = pk2(s[2 * 64], s[3 * 64]); o.z = pk2(s[4 * 64], s[5 * 64]); o.w = pk2(s[6 * 64], s[7 * 64]);
        const int drow = (n < 32) ? dA + n : dB + n - 32;
        *(GAS v4u*)(WT + (size_t)drow * ldt + k0 + 8 * c) = o; }
    LDS_WAIT(); asm volatile("" ::: "memory");
}
struct P0Desc { const float* src; bf16* dst; int ldw, ldt, dA, dB, nt; };
__device__ __forceinline__ void p0_load(const P0Desc& d, f32x4 (&R)[16], int lane) {
    const int c16 = lane & 15, kr = lane >> 4;
#pragma unroll
    for (int it = 0; it < 16; ++it) R[it] = __builtin_nontemporal_load((const f32x4*)(d.src + (size_t)(4 * it + kr) * d.ldw + 4 * c16));
}
__device__ __forceinline__ void p0_to_lds(const f32x4 (&R)[16], LAS float* scr, int lane) {
    const int c16 = lane & 15, kr = lane >> 4;
#pragma unroll
    for (int it = 0; it < 16; ++it) { const int k = 4 * it + kr; *(LAS f32x4*)(scr + k * 64 + ((4 * c16) ^ (8 * ((k >> 3) & 7)))) = R[it]; }
}
__device__ __forceinline__ void p0_store(const P0Desc& d, LAS float* scr, int lane) {
    const int c = lane & 7;
#pragma unroll
    for (int j = 0; j < 8; ++j) { const int n = (lane >> 3) + 8 * j; const LAS float* s = scr + (8 * c) * 64 + (n ^ (8 * c));
        v4u o; o.x = pk2(s[0 * 64], s[1 * 64]); o.y = pk2(s[2 * 64], s[3 * 64]); o.z = pk2(s[4 * 64], s[5 * 64]); o.w = pk2(s[6 * 64], s[7 * 64]);
        const int drow = (n < 32) ? d.dA + n : d.dB + n - 32;
        GAS v4u* q = (GAS v4u*)(d.dst + (size_t)drow * d.ldt + 8 * c); if (d.nt) __builtin_nontemporal_store(o, q); else *q = o; }
}
__device__ __forceinline__ void rms_row_to_bf16(const float* __restrict__ xrow, const float* __restrict__ g, bf16* __restrict__ orow, int lane) {
    const f32x4* xr = (const f32x4*)xrow + lane; const f32x4* gr = (const f32x4*)g + lane;
    f32x4 v[8]; float s = 0.f;
#pragma unroll
    for (int j = 0; j < 8; ++j) { v[j] = __builtin_nontemporal_load(xr + 64 * j); s += (v[j].x * v[j].x + v[j].y * v[j].y) + (v[j].z * v[j].z + v[j].w * v[j].w); }
    const float r = rsqrtf(wave_sum(s) * (1.f / 2048.f) + mk::EPS);
    unsigned long long* o8 = (unsigned long long*)orow + lane;
#pragma unroll
    for (int j = 0; j < 8; ++j) { const f32x4 gg = gr[64 * j]; o8[64 * j] = (unsigned long long)pk2(v[j].x * r * gg.x, v[j].y * r * gg.y) | ((unsigned long long)pk2(v[j].z * r * gg.z, v[j].w * r * gg.w) << 32); }
}
__device__ __forceinline__ int win_dest_row(int n32  ) {
    const int pn = n32 >> 3, ga = n32 & 7;
    if (pn < 12 || pn >= 20) return n32 * 32;
    const int gs = 4 * ((ga >> 1) & 1) + 2 * (ga >> 2) + (ga & 1);
    return (pn * 8 + gs) * 32;
}

#ifndef MK_TS
#define MK_TS -1
#endif
struct Args { const float* in[21]; float* out; unsigned char* ws; };

__global__ void __launch_bounds__(NWAVES * 64, 2) mk_fwd(Args args) {
    extern __shared__ __attribute__((aligned(16))) unsigned char lds[];
    LAS unsigned char* ldsl = (LAS unsigned char*)lds;
    volatile LAS unsigned* MISC = (volatile LAS unsigned*)(ldsl + MISC_OFF);
    const int tid = threadIdx.x, lane = tid & 63, wave = __builtin_amdgcn_readfirstlane(tid >> 6);
    const int G = gridDim.x, bx = blockIdx.x;
    const int vcu = (G % 8 == 0) ? (bx % 8) * (G / 8) + bx / 8 : bx;
    unsigned char* ws = args.ws; unsigned char* dob = (unsigned char*)args.out;
    gu32* ctl = (gu32*)(ws + mk::WS_CTL);
#define I_x args.in[0]
#define I_mem args.in[1]
#define I_g_mix args.in[2]
#define I_w_in args.in[3]
#define I_gq args.in[4]
#define I_gk args.in[5]
#define I_rpb args.in[6]
#define I_lgf_in args.in[7]
#define I_lgb_in args.in[8]
#define I_gn args.in[9]
#define I_g_mem args.in[10]
#define I_w_mkv args.in[11]
#define I_gxq args.in[12]
#define I_gxk args.in[13]
#define I_w_na args.in[14]
#define I_w_ret args.in[15]
#define I_w_memb args.in[16]
#define I_w_out args.in[17]
#define I_g_ffn args.in[18]
#define I_w_ff1 args.in[19]
#define I_w_ff2 args.in[20]
#define I_out args.out
#define cosT ((float*)(ws + mk::WS_COS))
#define sinT ((float*)(ws + mk::WS_SIN))
#define ssq_naq ((float*)(ws + mk::WS_SSQ_NAQ))
#define ssq_nak ((float*)(ws + mk::WS_SSQ_NAK))
#define ssq_xq ((float*)(ws + mk::WS_SSQ_XQ))
#define xl ((float*)(ws + mk::WS_XL))
#define ssq_x1 ((float*)(ws + mk::WS_SSQ_X1))
#define tab ((float*)(ws + mk::WS_TAB))
#define MEMN ((bf16*)(ws + mk::WS_MEMN))
#define MKb ((bf16*)(ws + mk::WS_MK))
#define MVT ((bf16*)(ws + mk::WS_MVT))
#define WinT ((bf16*)(ws + mk::WS_WIN))
#define Wff1T ((bf16*)(ws + mk::WS_WFF1))
#define Wff2T ((bf16*)(ws + mk::WS_WFF2))
#define WretT ((bf16*)(ws + mk::WS_WRET))
#define WoutT ((bf16*)(ws + mk::WS_WOUT))
#define WnmT ((bf16*)(ws + mk::WS_WNM))
#define WmkvT ((bf16*)(ws + mk::WS_WMKV))
#define NAQKV ((bf16*)(ws + mk::WS_NAQKV))
#define K0 ((bf16*)(ws + mk::WS_K0))
#define RG ((bf16*)(ws + mk::WS_RG))
#define XQ ((bf16*)(ws + mk::WS_XQ))
#define GATES ((bf16*)(ws + mk::WS_GATES))
#define AR ((bf16*)(ws + mk::WS_AR))
#define BR ((bf16*)(ws + mk::WS_BR))
#define KV ((bf16*)(ws + mk::WS_KV))
#define ORET ((bf16*)(ws + mk::WS_ORET))
#define MERGED ((bf16*)(ws + mk::WS_MERGED))
#define X1B ((bf16*)(ws + mk::WS_X1B))
#define HFF ((bf16*)(ws + mk::WS_HFF))
#define HN ((bf16*)(dob + mk::DO_HN))
#define KT ((bf16*)(dob + mk::DO_KT))
#define XP ((bf16*)(dob + mk::DO_XP))
#define ONM ((bf16*)(dob + mk::DO_ONM))
    for (int u = tid; u < (LDS_BYTES - LDSCTL_OFF) / 4; u += NWAVES * 64) ((LAS unsigned*)(ldsl + LDSCTL_OFF))[u] = 0u;
    __syncthreads();
    XcdBarrier bar = xcd_barrier_post((unsigned*)(ctl + CW_BAR), MISC + 8);
#define GRID_BAR() do { xcd_barrier(bar); MK_STAMP(); } while (0)
    int n_stamp_ = 0;
#define MK_STAMP() do { if (MK_TS >= 0) { if (bx == 0 && tid == 0) MISC[16 + n_stamp_] = (unsigned)__builtin_amdgcn_s_memrealtime(); ++n_stamp_; } } while (0)
    MK_STAMP();
    LAS float* scr = (LAS float*)(ldsl + RING_OFF + wave * 16384);
    const int gw = vcu * NWAVES + wave, NGW = G * NWAVES;

    {
    if (vcu < 16) {
        if (tid == 0) {
            unsigned sp = 0; while (__hip_atomic_load((unsigned*)(ctl + CW_P0A), __ATOMIC_RELAXED, __HIP_MEMORY_SCOPE_AGENT) < (unsigned)(G - 16)) { __builtin_amdgcn_s_sleep(2); if (++sp > (1u << 22)) break; }
            __builtin_amdgcn_fence(__ATOMIC_ACQUIRE, "agent"); asm volatile("s_waitcnt vmcnt(0)" ::: "memory");
        }
        __syncthreads();
        mk::SchedOne S; S.has = true; const pg8::Gemm g{2048, 2048, 2048};
        mk::EpiMKV E{MKb, MVT, tab, tab, 0};
        if (vcu < 8) { S.u.pm = vcu >> 2; S.u.pn = vcu & 3; S.a = (const char*)(MEMN + (size_t)S.u.pm * 256 * 2048); S.b = (const char*)(WmkvT + (size_t)S.u.pn * 256 * 2048); E.mode = 0; }
        else { const int c = vcu - 8; S.u.pm = c >> 1; S.u.pn = c & 1; S.a = (const char*)(WmkvT + (size_t)(1024 + S.u.pm * 256) * 2048); S.b = (const char*)(MEMN + (size_t)S.u.pn * 256 * 2048); E.mode = 1; }
        pg8::gemm_phase<mk::EpiMKV, mk::SchedOne, false>(ldsl + RING_OFF, g, S, E);
    } else {
        const int gw2 = (vcu - 16) * NWAVES + wave, NGW2 = (G - 16) * NWAVES;
        {
            for (int i = gw2 * 64 + lane; i < 4096 * 64; i += NGW2 * 64) { const int s = i >> 6, f = i & 63;
                const float inv = powf(10000.0f, -(float)f / 64.0f), ang = (float)s * inv; cosT[i] = cosf(ang); sinT[i] = sinf(ang); }
            if (vcu == 16) {
                if (tid < 128) tab[mk::TAB_CS_NAQ + tid] = I_gq[tid] * I_gk[tid] * 0.08838834764831845f;
                if (tid < 256) tab[mk::TAB_CS_MK + tid] = I_gxq[tid] * I_gxk[tid] * 0.0625f;
                if (tid < 8) { tab[mk::TAB_L2F + tid] = -log1pf(expf(-I_lgf_in[tid])) * mk::LOG2E; tab[mk::TAB_L2B + tid] = -log1pf(expf(-I_lgb_in[tid])) * mk::LOG2E; }
            }
            for (int m = gw2; m < 512; m += NGW2) rms_row_to_bf16(I_mem + (size_t)m * 2048, I_g_mem, MEMN + (size_t)m * 2048, lane);
            for (int it = gw2; it < 32 * 32; it += NGW2) { const int kb = it >> 5, nb = it & 31; p0_item(I_w_mkv, 2048, 64 * kb, 64 * nb, WmkvT, 2048, 64 * nb, 64 * nb + 32, nullptr, scr, lane); }
            VM_WAIT(); __syncthreads();
            if (tid == 0) { __builtin_amdgcn_fence(__ATOMIC_RELEASE, "agent"); asm volatile("s_waitcnt vmcnt(0)" ::: "memory");
                (void)__hip_atomic_fetch_add((unsigned*)(ctl + CW_P0A), 1u, __ATOMIC_RELAXED, __HIP_MEMORY_SCOPE_AGENT); }
        }
        constexpr int I_IN = 32 * 256, I_FF1 = 32 * 128, I_FF2 = 128 * 32, I_RET = 32 * 32, I_OUT = 32 * 32, I_NA = 16 * 32, I_MEM = 16 * 32;
        constexpr int NITEMS = I_IN + I_FF1 + I_FF2 + I_RET + I_OUT + I_NA + I_MEM;
#define P0_DECODE(d, item) do { int r = (item); \
            if (r < I_IN) { const int kb = r >> 8, nb = r & 255; d.src = I_w_in + (size_t)(64 * kb) * 16384 + 64 * nb; d.ldw = 16384; d.dst = WinT + 64 * kb; d.ldt = 2048; d.dA = win_dest_row(2 * nb); d.dB = win_dest_row(2 * nb + 1); d.nt = 0; break; } r -= I_IN; \
            if (r < I_FF1) { const int kb = r >> 7, nb = r & 127; d.src = I_w_ff1 + (size_t)(64 * kb) * 8192 + 64 * nb; d.ldw = 8192; d.dst = Wff1T + 64 * kb; d.ldt = 2048; d.dA = 64 * nb; d.dB = 64 * nb + 32; d.nt = 1; break; } r -= I_FF1; \
            if (r < I_FF2) { const int kb = r >> 5, nb = r & 31; d.src = I_w_ff2 + (size_t)(64 * kb) * 2048 + 64 * nb; d.ldw = 2048; d.dst = Wff2T + 64 * kb; d.ldt = 8192; d.dA = 64 * nb; d.dB = 64 * nb + 32; d.nt = 1; break; } r -= I_FF2; \
            if (r < I_RET) { const int kb = r >> 5, nb = r & 31; d.src = I_w_ret + (size_t)(64 * kb) * 2048 + 64 * nb; d.ldw = 2048; d.dst = WretT + 64 * kb; d.ldt = 2048; d.dA = 64 * nb; d.dB = 64 * nb + 32; d.nt = 1; break; } r -= I_RET; \
            if (r < I_OUT) { const int kb = r >> 5, nb = r & 31; d.src = I_w_out + (size_t)(64 * kb) * 2048 + 64 * nb; d.ldw = 2048; d.dst = WoutT + 64 * kb; d.ldt = 2048; d.dA = 64 * nb; d.dB = 64 * nb + 32; d.nt = 1; break; } r -= I_OUT; \
            if (r < I_NA) { const int kb = r >> 5, nb = r & 31; d.src = I_w_na + (size_t)(64 * kb) * 2048 + 64 * nb; d.ldw = 2048; d.dst = WnmT + 64 * kb; d.ldt = 2048; d.dA = 64 * nb; d.dB = 64 * nb + 32; d.nt = 1; break; } r -= I_NA; \
            { const int kb = r >> 5, nb = r & 31; d.src = I_w_memb + (size_t)(64 * kb) * 2048 + 64 * nb; d.ldw = 2048; d.dst = WnmT + 1024 + 64 * kb; d.ldt = 2048; d.dA = 64 * nb; d.dB = 64 * nb + 32; d.nt = 1; } } while (0)
        {
            f32x4 R0[16], R1[16]; P0Desc d0, d1; int it = gw2;
            if (it < NITEMS) { P0_DECODE(d0, it); p0_load(d0, R0, lane); }
            if (it + NGW2 < NITEMS) { P0_DECODE(d1, it + NGW2); p0_load(d1, R1, lane); }
            for (; it < NITEMS; it += 2 * NGW2) {
                p0_to_lds(R0, scr, lane); const P0Desc c0 = d0;
                if (it + 2 * NGW2 < NITEMS) { P0_DECODE(d0, it + 2 * NGW2); p0_load(d0, R0, lane); }
                LDS_WAIT(); asm volatile("" ::: "memory"); p0_store(c0, scr, lane); LDS_WAIT(); asm volatile("" ::: "memory");
                if (it + NGW2 < NITEMS) {
                    p0_to_lds(R1, scr, lane); const P0Desc c1 = d1;
                    if (it + 3 * NGW2 < NITEMS) { P0_DECODE(d1, it + 3 * NGW2); p0_load(d1, R1, lane); }
                    LDS_WAIT(); asm volatile("" ::: "memory"); p0_store(c1, scr, lane); LDS_WAIT(); asm volatile("" ::: "memory");
                }
            }
        }
#undef P0_DECODE
        for (int m = gw2; m < mk::M; m += NGW2) rms_row_to_bf16(I_x + (size_t)m * 2048, I_g_mix, HN + (size_t)m * 2048, lane);
    }
    GRID_BAR();
    }
    {
    {
        mk::SchedProj S; S.o.init(mk::M, mk::D_IN, G, bx); S.hn_ = (const char*)HN; S.wt_ = (const char*)WinT;
        const pg8::Gemm g{2048, 2048, 2048};
        mk::EpiProj E{ws};
        pg8::gemm_phase<mk::EpiProj, mk::SchedProj, true>(ldsl + RING_OFF, g, S, E);
    }
    GRID_BAR();
    }
    {
    {
        const int c = bx, bh = c >> 4, nc = c & 15, b = bh >> 3, h = bh & 7;
        const float l2f = tab[mk::TAB_L2F + h], l2b = tab[mk::TAB_L2B + h];
        {
            bf16* kt = KT + (size_t)c * 65536; const bf16* ksrc = K0 + ((size_t)b * 4096 + nc * 256) * 1024 + h * 128;
            LAS float* t = scr;
            const int tok0 = wave * 32;
#pragma unroll
            for (int it = 0; it < 8; ++it) { const int tr = 4 * it + (lane >> 4), c8 = (lane & 15) * 8; const v4u w = *(const v4u*)(ksrc + (size_t)(tok0 + tr) * 1024 + c8);
                LAS float* d = t + tr * 128 + (c8 ^ (8 * (tr >> 3))); d[0] = bf2f_(w.x & 0xffffu); d[1] = bf2f_(w.x >> 16); d[2] = bf2f_(w.y & 0xffffu); d[3] = bf2f_(w.y >> 16);
                d[4] = bf2f_(w.z & 0xffffu); d[5] = bf2f_(w.z >> 16); d[6] = bf2f_(w.w & 0xffffu); d[7] = bf2f_(w.w >> 16); }
            LDS_WAIT(); asm volatile("" ::: "memory");
            const int q = lane & 3;
            float df[8], db[8];
#pragma unroll
            for (int i = 0; i < 8; ++i) { const int tk = tok0 + 8 * q + i; df[i] = pg8::fexp2(l2f * (float)(255 - tk)); db[i] = pg8::fexp2(l2b * (float)tk); }
#pragma unroll
            for (int j = 0; j < 8; ++j) { const int dk = (lane >> 2) + 16 * j; const LAS float* s = t + (8 * q) * 128 + (dk ^ (8 * q));
                float v[8];
#pragma unroll
                for (int i = 0; i < 8; ++i) v[i] = s[i * 128];
                v4u o; o.x = pk2(v[0] * df[0], v[1] * df[1]); o.y = pk2(v[2] * df[2], v[3] * df[3]); o.z = pk2(v[4] * df[4], v[5] * df[5]); o.w = pk2(v[6] * df[6], v[7] * df[7]);
                *(GAS v4u*)(kt + (size_t)dk * 256 + tok0 + 8 * q) = o;
                o.x = pk2(v[0] * db[0], v[1] * db[1]); o.y = pk2(v[2] * db[2], v[3] * db[3]); o.z = pk2(v[4] * db[4], v[5] * db[5]); o.w = pk2(v[6] * db[6], v[7] * db[7]);
                *(GAS v4u*)(kt + (size_t)(128 + dk) * 256 + tok0 + 8 * q) = o; }
            VM_WAIT(); LDS_WAIT(); __syncthreads();
        }
        MK_STAMP();
        {
            bf16* arc = AR + ((size_t)bh * 4096 + nc * 256) * 512;
            mk::SchedList3 S; S.n = (bx < 128) ? 3 : 2;
            S.u0.a = (const char*)(BR + (size_t)c * 256 * 512); S.u0.b = (const char*)(KT + (size_t)c * 65536); S.u0.lda = 512; S.u0.ldb = 256; S.u0.nt = 4; S.u0.kind = 0; S.u0.perm = 1;
            S.u1.a = (const char*)(arc + 256); S.u1.b = (const char*)(K0 + ((size_t)b * 4096 + nc * 256) * 1024 + h * 128); S.u1.lda = 512; S.u1.ldb = 1024; S.u1.nt = 2; S.u1.kind = 1; S.u1.perm = 1;
            const int xb = (bx >> 6) & 1, xh = (bx >> 4) & 3, qt = bx & 15; const size_t tok0 = (size_t)xb * 4096 + qt * 256;
            S.u2.a = (const char*)(XQ + tok0 * 1024 + xh * 256); S.u2.b = (const char*)(MKb + (size_t)xb * 256 * 1024 + xh * 256); S.u2.lda = 1024; S.u2.ldb = 1024; S.u2.nt = 4; S.u2.kind = 2; S.u2.perm = 1;
            mk::EpiM1 E{mk::EpiF32{KV + (size_t)c * 65536}, mk::EpiP{arc, l2f, l2b},
                        mk::EpiXS{XP + tok0 * 1024 + xh * 256, xl + tok0 * 16 + xh * 4, ssq_xq + tok0 * 16 + xh * 4, tab + mk::TAB_SSQ_MK + (size_t)xb * 256 * 16 + xh * 4}};
            pg8::gemm_stream<mk::EpiM1, mk::SchedList3, true>(ldsl + RING_OFF, S, E);
        }
        MK_STAMP();
    }
    GRID_BAR();
    }
    {
    {
        for (int e = (vcu * 512 + tid); e < 16 * 65536; e += G * 512) {
            const int bh = e >> 16, r = e & 65535, col = r & 255, h = bh & 7;
            const bool fwd = col < 128; const float dec = pg8::fexp2((fwd ? tab[mk::TAB_L2F + h] : tab[mk::TAB_L2B + h]) * 256.0f);
            const bf16* kvp = KV + (size_t)bh * 16 * 65536 + r; bf16* brp = BR + ((size_t)bh * 16 * 256 + (r >> 8)) * 512 + 256 + col;
            float kvv[16];
#pragma unroll
            for (int n = 0; n < 16; ++n) kvv[n] = bf2f_(__builtin_nontemporal_load(kvp + (size_t)n * 65536));
            float s = 0.f;
            if (fwd) {
#pragma unroll
                for (int n = 0; n < 16; ++n) { brp[(size_t)n * 256 * 512] = (bf16)f2bf(s); s = dec * s + kvv[n]; }
            } else {
#pragma unroll
                for (int n = 15; n >= 0; --n) { brp[(size_t)n * 256 * 512] = (bf16)f2bf(s); s = dec * s + kvv[n]; }
            }
        }
        __syncthreads();
        MK_STAMP();
        { const int b = bx >> 7, h = (bx >> 4) & 7, i4 = bx & 15;
        na::na_unit(b, h, i4, NAQKV, ssq_naq, ssq_nak, I_rpb, ONM, (char*)lds); }
        MK_STAMP();
    }
    GRID_BAR();
    }
    {
    {
        const int c = bx, bh = c >> 4, nc = c & 15, b = bh >> 3, h = bh & 7;
        {
            const int xb = (bx >> 6) & 1, xh = (bx >> 4) & 3, qt = bx & 15; const size_t tok0 = (size_t)xb * 4096 + qt * 256;
            const size_t o0 = ((size_t)b * 4096 + nc * 256) * 2048 + h * 256;
            const bool hx = bx < 128;
            mk::SchedList3 S; S.n = hx ? 2 : 1;
            const char* const ra = (const char*)(AR + ((size_t)bh * 4096 + nc * 256) * 512); const char* const rb = (const char*)(BR + (size_t)c * 256 * 512);
            S.u0.a = hx ? (const char*)(XP + tok0 * 1024 + xh * 256) : ra; S.u0.b = hx ? (const char*)(MVT + (size_t)xh * 256 * 512 + xb * 256) : rb;
            S.u0.lda = hx ? 1024 : 512; S.u0.ldb = 512; S.u0.nt = hx ? 4 : 8; S.u0.kind = hx ? 0 : 1; S.u0.perm = 1;
            S.u1.a = ra; S.u1.b = rb; S.u1.lda = 512; S.u1.ldb = 512; S.u1.nt = 8; S.u1.kind = 1; S.u1.perm = 1;
            S.u2.a = ra; S.u2.b = rb; S.u2.lda = 512; S.u2.ldb = 512; S.u2.nt = 8; S.u2.kind = 1; S.u2.perm = 1;
            mk::EpiM3 E{mk::EpiXO{ONM + tok0 * 2048 + 1024 + xh * 256, xl + tok0 * 16 + xh * 4}, mk::EpiGN{ORET + o0, RG + o0, I_gn + h * 256}};
            pg8::gemm_stream<mk::EpiM3, mk::SchedList3, true>(ldsl + RING_OFF, S, E);
        }
        MK_STAMP();
    }
    GRID_BAR();
    }
    {
    {
        mk::SchedBR S; S.o.init(mk::M, 2048, G, bx); S.onm = (const char*)ONM; S.oret = (const char*)ORET; S.wnm = (const char*)WnmT; S.wret = (const char*)WretT;
        const pg8::Gemm g{2048, 2048, 1024}; mk::EpiGate4 E{MERGED, GATES};
        pg8::gemm_phase<mk::EpiGate4, mk::SchedBR, true>(ldsl + RING_OFF, g, S, E);
    }
    GRID_BAR();
    }
    {
    {
        mk::SchedGrid S; S.o.init(mk::M, 2048, G, bx); S.A = (const char*)MERGED; S.B = (const char*)WoutT; S.ta = 256u * 2048u * 2u; S.tb = 256u * 2048u * 2u;
        const pg8::Gemm g{2048, 2048, 2048}; mk::EpiWout E{I_x, I_out, X1B, ssq_x1, I_g_ffn};
        pg8::gemm_phase<mk::EpiWout, mk::SchedGrid, false>(ldsl + RING_OFF, g, S, E);
    }
    GRID_BAR();
    }
    {
    {
        mk::SchedGrid S; S.o.init(mk::M, 8192, G, bx); S.A = (const char*)X1B; S.B = (const char*)Wff1T; S.ta = 256u * 2048u * 2u; S.tb = 256u * 2048u * 2u;
        const pg8::Gemm g{2048, 2048, 2048}; mk::EpiFF1 E{HFF, ssq_x1};
        pg8::gemm_phase<mk::EpiFF1, mk::SchedGrid, true>(ldsl + RING_OFF, g, S, E);
    }
    GRID_BAR();
    }
    if (false) {
        mk::SchedGrid S; S.o.init(mk::M, 2048, G, bx); S.A = (const char*)HFF; S.B = (const char*)Wff2T; S.ta = 256u * (unsigned)mk::LDH * 2u; S.tb = 256u * 8192u * 2u;
        const pg8::Gemm g{mk::LDH, 8192, 8192}; mk::EpiFF2 E{I_out, (float*)AR};
        pg8::gemm_phase<mk::EpiFF2, mk::SchedGrid, false>(ldsl + RING_OFF, g, S, E);
        GRID_BAR();
    }
    {
        mk::SchedGrid S; S.o.init(mk::M, 2048, G, bx); S.A = (const char*)HFF; S.B = (const char*)Wff2T; S.ta = 256u * (unsigned)mk::LDH * 2u; S.tb = 256u * 8192u * 2u;
        const pg8::Gemm g{mk::LDH, 8192, 8192}; mk::EpiFF2 E{I_out, I_out};
        pg8::gemm_phase<mk::EpiFF2, mk::SchedGrid, false>(ldsl + RING_OFF, g, S, E);
    }
    MK_STAMP();
    if (MK_TS >= 0 && bx == 0 && tid == 0) {
        const unsigned dt = MISC[16 + MK_TS + 1] - MISC[16 + MK_TS]; const unsigned long long t0 = __builtin_amdgcn_s_memrealtime();
        while (__builtin_amdgcn_s_memrealtime() - t0 < 8ull * dt) __builtin_amdgcn_s_sleep(8);
    }
}

extern "C" void kernel_launch(void* const* d_in, const int* in_sizes, int n_in, void* d_out, int out_size, void* d_ws, size_t ws_size, hipStream_t stream) {
    static int grid = 0;
    if (grid == 0) {
        if (n_in != 21 || out_size != mk::M * mk::D || ws_size < mk::WS_END) { fprintf(stderr, "kernel_launch: unexpected shapes (n_in %d out %d ws %zu); nothing launched\n", n_in, out_size, ws_size); grid = -1; return; }
        int dev = 0, cus = 0;
        if (hipGetDevice(&dev) != hipSuccess || hipDeviceGetAttribute(&cus, hipDeviceAttributeMultiprocessorCount, dev) != hipSuccess) { grid = -1; return; }
        if (hipFuncSetAttribute((const void*)mk_fwd, hipFuncAttributeMaxDynamicSharedMemorySize, LDS_BYTES) != hipSuccess) { fprintf(stderr, "kernel_launch: hipFuncSetAttribute failed\n"); grid = -1; return; }
        (void)hipGetLastError();
        grid = cus;
        if (grid != 256) fprintf(stderr, "kernel_launch: %d CUs; this kernel's unit maps assume 256\n", grid);
    }
    if (grid < 0) return;
    if (hipMemsetAsync((char*)d_ws + mk::WS_CTL, 0, mk::CTL_ZERO_BYTES, stream) != hipSuccess) return;
    Args a{};
    for (int i = 0; i < 21; ++i) a.in[i] = (const float*)d_in[i];
    a.out = (float*)d_out; a.ws = (unsigned char*)d_ws;
    hipLaunchKernelGGL(mk_fwd, dim3(grid), dim3(NWAVES * 64), LDS_BYTES, stream, a);
}
```

```cpp
#include <hip/hip_runtime.h>
#include <cstdio>
#include <cstdint>

namespace pg8 {
#define PG8_LAS __attribute__((address_space(3)))
typedef unsigned short bf16_t;
typedef short bf16x8 __attribute__((ext_vector_type(8)));
typedef float f32x4 __attribute__((ext_vector_type(4)));
typedef float f32x2 __attribute__((ext_vector_type(2)));
typedef unsigned u32x4 __attribute__((ext_vector_type(4)));
typedef unsigned u32x2 __attribute__((ext_vector_type(2)));
constexpr int BM = 256, BK = 64, HALF = 128, HTB = HALF * BK * 2, STAGE_BYTES = 8 * HTB, NXCD = 8, WGM = 4;

__host__ __device__ __forceinline__ int lds_byte(int r, int c) { const int st = (r >> 4) * 2 + (c >> 5), rr = r & 15, cc = c & 31, ob = rr * 64 + cc * 2; return st * 1024 + (ob ^ (((ob >> 9) & 1) << 5)); }
__host__ __device__ __forceinline__ void stage_rc(int b, int& R, int& C) { const int st = b / 1024, sb = b % 1024, swz = sb ^ (((sb >> 9) & 1) << 5); R = (st >> 1) * 16 + swz / 64; C = (st & 1) * 32 + (swz % 64) / 2; }
__host__ __device__ __forceinline__ int perm32(int rho) { const int n = rho >> 4, i = rho & 15; return 8 * (i >> 2) + 4 * n + (i & 3); }

struct Unit { int pm, pn, sub; };
struct Gemm { int lda, ldb, K; };

struct GridOrder {
    int nM, nN, nwg, G, c;
    __device__ void init(int M, int N, int G_, int c_) { nM = M / BM; nN = N / BM; nwg = nM * nN; G = G_; c = c_; }
    __device__ bool next(int i, Unit& u) const {
        const long L = (long)i * G + c; if (L >= nwg) return false;
        int wgid = (int)L; { const int q = nwg / NXCD, r = nwg % NXCD, xcd = wgid % NXCD, off = wgid / NXCD; wgid = (xcd < r ? xcd * (q + 1) : r * (q + 1) + (xcd - r) * q) + off; }
        const int nig = WGM * nN, gid = wgid / nig, fm = gid * WGM, gsz = (nM - fm) < WGM ? (nM - fm) : WGM;
        u.pm = fm + ((wgid % nig) % gsz); u.pn = (wgid % nig) / gsz; u.sub = 0; return true;
    }
};

typedef float f32x2_cv __attribute__((ext_vector_type(2))); typedef __bf16 bf16x2_cv __attribute__((ext_vector_type(2)));
__device__ __forceinline__ unsigned cvt_pk_bf16(float lo, float hi) { const f32x2_cv v = {lo, hi}; const bf16x2_cv b = __builtin_convertvector(v, bf16x2_cv); return __builtin_bit_cast(unsigned, b); }
__device__ __forceinline__ void store8(bf16_t* p, f32x4 v0, f32x4 v1) { u32x4 w; w.x = cvt_pk_bf16(v0[0], v0[1]); w.y = cvt_pk_bf16(v0[2], v0[3]); w.z = cvt_pk_bf16(v1[0], v1[1]); w.w = cvt_pk_bf16(v1[2], v1[3]); *(u32x4*)p = w; }
__device__ __forceinline__ void store4(bf16_t* p, f32x4 v0) { u32x2 w; w.x = cvt_pk_bf16(v0[0], v0[1]); w.y = cvt_pk_bf16(v0[2], v0[3]); *(u32x2*)p = w; }
__device__ __forceinline__ float bf2f(unsigned short h) { return __uint_as_float((unsigned)h << 16); }
__device__ __forceinline__ void load8(const bf16_t* p, f32x4& v0, f32x4& v1) { const u32x4 w = *(const u32x4*)p;
    v0[0] = __uint_as_float(w.x << 16); v0[1] = __uint_as_float(w.x & 0xffff0000u); v0[2] = __uint_as_float(w.y << 16); v0[3] = __uint_as_float(w.y & 0xffff0000u);
    v1[0] = __uint_as_float(w.z << 16); v1[1] = __uint_as_float(w.z & 0xffff0000u); v1[2] = __uint_as_float(w.w << 16); v1[3] = __uint_as_float(w.w & 0xffff0000u); }
__device__ __forceinline__ void load8_nt(const bf16_t* p, f32x4& v0, f32x4& v1) { const u32x4 w = __builtin_nontemporal_load((const u32x4*)p);
    v0[0] = __uint_as_float(w.x << 16); v0[1] = __uint_as_float(w.x & 0xffff0000u); v0[2] = __uint_as_float(w.y << 16); v0[3] = __uint_as_float(w.y & 0xffff0000u);
    v1[0] = __uint_as_float(w.z << 16); v1[1] = __uint_as_float(w.z & 0xffff0000u); v1[2] = __uint_as_float(w.w << 16); v1[3] = __uint_as_float(w.w & 0xffff0000u); }
__device__ __forceinline__ void load8_l2(const bf16_t* p, f32x4& v0, f32x4& v1) { u32x4 w; const unsigned long long a = __hip_atomic_load((const unsigned long long*)p, __ATOMIC_RELAXED, __HIP_MEMORY_SCOPE_AGENT), b = __hip_atomic_load((const unsigned long long*)p + 1, __ATOMIC_RELAXED, __HIP_MEMORY_SCOPE_AGENT);
    w.x = (unsigned)a; w.y = (unsigned)(a >> 32); w.z = (unsigned)b; w.w = (unsigned)(b >> 32);
    v0[0] = __uint_as_float(w.x << 16); v0[1] = __uint_as_float(w.x & 0xffff0000u); v0[2] = __uint_as_float(w.y << 16); v0[3] = __uint_as_float(w.y & 0xffff0000u);
    v1[0] = __uint_as_float(w.z << 16); v1[1] = __uint_as_float(w.z & 0xffff0000u); v1[2] = __uint_as_float(w.w << 16); v1[3] = __uint_as_float(w.w & 0xffff0000u); }
__device__ __forceinline__ float fexp2(float x) { return __builtin_amdgcn_exp2f(x); }
__device__ __forceinline__ float frcp(float x) { return __builtin_amdgcn_rcpf(x); }
__device__ __forceinline__ float sigmoidf_(float x) { return frcp(1.f + fexp2(-1.4426950408889634f * x)); }

template <class Epi, class Sched, bool ALIGN_EPI>
__device__ __forceinline__ void gemm_phase(PG8_LAS unsigned char* lds, const Gemm g, const Sched& S, const Epi& E) {
    int tid_ = threadIdx.x; asm volatile("" : "+v"(tid_));
    const int tid = tid_, wid = __builtin_amdgcn_readfirstlane(tid >> 6), lane = tid & 63, wr = wid >> 2, wc = wid & 3, fr = lane & 15, fq = lane >> 4;
    unsigned voffA[2], voffB[2];
#pragma unroll
    for (int i = 0; i < 2; ++i) { int R, C; stage_rc(tid * 16 + i * 8192, R, C); const int Rb = Epi::PERM ? ((R & ~31) + perm32(R & 31)) : R;
        voffA[i] = (unsigned)(R * g.lda + C) * 2u; voffB[i] = (unsigned)(Rb * g.ldb + C) * 2u; }
    const size_t kstep = (size_t)(BK * 2);
    const size_t hstepA = (size_t)HALF * g.lda * 2, hstepB = (size_t)HALF * g.ldb * 2;
    const unsigned ldsw = (unsigned)wid * 1024u;
    const int aoff = lds_byte(wr * 64 + fr, fq * 8), boff = lds_byte(wc * 32 + fr, fq * 8);
#define PG8_SA(b, h) (((b) * 2 + (h)) * HTB)
#define PG8_SB(b, h) ((4 + (b) * 2 + (h)) * HTB)
#define PG8_STAGE(bufoff, gbase, voff) do { _Pragma("unroll") for (int _i = 0; _i < 2; ++_i) \
        __builtin_amdgcn_global_load_lds((const unsigned*)((const char*)(gbase) + (voff)[_i]), (PG8_LAS unsigned*)(lds + (bufoff) + ldsw + _i * 8192), 16, 0, 0); } while (0)
#define PG8_LDA(dst, b, h) do { _Pragma("unroll") for (int m = 0; m < 4; ++m) _Pragma("unroll") for (int k = 0; k < 2; ++k) dst[m][k] = *(const PG8_LAS bf16x8*)(lds + PG8_SA(b, h) + aoff + m * 2048 + k * 1024); } while (0)
#define PG8_LDB(dst, b, h) do { _Pragma("unroll") for (int n = 0; n < 2; ++n) _Pragma("unroll") for (int k = 0; k < 2; ++k) dst[n][k] = *(const PG8_LAS bf16x8*)(lds + PG8_SB(b, h) + boff + n * 2048 + k * 1024); } while (0)
#define PG8_MMA(ai, bj, At, Bt) do { __builtin_amdgcn_s_setprio(1); _Pragma("unroll") for (int m = 0; m < 4; ++m) _Pragma("unroll") for (int n = 0; n < 2; ++n) _Pragma("unroll") for (int k = 0; k < 2; ++k) \
        acc[ai][bj][m][n] = __builtin_amdgcn_mfma_f32_16x16x32_bf16(Bt[n][k], At[m][k], acc[ai][bj][m][n], 0, 0, 0); __builtin_amdgcn_s_setprio(0); } while (0)
#define PG8_WAIT_V(n) asm volatile("s_waitcnt vmcnt(" #n ")" ::: "memory")
#define PG8_WAIT_L(n) asm volatile("s_waitcnt lgkmcnt(" #n ")" ::: "memory")
#define PG8_BAR __builtin_amdgcn_s_barrier()
#define PG8_SCHED __builtin_amdgcn_sched_barrier(0)
    Unit cur, nxt; int ui = 0;
    if (!S.next(0, cur)) return;
    f32x4 acc[2][2][4][2];
    if constexpr (Epi::INIT_C) { int fr2 = fr, fq2 = fq; asm volatile("" : "+v"(fr2), "+v"(fq2)); E.init_c(acc, cur, wr, wc, fr2, fq2); }
    else {
#pragma unroll
    for (int a = 0; a < 2; ++a)
#pragma unroll
        for (int b = 0; b < 2; ++b)
#pragma unroll
            for (int m = 0; m < 4; ++m)
#pragma unroll
                for (int n = 0; n < 2; ++n) acc[a][b][m][n] = (f32x4){0.f, 0.f, 0.f, 0.f};
    }
    bf16x8 At[4][2], B0[2][2], B1[2][2];
    const char* cA; const char* cB; S.ptrs(cur, cA, cB);
    PG8_STAGE(PG8_SB(0, 0), cB, voffB); PG8_STAGE(PG8_SB(0, 1), cB + hstepB, voffB); PG8_STAGE(PG8_SA(0, 0), cA, voffA); PG8_STAGE(PG8_SA(0, 1), cA + hstepA, voffA);
    if (wr == 1) PG8_BAR;
    PG8_WAIT_V(2); PG8_BAR;
    PG8_STAGE(PG8_SB(1, 0), cB + kstep, voffB); PG8_STAGE(PG8_SA(1, 0), cA + kstep, voffA); PG8_STAGE(PG8_SB(1, 1), cB + hstepB + kstep, voffB);
    PG8_WAIT_V(6); PG8_BAR;
    for (;;) {
        const bool has_next = S.next(ui + 1, nxt); const int nt = S.nt(cur, g.K) ;
        const char* nA = cA; const char* nB = cB; if (has_next) S.ptrs(nxt, nA, nB);
        for (int t = 0; t < nt; t += 2) {
            const bool last = (t == nt - 2);
            const char* a1 = cA + (size_t)(t + 1) * kstep;
            const char* a2 = last ? nA : cA + (size_t)(t + 2) * kstep; const char* b2 = last ? nB : cB + (size_t)(t + 2) * kstep;
            const char* a3 = a2 + kstep; const char* b3 = b2 + kstep;
            PG8_LDB(B0, 0, 0); PG8_LDB(B1, 0, 1); PG8_SCHED; PG8_LDA(At, 0, 0); PG8_STAGE(PG8_SA(1, 1), a1 + hstepA, voffA);
            PG8_WAIT_V(8); PG8_WAIT_L(0); PG8_BAR; PG8_MMA(0, 0, At, B0); PG8_MMA(0, 1, At, B1); PG8_BAR; PG8_SCHED;
            PG8_LDA(At, 0, 1); PG8_STAGE(PG8_SB(0, 0), b2, voffB); PG8_STAGE(PG8_SB(0, 1), b2 + hstepB, voffB); PG8_STAGE(PG8_SA(0, 0), a2, voffA);
            PG8_WAIT_V(8); PG8_WAIT_L(0); PG8_BAR; PG8_MMA(1, 0, At, B0); PG8_MMA(1, 1, At, B1); PG8_BAR; PG8_SCHED;
            PG8_LDB(B0, 1, 0); PG8_LDB(B1, 1, 1); PG8_SCHED; PG8_LDA(At, 1, 0); PG8_STAGE(PG8_SA(0, 1), a2 + hstepA, voffA);
            PG8_WAIT_V(8); PG8_WAIT_L(0); PG8_BAR; PG8_MMA(0, 0, At, B0); PG8_MMA(0, 1, At, B1); PG8_BAR; PG8_SCHED;
            PG8_LDA(At, 1, 1); PG8_STAGE(PG8_SB(1, 0), b3, voffB); PG8_STAGE(PG8_SB(1, 1), b3 + hstepB, voffB); PG8_STAGE(PG8_SA(1, 0), a3, voffA);
            PG8_WAIT_V(8); PG8_WAIT_L(0); PG8_BAR; PG8_MMA(1, 0, At, B0); PG8_MMA(1, 1, At, B1); PG8_BAR; PG8_SCHED;
        }
        if constexpr (ALIGN_EPI) { if (wr == 0) PG8_BAR; }
        if constexpr (!Epi::AFTER_DRAIN) { int fr2 = fr, fq2 = fq; asm volatile("" : "+v"(fr2), "+v"(fq2)); E(acc, cur, wr, wc, fr2, fq2); }
        if (!has_next) break;
        if constexpr (Epi::INIT_C) { int fr2 = fr, fq2 = fq; asm volatile("" : "+v"(fr2), "+v"(fq2)); E.init_c(acc, nxt, wr, wc, fr2, fq2); }
        else {
#pragma unroll
        for (int a = 0; a < 2; ++a)
#pragma unroll
            for (int b = 0; b < 2; ++b)
#pragma unroll
                for (int m = 0; m < 4; ++m)
#pragma unroll
                    for (int n = 0; n < 2; ++n) acc[a][b][m][n] = (f32x4){0.f, 0.f, 0.f, 0.f};
        }
        cur = nxt; cA = nA; cB = nB; ++ui;
        if constexpr (ALIGN_EPI) { if (wr == 1) PG8_BAR; }
    }
    PG8_WAIT_V(0);
    if constexpr (!ALIGN_EPI) { if (wr == 0) PG8_BAR; }
    PG8_BAR;
    if constexpr (Epi::AFTER_DRAIN) { int fr2 = fr, fq2 = fq; asm volatile("" : "+v"(fr2), "+v"(fq2)); E.fused(acc, cur, wr, wc, fr2, fq2, lds, wid, lane); }
#undef PG8_SA
#undef PG8_SB
#undef PG8_STAGE
#undef PG8_LDA
#undef PG8_LDB
#undef PG8_MMA
#undef PG8_WAIT_V
#undef PG8_WAIT_L
#undef PG8_BAR
#undef PG8_SCHED
}
struct UnitG { const char* a; const char* b; int lda, ldb, nt, kind, perm; };
template <class Epi, class Sched, bool ALIGN_EPI>
__device__ __forceinline__ void gemm_stream(PG8_LAS unsigned char* lds, const Sched& S, const Epi& E) {
    int tid_ = threadIdx.x; asm volatile("" : "+v"(tid_));
    const int tid = tid_, wid = __builtin_amdgcn_readfirstlane(tid >> 6), lane = tid & 63, wr = wid >> 2, wc = wid & 3, fr = lane & 15, fq = lane >> 4;
#define PG8_VOFF(u, vA, vB) do { _Pragma("unroll") for (int i_ = 0; i_ < 2; ++i_) { int R_, C_; stage_rc(tid * 16 + i_ * 8192, R_, C_); const int Rb_ = (u).perm ? ((R_ & ~31) + perm32(R_ & 31)) : R_; \
        vA[i_] = (unsigned)(R_ * (u).lda + C_) * 2u; vB[i_] = (unsigned)(Rb_ * (u).ldb + C_) * 2u; } } while (0)
    const size_t kstep = (size_t)(BK * 2);
    const unsigned ldsw = (unsigned)wid * 1024u;
    const int aoff = lds_byte(wr * 64 + fr, fq * 8), boff = lds_byte(wc * 32 + fr, fq * 8);
#undef PG8_SA
#undef PG8_SB
#undef PG8_STAGE
#undef PG8_LDA
#undef PG8_LDB
#undef PG8_MMA
#undef PG8_WAIT_V
#undef PG8_WAIT_L
#undef PG8_BAR
#undef PG8_SCHED
#define PG8_SA(b, h) (((b) * 2 + (h)) * HTB)
#define PG8_SB(b, h) ((4 + (b) * 2 + (h)) * HTB)
#define PG8_STAGE(bufoff, gbase, voff) do { _Pragma("unroll") for (int _i = 0; _i < 2; ++_i) \
        __builtin_amdgcn_global_load_lds((const unsigned*)((const char*)(gbase) + (voff)[_i]), (PG8_LAS unsigned*)(lds + (bufoff) + ldsw + _i * 8192), 16, 0, 0); } while (0)
#define PG8_LDA(dst, b, h) do { _Pragma("unroll") for (int m = 0; m < 4; ++m) _Pragma("unroll") for (int k = 0; k < 2; ++k) dst[m][k] = *(const PG8_LAS bf16x8*)(lds + PG8_SA(b, h) + aoff + m * 2048 + k * 1024); } while (0)
#define PG8_LDB(dst, b, h) do { _Pragma("unroll") for (int n = 0; n < 2; ++n) _Pragma("unroll") for (int k = 0; k < 2; ++k) dst[n][k] = *(const PG8_LAS bf16x8*)(lds + PG8_SB(b, h) + boff + n * 2048 + k * 1024); } while (0)
#define PG8_MMA(ai, bj, At, Bt) do { __builtin_amdgcn_s_setprio(1); _Pragma("unroll") for (int m = 0; m < 4; ++m) _Pragma("unroll") for (int n = 0; n < 2; ++n) _Pragma("unroll") for (int k = 0; k < 2; ++k) \
        acc[ai][bj][m][n] = __builtin_amdgcn_mfma_f32_16x16x32_bf16(Bt[n][k], At[m][k], acc[ai][bj][m][n], 0, 0, 0); __builtin_amdgcn_s_setprio(0); } while (0)
#define PG8_WAIT_V(n) asm volatile("s_waitcnt vmcnt(" #n ")" ::: "memory")
#define PG8_WAIT_L(n) asm volatile("s_waitcnt lgkmcnt(" #n ")" ::: "memory")
#define PG8_BAR __builtin_amdgcn_s_barrier()
#define PG8_SCHED __builtin_amdgcn_sched_barrier(0)
    UnitG cur, nxt; int ui = 0;
    if (!S.next(0, cur)) return;
    unsigned voffA[2], voffB[2]; PG8_VOFF(cur, voffA, voffB);
    size_t hstepA = (size_t)HALF * cur.lda * 2, hstepB = (size_t)HALF * cur.ldb * 2;
    f32x4 acc[2][2][4][2];
#pragma unroll
    for (int a = 0; a < 2; ++a)
#pragma unroll
        for (int b = 0; b < 2; ++b)
#pragma unroll
            for (int m = 0; m < 4; ++m)
#pragma unroll
                for (int n = 0; n < 2; ++n) acc[a][b][m][n] = (f32x4){0.f, 0.f, 0.f, 0.f};
    bf16x8 At[4][2], B0[2][2], B1[2][2];
    const char* cA = cur.a; const char* cB = cur.b;
    PG8_STAGE(PG8_SB(0, 0), cB, voffB); PG8_STAGE(PG8_SB(0, 1), cB + hstepB, voffB); PG8_STAGE(PG8_SA(0, 0), cA, voffA); PG8_STAGE(PG8_SA(0, 1), cA + hstepA, voffA);
    if (wr == 1) PG8_BAR;
    PG8_WAIT_V(2); PG8_BAR;
    PG8_STAGE(PG8_SB(1, 0), cB + kstep, voffB); PG8_STAGE(PG8_SA(1, 0), cA + kstep, voffA); PG8_STAGE(PG8_SB(1, 1), cB + hstepB + kstep, voffB);
    PG8_WAIT_V(6); PG8_BAR;
    for (;;) {
        const bool has_next = S.next(ui + 1, nxt); const int nt = cur.nt; if (!has_next) nxt = cur;
        const char* nA = nxt.a; const char* nB = nxt.b;
        const size_t nhA = (size_t)HALF * nxt.lda * 2, nhB = (size_t)HALF * nxt.ldb * 2;
        for (int t = 0; t < nt; t += 2) {
            const bool last = (t == nt - 2);
            const char* a1 = cA + (size_t)(t + 1) * kstep;
            const char* a2 = last ? nA : cA + (size_t)(t + 2) * kstep; const char* b2 = last ? nB : cB + (size_t)(t + 2) * kstep;
            const char* a3 = a2 + kstep; const char* b3 = b2 + kstep;
            unsigned xvA[2], xvB[2]; if (last) { PG8_VOFF(nxt, xvA, xvB); } else { xvA[0] = voffA[0]; xvA[1] = voffA[1]; xvB[0] = voffB[0]; xvB[1] = voffB[1]; }
            const size_t xhA = last ? nhA : hstepA, xhB = last ? nhB : hstepB;
            PG8_LDB(B0, 0, 0); PG8_LDB(B1, 0, 1); PG8_SCHED; PG8_LDA(At, 0, 0); PG8_STAGE(PG8_SA(1, 1), a1 + hstepA, voffA);
            PG8_WAIT_V(8); PG8_WAIT_L(0); PG8_BAR; PG8_MMA(0, 0, At, B0); PG8_MMA(0, 1, At, B1); PG8_BAR; PG8_SCHED;
            PG8_LDA(At, 0, 1); PG8_STAGE(PG8_SB(0, 0), b2, xvB); PG8_STAGE(PG8_SB(0, 1), b2 + xhB, xvB); PG8_STAGE(PG8_SA(0, 0), a2, xvA);
            PG8_WAIT_V(8); PG8_WAIT_L(0); PG8_BAR; PG8_MMA(1, 0, At, B0); PG8_MMA(1, 1, At, B1); PG8_BAR; PG8_SCHED;
            PG8_LDB(B0, 1, 0); PG8_LDB(B1, 1, 1); PG8_SCHED; PG8_LDA(At, 1, 0); PG8_STAGE(PG8_SA(0, 1), a2 + xhA, xvA);
            PG8_WAIT_V(8); PG8_WAIT_L(0); PG8_BAR; PG8_MMA(0, 0, At, B0); PG8_MMA(0, 1, At, B1); PG8_BAR; PG8_SCHED;
            PG8_LDA(At, 1, 1); PG8_STAGE(PG8_SB(1, 0), b3, xvB); PG8_STAGE(PG8_SB(1, 1), b3 + xhB, xvB); PG8_STAGE(PG8_SA(1, 0), a3, xvA);
            PG8_WAIT_V(8); PG8_WAIT_L(0); PG8_BAR; PG8_MMA(1, 0, At, B0); PG8_MMA(1, 1, At, B1); PG8_BAR; PG8_SCHED;
        }
        if constexpr (ALIGN_EPI) { if (wr == 0) PG8_BAR; }
        if (!E.after_drain(cur)) { int fr2 = fr, fq2 = fq; asm volatile("" : "+v"(fr2), "+v"(fq2)); E(acc, cur, wr, wc, fr2, fq2); }
        if (!has_next) break;
#pragma unroll
        for (int a = 0; a < 2; ++a)
#pragma unroll
            for (int b = 0; b < 2; ++b)
#pragma unroll
                for (int m = 0; m < 4; ++m)
#pragma unroll
                    for (int n = 0; n < 2; ++n) acc[a][b][m][n] = (f32x4){0.f, 0.f, 0.f, 0.f};
        cur = nxt; cA = nA; cB = nB; ++ui; PG8_VOFF(cur, voffA, voffB); hstepA = nhA; hstepB = nhB;
        if constexpr (ALIGN_EPI) { if (wr == 1) PG8_BAR; }
    }
    PG8_WAIT_V(0);
    if constexpr (!ALIGN_EPI) { if (wr == 0) PG8_BAR; }
    PG8_BAR;
    if (E.after_drain(cur)) { int fr2 = fr, fq2 = fq; asm volatile("" : "+v"(fr2), "+v"(fq2)); E.fused(acc, cur, wr, wc, fr2, fq2, lds, wid, lane); }
#undef PG8_SA
#undef PG8_SB
#undef PG8_STAGE
#undef PG8_LDA
#undef PG8_LDB
#undef PG8_MMA
#undef PG8_WAIT_V
#undef PG8_WAIT_L
#undef PG8_BAR
#undef PG8_SCHED
#undef PG8_VOFF
}
}

namespace mk {
using pg8::bf16_t; using pg8::f32x4; using pg8::f32x2; using pg8::u32x4; using pg8::u32x2; using pg8::Unit;
constexpr int D = 2048, BATCH = 2, SEQ = 4096, M = BATCH * SEQ, D_IN = 16384, D_FF = 8192, N_MEM = 256;
constexpr float EPS = 1e-6f, LOG2E = 1.4426950408889634f;
constexpr size_t MiB = 1u << 20;
constexpr size_t WS_CTL = 0, CTL_ZERO_BYTES = 1 * MiB;
constexpr size_t WS_COS = 1 * MiB, WS_SIN = 2 * MiB;
constexpr size_t WS_SSQ_NAQ = 3 * MiB, WS_SSQ_NAK = 4 * MiB;
constexpr size_t WS_SSQ_XQ = 5 * MiB, WS_XL = 5 * MiB + 512 * 1024;
constexpr size_t WS_SSQ_X1 = 6 * MiB;
constexpr size_t WS_TAB = 6 * MiB + 512 * 1024;
constexpr int TAB_CS_NAQ = 0, TAB_CS_MK = 128, TAB_L2F = 384, TAB_L2B = 392, TAB_SSQ_MK = 1024;
constexpr size_t WS_MEMN = 8 * MiB, WS_MK = 10 * MiB, WS_MVT = 11 * MiB;
constexpr size_t WS_WIN = 16 * MiB, WS_WFF1 = 80 * MiB, WS_WFF2 = 112 * MiB, WS_WRET = 144 * MiB, WS_WOUT = 152 * MiB, WS_WNM = 160 * MiB  , WS_WMKV = 168 * MiB;
constexpr size_t WS_NAQKV = 176 * MiB, WS_K0 = 224 * MiB, WS_RG = 240 * MiB, WS_XQ = 272 * MiB, WS_GATES = 288 * MiB;
constexpr size_t WS_AR = 384 * MiB, WS_BR = 448 * MiB, WS_END = 512 * MiB;
constexpr size_t WS_KV = WS_WIN;
constexpr size_t WS_ORET = 16 * MiB;
constexpr size_t WS_MERGED = WS_NAQKV;
constexpr size_t WS_X1B = WS_AR;
constexpr size_t WS_HFF = 176 * MiB;
constexpr int LDH = 8192;
constexpr size_t DO_HN = 0, DO_KT = 0, DO_XP = 32 * MiB, DO_ONM = 0;

struct SchedGrid {
    pg8::GridOrder o; const char* A; const char* B; size_t ta, tb;
    __device__ __forceinline__ bool next(int i, Unit& u) const { return o.next(i, u); }
    __device__ __forceinline__ void ptrs(const Unit& u, const char*& a, const char*& b) const { a = A + (size_t)u.pm * ta; b = B + (size_t)u.pn * tb; }
    __device__ __forceinline__ int nt(const Unit&, int K) const { return K / 64; }
};
struct SchedProj {
    pg8::GridOrder o; const char* hn_; const char* wt_;
    __device__ __forceinline__ bool next(int i, Unit& u) const { return o.next(i, u); }
    __device__ __forceinline__ void ptrs(const Unit& u, const char*& a, const char*& b) const {
        const char* h = hn_ + (size_t)u.pm * (256u * 2048u * 2u); const char* w = wt_ + (size_t)u.pn * (256u * 2048u * 2u);
        const bool sw = (u.pn >= 20 && u.pn < 28); a = sw ? w : h; b = sw ? h : w; }
    __device__ __forceinline__ int nt(const Unit&, int K) const { return K / 64; }
};
struct SchedOne { bool has; Unit u; const char* a; const char* b;
    __device__ __forceinline__ bool next(int i, Unit& uu) const { if (i != 0 || !has) return false; uu = u; return true; }
    __device__ __forceinline__ void ptrs(const Unit&, const char*& aa, const char*& bb) const { aa = a; bb = b; }
    __device__ __forceinline__ int nt(const Unit&, int K) const { return K / 64; }
};

#define MK_ROWS_BEGIN _Pragma("unroll") for (int ai = 0; ai < 2; ++ai) { _Pragma("unroll") for (int m = 0; m < 4; ++m) { const int rl = ai * 128 + wr * 64 + m * 16 + fr;
#define MK_ROWS_END __builtin_amdgcn_sched_barrier(0); } }
#define MK_ROWS_END_NB } }
#define MK_ROWS_END2 if (m & 1) __builtin_amdgcn_sched_barrier(0); } }
#define MK_RL(ai, m) ((ai) * 128 + wr * 64 + (m) * 16 + fr)
__device__ __forceinline__ float sq8(const f32x4& a, const f32x4& b) { return (a[0] * a[0] + a[1] * a[1]) + (a[2] * a[2] + a[3] * a[3]) + (b[0] * b[0] + b[1] * b[1]) + (b[2] * b[2] + b[3] * b[3]); }
__device__ __forceinline__ float red_fq(float s) {
    { auto r = __builtin_amdgcn_permlane16_swap(__float_as_uint(s), __float_as_uint(s), false, false); s = __uint_as_float(r[0]) + __uint_as_float(r[1]); }
    { auto r = __builtin_amdgcn_permlane32_swap(__float_as_uint(s), __float_as_uint(s), false, false); s = __uint_as_float(r[0]) + __uint_as_float(r[1]); }
    return s; }

struct EpiProj {
    static constexpr bool PERM = true, AFTER_DRAIN = false, INIT_C = false;
    unsigned char* ws;
    __device__ __forceinline__ void operator()(const f32x4 (&acc)[2][2][4][2], const Unit& u, int wr, int wc, int fr, int fq) const {
        bf16_t* const naqkv = (bf16_t*)(ws + WS_NAQKV); bf16_t* const k0 = (bf16_t*)(ws + WS_K0); bf16_t* const rg = (bf16_t*)(ws + WS_RG); bf16_t* const xq = (bf16_t*)(ws + WS_XQ);
        bf16_t* const gates = (bf16_t*)(ws + WS_GATES); bf16_t* const ar = (bf16_t*)(ws + WS_AR); bf16_t* const br = (bf16_t*)(ws + WS_BR);
        float* const ssq_naq = (float*)(ws + WS_SSQ_NAQ); float* const ssq_nak = (float*)(ws + WS_SSQ_NAK); float* const ssq_xq = (float*)(ws + WS_SSQ_XQ);
        const float* const cosT = (const float*)(ws + WS_COS); const float* const sinT = (const float*)(ws + WS_SIN); const float* const tab = (const float*)(ws + WS_TAB);
        const int pn = u.pn, row0 = u.pm * 256, cw = wc * 32 + 8 * fq;
        if (pn < 8) {
            const bool isq = pn < 4; float* ssq = isq ? ssq_naq : ssq_nak; const int hb = isq ? 2 * pn : 2 * (pn - 4);
            f32x4 c0 = (f32x4){1.f, 1.f, 1.f, 1.f}, c1 = c0; if (isq) { c0 = *(const f32x4*)(tab + TAB_CS_NAQ + cw); c1 = *(const f32x4*)(tab + TAB_CS_NAQ + cw + 4); }
            MK_ROWS_BEGIN  const int row = row0 + rl;
#pragma unroll
                for (int bj = 0; bj < 2; ++bj) { const f32x4 v0 = acc[ai][bj][m][0], v1 = acc[ai][bj][m][1]; const float q = red_fq(sq8(v0, v1));
                    if (fq == 0) ssq[(size_t)row * 32 + (hb + bj) * 4 + wc] = q;
                    pg8::store8(naqkv + (size_t)row * 3072 + pn * 256 + bj * 128 + cw, v0 * c0, v1 * c1); }  MK_ROWS_END
        } else if (pn < 12) {
            MK_ROWS_BEGIN  const int row = row0 + rl;
#pragma unroll
                for (int bj = 0; bj < 2; ++bj) pg8::store8(naqkv + (size_t)row * 3072 + pn * 256 + bj * 128 + cw, acc[ai][bj][m][0], acc[ai][bj][m][1]);  MK_ROWS_END
        } else if (pn < 20) {
            const bool isq = pn < 16; const int head = 2 * (pn & 3) + (wc >> 1), i0 = 32 * (wc & 1) + 8 * fq;
            const float l2f = tab[TAB_L2F + head], l2b = tab[TAB_L2B + head];
            MK_ROWS_BEGIN  const int row = row0 + rl, s = row & 4095, b = row >> 12;
                const f32x4 cs0 = *(const f32x4*)(cosT + s * 64 + i0), cs1 = *(const f32x4*)(cosT + s * 64 + i0 + 4), sn0 = *(const f32x4*)(sinT + s * 64 + i0), sn1 = *(const f32x4*)(sinT + s * 64 + i0 + 4);
                const f32x4 a0 = acc[ai][0][m][0], a1 = acc[ai][0][m][1], b0 = acc[ai][1][m][0], b1 = acc[ai][1][m][1];
                const f32x4 lo0 = a0 * cs0 - b0 * sn0, lo1 = a1 * cs1 - b1 * sn1, hi0 = a0 * sn0 + b0 * cs0, hi1 = a1 * sn1 + b1 * cs1;
                if (isq) { const int c = row & 255; const float df = pg8::fexp2(l2f * (float)(c + 1)), db = pg8::fexp2(l2b * (float)(256 - c));
                    bf16_t* d = ar + ((size_t)(b * 8 + head) * 4096 + s) * 512 + 256 + i0;
                    pg8::store8(d, lo0 * df, lo1 * df); pg8::store8(d + 64, hi0 * df, hi1 * df); pg8::store8(d + 128, lo0 * db, lo1 * db); pg8::store8(d + 192, hi0 * db, hi1 * db);
                } else { const float sc = 0.08838834764831845f; bf16_t* d = k0 + (size_t)row * 1024 + head * 128 + i0;
                    pg8::store8(d, lo0 * sc, lo1 * sc); pg8::store8(d + 64, hi0 * sc, hi1 * sc); }  MK_ROWS_END2
        } else if (pn < 28) {
            const int hv = pn - 20, b = u.pm >> 4, nc = u.pm & 15;
            bf16_t* base = br + ((size_t)((b * 8 + hv) * 16 + nc) * 256) * 512;
            MK_ROWS_BEGIN
#pragma unroll
                for (int bj = 0; bj < 2; ++bj) pg8::store8(base + (size_t)rl * 512 + bj * 128 + cw, acc[ai][bj][m][0], acc[ai][bj][m][1]);  MK_ROWS_END
        } else if (pn < 36) {
            MK_ROWS_BEGIN  const int row = row0 + rl;
#pragma unroll
                for (int bj = 0; bj < 2; ++bj) { f32x4 v0 = acc[ai][bj][m][0], v1 = acc[ai][bj][m][1];
#pragma unroll
                    for (int e = 0; e < 4; ++e) { v0[e] = v0[e] * pg8::sigmoidf_(v0[e]); v1[e] = v1[e] * pg8::sigmoidf_(v1[e]); }
                    pg8::store8(rg + (size_t)row * 2048 + (pn - 28) * 256 + bj * 128 + cw, v0, v1); }  MK_ROWS_END
        } else if (pn < 40) {
            MK_ROWS_BEGIN  const int row = row0 + rl;
                const float q = red_fq(sq8(acc[ai][0][m][0], acc[ai][0][m][1]) + sq8(acc[ai][1][m][0], acc[ai][1][m][1]));
                if (fq == 0) ssq_xq[(size_t)row * 16 + (pn - 36) * 4 + wc] = q;
#pragma unroll
                for (int bj = 0; bj < 2; ++bj) pg8::store8(xq + (size_t)row * 1024 + (pn - 36) * 256 + bj * 128 + cw, acc[ai][bj][m][0], acc[ai][bj][m][1]);  MK_ROWS_END
        } else {
            MK_ROWS_BEGIN  const int row = row0 + rl;
#pragma unroll
                for (int bj = 0; bj < 2; ++bj) { f32x4 v0 = acc[ai][bj][m][0], v1 = acc[ai][bj][m][1];
#pragma unroll
                    for (int e = 0; e < 4; ++e) { v0[e] = pg8::sigmoidf_(v0[e]); v1[e] = pg8::sigmoidf_(v1[e]); }
                    pg8::store8(gates + (size_t)row * 6144 + (pn - 40) * 256 + bj * 128 + cw, v0, v1); }  MK_ROWS_END
        }
    }
};
struct EpiMKV {
    static constexpr bool PERM = true, AFTER_DRAIN = false, INIT_C = false;
    bf16_t *mk, *mvt; float* tabw; const float* tab; int mode;
    __device__ __forceinline__ void operator()(const f32x4 (&acc)[2][2][4][2], const Unit& u, int wr, int wc, int fr, int fq) const {
        const int cw = wc * 32 + 8 * fq, row0 = u.pm * 256;
        if (mode == 0) {
            MK_ROWS_BEGIN  const int row = row0 + rl;
                const float q = red_fq(sq8(acc[ai][0][m][0], acc[ai][0][m][1]) + sq8(acc[ai][1][m][0], acc[ai][1][m][1]));
                if (fq == 0) tabw[TAB_SSQ_MK + row * 16 + u.pn * 4 + wc] = q;
#pragma unroll
                for (int bj = 0; bj < 2; ++bj) { const f32x4 c0 = *(const f32x4*)(tab + TAB_CS_MK + bj * 128 + cw), c1 = *(const f32x4*)(tab + TAB_CS_MK + bj * 128 + cw + 4);
                    pg8::store8(mk + (size_t)row * 1024 + u.pn * 256 + bj * 128 + cw, acc[ai][bj][m][0] * c0, acc[ai][bj][m][1] * c1); }  MK_ROWS_END
        } else {
            MK_ROWS_BEGIN  const int row = row0 + rl;
#pragma unroll
                for (int bj = 0; bj < 2; ++bj) pg8::store8(mvt + (size_t)row * 512 + u.pn * 256 + bj * 128 + cw, acc[ai][bj][m][0], acc[ai][bj][m][1]);  MK_ROWS_END
        }
    }
};
struct EpiF32 {
    static constexpr bool PERM = true, AFTER_DRAIN = false, INIT_C = false;
    bf16_t* C;
    __device__ __forceinline__ void operator()(const f32x4 (&acc)[2][2][4][2], const Unit&, int wr, int wc, int fr, int fq) const {
        const int cw = wc * 32 + 8 * fq;
        MK_ROWS_BEGIN
#pragma unroll
            for (int bj = 0; bj < 2; ++bj) pg8::store8(C + (size_t)rl * 256 + bj * 128 + cw, acc[ai][bj][m][0], acc[ai][bj][m][1]);  MK_ROWS_END
    }
};
struct EpiP {
    static constexpr bool PERM = true, AFTER_DRAIN = false, INIT_C = false;
    bf16_t* P; float l2f, l2b;
    __device__ __forceinline__ void operator()(const f32x4 (&acc)[2][2][4][2], const Unit&, int wr, int wc, int fr, int fq) const {
        const int cw = wc * 32 + 8 * fq;
        MK_ROWS_BEGIN  const int c = rl; const float rowf = -l2f * (float)(c + 1);
#pragma unroll
            for (int bj = 0; bj < 2; ++bj) { f32x4 v[2] = {acc[ai][bj][m][0], acc[ai][bj][m][1]};
#pragma unroll
                for (int n = 0; n < 2; ++n)
#pragma unroll
                    for (int e = 0; e < 4; ++e) { const int cp = bj * 128 + cw + 4 * n + e;
                        const float ex = (c >= cp) ? (-l2f * (float)(cp + 1)) : (l2b * (float)(cp - c) + rowf);
                        v[n][e] *= pg8::fexp2(ex); }
                pg8::store8(P + (size_t)c * 512 + bj * 128 + cw, v[0], v[1]); }  MK_ROWS_END
    }
};
struct EpiGN {
    static constexpr bool PERM = true, AFTER_DRAIN = true, INIT_C = false;
    bf16_t* oret; const bf16_t* rgv; const float* gn;
    __device__ __forceinline__ void fused(f32x4 (&acc)[2][2][4][2], const Unit&, int wr, int wc, int fr, int fq, PG8_LAS unsigned char* lds, int wid, int lane) const {
        PG8_LAS f32x2* P = (PG8_LAS f32x2*)lds;
        const int cw = wc * 32 + 8 * fq;
        MK_ROWS_BEGIN  float s = 0.f;
#pragma unroll
            for (int bj = 0; bj < 2; ++bj)
#pragma unroll
                for (int n = 0; n < 2; ++n) { const f32x4 x = acc[ai][bj][m][n]; s += (x[0] + x[1]) + (x[2] + x[3]); }
            s = red_fq(s); const float mw = s * (1.0f / 64.0f); float q = 0.f;
#pragma unroll
            for (int bj = 0; bj < 2; ++bj)
#pragma unroll
                for (int n = 0; n < 2; ++n) { const f32x4 d = acc[ai][bj][m][n] - mw; q += (d[0] * d[0] + d[1] * d[1]) + (d[2] * d[2] + d[3] * d[3]); }
            q = red_fq(q);
            if (fq == 0) P[rl * 4 + wc] = (f32x2){mw, q};  MK_ROWS_END
        asm volatile("s_waitcnt lgkmcnt(0)" ::: "memory"); __builtin_amdgcn_s_barrier(); asm volatile("" ::: "memory");
        f32x4 g0[2], g1[2];
#pragma unroll
        for (int bj = 0; bj < 2; ++bj) { g0[bj] = *(const f32x4*)(gn + bj * 128 + cw); g1[bj] = *(const f32x4*)(gn + bj * 128 + cw + 4); }
        MK_ROWS_BEGIN  const f32x2 a = P[rl * 4 + 0], b = P[rl * 4 + 1], c = P[rl * 4 + 2], d = P[rl * 4 + 3];
            const float mt = (a.x + b.x + c.x + d.x) * 0.25f;
            const float da = a.x - mt, db = b.x - mt, dc = c.x - mt, dd = d.x - mt;
            const float m2 = (a.y + b.y) + (c.y + d.y) + 64.0f * ((da * da + db * db) + (dc * dc + dd * dd));
            const float rstd = 1.0f / sqrtf(m2 * (1.0f / 256.0f) + EPS);
#pragma unroll
            for (int bj = 0; bj < 2; ++bj) { f32x4 r0, r1; pg8::load8(rgv + (size_t)rl * 2048 + bj * 128 + cw, r0, r1);
                const f32x4 o0 = (acc[ai][bj][m][0] - mt) * rstd * g0[bj] * r0, o1 = (acc[ai][bj][m][1] - mt) * rstd * g1[bj] * r1;
                pg8::store8(oret + (size_t)rl * 2048 + bj * 128 + cw, o0, o1); }  MK_ROWS_END_NB
        asm volatile("s_waitcnt lgkmcnt(0)" ::: "memory"); __builtin_amdgcn_s_barrier(); asm volatile("" ::: "memory");
    }
};
struct EpiXS {
    static constexpr bool PERM = true, AFTER_DRAIN = false, INIT_C = false;
    bf16_t* xp; float* xl; const float* ssq_q; const float* ssq_k;
    __device__ __forceinline__ void operator()(const f32x4 (&acc)[2][2][4][2], const Unit&, int wr, int wc, int fr, int fq) const {
        const int cw = wc * 32 + 8 * fq;
        float rk[2][8];
#pragma unroll
        for (int bj = 0; bj < 2; ++bj)
#pragma unroll
            for (int j = 0; j < 8; ++j) { const f32x4 p = *(const f32x4*)(ssq_k + (size_t)(bj * 128 + cw + j) * 16); rk[bj][j] = rsqrtf(((p[0] + p[1]) + (p[2] + p[3])) * (1.0f / 256.0f) + EPS) * LOG2E; }
#pragma unroll
        for (int ai = 0; ai < 2; ++ai) {
            float rqa[4];
#pragma unroll
            for (int m = 0; m < 4; ++m) { const f32x4 pq = *(const f32x4*)(ssq_q + (size_t)MK_RL(ai, m) * 16); rqa[m] = rsqrtf(((pq[0] + pq[1]) + (pq[2] + pq[3])) * (1.0f / 256.0f) + EPS); }
#pragma unroll
            for (int m = 0; m < 4; ++m) { const int rl = MK_RL(ai, m); const float rq = rqa[m];
                float s = 0.f;
#pragma unroll
                for (int bj = 0; bj < 2; ++bj) { f32x4 v[2] = {acc[ai][bj][m][0], acc[ai][bj][m][1]};
#pragma unroll
                    for (int n = 0; n < 2; ++n)
#pragma unroll
                        for (int e = 0; e < 4; ++e) { v[n][e] = pg8::fexp2(v[n][e] * rq * rk[bj][4 * n + e]); s += v[n][e]; }
                    pg8::store8(xp + (size_t)rl * 1024 + bj * 128 + cw, v[0], v[1]); }
                s = red_fq(s); if (fq == 0) xl[(size_t)rl * 16 + wc] = s;
                __builtin_amdgcn_sched_barrier(0); }
        }
    }
};
struct EpiXO {
    static constexpr bool PERM = true, AFTER_DRAIN = false, INIT_C = false;
    bf16_t* omem; const float* xl;
    __device__ __forceinline__ void operator()(const f32x4 (&acc)[2][2][4][2], const Unit&, int wr, int wc, int fr, int fq) const {
        const int cw = wc * 32 + 8 * fq;
        float ila[2][4];
#pragma unroll
        for (int ai = 0; ai < 2; ++ai)
#pragma unroll
            for (int m = 0; m < 4; ++m) { const f32x4 p = *(const f32x4*)(xl + (size_t)MK_RL(ai, m) * 16); ila[ai][m] = pg8::frcp((p[0] + p[1]) + (p[2] + p[3])); }
        MK_ROWS_BEGIN  const float il = ila[ai][m];
#pragma unroll
            for (int bj = 0; bj < 2; ++bj) pg8::store8(omem + (size_t)rl * 2048 + bj * 128 + cw, acc[ai][bj][m][0] * il, acc[ai][bj][m][1] * il);  MK_ROWS_END
    }
};
struct EpiGate4 {
    static constexpr bool PERM = true, AFTER_DRAIN = false, INIT_C = false;
    bf16_t* merged; const bf16_t* gates;
    __device__ __forceinline__ void operator()(const f32x4 (&acc)[2][2][4][2], const Unit& u, int wr, int wc, int fr, int fq) const {
        const int cw = wc * 32 + 8 * fq; const bf16_t* gate = gates + u.sub * 2048; const bool first = u.sub == 0;
        MK_ROWS_BEGIN  const size_t row = (size_t)u.pm * 256 + rl;
#pragma unroll
            for (int bj = 0; bj < 2; ++bj) { const int col = u.pn * 256 + bj * 128 + cw; f32x4 g0, g1; pg8::load8(gate + row * 6144 + col, g0, g1);
                f32x4 v0 = acc[ai][bj][m][0] * g0, v1 = acc[ai][bj][m][1] * g1;
                if (!first) { f32x4 t0, t1; pg8::load8(merged + row * 2048 + col, t0, t1); v0 += t0; v1 += t1; }
                pg8::store8(merged + row * 2048 + col, v0, v1); }  MK_ROWS_END_NB
    }
};
struct SchedBR {
    pg8::GridOrder o; const char* onm; const char* oret; const char* wnm; const char* wret;
    __device__ __forceinline__ bool next(int i, Unit& u) const { if (i >= 3) return false; const bool ok = o.next(0, u); u.sub = i; return ok; }
    __device__ __forceinline__ void ptrs(const Unit& u, const char*& a, const char*& b) const {
        const size_t ra = (size_t)u.pm * (256u * 2048u * 2u), rb = (size_t)u.pn * (256u * 2048u * 2u);
        const bool nm = (u.sub != 1); const size_t co = (u.sub == 2) ? 2048u : 0u;
        a = (nm ? onm : oret) + ra + co; b = (nm ? wnm : wret) + rb + co; }
    __device__ __forceinline__ int nt(const Unit& u, int) const { return u.sub == 1 ? 32 : 16; }
};
struct EpiWout {
    static constexpr bool PERM = false, AFTER_DRAIN = true, INIT_C = true;
    const float* x; float* x1; bf16_t* x1b; float* ssq; const float* gffn;
    __device__ __forceinline__ void init_c(f32x4 (&acc)[2][2][4][2], const Unit& u, int wr, int wc, int fr, int fq) const {
        const int col0 = u.pn * 256 + wc * 32 + 4 * fq;
        MK_ROWS_BEGIN  const size_t off = ((size_t)u.pm * 256 + rl) * 2048 + col0;
#pragma unroll
            for (int bj = 0; bj < 2; ++bj)
#pragma unroll
                for (int n = 0; n < 2; ++n) acc[ai][bj][m][n] = __builtin_nontemporal_load((const f32x4*)(x + off + bj * 128 + n * 16));  MK_ROWS_END_NB
    }
    __device__ __forceinline__ void fused(f32x4 (&acc)[2][2][4][2], const Unit& u, int wr, int wc, int fr, int fq, PG8_LAS unsigned char* lds, int wid, int lane) const {
        PG8_LAS float* P = (PG8_LAS float*)lds;
        const int col0 = u.pn * 256 + wc * 32 + 4 * fq;
        MK_ROWS_BEGIN  const size_t off = ((size_t)u.pm * 256 + rl) * 2048 + col0; float q = 0.f;
#pragma unroll
            for (int bj = 0; bj < 2; ++bj)
#pragma unroll
                for (int n = 0; n < 2; ++n) { const f32x4 v = acc[ai][bj][m][n];
                    *(f32x4*)(x1 + off + bj * 128 + n * 16) = v; pg8::store4(x1b + off + bj * 128 + n * 16, v * *(const f32x4*)(gffn + col0 + bj * 128 + n * 16)); q += (v[0] * v[0] + v[1] * v[1]) + (v[2] * v[2] + v[3] * v[3]); }
            q = red_fq(q); if (fq == 0) P[rl * 4 + wc] = q;  MK_ROWS_END_NB
        asm volatile("s_waitcnt lgkmcnt(0)" ::: "memory"); __builtin_amdgcn_s_barrier(); asm volatile("" ::: "memory");
        if (threadIdx.x < 256) { const int r = threadIdx.x; const f32x4 p = *(const PG8_LAS f32x4*)(P + r * 4); ssq[((size_t)u.pm * 256 + r) * 8 + u.pn] = (p[0] + p[1]) + (p[2] + p[3]); }
        asm volatile("s_waitcnt lgkmcnt(0)" ::: "memory"); __builtin_amdgcn_s_barrier(); asm volatile("" ::: "memory");
    }
};
struct EpiFF1 {
    static constexpr bool PERM = true, AFTER_DRAIN = false, INIT_C = false;
    bf16_t* hff; const float* ssq;
    __device__ __forceinline__ void operator()(const f32x4 (&acc)[2][2][4][2], const Unit& u, int wr, int wc, int fr, int fq) const {
        const int cw = wc * 32 + 8 * fq;
        float ra[2][4];
#pragma unroll
        for (int ai = 0; ai < 2; ++ai)
#pragma unroll
            for (int m = 0; m < 4; ++m) { const size_t row = (size_t)u.pm * 256 + MK_RL(ai, m); const f32x4 p0 = *(const f32x4*)(ssq + row * 8), p1 = *(const f32x4*)(ssq + row * 8 + 4);
                ra[ai][m] = rsqrtf((((p0[0] + p0[1]) + (p0[2] + p0[3])) + ((p1[0] + p1[1]) + (p1[2] + p1[3]))) * (1.0f / 2048.0f) + EPS); }
        MK_ROWS_BEGIN  const size_t row = (size_t)u.pm * 256 + rl; const float r = ra[ai][m];
#pragma unroll
            for (int bj = 0; bj < 2; ++bj) { f32x4 v0 = acc[ai][bj][m][0] * r, v1 = acc[ai][bj][m][1] * r;
#pragma unroll
                for (int e = 0; e < 4; ++e) { const float a = fmaxf(v0[e], 0.f), b = fmaxf(v1[e], 0.f); v0[e] = a * a; v1[e] = b * b; }
                pg8::store8(hff + row * LDH + u.pn * 256 + bj * 128 + cw, v0, v1); }  MK_ROWS_END
    }
};
struct EpiFF2 {
    static constexpr bool PERM = false, AFTER_DRAIN = false, INIT_C = true;
    const float* src; float* out;
    __device__ __forceinline__ void init_c(f32x4 (&acc)[2][2][4][2], const Unit& u, int wr, int wc, int fr, int fq) const {
        const int col0 = u.pn * 256 + wc * 32 + 4 * fq;
        MK_ROWS_BEGIN  const size_t off = ((size_t)u.pm * 256 + rl) * 2048 + col0;
#pragma unroll
            for (int bj = 0; bj < 2; ++bj)
#pragma unroll
                for (int n = 0; n < 2; ++n) acc[ai][bj][m][n] = *(const f32x4*)(src + off + bj * 128 + n * 16);  MK_ROWS_END_NB
    }
    __device__ __forceinline__ void operator()(const f32x4 (&acc)[2][2][4][2], const Unit& u, int wr, int wc, int fr, int fq) const {
        const int col0 = u.pn * 256 + wc * 32 + 4 * fq;
        MK_ROWS_BEGIN  const size_t off = ((size_t)u.pm * 256 + rl) * 2048 + col0;
#pragma unroll
            for (int bj = 0; bj < 2; ++bj)
#pragma unroll
                for (int n = 0; n < 2; ++n) { const size_t o2 = off + bj * 128 + n * 16; *(f32x4*)(out + o2) = acc[ai][bj][m][n]; }  MK_ROWS_END_NB
    }
};

struct SchedList3 {
    pg8::UnitG u0, u1, u2; int n;
    __device__ __forceinline__ bool next(int i, pg8::UnitG& u) const { if (i >= n) return false;
        u.a = (i == 0) ? u0.a : ((i == 1) ? u1.a : u2.a); u.b = (i == 0) ? u0.b : ((i == 1) ? u1.b : u2.b);
        u.lda = (i == 0) ? u0.lda : ((i == 1) ? u1.lda : u2.lda); u.ldb = (i == 0) ? u0.ldb : ((i == 1) ? u1.ldb : u2.ldb);
        u.nt = (i == 0) ? u0.nt : ((i == 1) ? u1.nt : u2.nt); u.kind = (i == 0) ? u0.kind : ((i == 1) ? u1.kind : u2.kind); u.perm = (i == 0) ? u0.perm : ((i == 1) ? u1.perm : u2.perm);
        return true; }
};
struct EpiM1 {
    EpiF32 e0; EpiP e1; EpiXS e2;
    __device__ __forceinline__ bool after_drain(const pg8::UnitG&) const { return false; }
    __device__ __forceinline__ void operator()(const f32x4 (&acc)[2][2][4][2], const pg8::UnitG& u, int wr, int wc, int fr, int fq) const {
        Unit d; d.pm = 0; d.pn = 0; d.sub = 0;
        if (u.kind == 0) e0(acc, d, wr, wc, fr, fq); else if (u.kind == 1) e1(acc, d, wr, wc, fr, fq); else e2(acc, d, wr, wc, fr, fq); }
    __device__ __forceinline__ void fused(f32x4 (&)[2][2][4][2], const pg8::UnitG&, int, int, int, int, PG8_LAS unsigned char*, int, int) const {}
};
struct EpiM3 {
    EpiXO e0; EpiGN e1;
    __device__ __forceinline__ bool after_drain(const pg8::UnitG& u) const { return u.kind == 1; }
    __device__ __forceinline__ void operator()(const f32x4 (&acc)[2][2][4][2], const pg8::UnitG& u, int wr, int wc, int fr, int fq) const { Unit d; d.pm = 0; d.pn = 0; d.sub = 0; e0(acc, d, wr, wc, fr, fq); }
    __device__ __forceinline__ void fused(f32x4 (&acc)[2][2][4][2], const pg8::UnitG&, int wr, int wc, int fr, int fq, PG8_LAS unsigned char* lds, int wid, int lane) const {
        Unit d; d.pm = 0; d.pn = 0; d.sub = 0; e1.fused(acc, d, wr, wc, fr, fq, lds, wid, lane); }
};
#undef MK_ROWS_BEGIN
#undef MK_ROWS_END
#undef MK_ROWS_END_NB
#undef MK_ROWS_END2
#undef MK_RL
}

namespace na {
using bf16 = unsigned short;
using bf16x8 = __attribute__((ext_vector_type(8))) short;
using s16x4  = __attribute__((ext_vector_type(4))) short;
using f32x16 = __attribute__((ext_vector_type(16))) float;
using f32x4  = __attribute__((ext_vector_type(4))) float;
using u32x4  = __attribute__((ext_vector_type(4))) unsigned;
constexpr int DH = 128, NW = 8, QBLK = 32, KVBLK = 64, LDQ = 3072;
constexpr size_t SHM_V = KVBLK * DH * 2, SHM_K = KVBLK * DH * 2;
constexpr int NBUF = 3;
constexpr int OFF_RK = NBUF * SHM_V + NBUF * SHM_K;
constexpr int OFF_BIAS = OFF_RK + 768 * 4;
constexpr int BIAS_PAD = 64, BIAS_N = 64 + 15 * 31 + 79;
constexpr int OFF_LI = OFF_BIAS + ((BIAS_N * 4 + 15) / 16) * 16;
constexpr int NA_LDS_BYTES = OFF_LI + NW * 64 * 4;
#define KSWZ(row, colB) ((row) * 256 + ((colB) ^ (((row) & 7) << 4)))
#define SBAR() __builtin_amdgcn_sched_barrier(0)
__device__ __forceinline__ int crow(int r, int hi) { return (r & 3) + 8 * (r >> 2) + 4 * hi; }
__device__ __forceinline__ unsigned cvtpk(float lo, float hi) { return pg8::cvt_pk_bf16(lo, hi); }

__device__ __forceinline__ void procP(f32x16& p0, f32x16& p1, float& lsum, bool inwin, const float* rk_t  , const float* bias_l  ,
                                      float rqs, int cs, int hi) {
  if (!inwin) { p0 = f32x16{}; p1 = f32x16{}; return; }
#pragma unroll
  for (int g = 0; g < 4; ++g) {
    const f32x4 k0 = *(const f32x4*)(rk_t + 8 * g + 4 * hi), k1 = *(const f32x4*)(rk_t + 32 + 8 * g + 4 * hi);
#pragma unroll
    for (int e = 0; e < 4; ++e) { const int r = 4 * g + e; const int w0 = e + 8 * g + 4 * hi, w1 = w0 + 32;
      const float x0 = fmaf(p0[r], rqs * k0[e], bias_l[w0]), x1 = fmaf(p1[r], rqs * k1[e], bias_l[w1]);
      const float e0 = __builtin_amdgcn_exp2f(x0), e1 = __builtin_amdgcn_exp2f(x1);
      const float v0 = ((unsigned)(w0 - cs) < 16u) ? e0 : 0.f, v1 = ((unsigned)(w1 - cs) < 16u) ? e1 : 0.f;
      p0[r] = v0; p1[r] = v1; lsum += v0 + v1; }
  }
}
__device__ __forceinline__ void packP(const f32x16& p0, const f32x16& p1, bf16x8& pa0, bf16x8& pa1, bf16x8& pa2, bf16x8& pa3) {
#define PK4(P, BASE, OUT) do { unsigned a0 = cvtpk(P[BASE + 0], P[BASE + 1]), a1 = cvtpk(P[BASE + 2], P[BASE + 3]);   \
    unsigned b0 = cvtpk(P[BASE + 4], P[BASE + 5]), b1 = cvtpk(P[BASE + 6], P[BASE + 7]);                              \
    auto r0 = __builtin_amdgcn_permlane32_swap(a0, b0, false, false); auto r1 = __builtin_amdgcn_permlane32_swap(a1, b1, false, false); \
    u32x4 w = {r0[0], r1[0], r0[1], r1[1]}; OUT = *reinterpret_cast<bf16x8*>(&w); } while (0)
  PK4(p0, 0, pa0); PK4(p0, 8, pa1); PK4(p1, 0, pa2); PK4(p1, 8, pa3);
#undef PK4
}
__device__ __forceinline__ void qkt(f32x16& p0, f32x16& p1, const bf16* Ks, const bf16x8* qr, int r32, int hi) {
  p0 = f32x16{}; p1 = f32x16{};
#pragma unroll
  for (int d0 = 0; d0 < 8; ++d0) { int cb = (d0 * 16 + hi * 8) * 2;
    bf16x8 b0 = *reinterpret_cast<const bf16x8*>((const char*)Ks + KSWZ(r32, cb));
    bf16x8 b1 = *reinterpret_cast<const bf16x8*>((const char*)Ks + KSWZ(32 + r32, cb));
    p0 = __builtin_amdgcn_mfma_f32_32x32x16_bf16(b0, qr[d0], p0, 0, 0, 0);
    p1 = __builtin_amdgcn_mfma_f32_32x32x16_bf16(b1, qr[d0], p1, 0, 0, 0); }
}
__device__ __forceinline__ int v_st(int k, int c) { const int kk = (k & ~0xC) | ((k & 4) << 1) | ((k & 8) >> 1); return ((kk >> 3) * 4 + (c >> 5)) * 512 + ((kk & 7) * 32 + (c & 31)) * 2; }
__device__ __forceinline__ int v_rd_base(int lane) { return ((lane & 3) << 3) | (((lane >> 2) & 3) << 6) | (((lane >> 4) & 1) << 5) | (((lane >> 5) & 1) << 8); }
constexpr int v_rd_off(int d0, int ks, int half) { return d0 * 512 + ks * 4096 + half * 2048; }
template <int OFF> __device__ __forceinline__ s16x4 tr_read(int vb) {
  s16x4 r; asm volatile("ds_read_b64_tr_b16 %0, %1 offset:%2" : "=&v"(r) : "v"(vb), "i"(OFF) : "memory"); return r;
}
template <int D0> __device__ __forceinline__ void pv_one(f32x16& od, int vb, bf16x8 pa0, bf16x8 pa1, bf16x8 pa2, bf16x8 pa3) {
  const s16x4 l0 = tr_read<v_rd_off(D0, 0, 0)>(vb), h0 = tr_read<v_rd_off(D0, 0, 1)>(vb), l1 = tr_read<v_rd_off(D0, 1, 0)>(vb), h1 = tr_read<v_rd_off(D0, 1, 1)>(vb);
  const s16x4 l2 = tr_read<v_rd_off(D0, 2, 0)>(vb), h2 = tr_read<v_rd_off(D0, 2, 1)>(vb), l3 = tr_read<v_rd_off(D0, 3, 0)>(vb), h3 = tr_read<v_rd_off(D0, 3, 1)>(vb);
  asm volatile("s_waitcnt lgkmcnt(0)" ::: "memory"); SBAR();
#define PK(L, H) (bf16x8){L[0], L[1], L[2], L[3], H[0], H[1], H[2], H[3]}
  od = __builtin_amdgcn_mfma_f32_32x32x16_bf16(pa0, PK(l0, h0), od, 0, 0, 0);
  od = __builtin_amdgcn_mfma_f32_32x32x16_bf16(pa1, PK(l1, h1), od, 0, 0, 0);
  od = __builtin_amdgcn_mfma_f32_32x32x16_bf16(pa2, PK(l2, h2), od, 0, 0, 0);
  od = __builtin_amdgcn_mfma_f32_32x32x16_bf16(pa3, PK(l3, h3), od, 0, 0, 0);
#undef PK
}
__device__ __forceinline__ void pv_d0(f32x16* o, int vb, bf16x8 pa0, bf16x8 pa1, bf16x8 pa2, bf16x8 pa3) {
  pv_one<0>(o[0], vb, pa0, pa1, pa2, pa3); pv_one<1>(o[1], vb, pa0, pa1, pa2, pa3); pv_one<2>(o[2], vb, pa0, pa1, pa2, pa3); pv_one<3>(o[3], vb, pa0, pa1, pa2, pa3);
}

__device__ __forceinline__ void na_unit(int b, int h, int i4, const bf16* __restrict__ qkv, const float* __restrict__ ssq_q, const float* __restrict__ ssq_k,
                                        const float* __restrict__ rpb, bf16* __restrict__ ona, char* lds) {
  int tid_ = threadIdx.x; asm volatile("" : "+v"(tid_));
  const int tid = tid_, wid = __builtin_amdgcn_readfirstlane(tid >> 6), lane = tid & 63, r32 = lane & 31, hi = lane >> 5;
  bf16* V_lds = (bf16*)lds; bf16* K_lds = (bf16*)(lds + NBUF * SHM_V);
  float* rkL = (float*)(lds + OFF_RK); float* biasL = (float*)(lds + OFF_BIAS); float* li_l = (float*)(lds + OFF_LI) + wid * 64;
  const int NT = (i4 == 0 || i4 == 15) ? 8 : 11, rbase = (i4 == 0) ? 0 : ((i4 == 15) ? 56 : 4 * i4 - 4);
  const int qrow = 4 * i4 + (wid >> 1), qc = 32 * (wid & 1) + r32;
  int rs = qrow - 4; rs = rs < 0 ? 0 : (rs > 56 ? 56 : rs);
  int cs = qc - 8; cs = cs < 0 ? 0 : (cs > 48 ? 48 : cs);
  const size_t tok_q = (size_t)b * 4096 + qrow * 64 + qc, tok_k0 = (size_t)b * 4096 + rbase * 64;
  for (int i = tid; i < NT * 64; i += 512) { const f32x4 p = *(const f32x4*)(ssq_k + (tok_k0 + i) * 32 + h * 4); rkL[i] = rsqrtf(((p[0] + p[1]) + (p[2] + p[3])) * (1.0f / 128.0f) + 1e-6f); }
  for (int i = tid; i < BIAS_N; i += 512) { const int j = i - BIAS_PAD; biasL[i] = (j >= 0 && j < 15 * 31) ? rpb[h * 465 + j] * 1.4426950408889634f : 0.f; }
  float rqs; { const f32x4 p = *(const f32x4*)(ssq_q + tok_q * 32 + h * 4); rqs = rsqrtf(((p[0] + p[1]) + (p[2] + p[3])) * (1.0f / 128.0f) + 1e-6f) * 1.4426950408889634f; }
  float l_reg = 0; f32x16 o[4] = {}; bf16x8 qr[8];
  const bf16* Qw = qkv + tok_q * LDQ + h * 128 + hi * 8;
#pragma unroll
  for (int d0 = 0; d0 < 8; ++d0) qr[d0] = *reinterpret_cast<const bf16x8*>(Qw + d0 * 16);
  const bf16* Kh = qkv + tok_k0 * LDQ + 1024 + h * 128; const bf16* Vh = qkv + tok_k0 * LDQ + 2048 + h * 128;
  const int sr = tid >> 4, sc = (tid & 15) * 8, vst0 = v_st(sr, sc), vst1 = v_st(32 + sr, sc);
  const int vb0 = (int)(uintptr_t)V_lds + v_rd_base(lane);
  struct { bf16x8 vs0, vs1, ks0, ks1; } sr_[2];
#define SLOAD(i, k0) do { sr_[i].vs0 = *(const bf16x8*)(&Vh[(long)((k0) + sr) * LDQ + sc]); sr_[i].vs1 = *(const bf16x8*)(&Vh[(long)((k0) + 32 + sr) * LDQ + sc]); \
    sr_[i].ks0 = *(const bf16x8*)(&Kh[(long)((k0) + sr) * LDQ + sc]); sr_[i].ks1 = *(const bf16x8*)(&Kh[(long)((k0) + 32 + sr) * LDQ + sc]); } while (0)
#define SWRITE(bb, i) do { *(bf16x8*)((char*)V_lds + (bb) * SHM_V + vst0) = sr_[i].vs0;          \
    *(bf16x8*)((char*)V_lds + (bb) * SHM_V + vst1) = sr_[i].vs1; int kc = sc * 2;               \
    *(bf16x8*)((char*)K_lds + (bb) * SHM_K + KSWZ(sr, kc)) = sr_[i].ks0;                       \
    *(bf16x8*)((char*)K_lds + (bb) * SHM_K + KSWZ(32 + sr, kc)) = sr_[i].ks1; } while (0)
#define SWAIT() asm volatile("s_waitcnt vmcnt(0)" ::: "memory")
#define TILE_ARGS(j) ((unsigned)(rbase + (j) - rs) < 8u), rkL + (j) * 64, biasL + BIAS_PAD + (rbase + (j) - qrow + 7) * 31 + 15 - qc, rqs, cs, hi
  f32x16 p0, p1; bf16x8 pa0, pa1, pa2, pa3;
#define NA_TILE(j, bo) do { if ((unsigned)(rbase + (j) - rs) < 8u) {     \
      SBAR(); qkt(p0, p1, (const bf16*)((const char*)K_lds + (bo) * SHM_K), qr, r32, hi); \
      procP(p0, p1, l_reg, TILE_ARGS(j)); \
      packP(p0, p1, pa0, pa1, pa2, pa3); SBAR(); \
      pv_d0(o, vb0 + (bo) * (int)SHM_V, pa0, pa1, pa2, pa3); } } while (0)
  SLOAD(0, 0); SLOAD(1, KVBLK); SWRITE(0, 0); SLOAD(0, 2 * KVBLK); SWRITE(1, 1); SLOAD(1, 3 * KVBLK); __syncthreads();
  int b0 = 0;
  for (int j = 0; j < NT; j += 2) {
    const int b1 = (b0 == 2) ? 0 : b0 + 1, b2 = (b1 == 2) ? 0 : b1 + 1;
    NA_TILE(j, b0);
    if (j + 2 < NT) { SWRITE(b2, 0); if (j + 4 < NT) SLOAD(0, (j + 4) * KVBLK); }
    __syncthreads();
    if (j + 1 < NT) NA_TILE(j + 1, b1);
    if (j + 3 < NT) { SWRITE(b0, 1); if (j + 5 < NT) SLOAD(1, (j + 5) * KVBLK); }
    __syncthreads();
    b0 = b2;
  }
#undef NA_TILE
  { auto rr = __builtin_amdgcn_permlane32_swap(__float_as_uint(l_reg), __float_as_uint(l_reg), false, false); l_reg = __uint_as_float(rr[0]) + __uint_as_float(rr[1]); }
  if (hi == 0) li_l[r32] = l_reg; asm volatile("s_waitcnt lgkmcnt(0)" ::: "memory");
  float rli[16];
#pragma unroll
  for (int r = 0; r < 16; ++r) rli[r] = __builtin_amdgcn_rcpf(li_l[crow(r, hi)]);
  bf16* Ow = ona + ((size_t)b * 4096 + qrow * 64 + 32 * (wid & 1)) * 2048 + h * 128;
#pragma unroll
  for (int r = 0; r < 16; ++r) { const int orow = crow(r, hi);
#pragma unroll
    for (int d0 = 0; d0 < 4; ++d0) { const float v = o[d0][r] * rli[r]; unsigned u = __float_as_uint(v); u += 0x7fffu + ((u >> 16) & 1u); Ow[(size_t)orow * 2048 + d0 * 32 + r32] = (bf16)(u >> 16); } }
  __syncthreads();
#undef SLOAD
#undef SWRITE
#undef SWAIT
#undef TILE_ARGS
}
#undef KSWZ
#undef SBAR
}

constexpr int NWAVES = 8;
constexpr int RING_OFF = 0, RING_BYTES = 131072;
constexpr int LDSCTL_OFF = RING_BYTES, MISC_OFF = LDSCTL_OFF + 320;
constexpr int LDS_BYTES = 147456;
static_assert(MISC_OFF + 128 <= LDS_BYTES && na::NA_LDS_BYTES <= RING_BYTES, "LDS map");
constexpr int CW_TMO = 0, CW_P0A = 64, CW_BAR = 4096;

#define GAS __attribute__((address_space(1)))
#define LAS __attribute__((address_space(3)))
typedef unsigned short bf16;
typedef unsigned v4u __attribute__((ext_vector_type(4)));
typedef float f32x4 __attribute__((ext_vector_type(4)));
typedef GAS unsigned gu32;
#define LDS_WAIT() asm volatile("s_waitcnt lgkmcnt(0)" ::: "memory")
#define VM_WAIT() asm volatile("s_waitcnt vmcnt(0)" ::: "memory")
__device__ __forceinline__ unsigned f2bf(float f) { unsigned u = __builtin_bit_cast(unsigned, f); return (u + 0x7fffu + ((u >> 16) & 1u)) >> 16; }
__device__ __forceinline__ unsigned pk2(float lo, float hi) { return f2bf(lo) | (f2bf(hi) << 16); }
__device__ __forceinline__ float bf2f_(unsigned h) { return __uint_as_float(h << 16); }

#define XB_TMO      128
#define XB_XCNT(j)  (256  + 64 * (j))
#define XB_XSUB(j)  (1280 + 64 * (j))
#define XB_XGEN(j)  (2304 + 64 * (j))
#define XB_TOP      3328
#define XB_TOPGEN   3392
#define XCD_BAR_WORDS 3456
#define XB_SPIN_CAP (1u << 18)
__device__ __forceinline__ unsigned xb_ld(unsigned* p)              { return __hip_atomic_load(p, __ATOMIC_RELAXED, __HIP_MEMORY_SCOPE_AGENT); }
__device__ __forceinline__ unsigned xb_add(unsigned* p, unsigned v) { return __hip_atomic_fetch_add(p, v, __ATOMIC_RELAXED, __HIP_MEMORY_SCOPE_AGENT); }
__device__ __forceinline__ unsigned xb_xcc_id() { return (unsigned)__builtin_amdgcn_s_getreg((3 << 11) | 20) & 0xFu; }
#define XB_SPIN(cond, bar) do { unsigned _sp = 0; while (cond) { __builtin_amdgcn_s_sleep(1); \
    if ((++_sp & 255u) == 0u) { if (xb_ld(&(bar)[XB_TMO])) break; if (_sp > XB_SPIN_CAP) { atomicAdd(&(bar)[XB_TMO], 1u); break; } } } } while (0)
struct XcdBarrier { unsigned* bar; unsigned x; volatile LAS unsigned* st; };
__device__ __forceinline__ XcdBarrier xcd_barrier_post(unsigned* bar, volatile LAS unsigned* st) {
    XcdBarrier b; b.bar = bar; b.x = xb_xcc_id(); b.st = st;
    if (threadIdx.x == 0) (void)xb_add(&bar[XB_XCNT(b.x)], 1u);
    return b;
}
__device__ __forceinline__ void xcd_barrier_complete(unsigned* bar, unsigned x, unsigned& nloc, unsigned& nx) {
    const unsigned G = gridDim.x * gridDim.y * gridDim.z;
    unsigned sum, cnt, mine, sp = 0u;
    for (;;) {
        sum = 0u; cnt = 0u; mine = 0u;
#pragma unroll
        for (unsigned j = 0; j < 16; ++j) { const unsigned c = xb_ld(&bar[XB_XCNT(j)]); sum += c; cnt += (c > 0u) ? 1u : 0u; mine = (j == x) ? c : mine; }
        if (sum == G) break;
        __builtin_amdgcn_s_sleep(1);
        if ((++sp & 255u) == 0u) { if (xb_ld(&bar[XB_TMO])) break; if (sp > XB_SPIN_CAP) { atomicAdd(&bar[XB_TMO], 1u); break; } }
    }
    nloc = mine > 0u ? mine : 1u; nx = cnt > 0u ? cnt : 1u;
}
__device__ __forceinline__ void xcd_barrier(const XcdBarrier& b) {
    asm volatile("s_waitcnt vmcnt(0)" ::: "memory");
    __syncthreads();
    if (threadIdx.x == 0) {
        unsigned* bar = b.bar;
        __builtin_amdgcn_s_waitcnt(0);
        unsigned nloc = b.st[0], nx = b.st[1];
        if (nloc == 0u) { xcd_barrier_complete(bar, b.x, nloc, nx); b.st[0] = nloc; b.st[1] = nx; }
        const unsigned old = xb_add(&bar[XB_XSUB(b.x)], 1u);
        const unsigned gen = old / nloc;
        if (old + 1u == (gen + 1u) * nloc) {
            __builtin_amdgcn_fence(__ATOMIC_RELEASE, "agent");
            asm volatile("s_waitcnt vmcnt(0)" ::: "memory");
            const unsigned og = xb_add(&bar[XB_TOP], 1u);
            const unsigned tg = og / nx;
            if (og + 1u == (tg + 1u) * nx) xb_add(&bar[XB_TOPGEN], 1u);
            else XB_SPIN(xb_ld(&bar[XB_TOPGEN]) == tg, bar);
            __builtin_amdgcn_fence(__ATOMIC_ACQUIRE, "agent");
            xb_add(&bar[XB_XGEN(b.x)], 1u);
            asm volatile("s_waitcnt vmcnt(0)" ::: "memory");
        } else {
            XB_SPIN(xb_ld(&bar[XB_XGEN(b.x)]) == gen, bar);
            __builtin_amdgcn_fence(__ATOMIC_ACQUIRE, "agent");
            asm volatile("s_waitcnt vmcnt(0)" ::: "memory");
        }
    }
    __syncthreads();
}

__device__ __forceinline__ float wave_sum(float v) {
#pragma unroll
    for (int o = 1; o < 64; o <<= 1) v += __shfl_xor(v, o);
    return v;
}
__device__ __forceinline__ void p0_item(const float* __restrict__ W, int ldw, int k0, int n0, bf16* __restrict__ WT, int ldt, int dA, int dB, const float* __restrict__ kscale, LAS float* scr, int lane) {
    const int c16 = lane & 15, kr = lane >> 4;
#pragma unroll
    for (int it = 0; it < 16; ++it) { const int k = 4 * it + kr;
        f32x4 v = __builtin_nontemporal_load((const f32x4*)(W + (size_t)(k0 + k) * ldw + n0 + 4 * c16));
        if (kscale) v = v * kscale[k0 + k];
        *(LAS f32x4*)(scr + k * 64 + ((4 * c16) ^ (8 * ((k >> 3) & 7)))) = v; }
    LDS_WAIT(); asm volatile("" ::: "memory");
    const int c = lane & 7;
#pragma unroll
    for (int j = 0; j < 8; ++j) { const int n = (lane >> 3) + 8 * j; const LAS float* s = scr + (8 * c) * 64 + (n ^ (8 * c));
        v4u o; o.x = pk2(s[0 * 64], s[1 * 64]); o.y = pk2(s[2 * 64], s[3 * 64]); o.z = pk2(s[4 * 64], s[5 * 64]); o.w = pk2(s[6 * 64], s[7 * 64]);
        const int drow = (n < 32) ? dA + n : dB + n - 32;
        *(GAS v4u*)(WT + (size_t)drow * ldt + k0 + 8 * c) = o; }
    LDS_WAIT(); asm volatile("" ::: "memory");
}
struct P0Desc { const float* src; bf16* dst; int ldw, ldt, dA, dB, nt; };
__device__ __forceinline__ void p0_load(const P0Desc& d, f32x4 (&R)[16], int lane) {
    const int c16 = lane & 15, kr = lane >> 4;
#pragma unroll
    for (int it = 0; it < 16; ++it) R[it] = __builtin_nontemporal_load((const f32x4*)(d.src + (size_t)(4 * it + kr) * d.ldw + 4 * c16));
}
__device__ __forceinline__ void p0_to_lds(const f32x4 (&R)[16], LAS float* scr, int lane) {
    const int c16 = lane & 15, kr = lane >> 4;
#pragma unroll
    for (int it = 0; it < 16; ++it) { const int k = 4 * it + kr; *(LAS f32x4*)(scr + k * 64 + ((4 * c16) ^ (8 * ((k >> 3) & 7)))) = R[it]; }
}
__device__ __forceinline__ void p0_store(const P0Desc& d, LAS float* scr, int lane) {
    const int c = lane & 7;
#pragma unroll
    for (int j = 0; j < 8; ++j) { const int n = (lane >> 3) + 8 * j; const LAS float* s = scr + (8 * c) * 64 + (n ^ (8 * c));
        v4u o; o.x = pk2(s[0 * 64], s[1 * 64]); o.y = pk2(s[2 * 64], s[3 * 64]); o.z = pk2(s[4 * 64], s[5 * 64]); o.w = pk2(s[6 * 64], s[7 * 64]);
        const int drow = (n < 32) ? d.dA + n : d.dB + n - 32;
        GAS v4u* q = (GAS v4u*)(d.dst + (size_t)drow * d.ldt + 8 * c); if (d.nt) __builtin_nontemporal_store(o, q); else *q = o; }
}
__device__ __forceinline__ void rms_row_to_bf16(const float* __restrict__ xrow, const float* __restrict__ g, bf16* __restrict__ orow, int lane) {
    const f32x4* xr = (const f32x4*)xrow + lane; const f32x4* gr = (const f32x4*)g + lane;
    f32x4 v[8]; float s = 0.f;
#pragma unroll
    for (int j = 0; j < 8; ++j) { v[j] = __builtin_nontemporal_load(xr + 64 * j); s += (v[j].x * v[j].x + v[j].y * v[j].y) + (v[j].z * v[j].z + v[j].w * v[j].w); }
    const float r = rsqrtf(wave_sum(s) * (1.f / 2048.f) + mk::EPS);
    unsigned long long* o8 = (unsigned long long*)orow + lane;
#pragma unroll
    for (int j = 0; j < 8; ++j) { const f32x4 gg = gr[64 * j]; o8[64 * j] = (unsigned long long)pk2(v[j].x * r * gg.x, v[j].y * r * gg.y) | ((unsigned long long)pk2(v[j].z * r * gg.z, v[j].w * r * gg.w) << 32); }
}
__device__ __forceinline__ int win_dest_row(int n32  ) {
    const int pn = n32 >> 3, ga = n32 & 7;
    if (pn < 12 || pn >= 20) return n32 * 32;
    const int gs = 4 * ((ga >> 1) & 1) + 2 * (ga >> 2) + (ga & 1);
    return (pn * 8 + gs) * 32;
}

#ifndef MK_TS
#define MK_TS -1
#endif
struct Args { const float* in[21]; float* out; unsigned char* ws; };

__global__ void __launch_bounds__(NWAVES * 64, 2) mk_fwd(Args args) {
    extern __shared__ __attribute__((aligned(16))) unsigned char lds[];
    LAS unsigned char* ldsl = (LAS unsigned char*)lds;
    volatile LAS unsigned* MISC = (volatile LAS unsigned*)(ldsl + MISC_OFF);
    const int tid = threadIdx.x, lane = tid & 63, wave = __builtin_amdgcn_readfirstlane(tid >> 6);
    const int G = gridDim.x, bx = blockIdx.x;
    const int vcu = (G % 8 == 0) ? (bx % 8) * (G / 8) + bx / 8 : bx;
    unsigned char* ws = args.ws; unsigned char* dob = (unsigned char*)args.out;
    gu32* ctl = (gu32*)(ws + mk::WS_CTL);
#define I_x args.in[0]
#define I_mem args.in[1]
#define I_g_mix args.in[2]
#define I_w_in args.in[3]
#define I_gq args.in[4]
#define I_gk args.in[5]
#define I_rpb args.in[6]
#define I_lgf_in args.in[7]
#define I_lgb_in args.in[8]
#define I_gn args.in[9]
#define I_g_mem args.in[10]
#define I_w_mkv args.in[11]
#define I_gxq args.in[12]
#define I_gxk args.in[13]
#define I_w_na args.in[14]
#define I_w_ret args.in[15]
#define I_w_memb args.in[16]
#define I_w_out args.in[17]
#define I_g_ffn args.in[18]
#define I_w_ff1 args.in[19]
#define I_w_ff2 args.in[20]
#define I_out args.out
#define cosT ((float*)(ws + mk::WS_COS))
#define sinT ((float*)(ws + mk::WS_SIN))
#define ssq_naq ((float*)(ws + mk::WS_SSQ_NAQ))
#define ssq_nak ((float*)(ws + mk::WS_SSQ_NAK))
#define ssq_xq ((float*)(ws + mk::WS_SSQ_XQ))
#define xl ((float*)(ws + mk::WS_XL))
#define ssq_x1 ((float*)(ws + mk::WS_SSQ_X1))
#define tab ((float*)(ws + mk::WS_TAB))
#define MEMN ((bf16*)(ws + mk::WS_MEMN))
#define MKb ((bf16*)(ws + mk::WS_MK))
#define MVT ((bf16*)(ws + mk::WS_MVT))
#define WinT ((bf16*)(ws + mk::WS_WIN))
#define Wff1T ((bf16*)(ws + mk::WS_WFF1))
#define Wff2T ((bf16*)(ws + mk::WS_WFF2))
#define WretT ((bf16*)(ws + mk::WS_WRET))
#define WoutT ((bf16*)(ws + mk::WS_WOUT))
#define WnmT ((bf16*)(ws + mk::WS_WNM))
#define WmkvT ((bf16*)(ws + mk::WS_WMKV))
#define NAQKV ((bf16*)(ws + mk::WS_NAQKV))
#define K0 ((bf16*)(ws + mk::WS_K0))
#define RG ((bf16*)(ws + mk::WS_RG))
#define XQ ((bf16*)(ws + mk::WS_XQ))
#define GATES ((bf16*)(ws + mk::WS_GATES))
#define AR ((bf16*)(ws + mk::WS_AR))
#define BR ((bf16*)(ws + mk::WS_BR))
#define KV ((bf16*)(ws + mk::WS_KV))
#define ORET ((bf16*)(ws + mk::WS_ORET))
#define MERGED ((bf16*)(ws + mk::WS_MERGED))
#define X1B ((bf16*)(ws + mk::WS_X1B))
#define HFF ((bf16*)(ws + mk::WS_HFF))
#define HN ((bf16*)(dob + mk::DO_HN))
#define KT ((bf16*)(dob + mk::DO_KT))
#define XP ((bf16*)(dob + mk::DO_XP))
#define ONM ((bf16*)(dob + mk::DO_ONM))
    for (int u = tid; u < (LDS_BYTES - LDSCTL_OFF) / 4; u += NWAVES * 64) ((LAS unsigned*)(ldsl + LDSCTL_OFF))[u] = 0u;
    __syncthreads();
    XcdBarrier bar = xcd_barrier_post((unsigned*)(ctl + CW_BAR), MISC + 8);
#define GRID_BAR() do { xcd_barrier(bar); MK_STAMP(); } while (0)
    int n_stamp_ = 0;
#define MK_STAMP() do { if (MK_TS >= 0) { if (bx == 0 && tid == 0) MISC[16 + n_stamp_] = (unsigned)__builtin_amdgcn_s_memrealtime(); ++n_stamp_; } } while (0)
    MK_STAMP();
    LAS float* scr = (LAS float*)(ldsl + RING_OFF + wave * 16384);
    const int gw = vcu * NWAVES + wave, NGW = G * NWAVES;

    {
    if (vcu < 16) {
        if (tid == 0) {
            unsigned sp = 0; while (__hip_atomic_load((unsigned*)(ctl + CW_P0A), __ATOMIC_RELAXED, __HIP_MEMORY_SCOPE_AGENT) < (unsigned)(G - 16)) { __builtin_amdgcn_s_sleep(2); if (++sp > (1u << 22)) break; }
            __builtin_amdgcn_fence(__ATOMIC_ACQUIRE, "agent"); asm volatile("s_waitcnt vmcnt(0)" ::: "memory");
        }
        __syncthreads();
        mk::SchedOne S; S.has = true; const pg8::Gemm g{2048, 2048, 2048};
        mk::EpiMKV E{MKb, MVT, tab, tab, 0};
        if (vcu < 8) { S.u.pm = vcu >> 2; S.u.pn = vcu & 3; S.a = (const char*)(MEMN + (size_t)S.u.pm * 256 * 2048); S.b = (const char*)(WmkvT + (size_t)S.u.pn * 256 * 2048); E.mode = 0; }
        else { const int c = vcu - 8; S.u.pm = c >> 1; S.u.pn = c & 1; S.a = (const char*)(WmkvT + (size_t)(1024 + S.u.pm * 256) * 2048); S.b = (const char*)(MEMN + (size_t)S.u.pn * 256 * 2048); E.mode = 1; }
        pg8::gemm_phase<mk::EpiMKV, mk::SchedOne, false>(ldsl + RING_OFF, g, S, E);
    } else {
        const int gw2 = (vcu - 16) * NWAVES + wave, NGW2 = (G - 16) * NWAVES;
        {
            for (int i = gw2 * 64 + lane; i < 4096 * 64; i += NGW2 * 64) { const int s = i >> 6, f = i & 63;
                const float inv = powf(10000.0f, -(float)f / 64.0f), ang = (float)s * inv; cosT[i] = cosf(ang); sinT[i] = sinf(ang); }
            if (vcu == 16) {
                if (tid < 128) tab[mk::TAB_CS_NAQ + tid] = I_gq[tid] * I_gk[tid] * 0.08838834764831845f;
                if (tid < 256) tab[mk::TAB_CS_MK + tid] = I_gxq[tid] * I_gxk[tid] * 0.0625f;
                if (tid < 8) { tab[mk::TAB_L2F + tid] = -log1pf(expf(-I_lgf_in[tid])) * mk::LOG2E; tab[mk::TAB_L2B + tid] = -log1pf(expf(-I_lgb_in[tid])) * mk::LOG2E; }
            }
            for (int m = gw2; m < 512; m += NGW2) rms_row_to_bf16(I_mem + (size_t)m * 2048, I_g_mem, MEMN + (size_t)m * 2048, lane);
            for (int it = gw2; it < 32 * 32; it += NGW2) { const int kb = it >> 5, nb = it & 31; p0_item(I_w_mkv, 2048, 64 * kb, 64 * nb, WmkvT, 2048, 64 * nb, 64 * nb + 32, nullptr, scr, lane); }
            VM_WAIT(); __syncthreads();
            if (tid == 0) { __builtin_amdgcn_fence(__ATOMIC_RELEASE, "agent"); asm volatile("s_waitcnt vmcnt(0)" ::: "memory");
                (void)__hip_atomic_fetch_add((unsigned*)(ctl + CW_P0A), 1u, __ATOMIC_RELAXED, __HIP_MEMORY_SCOPE_AGENT); }
        }
        constexpr int I_IN = 32 * 256, I_FF1 = 32 * 128, I_FF2 = 128 * 32, I_RET = 32 * 32, I_OUT = 32 * 32, I_NA = 16 * 32, I_MEM = 16 * 32;
        constexpr int NITEMS = I_IN + I_FF1 + I_FF2 + I_RET + I_OUT + I_NA + I_MEM;
#define P0_DECODE(d, item) do { int r = (item); \
            if (r < I_IN) { const int kb = r >> 8, nb = r & 255; d.src = I_w_in + (size_t)(64 * kb) * 16384 + 64 * nb; d.ldw = 16384; d.dst = WinT + 64 * kb; d.ldt = 2048; d.dA = win_dest_row(2 * nb); d.dB = win_dest_row(2 * nb + 1); d.nt = 0; break; } r -= I_IN; \
            if (r < I_FF1) { const int kb = r >> 7, nb = r & 127; d.src = I_w_ff1 + (size_t)(64 * kb) * 8192 + 64 * nb; d.ldw = 8192; d.dst = Wff1T + 64 * kb; d.ldt = 2048; d.dA = 64 * nb; d.dB = 64 * nb + 32; d.nt = 1; break; } r -= I_FF1; \
            if (r < I_FF2) { const int kb = r >> 5, nb = r & 31; d.src = I_w_ff2 + (size_t)(64 * kb) * 2048 + 64 * nb; d.ldw = 2048; d.dst = Wff2T + 64 * kb; d.ldt = 8192; d.dA = 64 * nb; d.dB = 64 * nb + 32; d.nt = 1; break; } r -= I_FF2; \
            if (r < I_RET) { const int kb = r >> 5, nb = r & 31; d.src = I_w_ret + (size_t)(64 * kb) * 2048 + 64 * nb; d.ldw = 2048; d.dst = WretT + 64 * kb; d.ldt = 2048; d.dA = 64 * nb; d.dB = 64 * nb + 32; d.nt = 1; break; } r -= I_RET; \
            if (r < I_OUT) { const int kb = r >> 5, nb = r & 31; d.src = I_w_out + (size_t)(64 * kb) * 2048 + 64 * nb; d.ldw = 2048; d.dst = WoutT + 64 * kb; d.ldt = 2048; d.dA = 64 * nb; d.dB = 64 * nb + 32; d.nt = 1; break; } r -= I_OUT; \
            if (r < I_NA) { const int kb = r >> 5, nb = r & 31; d.src = I_w_na + (size_t)(64 * kb) * 2048 + 64 * nb; d.ldw = 2048; d.dst = WnmT + 64 * kb; d.ldt = 2048; d.dA = 64 * nb; d.dB = 64 * nb + 32; d.nt = 1; break; } r -= I_NA; \
            { const int kb = r >> 5, nb = r & 31; d.src = I_w_memb + (size_t)(64 * kb) * 2048 + 64 * nb; d.ldw = 2048; d.dst = WnmT + 1024 + 64 * kb; d.ldt = 2048; d.dA = 64 * nb; d.dB = 64 * nb + 32; d.nt = 1; } } while (0)
        {
            f32x4 R0[16], R1[16]; P0Desc d0, d1; int it = gw2;
            if (it < NITEMS) { P0_DECODE(d0, it); p0_load(d0, R0, lane); }
            if (it + NGW2 < NITEMS) { P0_DECODE(d1, it + NGW2); p0_load(d1, R1, lane); }
            for (; it < NITEMS; it += 2 * NGW2) {
                p0_to_lds(R0, scr, lane); const P0Desc c0 = d0;
                if (it + 2 * NGW2 < NITEMS) { P0_DECODE(d0, it + 2 * NGW2); p0_load(d0, R0, lane); }
                LDS_WAIT(); asm volatile("" ::: "memory"); p0_store(c0, scr, lane); LDS_WAIT(); asm volatile("" ::: "memory");
                if (it + NGW2 < NITEMS) {
                    p0_to_lds(R1, scr, lane); const P0Desc c1 = d1;
                    if (it + 3 * NGW2 < NITEMS) { P0_DECODE(d1, it + 3 * NGW2); p0_load(d1, R1, lane); }
                    LDS_WAIT(); asm volatile("" ::: "memory"); p0_store(c1, scr, lane); LDS_WAIT(); asm volatile("" ::: "memory");
                }
            }
        }
#undef P0_DECODE
        for (int m = gw2; m < mk::M; m += NGW2) rms_row_to_bf16(I_x + (size_t)m * 2048, I_g_mix, HN + (size_t)m * 2048, lane);
    }
    GRID_BAR();
    }
    {
    {
        mk::SchedProj S; S.o.init(mk::M, mk::D_IN, G, bx); S.hn_ = (const char*)HN; S.wt_ = (const char*)WinT;
        const pg8::Gemm g{2048, 2048, 2048};
        mk::EpiProj E{ws};
        pg8::gemm_phase<mk::EpiProj, mk::SchedProj, true>(ldsl + RING_OFF, g, S, E);
    }
    GRID_BAR();
    }
    {
    {
        const int c = bx, bh = c >> 4, nc = c & 15, b = bh >> 3, h = bh & 7;
        const float l2f = tab[mk::TAB_L2F + h], l2b = tab[mk::TAB_L2B + h];
        {
            bf16* kt = KT + (size_t)c * 65536; const bf16* ksrc = K0 + ((size_t)b * 4096 + nc * 256) * 1024 + h * 128;
            LAS float* t = scr;
            const int tok0 = wave * 32;
#pragma unroll
            for (int it = 0; it < 8; ++it) { const int tr = 4 * it + (lane >> 4), c8 = (lane & 15) * 8; const v4u w = *(const v4u*)(ksrc + (size_t)(tok0 + tr) * 1024 + c8);
                LAS float* d = t + tr * 128 + (c8 ^ (8 * (tr >> 3))); d[0] = bf2f_(w.x & 0xffffu); d[1] = bf2f_(w.x >> 16); d[2] = bf2f_(w.y & 0xffffu); d[3] = bf2f_(w.y >> 16);
                d[4] = bf2f_(w.z & 0xffffu); d[5] = bf2f_(w.z >> 16); d[6] = bf2f_(w.w & 0xffffu); d[7] = bf2f_(w.w >> 16); }
            LDS_WAIT(); asm volatile("" ::: "memory");
            const int q = lane & 3;
            float df[8], db[8];
#pragma unroll
            for (int i = 0; i < 8; ++i) { const int tk = tok0 + 8 * q + i; df[i] = pg8::fexp2(l2f * (float)(255 - tk)); db[i] = pg8::fexp2(l2b * (float)tk); }
#pragma unroll
            for (int j = 0; j < 8; ++j) { const int dk = (lane >> 2) + 16 * j; const LAS float* s = t + (8 * q) * 128 + (dk ^ (8 * q));
                float v[8];
#pragma unroll
                for (int i = 0; i < 8; ++i) v[i] = s[i * 128];
                v4u o; o.x = pk2(v[0] * df[0], v[1] * df[1]); o.y = pk2(v[2] * df[2], v[3] * df[3]); o.z = pk2(v[4] * df[4], v[5] * df[5]); o.w = pk2(v[6] * df[6], v[7] * df[7]);
                *(GAS v4u*)(kt + (size_t)dk * 256 + tok0 + 8 * q) = o;
                o.x = pk2(v[0] * db[0], v[1] * db[1]); o.y = pk2(v[2] * db[2], v[3] * db[3]); o.z = pk2(v[4] * db[4], v[5] * db[5]); o.w = pk2(v[6] * db[6], v[7] * db[7]);
                *(GAS v4u*)(kt + (size_t)(128 + dk) * 256 + tok0 + 8 * q) = o; }
            VM_WAIT(); LDS_WAIT(); __syncthreads();
        }
        MK_STAMP();
        {
            bf16* arc = AR + ((size_t)bh * 4096 + nc * 256) * 512;
            mk::SchedList3 S; S.n = (bx < 128) ? 3 : 2;
            S.u0.a = (const char*)(BR + (size_t)c * 256 * 512); S.u0.b = (const char*)(KT + (size_t)c * 65536); S.u0.lda = 512; S.u0.ldb = 256; S.u0.nt = 4; S.u0.kind = 0; S.u0.perm = 1;
            S.u1.a = (const char*)(arc + 256); S.u1.b = (const char*)(K0 + ((size_t)b * 4096 + nc * 256) * 1024 + h * 128); S.u1.lda = 512; S.u1.ldb = 1024; S.u1.nt = 2; S.u1.kind = 1; S.u1.perm = 1;
            const int xb = (bx >> 6) & 1, xh = (bx >> 4) & 3, qt = bx & 15; const size_t tok0 = (size_t)xb * 4096 + qt * 256;
            S.u2.a = (const char*)(XQ + tok0 * 1024 + xh * 256); S.u2.b = (const char*)(MKb + (size_t)xb * 256 * 1024 + xh * 256); S.u2.lda = 1024; S.u2.ldb = 1024; S.u2.nt = 4; S.u2.kind = 2; S.u2.perm = 1;
            mk::EpiM1 E{mk::EpiF32{KV + (size_t)c * 65536}, mk::EpiP{arc, l2f, l2b},
                        mk::EpiXS{XP + tok0 * 1024 + xh * 256, xl + tok0 * 16 + xh * 4, ssq_xq + tok0 * 16 + xh * 4, tab + mk::TAB_SSQ_MK + (size_t)xb * 256 * 16 + xh * 4}};
            pg8::gemm_stream<mk::EpiM1, mk::SchedList3, true>(ldsl + RING_OFF, S, E);
        }
        MK_STAMP();
    }
    GRID_BAR();
    }
    {
    {
        for (int e = (vcu * 512 + tid); e < 16 * 65536; e += G * 512) {
            const int bh = e >> 16, r = e & 65535, col = r & 255, h = bh & 7;
            const bool fwd = col < 128; const float dec = pg8::fexp2((fwd ? tab[mk::TAB_L2F + h] : tab[mk::TAB_L2B + h]) * 256.0f);
            const bf16* kvp = KV + (size_t)bh * 16 * 65536 + r; bf16* brp = BR + ((size_t)bh * 16 * 256 + (r >> 8)) * 512 + 256 + col;
            float kvv[16];
#pragma unroll
            for (int n = 0; n < 16; ++n) kvv[n] = bf2f_(__builtin_nontemporal_load(kvp + (size_t)n * 65536));
            float s = 0.f;
            if (fwd) {
#pragma unroll
                for (int n = 0; n < 16; ++n) { brp[(size_t)n * 256 * 512] = (bf16)f2bf(s); s = dec * s + kvv[n]; }
            } else {
#pragma unroll
                for (int n = 15; n >= 0; --n) { brp[(size_t)n * 256 * 512] = (bf16)f2bf(s); s = dec * s + kvv[n]; }
            }
        }
        __syncthreads();
        MK_STAMP();
        { const int b = bx >> 7, h = (bx >> 4) & 7, i4 = bx & 15;
        na::na_unit(b, h, i4, NAQKV, ssq_naq, ssq_nak, I_rpb, ONM, (char*)lds); }
        MK_STAMP();
    }
    GRID_BAR();
    }
    {
    {
        const int c = bx, bh = c >> 4, nc = c & 15, b = bh >> 3, h = bh & 7;
        {
            const int xb = (bx >> 6) & 1, xh = (bx >> 4) & 3, qt = bx & 15; const size_t tok0 = (size_t)xb * 4096 + qt * 256;
            const size_t o0 = ((size_t)b * 4096 + nc * 256) * 2048 + h * 256;
            const bool hx = bx < 128;
            mk::SchedList3 S; S.n = hx ? 2 : 1;
            const char* const ra = (const char*)(AR + ((size_t)bh * 4096 + nc * 256) * 512); const char* const rb = (const char*)(BR + (size_t)c * 256 * 512);
            S.u0.a = hx ? (const char*)(XP + tok0 * 1024 + xh * 256) : ra; S.u0.b = hx ? (const char*)(MVT + (size_t)xh * 256 * 512 + xb * 256) : rb;
            S.u0.lda = hx ? 1024 : 512; S.u0.ldb = 512; S.u0.nt = hx ? 4 : 8; S.u0.kind = hx ? 0 : 1; S.u0.perm = 1;
            S.u1.a = ra; S.u1.b = rb; S.u1.lda = 512; S.u1.ldb = 512; S.u1.nt = 8; S.u1.kind = 1; S.u1.perm = 1;
            S.u2.a = ra; S.u2.b = rb; S.u2.lda = 512; S.u2.ldb = 512; S.u2.nt = 8; S.u2.kind = 1; S.u2.perm = 1;
            mk::EpiM3 E{mk::EpiXO{ONM + tok0 * 2048 + 1024 + xh * 256, xl + tok0 * 16 + xh * 4}, mk::EpiGN{ORET + o0, RG + o0, I_gn + h * 256}};
            pg8::gemm_stream<mk::EpiM3, mk::SchedList3, true>(ldsl + RING_OFF, S, E);
        }
        MK_STAMP();
    }
    GRID_BAR();
    }
    {
    {
        mk::SchedBR S; S.o.init(mk::M, 2048, G, bx); S.onm = (const char*)ONM; S.oret = (const char*)ORET; S.wnm = (const char*)WnmT; S.wret = (const char*)WretT;
        const pg8::Gemm g{2048, 2048, 1024}; mk::EpiGate4 E{MERGED, GATES};
        pg8::gemm_phase<mk::EpiGate4, mk::SchedBR, true>(ldsl + RING_OFF, g, S, E);
    }
    GRID_BAR();
    }
    {
    {
        mk::SchedGrid S; S.o.init(mk::M, 2048, G, bx); S.A = (const char*)MERGED; S.B = (const char*)WoutT; S.ta = 256u * 2048u * 2u; S.tb = 256u * 2048u * 2u;
        const pg8::Gemm g{2048, 2048, 2048}; mk::EpiWout E{I_x, I_out, X1B, ssq_x1, I_g_ffn};
        pg8::gemm_phase<mk::EpiWout, mk::SchedGrid, false>(ldsl + RING_OFF, g, S, E);
    }
    GRID_BAR();
    }
    {
    {
        mk::SchedGrid S; S.o.init(mk::M, 8192, G, bx); S.A = (const char*)X1B; S.B = (const char*)Wff1T; S.ta = 256u * 2048u * 2u; S.tb = 256u * 2048u * 2u;
        const pg8::Gemm g{2048, 2048, 2048}; mk::EpiFF1 E{HFF, ssq_x1};
        pg8::gemm_phase<mk::EpiFF1, mk::SchedGrid, true>(ldsl + RING_OFF, g, S, E);
    }
    GRID_BAR();
    }
    if (false) {
        mk::SchedGrid S; S.o.init(mk::M, 2048, G, bx); S.A = (const char*)HFF; S.B = (const char*)Wff2T; S.ta = 256u * (unsigned)mk::LDH * 2u; S.tb = 256u * 8192u * 2u;
        const pg8::Gemm g{mk::LDH, 8192, 8192}; mk::EpiFF2 E{I_out, (float*)AR};
        pg8::gemm_phase<mk::EpiFF2, mk::SchedGrid, false>(ldsl + RING_OFF, g, S, E);
        GRID_BAR();
    }
    {
        mk::SchedGrid S; S.o.init(mk::M, 2048, G, bx); S.A = (const char*)HFF; S.B = (const char*)Wff2T; S.ta = 256u * (unsigned)mk::LDH * 2u; S.tb = 256u * 8192u * 2u;
        const pg8::Gemm g{mk::LDH, 8192, 8192}; mk::EpiFF2 E{I_out, I_out};
        pg8::gemm_phase<mk::EpiFF2, mk::SchedGrid, false>(ldsl + RING_OFF, g, S, E);
    }
    MK_STAMP();
    if (MK_TS >= 0 && bx == 0 && tid == 0) {
        const unsigned dt = MISC[16 + MK_TS + 1] - MISC[16 + MK_TS]; const unsigned long long t0 = __builtin_amdgcn_s_memrealtime();
        while (__builtin_amdgcn_s_memrealtime() - t0 < 8ull * dt) __builtin_amdgcn_s_sleep(8);
    }
}

extern "C" void kernel_launch(void* const* d_in, const int* in_sizes, int n_in, void* d_out, int out_size, void* d_ws, size_t ws_size, hipStream_t stream) {
    static int grid = 0;
    if (grid == 0) {
        if (n_in != 21 || out_size != mk::M * mk::D || ws_size < mk::WS_END) { fprintf(stderr, "kernel_launch: unexpected shapes (n_in %d out %d ws %zu); nothing launched\n", n_in, out_size, ws_size); grid = -1; return; }
        int dev = 0, cus = 0;
        if (hipGetDevice(&dev) != hipSuccess || hipDeviceGetAttribute(&cus, hipDeviceAttributeMultiprocessorCount, dev) != hipSuccess) { grid = -1; return; }
        if (hipFuncSetAttribute((const void*)mk_fwd, hipFuncAttributeMaxDynamicSharedMemorySize, LDS_BYTES) != hipSuccess) { fprintf(stderr, "kernel_launch: hipFuncSetAttribute failed\n"); grid = -1; return; }
        (void)hipGetLastError();
        grid = cus;
        if (grid != 256) fprintf(stderr, "kernel_launch: %d CUs; this kernel's unit maps assume 256\n", grid);
    }
    if (grid < 0) return;
    if (hipMemsetAsync((char*)d_ws + mk::WS_CTL, 0, mk::CTL_ZERO_BYTES, stream) != hipSuccess) return;
    Args a{};
    for (int i = 0; i < 21; ++i) a.in[i] = (const float*)d_in[i];
    a.out = (float*)d_out; a.ws = (unsigned char*)d_ws;
    hipLaunchKernelGGL(mk_fwd, dim3(grid), dim3(NWAVES * 64), LDS_BYTES, stream, a);
}
```

```cpp
#include <hip/hip_runtime.h>
#include <cstdio>
#include <cstdint>

#if defined(MK_TS)
#define PG8_DBG_STAMP() do { if (blockIdx.x == 0 && threadIdx.x == 0) { volatile __attribute__((address_space(3))) unsigned* M_ = (volatile __attribute__((address_space(3))) unsigned*)131392; const unsigned n_ = M_[15]; M_[16 + n_] = (unsigned)__builtin_amdgcn_s_memrealtime(); M_[15] = n_ + 1u; } } while (0)
#else
#define PG8_DBG_STAMP() do {} while (0)
#endif
namespace pg8 {
#define PG8_LAS __attribute__((address_space(3)))
typedef unsigned short bf16_t;
typedef short bf16x8 __attribute__((ext_vector_type(8)));
typedef float f32x4 __attribute__((ext_vector_type(4)));
typedef float f32x2 __attribute__((ext_vector_type(2)));
typedef unsigned u32x4 __attribute__((ext_vector_type(4)));
typedef unsigned u32x2 __attribute__((ext_vector_type(2)));
constexpr int BM = 256, BK = 64, HALF = 128, HTB = HALF * BK * 2, STAGE_BYTES = 8 * HTB, NXCD = 8, WGM = 4;

__host__ __device__ __forceinline__ int lds_byte(int r, int c) { const int st = (r >> 4) * 2 + (c >> 5), rr = r & 15, cc = c & 31, ob = rr * 64 + cc * 2; return st * 1024 + (ob ^ (((ob >> 9) & 1) << 5)); }
__host__ __device__ __forceinline__ void stage_rc(int b, int& R, int& C) { const int st = b / 1024, sb = b % 1024, swz = sb ^ (((sb >> 9) & 1) << 5); R = (st >> 1) * 16 + swz / 64; C = (st & 1) * 32 + (swz % 64) / 2; }
__host__ __device__ __forceinline__ int perm32(int rho) { const int n = rho >> 4, i = rho & 15; return 8 * (i >> 2) + 4 * n + (i & 3); }

struct Unit { int pm, pn, sub; };
struct Gemm { int lda, ldb, K; };

struct GridOrder {
    int nM, nN, nwg, G, c;
    __device__ void init(int M, int N, int G_, int c_) { nM = M / BM; nN = N / BM; nwg = nM * nN; G = G_; c = c_; }
    __device__ bool next(int i, Unit& u) const {
        const long L = (long)i * G + c; if (L >= nwg) return false;
        int wgid = (int)L; { const int q = nwg / NXCD, r = nwg % NXCD, xcd = wgid % NXCD, off = wgid / NXCD; wgid = (xcd < r ? xcd * (q + 1) : r * (q + 1) + (xcd - r) * q) + off; }
        const int nig = WGM * nN, gid = wgid / nig, fm = gid * WGM, gsz = (nM - fm) < WGM ? (nM - fm) : WGM;
        u.pm = fm + ((wgid % nig) % gsz); u.pn = (wgid % nig) / gsz; u.sub = 0; return true;
    }
};

typedef float f32x2_cv __attribute__((ext_vector_type(2))); typedef __bf16 bf16x2_cv __attribute__((ext_vector_type(2)));
__device__ __forceinline__ unsigned cvt_pk_bf16(float lo, float hi) { const f32x2_cv v = {lo, hi}; const bf16x2_cv b = __builtin_convertvector(v, bf16x2_cv); return __builtin_bit_cast(unsigned, b); }
__device__ __forceinline__ void store8(bf16_t* p, f32x4 v0, f32x4 v1) { u32x4 w; w.x = cvt_pk_bf16(v0[0], v0[1]); w.y = cvt_pk_bf16(v0[2], v0[3]); w.z = cvt_pk_bf16(v1[0], v1[1]); w.w = cvt_pk_bf16(v1[2], v1[3]); *(u32x4*)p = w; }
__device__ __forceinline__ void store4(bf16_t* p, f32x4 v0) { u32x2 w; w.x = cvt_pk_bf16(v0[0], v0[1]); w.y = cvt_pk_bf16(v0[2], v0[3]); *(u32x2*)p = w; }
__device__ __forceinline__ float bf2f(unsigned short h) { return __uint_as_float((unsigned)h << 16); }
__device__ __forceinline__ void load8(const bf16_t* p, f32x4& v0, f32x4& v1) { const u32x4 w = *(const u32x4*)p;
    v0[0] = __uint_as_float(w.x << 16); v0[1] = __uint_as_float(w.x & 0xffff0000u); v0[2] = __uint_as_float(w.y << 16); v0[3] = __uint_as_float(w.y & 0xffff0000u);
    v1[0] = __uint_as_float(w.z << 16); v1[1] = __uint_as_float(w.z & 0xffff0000u); v1[2] = __uint_as_float(w.w << 16); v1[3] = __uint_as_float(w.w & 0xffff0000u); }
__device__ __forceinline__ void load8_nt(const bf16_t* p, f32x4& v0, f32x4& v1) { const u32x4 w = __builtin_nontemporal_load((const u32x4*)p);
    v0[0] = __uint_as_float(w.x << 16); v0[1] = __uint_as_float(w.x & 0xffff0000u); v0[2] = __uint_as_float(w.y << 16); v0[3] = __uint_as_float(w.y & 0xffff0000u);
    v1[0] = __uint_as_float(w.z << 16); v1[1] = __uint_as_float(w.z & 0xffff0000u); v1[2] = __uint_as_float(w.w << 16); v1[3] = __uint_as_float(w.w & 0xffff0000u); }
__device__ __forceinline__ void load8_l2(const bf16_t* p, f32x4& v0, f32x4& v1) { u32x4 w; const unsigned long long a = __hip_atomic_load((const unsigned long long*)p, __ATOMIC_RELAXED, __HIP_MEMORY_SCOPE_AGENT), b = __hip_atomic_load((const unsigned long long*)p + 1, __ATOMIC_RELAXED, __HIP_MEMORY_SCOPE_AGENT);
    w.x = (unsigned)a; w.y = (unsigned)(a >> 32); w.z = (unsigned)b; w.w = (unsigned)(b >> 32);
    v0[0] = __uint_as_float(w.x << 16); v0[1] = __uint_as_float(w.x & 0xffff0000u); v0[2] = __uint_as_float(w.y << 16); v0[3] = __uint_as_float(w.y & 0xffff0000u);
    v1[0] = __uint_as_float(w.z << 16); v1[1] = __uint_as_float(w.z & 0xffff0000u); v1[2] = __uint_as_float(w.w << 16); v1[3] = __uint_as_float(w.w & 0xffff0000u); }
__device__ __forceinline__ float fexp2(float x) { return __builtin_amdgcn_exp2f(x); }
__device__ __forceinline__ float frcp(float x) { return __builtin_amdgcn_rcpf(x); }
__device__ __forceinline__ float sigmoidf_(float x) { return frcp(1.f + fexp2(-1.4426950408889634f * x)); }

template <class Epi, class Sched, bool ALIGN_EPI>
__device__ __forceinline__ void gemm_phase(PG8_LAS unsigned char* lds, const Gemm g, const Sched& S, const Epi& E) {
    int tid_ = threadIdx.x; asm volatile("" : "+v"(tid_));
    const int tid = tid_, wid = __builtin_amdgcn_readfirstlane(tid >> 6), lane = tid & 63, wr = wid >> 2, wc = wid & 3, fr = lane & 15, fq = lane >> 4;
    unsigned voffA[2], voffB[2];
#pragma unroll
    for (int i = 0; i < 2; ++i) { int R, C; stage_rc(tid * 16 + i * 8192, R, C); const int Rb = Epi::PERM ? ((R & ~31) + perm32(R & 31)) : R;
        voffA[i] = (unsigned)(R * g.lda + C) * 2u; voffB[i] = (unsigned)(Rb * g.ldb + C) * 2u; }
    const size_t kstep = (size_t)(BK * 2);
    const size_t hstepA = (size_t)HALF * g.lda * 2, hstepB = (size_t)HALF * g.ldb * 2;
    const unsigned ldsw = (unsigned)wid * 1024u;
    const int aoff = lds_byte(wr * 64 + fr, fq * 8), boff = lds_byte(wc * 32 + fr, fq * 8);
#define PG8_SA(b, h) (((b) * 2 + (h)) * HTB)
#define PG8_SB(b, h) ((4 + (b) * 2 + (h)) * HTB)
#define PG8_STAGE(bufoff, gbase, voff) do { _Pragma("unroll") for (int _i = 0; _i < 2; ++_i) \
        __builtin_amdgcn_global_load_lds((const unsigned*)((const char*)(gbase) + (voff)[_i]), (PG8_LAS unsigned*)(lds + (bufoff) + ldsw + _i * 8192), 16, 0, 0); } while (0)
#define PG8_LDA(dst, b, h) do { _Pragma("unroll") for (int m = 0; m < 4; ++m) _Pragma("unroll") for (int k = 0; k < 2; ++k) dst[m][k] = *(const PG8_LAS bf16x8*)(lds + PG8_SA(b, h) + aoff + m * 2048 + k * 1024); } while (0)
#define PG8_LDB(dst, b, h) do { _Pragma("unroll") for (int n = 0; n < 2; ++n) _Pragma("unroll") for (int k = 0; k < 2; ++k) dst[n][k] = *(const PG8_LAS bf16x8*)(lds + PG8_SB(b, h) + boff + n * 2048 + k * 1024); } while (0)
#define PG8_MMA(ai, bj, At, Bt) do { __builtin_amdgcn_s_setprio(1); _Pragma("unroll") for (int m = 0; m < 4; ++m) _Pragma("unroll") for (int n = 0; n < 2; ++n) _Pragma("unroll") for (int k = 0; k < 2; ++k) \
        acc[ai][bj][m][n] = __builtin_amdgcn_mfma_f32_16x16x32_bf16(Bt[n][k], At[m][k], acc[ai][bj][m][n], 0, 0, 0); __builtin_amdgcn_s_setprio(0); } while (0)
#define PG8_WAIT_V(n) asm volatile("s_waitcnt vmcnt(" #n ")" ::: "memory")
#define PG8_WAIT_L(n) asm volatile("s_waitcnt lgkmcnt(" #n ")" ::: "memory")
#define PG8_BAR __builtin_amdgcn_s_barrier()
#define PG8_SCHED __builtin_amdgcn_sched_barrier(0)
    Unit cur, nxt; int ui = 0;
    if (!S.next(0, cur)) return;
    f32x4 acc[2][2][4][2];
    if constexpr (Epi::INIT_C) { int fr2 = fr, fq2 = fq; asm volatile("" : "+v"(fr2), "+v"(fq2)); E.init_c(acc, cur, wr, wc, fr2, fq2); }
    else {
#pragma unroll
    for (int a = 0; a < 2; ++a)
#pragma unroll
        for (int b = 0; b < 2; ++b)
#pragma unroll
            for (int m = 0; m < 4; ++m)
#pragma unroll
                for (int n = 0; n < 2; ++n) acc[a][b][m][n] = (f32x4){0.f, 0.f, 0.f, 0.f};
    }
    bf16x8 At[4][2], B0[2][2], B1[2][2];
    const char* cA; const char* cB; S.ptrs(cur, cA, cB);
    PG8_STAGE(PG8_SB(0, 0), cB, voffB); PG8_STAGE(PG8_SB(0, 1), cB + hstepB, voffB); PG8_STAGE(PG8_SA(0, 0), cA, voffA); PG8_STAGE(PG8_SA(0, 1), cA + hstepA, voffA);
    if (wr == 1) PG8_BAR;
    PG8_WAIT_V(2); PG8_BAR;
    PG8_STAGE(PG8_SB(1, 0), cB + kstep, voffB); PG8_STAGE(PG8_SA(1, 0), cA + kstep, voffA); PG8_STAGE(PG8_SB(1, 1), cB + hstepB + kstep, voffB);
    PG8_WAIT_V(6); PG8_BAR;
    for (;;) {
        const bool has_next = S.next(ui + 1, nxt); const int nt = S.nt(cur, g.K) ;
        const char* nA = cA; const char* nB = cB; if (has_next) S.ptrs(nxt, nA, nB);
        for (int t = 0; t < nt; t += 2) {
            const bool last = (t == nt - 2);
            const char* a1 = cA + (size_t)(t + 1) * kstep;
            const char* a2 = last ? nA : cA + (size_t)(t + 2) * kstep; const char* b2 = last ? nB : cB + (size_t)(t + 2) * kstep;
            const char* a3 = a2 + kstep; const char* b3 = b2 + kstep;
            PG8_LDB(B0, 0, 0); PG8_LDB(B1, 0, 1); PG8_SCHED; PG8_LDA(At, 0, 0); PG8_STAGE(PG8_SA(1, 1), a1 + hstepA, voffA);
            PG8_WAIT_V(8); PG8_WAIT_L(0); PG8_BAR; PG8_MMA(0, 0, At, B0); PG8_MMA(0, 1, At, B1); PG8_BAR; PG8_SCHED;
            PG8_LDA(At, 0, 1); PG8_STAGE(PG8_SB(0, 0), b2, voffB); PG8_STAGE(PG8_SB(0, 1), b2 + hstepB, voffB); PG8_STAGE(PG8_SA(0, 0), a2, voffA);
            PG8_WAIT_V(8); PG8_WAIT_L(0); PG8_BAR; PG8_MMA(1, 0, At, B0); PG8_MMA(1, 1, At, B1); PG8_BAR; PG8_SCHED;
            PG8_LDB(B0, 1, 0); PG8_LDB(B1, 1, 1); PG8_SCHED; PG8_LDA(At, 1, 0); PG8_STAGE(PG8_SA(0, 1), a2 + hstepA, voffA);
            PG8_WAIT_V(8); PG8_WAIT_L(0); PG8_BAR; PG8_MMA(0, 0, At, B0); PG8_MMA(0, 1, At, B1); PG8_BAR; PG8_SCHED;
            PG8_LDA(At, 1, 1); PG8_STAGE(PG8_SB(1, 0), b3, voffB); PG8_STAGE(PG8_SB(1, 1), b3 + hstepB, voffB); PG8_STAGE(PG8_SA(1, 0), a3, voffA);
            PG8_WAIT_V(8); PG8_WAIT_L(0); PG8_BAR; PG8_MMA(1, 0, At, B0); PG8_MMA(1, 1, At, B1); PG8_BAR; PG8_SCHED;
        }
        if constexpr (ALIGN_EPI) { if (wr == 0) PG8_BAR; }
        if constexpr (!Epi::AFTER_DRAIN) { int fr2 = fr, fq2 = fq; asm volatile("" : "+v"(fr2), "+v"(fq2)); E(acc, cur, wr, wc, fr2, fq2); }
        if (!has_next) break;
        if constexpr (Epi::INIT_C) { int fr2 = fr, fq2 = fq; asm volatile("" : "+v"(fr2), "+v"(fq2)); E.init_c(acc, nxt, wr, wc, fr2, fq2); }
        else {
#pragma unroll
        for (int a = 0; a < 2; ++a)
#pragma unroll
            for (int b = 0; b < 2; ++b)
#pragma unroll
                for (int m = 0; m < 4; ++m)
#pragma unroll
                    for (int n = 0; n < 2; ++n) acc[a][b][m][n] = (f32x4){0.f, 0.f, 0.f, 0.f};
        }
        cur = nxt; cA = nA; cB = nB; ++ui;
        if constexpr (ALIGN_EPI) { if (wr == 1) PG8_BAR; }
    }
    PG8_WAIT_V(0);
    if constexpr (!ALIGN_EPI) { if (wr == 0) PG8_BAR; }
    PG8_BAR;
    if constexpr (Epi::AFTER_DRAIN) { int fr2 = fr, fq2 = fq; asm volatile("" : "+v"(fr2), "+v"(fq2)); E.fused(acc, cur, wr, wc, fr2, fq2, lds, wid, lane); }
#undef PG8_SA
#undef PG8_SB
#undef PG8_STAGE
#undef PG8_LDA
#undef PG8_LDB
#undef PG8_MMA
#undef PG8_WAIT_V
#undef PG8_WAIT_L
#undef PG8_BAR
#undef PG8_SCHED
}
struct UnitG { const char* a; const char* b; int lda, ldb, nt, kind, perm; };
template <class Epi, class Sched, bool ALIGN_EPI>
__device__ __forceinline__ void gemm_stream(PG8_LAS unsigned char* lds, const Sched& S, const Epi& E) {
    int tid_ = threadIdx.x; asm volatile("" : "+v"(tid_));
    const int tid = tid_, wid = __builtin_amdgcn_readfirstlane(tid >> 6), lane = tid & 63, wr = wid >> 2, wc = wid & 3, fr = lane & 15, fq = lane >> 4;
#define PG8_VOFF(u, vA, vB) do { _Pragma("unroll") for (int i_ = 0; i_ < 2; ++i_) { int R_, C_; stage_rc(tid * 16 + i_ * 8192, R_, C_); const int Rb_ = (u).perm ? ((R_ & ~31) + perm32(R_ & 31)) : R_; \
        vA[i_] = (unsigned)(R_ * (u).lda + C_) * 2u; vB[i_] = (unsigned)(Rb_ * (u).ldb + C_) * 2u; } } while (0)
    const size_t kstep = (size_t)(BK * 2);
    const unsigned ldsw = (unsigned)wid * 1024u;
    const int aoff = lds_byte(wr * 64 + fr, fq * 8), boff = lds_byte(wc * 32 + fr, fq * 8);
#undef PG8_SA
#undef PG8_SB
#undef PG8_STAGE
#undef PG8_LDA
#undef PG8_LDB
#undef PG8_MMA
#undef PG8_WAIT_V
#undef PG8_WAIT_L
#undef PG8_BAR
#undef PG8_SCHED
#define PG8_SA(b, h) (((b) * 2 + (h)) * HTB)
#define PG8_SB(b, h) ((4 + (b) * 2 + (h)) * HTB)
#define PG8_STAGE(bufoff, gbase, voff) do { _Pragma("unroll") for (int _i = 0; _i < 2; ++_i) \
        __builtin_amdgcn_global_load_lds((const unsigned*)((const char*)(gbase) + (voff)[_i]), (PG8_LAS unsigned*)(lds + (bufoff) + ldsw + _i * 8192), 16, 0, 0); } while (0)
#define PG8_LDA(dst, b, h) do { _Pragma("unroll") for (int m = 0; m < 4; ++m) _Pragma("unroll") for (int k = 0; k < 2; ++k) dst[m][k] = *(const PG8_LAS bf16x8*)(lds + PG8_SA(b, h) + aoff + m * 2048 + k * 1024); } while (0)
#define PG8_LDB(dst, b, h) do { _Pragma("unroll") for (int n = 0; n < 2; ++n) _Pragma("unroll") for (int k = 0; k < 2; ++k) dst[n][k] = *(const PG8_LAS bf16x8*)(lds + PG8_SB(b, h) + boff + n * 2048 + k * 1024); } while (0)
#define PG8_MMA(ai, bj, At, Bt) do { __builtin_amdgcn_s_setprio(1); _Pragma("unroll") for (int m = 0; m < 4; ++m) _Pragma("unroll") for (int n = 0; n < 2; ++n) _Pragma("unroll") for (int k = 0; k < 2; ++k) \
        acc[ai][bj][m][n] = __builtin_amdgcn_mfma_f32_16x16x32_bf16(Bt[n][k], At[m][k], acc[ai][bj][m][n], 0, 0, 0); __builtin_amdgcn_s_setprio(0); } while (0)
#define PG8_WAIT_V(n) asm volatile("s_waitcnt vmcnt(" #n ")" ::: "memory")
#define PG8_WAIT_L(n) asm volatile("s_waitcnt lgkmcnt(" #n ")" ::: "memory")
#define PG8_BAR __builtin_amdgcn_s_barrier()
#define PG8_SCHED __builtin_amdgcn_sched_barrier(0)
    UnitG cur, nxt; int ui = 0;
    if (!S.next(0, cur)) return;
    unsigned voffA[2], voffB[2]; PG8_VOFF(cur, voffA, voffB);
    size_t hstepA = (size_t)HALF * cur.lda * 2, hstepB = (size_t)HALF * cur.ldb * 2;
    f32x4 acc[2][2][4][2];
#pragma unroll
    for (int a = 0; a < 2; ++a)
#pragma unroll
        for (int b = 0; b < 2; ++b)
#pragma unroll
            for (int m = 0; m < 4; ++m)
#pragma unroll
                for (int n = 0; n < 2; ++n) acc[a][b][m][n] = (f32x4){0.f, 0.f, 0.f, 0.f};
    bf16x8 At[4][2], B0[2][2], B1[2][2];
    const char* cA = cur.a; const char* cB = cur.b;
    PG8_STAGE(PG8_SB(0, 0), cB, voffB); PG8_STAGE(PG8_SB(0, 1), cB + hstepB, voffB); PG8_STAGE(PG8_SA(0, 0), cA, voffA); PG8_STAGE(PG8_SA(0, 1), cA + hstepA, voffA);
    if (wr == 1) PG8_BAR;
    PG8_WAIT_V(2); PG8_BAR;
    PG8_STAGE(PG8_SB(1, 0), cB + kstep, voffB); PG8_STAGE(PG8_SA(1, 0), cA + kstep, voffA); PG8_STAGE(PG8_SB(1, 1), cB + hstepB + kstep, voffB);
    PG8_WAIT_V(6); PG8_BAR; PG8_DBG_STAMP();
    for (;;) {
        const bool has_next = S.next(ui + 1, nxt); const int nt = cur.nt; if (!has_next) nxt = cur;
        const char* nA = nxt.a; const char* nB = nxt.b;
        const size_t nhA = (size_t)HALF * nxt.lda * 2, nhB = (size_t)HALF * nxt.ldb * 2;
        for (int t = 0; t < nt; t += 2) {
            const bool last = (t == nt - 2);
            const char* a1 = cA + (size_t)(t + 1) * kstep;
            const char* a2 = last ? nA : cA + (size_t)(t + 2) * kstep; const char* b2 = last ? nB : cB + (size_t)(t + 2) * kstep;
            const char* a3 = a2 + kstep; const char* b3 = b2 + kstep;
            unsigned xvA[2], xvB[2]; if (last) { PG8_VOFF(nxt, xvA, xvB); } else { xvA[0] = voffA[0]; xvA[1] = voffA[1]; xvB[0] = voffB[0]; xvB[1] = voffB[1]; }
            const size_t xhA = last ? nhA : hstepA, xhB = last ? nhB : hstepB;
            PG8_LDB(B0, 0, 0); PG8_LDB(B1, 0, 1); PG8_SCHED; PG8_LDA(At, 0, 0); PG8_STAGE(PG8_SA(1, 1), a1 + hstepA, voffA);
            PG8_WAIT_V(8); PG8_WAIT_L(0); PG8_BAR; PG8_MMA(0, 0, At, B0); PG8_MMA(0, 1, At, B1); PG8_BAR; PG8_SCHED;
            PG8_LDA(At, 0, 1); PG8_STAGE(PG8_SB(0, 0), b2, xvB); PG8_STAGE(PG8_SB(0, 1), b2 + xhB, xvB); PG8_STAGE(PG8_SA(0, 0), a2, xvA);
            PG8_WAIT_V(8); PG8_WAIT_L(0); PG8_BAR; PG8_MMA(1, 0, At, B0); PG8_MMA(1, 1, At, B1); PG8_BAR; PG8_SCHED;
            PG8_LDB(B0, 1, 0); PG8_LDB(B1, 1, 1); PG8_SCHED; PG8_LDA(At, 1, 0); PG8_STAGE(PG8_SA(0, 1), a2 + xhA, xvA);
            PG8_WAIT_V(8); PG8_WAIT_L(0); PG8_BAR; PG8_MMA(0, 0, At, B0); PG8_MMA(0, 1, At, B1); PG8_BAR; PG8_SCHED;
            PG8_LDA(At, 1, 1); PG8_STAGE(PG8_SB(1, 0), b3, xvB); PG8_STAGE(PG8_SB(1, 1), b3 + xhB, xvB); PG8_STAGE(PG8_SA(1, 0), a3, xvA);
            PG8_WAIT_V(8); PG8_WAIT_L(0); PG8_BAR; PG8_MMA(1, 0, At, B0); PG8_MMA(1, 1, At, B1); PG8_BAR; PG8_SCHED;
        }
        if constexpr (ALIGN_EPI) { if (wr == 0) PG8_BAR; } PG8_DBG_STAMP();
        if (!E.after_drain(cur)) { int fr2 = fr, fq2 = fq; asm volatile("" : "+v"(fr2), "+v"(fq2)); E(acc, cur, wr, wc, fr2, fq2); }
        PG8_DBG_STAMP();
        if (!has_next) break;
#pragma unroll
        for (int a = 0; a < 2; ++a)
#pragma unroll
            for (int b = 0; b < 2; ++b)
#pragma unroll
                for (int m = 0; m < 4; ++m)
#pragma unroll
                    for (int n = 0; n < 2; ++n) acc[a][b][m][n] = (f32x4){0.f, 0.f, 0.f, 0.f};
        cur = nxt; cA = nA; cB = nB; ++ui; PG8_VOFF(cur, voffA, voffB); hstepA = nhA; hstepB = nhB;
        if constexpr (ALIGN_EPI) { if (wr == 1) PG8_BAR; }
    }
    PG8_WAIT_V(0);
    if constexpr (!ALIGN_EPI) { if (wr == 0) PG8_BAR; }
    PG8_BAR;
    if (E.after_drain(cur)) { int fr2 = fr, fq2 = fq; asm volatile("" : "+v"(fr2), "+v"(fq2)); E.fused(acc, cur, wr, wc, fr2, fq2, lds, wid, lane); }
#undef PG8_SA
#undef PG8_SB
#undef PG8_STAGE
#undef PG8_LDA
#undef PG8_LDB
#undef PG8_MMA
#undef PG8_WAIT_V
#undef PG8_WAIT_L
#undef PG8_BAR
#undef PG8_SCHED
#undef PG8_VOFF
}
}

namespace mk {
using pg8::bf16_t; using pg8::f32x4; using pg8::f32x2; using pg8::u32x4; using pg8::u32x2; using pg8::Unit;
constexpr int D = 2048, BATCH = 2, SEQ = 4096, M = BATCH * SEQ, D_IN = 16384, D_FF = 8192, N_MEM = 256;
constexpr float EPS = 1e-6f, LOG2E = 1.4426950408889634f;
constexpr size_t MiB = 1u << 20;
constexpr size_t WS_CTL = 0, CTL_ZERO_BYTES = 32 * 1024;
constexpr size_t WS_COS = 1 * MiB, WS_SIN = 2 * MiB;
constexpr size_t WS_SSQ_NAQ = 3 * MiB, WS_SSQ_NAK = 4 * MiB;
constexpr size_t WS_SSQ_XQ = 5 * MiB, WS_XL = 5 * MiB + 512 * 1024;
constexpr size_t WS_SSQ_X1 = 6 * MiB;
constexpr size_t WS_TAB = 6 * MiB + 512 * 1024;
constexpr int TAB_CS_NAQ = 0, TAB_CS_MK = 128, TAB_L2F = 384, TAB_L2B = 392, TAB_SSQ_MK = 1024;
constexpr size_t WS_MEMN = 8 * MiB, WS_MK = 10 * MiB, WS_MVT = 11 * MiB;
constexpr size_t WS_WIN = 16 * MiB, WS_WFF1 = 80 * MiB, WS_WFF2 = 112 * MiB, WS_WRET = 144 * MiB, WS_WOUT = 152 * MiB, WS_WNM = 160 * MiB  , WS_WMKV = 168 * MiB;
constexpr size_t WS_NAQKV = 176 * MiB, WS_K0 = 224 * MiB, WS_RG = 240 * MiB, WS_XQ = 272 * MiB, WS_GATES = 288 * MiB;
constexpr size_t WS_AR = 384 * MiB, WS_BR = 448 * MiB, WS_END = 512 * MiB;
constexpr size_t WS_KV = WS_WIN;
constexpr size_t WS_ORET = 16 * MiB;
constexpr size_t WS_MERGED = WS_NAQKV;
constexpr size_t WS_X1B = WS_AR;
constexpr size_t WS_HFF = 176 * MiB;
constexpr int LDH = 8192;
constexpr size_t DO_HN = 0, DO_KT = 0, DO_XP = 32 * MiB, DO_ONM = 0;

struct SchedGrid {
    pg8::GridOrder o; const char* A; const char* B; size_t ta, tb;
    __device__ __forceinline__ bool next(int i, Unit& u) const { return o.next(i, u); }
    __device__ __forceinline__ void ptrs(const Unit& u, const char*& a, const char*& b) const { a = A + (size_t)u.pm * ta; b = B + (size_t)u.pn * tb; }
    __device__ __forceinline__ int nt(const Unit&, int K) const { return K / 64; }
};
struct SchedProj {
    pg8::GridOrder o; const char* hn_; const char* wt_;
    __device__ __forceinline__ bool next(int i, Unit& u) const { return o.next(i, u); }
    __device__ __forceinline__ void ptrs(const Unit& u, const char*& a, const char*& b) const {
        const char* h = hn_ + (size_t)u.pm * (256u * 2048u * 2u); const char* w = wt_ + (size_t)u.pn * (256u * 2048u * 2u);
        const bool sw = (u.pn >= 20 && u.pn < 28); a = sw ? w : h; b = sw ? h : w; }
    __device__ __forceinline__ int nt(const Unit&, int K) const { return K / 64; }
};
struct SchedOne { bool has; Unit u; const char* a; const char* b;
    __device__ __forceinline__ bool next(int i, Unit& uu) const { if (i != 0 || !has) return false; uu = u; return true; }
    __device__ __forceinline__ void ptrs(const Unit&, const char*& aa, const char*& bb) const { aa = a; bb = b; }
    __device__ __forceinline__ int nt(const Unit&, int K) const { return K / 64; }
};

#define MK_ROWS_BEGIN _Pragma("unroll") for (int ai = 0; ai < 2; ++ai) { _Pragma("unroll") for (int m = 0; m < 4; ++m) { const int rl = ai * 128 + wr * 64 + m * 16 + fr;
#define MK_ROWS_END __builtin_amdgcn_sched_barrier(0); } }
#define MK_ROWS_END_NB } }
#define MK_ROWS_END2 if (m & 1) __builtin_amdgcn_sched_barrier(0); } }
#define MK_RL(ai, m) ((ai) * 128 + wr * 64 + (m) * 16 + fr)
__device__ __forceinline__ float sq8(const f32x4& a, const f32x4& b) { return (a[0] * a[0] + a[1] * a[1]) + (a[2] * a[2] + a[3] * a[3]) + (b[0] * b[0] + b[1] * b[1]) + (b[2] * b[2] + b[3] * b[3]); }
__device__ __forceinline__ float red_fq(float s) {
    { auto r = __builtin_amdgcn_permlane16_swap(__float_as_uint(s), __float_as_uint(s), false, false); s = __uint_as_float(r[0]) + __uint_as_float(r[1]); }
    { auto r = __builtin_amdgcn_permlane32_swap(__float_as_uint(s), __float_as_uint(s), false, false); s = __uint_as_float(r[0]) + __uint_as_float(r[1]); }
    return s; }

struct EpiProj {
    static constexpr bool PERM = true, AFTER_DRAIN = false, INIT_C = false;
    unsigned char* ws;
    __device__ __forceinline__ void operator()(const f32x4 (&acc)[2][2][4][2], const Unit& u, int wr, int wc, int fr, int fq) const {
        bf16_t* const naqkv = (bf16_t*)(ws + WS_NAQKV); bf16_t* const k0 = (bf16_t*)(ws + WS_K0); bf16_t* const rg = (bf16_t*)(ws + WS_RG); bf16_t* const xq = (bf16_t*)(ws + WS_XQ);
        bf16_t* const gates = (bf16_t*)(ws + WS_GATES); bf16_t* const ar = (bf16_t*)(ws + WS_AR); bf16_t* const br = (bf16_t*)(ws + WS_BR);
        float* const ssq_naq = (float*)(ws + WS_SSQ_NAQ); float* const ssq_nak = (float*)(ws + WS_SSQ_NAK); float* const ssq_xq = (float*)(ws + WS_SSQ_XQ);
        const float* const cosT = (const float*)(ws + WS_COS); const float* const sinT = (const float*)(ws + WS_SIN); const float* const tab = (const float*)(ws + WS_TAB);
        const int pn = u.pn, row0 = u.pm * 256, cw = wc * 32 + 8 * fq;
        if (pn < 8) {
            const bool isq = pn < 4; float* ssq = isq ? ssq_naq : ssq_nak; const int hb = isq ? 2 * pn : 2 * (pn - 4);
            f32x4 c0 = (f32x4){1.f, 1.f, 1.f, 1.f}, c1 = c0; if (isq) { c0 = *(const f32x4*)(tab + TAB_CS_NAQ + cw); c1 = *(const f32x4*)(tab + TAB_CS_NAQ + cw + 4); }
            MK_ROWS_BEGIN  const int row = row0 + rl;
#pragma unroll
                for (int bj = 0; bj < 2; ++bj) { const f32x4 v0 = acc[ai][bj][m][0], v1 = acc[ai][bj][m][1]; const float q = red_fq(sq8(v0, v1));
                    if (fq == 0) ssq[(size_t)row * 32 + (hb + bj) * 4 + wc] = q;
                    pg8::store8(naqkv + (size_t)row * 3072 + pn * 256 + bj * 128 + cw, v0 * c0, v1 * c1); }  MK_ROWS_END
        } else if (pn < 12) {
            MK_ROWS_BEGIN  const int row = row0 + rl;
#pragma unroll
                for (int bj = 0; bj < 2; ++bj) pg8::store8(naqkv + (size_t)row * 3072 + pn * 256 + bj * 128 + cw, acc[ai][bj][m][0], acc[ai][bj][m][1]);  MK_ROWS_END
        } else if (pn < 20) {
            const bool isq = pn < 16; const int head = 2 * (pn & 3) + (wc >> 1), i0 = 32 * (wc & 1) + 8 * fq;
            const float l2f = tab[TAB_L2F + head], l2b = tab[TAB_L2B + head];
            MK_ROWS_BEGIN  const int row = row0 + rl, s = row & 4095, b = row >> 12;
                const f32x4 cs0 = *(const f32x4*)(cosT + s * 64 + i0), cs1 = *(const f32x4*)(cosT + s * 64 + i0 + 4), sn0 = *(const f32x4*)(sinT + s * 64 + i0), sn1 = *(const f32x4*)(sinT + s * 64 + i0 + 4);
                const f32x4 a0 = acc[ai][0][m][0], a1 = acc[ai][0][m][1], b0 = acc[ai][1][m][0], b1 = acc[ai][1][m][1];
                const f32x4 lo0 = a0 * cs0 - b0 * sn0, lo1 = a1 * cs1 - b1 * sn1, hi0 = a0 * sn0 + b0 * cs0, hi1 = a1 * sn1 + b1 * cs1;
                if (isq) { const int c = row & 255; const float df = pg8::fexp2(l2f * (float)(c + 1)), db = pg8::fexp2(l2b * (float)(256 - c));
                    bf16_t* d = ar + ((size_t)(b * 8 + head) * 4096 + s) * 512 + 256 + i0;
                    pg8::store8(d, lo0 * df, lo1 * df); pg8::store8(d + 64, hi0 * df, hi1 * df); pg8::store8(d + 128, lo0 * db, lo1 * db); pg8::store8(d + 192, hi0 * db, hi1 * db);
                } else { const float sc = 0.08838834764831845f; bf16_t* d = k0 + (size_t)row * 1024 + head * 128 + i0;
                    pg8::store8(d, lo0 * sc, lo1 * sc); pg8::store8(d + 64, hi0 * sc, hi1 * sc); }  MK_ROWS_END2
        } else if (pn < 28) {
            const int hv = pn - 20, b = u.pm >> 4, nc = u.pm & 15;
            bf16_t* base = br + ((size_t)((b * 8 + hv) * 16 + nc) * 256) * 512;
            MK_ROWS_BEGIN
#pragma unroll
                for (int bj = 0; bj < 2; ++bj) pg8::store8(base + (size_t)rl * 512 + bj * 128 + cw, acc[ai][bj][m][0], acc[ai][bj][m][1]);  MK_ROWS_END
        } else if (pn < 36) {
            MK_ROWS_BEGIN  const int row = row0 + rl;
#pragma unroll
                for (int bj = 0; bj < 2; ++bj) { f32x4 v0 = acc[ai][bj][m][0], v1 = acc[ai][bj][m][1];
#pragma unroll
                    for (int e = 0; e < 4; ++e) { v0[e] = v0[e] * pg8::sigmoidf_(v0[e]); v1[e] = v1[e] * pg8::sigmoidf_(v1[e]); }
                    pg8::store8(rg + (size_t)row * 2048 + (pn - 28) * 256 + bj * 128 + cw, v0, v1); }  MK_ROWS_END
        } else if (pn < 40) {
            MK_ROWS_BEGIN  const int row = row0 + rl;
                const float q = red_fq(sq8(acc[ai][0][m][0], acc[ai][0][m][1]) + sq8(acc[ai][1][m][0], acc[ai][1][m][1]));
                if (fq == 0) ssq_xq[(size_t)row * 16 + (pn - 36) * 4 + wc] = q;
#pragma unroll
                for (int bj = 0; bj < 2; ++bj) pg8::store8(xq + (size_t)row * 1024 + (pn - 36) * 256 + bj * 128 + cw, acc[ai][bj][m][0], acc[ai][bj][m][1]);  MK_ROWS_END
        } else {
            MK_ROWS_BEGIN  const int row = row0 + rl;
#pragma unroll
                for (int bj = 0; bj < 2; ++bj) { f32x4 v0 = acc[ai][bj][m][0], v1 = acc[ai][bj][m][1];
#pragma unroll
                    for (int e = 0; e < 4; ++e) { v0[e] = pg8::sigmoidf_(v0[e]); v1[e] = pg8::sigmoidf_(v1[e]); }
                    pg8::store8(gates + (size_t)row * 6144 + (pn - 40) * 256 + bj * 128 + cw, v0, v1); }  MK_ROWS_END
        }
    }
};
struct EpiMKV {
    static constexpr bool PERM = true, AFTER_DRAIN = false, INIT_C = false;
    bf16_t *mk, *mvt; float* tabw; const float* tab; int mode;
    __device__ __forceinline__ void operator()(const f32x4 (&acc)[2][2][4][2], const Unit& u, int wr, int wc, int fr, int fq) const {
        const int cw = wc * 32 + 8 * fq, row0 = u.pm * 256;
        if (mode == 0) {
            MK_ROWS_BEGIN  const int row = row0 + rl;
                const float q = red_fq(sq8(acc[ai][0][m][0], acc[ai][0][m][1]) + sq8(acc[ai][1][m][0], acc[ai][1][m][1]));
                if (fq == 0) tabw[TAB_SSQ_MK + row * 16 + u.pn * 4 + wc] = q;
#pragma unroll
                for (int bj = 0; bj < 2; ++bj) { const f32x4 c0 = *(const f32x4*)(tab + TAB_CS_MK + bj * 128 + cw), c1 = *(const f32x4*)(tab + TAB_CS_MK + bj * 128 + cw + 4);
                    pg8::store8(mk + (size_t)row * 1024 + u.pn * 256 + bj * 128 + cw, acc[ai][bj][m][0] * c0, acc[ai][bj][m][1] * c1); }  MK_ROWS_END
        } else {
            MK_ROWS_BEGIN  const int row = row0 + rl;
#pragma unroll
                for (int bj = 0; bj < 2; ++bj) pg8::store8(mvt + (size_t)row * 512 + u.pn * 256 + bj * 128 + cw, acc[ai][bj][m][0], acc[ai][bj][m][1]);  MK_ROWS_END
        }
    }
};
struct EpiF32 {
    static constexpr bool PERM = true, AFTER_DRAIN = false, INIT_C = false;
    bf16_t* C;
    __device__ __forceinline__ void operator()(const f32x4 (&acc)[2][2][4][2], const Unit&, int wr, int wc, int fr, int fq) const {
        const int cw = wc * 32 + 8 * fq;
        MK_ROWS_BEGIN
#pragma unroll
            for (int bj = 0; bj < 2; ++bj) pg8::store8(C + (size_t)rl * 256 + bj * 128 + cw, acc[ai][bj][m][0], acc[ai][bj][m][1]);  MK_ROWS_END
    }
};
struct EpiP {
    static constexpr bool PERM = true, AFTER_DRAIN = false, INIT_C = false;
    bf16_t* P; float l2f, l2b;
    __device__ __forceinline__ void operator()(const f32x4 (&acc)[2][2][4][2], const Unit&, int wr, int wc, int fr, int fq) const {
        const int cw = wc * 32 + 8 * fq;
        MK_ROWS_BEGIN  const int c = rl; const float rowf = -l2f * (float)(c + 1);
#pragma unroll
            for (int bj = 0; bj < 2; ++bj) { f32x4 v[2] = {acc[ai][bj][m][0], acc[ai][bj][m][1]};
#pragma unroll
                for (int n = 0; n < 2; ++n)
#pragma unroll
                    for (int e = 0; e < 4; ++e) { const int cp = bj * 128 + cw + 4 * n + e;
                        const float ex = (c >= cp) ? (-l2f * (float)(cp + 1)) : (l2b * (float)(cp - c) + rowf);
                        v[n][e] *= pg8::fexp2(ex); }
                pg8::store8(P + (size_t)c * 512 + bj * 128 + cw, v[0], v[1]); }  MK_ROWS_END
    }
};
struct EpiGN {
    static constexpr bool PERM = true, AFTER_DRAIN = true, INIT_C = false;
    bf16_t* oret; const bf16_t* rgv; const float* gn;
    __device__ __forceinline__ void fused(f32x4 (&acc)[2][2][4][2], const Unit&, int wr, int wc, int fr, int fq, PG8_LAS unsigned char* lds, int wid, int lane) const {
        PG8_LAS f32x2* P = (PG8_LAS f32x2*)lds;
        const int cw = wc * 32 + 8 * fq;
        MK_ROWS_BEGIN  float s = 0.f;
#pragma unroll
            for (int bj = 0; bj < 2; ++bj)
#pragma unroll
                for (int n = 0; n < 2; ++n) { const f32x4 x = acc[ai][bj][m][n]; s += (x[0] + x[1]) + (x[2] + x[3]); }
            s = red_fq(s); const float mw = s * (1.0f / 64.0f); float q = 0.f;
#pragma unroll
            for (int bj = 0; bj < 2; ++bj)
#pragma unroll
                for (int n = 0; n < 2; ++n) { const f32x4 d = acc[ai][bj][m][n] - mw; q += (d[0] * d[0] + d[1] * d[1]) + (d[2] * d[2] + d[3] * d[3]); }
            q = red_fq(q);
            if (fq == 0) P[rl * 4 + wc] = (f32x2){mw, q};  MK_ROWS_END
        asm volatile("s_waitcnt lgkmcnt(0)" ::: "memory"); __builtin_amdgcn_s_barrier(); asm volatile("" ::: "memory");
        f32x4 g0[2], g1[2];
#pragma unroll
        for (int bj = 0; bj < 2; ++bj) { g0[bj] = *(const f32x4*)(gn + bj * 128 + cw); g1[bj] = *(const f32x4*)(gn + bj * 128 + cw + 4); }
        MK_ROWS_BEGIN  const f32x2 a = P[rl * 4 + 0], b = P[rl * 4 + 1], c = P[rl * 4 + 2], d = P[rl * 4 + 3];
            const float mt = (a.x + b.x + c.x + d.x) * 0.25f;
            const float da = a.x - mt, db = b.x - mt, dc = c.x - mt, dd = d.x - mt;
            const float m2 = (a.y + b.y) + (c.y + d.y) + 64.0f * ((da * da + db * db) + (dc * dc + dd * dd));
            const float rstd = 1.0f / sqrtf(m2 * (1.0f / 256.0f) + EPS);
#pragma unroll
            for (int bj = 0; bj < 2; ++bj) { f32x4 r0, r1; pg8::load8(rgv + (size_t)rl * 2048 + bj * 128 + cw, r0, r1);
                const f32x4 o0 = (acc[ai][bj][m][0] - mt) * rstd * g0[bj] * r0, o1 = (acc[ai][bj][m][1] - mt) * rstd * g1[bj] * r1;
                pg8::store8(oret + (size_t)rl * 2048 + bj * 128 + cw, o0, o1); }  MK_ROWS_END_NB
        asm volatile("s_waitcnt lgkmcnt(0)" ::: "memory"); __builtin_amdgcn_s_barrier(); asm volatile("" ::: "memory");
    }
};
struct EpiXS {
    static constexpr bool PERM = true, AFTER_DRAIN = false, INIT_C = false;
    bf16_t* xp; float* xl; const float* ssq_q; const float* ssq_k;
    __device__ __forceinline__ void operator()(const f32x4 (&acc)[2][2][4][2], const Unit&, int wr, int wc, int fr, int fq) const {
        const int cw = wc * 32 + 8 * fq;
        float rk[2][8];
#pragma unroll
        for (int bj = 0; bj < 2; ++bj)
#pragma unroll
            for (int j = 0; j < 8; ++j) { const f32x4 p = *(const f32x4*)(ssq_k + (size_t)(bj * 128 + cw + j) * 16); rk[bj][j] = rsqrtf(((p[0] + p[1]) + (p[2] + p[3])) * (1.0f / 256.0f) + EPS) * LOG2E; }
#pragma unroll
        for (int ai = 0; ai < 2; ++ai) {
            float rqa[4];
#pragma unroll
            for (int m = 0; m < 4; ++m) { const f32x4 pq = *(const f32x4*)(ssq_q + (size_t)MK_RL(ai, m) * 16); rqa[m] = rsqrtf(((pq[0] + pq[1]) + (pq[2] + pq[3])) * (1.0f / 256.0f) + EPS); }
#pragma unroll
            for (int m = 0; m < 4; ++m) { const int rl = MK_RL(ai, m); const float rq = rqa[m];
                float s = 0.f;
#pragma unroll
                for (int bj = 0; bj < 2; ++bj) { f32x4 v[2] = {acc[ai][bj][m][0], acc[ai][bj][m][1]};
#pragma unroll
                    for (int n = 0; n < 2; ++n)
#pragma unroll
                        for (int e = 0; e < 4; ++e) { v[n][e] = pg8::fexp2(v[n][e] * rq * rk[bj][4 * n + e]); s += v[n][e]; }
                    pg8::store8(xp + (size_t)rl * 1024 + bj * 128 + cw, v[0], v[1]); }
                s = red_fq(s); if (fq == 0) xl[(size_t)rl * 16 + wc] = s;
                __builtin_amdgcn_sched_barrier(0); }
        }
    }
};
struct EpiXO {
    static constexpr bool PERM = true, AFTER_DRAIN = false, INIT_C = false;
    bf16_t* omem; const float* xl;
    __device__ __forceinline__ void operator()(const f32x4 (&acc)[2][2][4][2], const Unit&, int wr, int wc, int fr, int fq) const {
        const int cw = wc * 32 + 8 * fq;
        float ila[2][4];
#pragma unroll
        for (int ai = 0; ai < 2; ++ai)
#pragma unroll
            for (int m = 0; m < 4; ++m) { const f32x4 p = *(const f32x4*)(xl + (size_t)MK_RL(ai, m) * 16); ila[ai][m] = pg8::frcp((p[0] + p[1]) + (p[2] + p[3])); }
        MK_ROWS_BEGIN  const float il = ila[ai][m];
#pragma unroll
            for (int bj = 0; bj < 2; ++bj) pg8::store8(omem + (size_t)rl * 2048 + bj * 128 + cw, acc[ai][bj][m][0] * il, acc[ai][bj][m][1] * il);  MK_ROWS_END
    }
};
struct EpiGate4 {
    static constexpr bool PERM = true, AFTER_DRAIN = false, INIT_C = false;
    bf16_t* merged; const bf16_t* gates;
    __device__ __forceinline__ void operator()(const f32x4 (&acc)[2][2][4][2], const Unit& u, int wr, int wc, int fr, int fq) const {
        const int cw = wc * 32 + 8 * fq; const bf16_t* gate = gates + u.sub * 2048; const bool first = u.sub == 0;
        MK_ROWS_BEGIN  const size_t row = (size_t)u.pm * 256 + rl;
#pragma unroll
            for (int bj = 0; bj < 2; ++bj) { const int col = u.pn * 256 + bj * 128 + cw; f32x4 g0, g1; pg8::load8(gate + row * 6144 + col, g0, g1);
                f32x4 v0 = acc[ai][bj][m][0] * g0, v1 = acc[ai][bj][m][1] * g1;
                if (!first) { f32x4 t0, t1; pg8::load8(merged + row * 2048 + col, t0, t1); v0 += t0; v1 += t1; }
                pg8::store8(merged + row * 2048 + col, v0, v1); }  MK_ROWS_END_NB
    }
};
struct SchedBR {
    pg8::GridOrder o; const char* onm; const char* oret; const char* wnm; const char* wret;
    __device__ __forceinline__ bool next(int i, Unit& u) const { if (i >= 3) return false; const bool ok = o.next(0, u); u.sub = i; return ok; }
    __device__ __forceinline__ void ptrs(const Unit& u, const char*& a, const char*& b) const {
        const size_t ra = (size_t)u.pm * (256u * 2048u * 2u), rb = (size_t)u.pn * (256u * 2048u * 2u);
        const bool nm = (u.sub != 1); const size_t co = (u.sub == 2) ? 2048u : 0u;
        a = (nm ? onm : oret) + ra + co; b = (nm ? wnm : wret) + rb + co; }
    __device__ __forceinline__ int nt(const Unit& u, int) const { return u.sub == 1 ? 32 : 16; }
};
struct EpiWout {
    static constexpr bool PERM = false, AFTER_DRAIN = true, INIT_C = true;
    const float* x; float* x1; bf16_t* x1b; float* ssq; const float* gffn;
    __device__ __forceinline__ void init_c(f32x4 (&acc)[2][2][4][2], const Unit& u, int wr, int wc, int fr, int fq) const {
        const int col0 = u.pn * 256 + wc * 32 + 4 * fq;
        MK_ROWS_BEGIN  const size_t off = ((size_t)u.pm * 256 + rl) * 2048 + col0;
#pragma unroll
            for (int bj = 0; bj < 2; ++bj)
#pragma unroll
                for (int n = 0; n < 2; ++n) acc[ai][bj][m][n] = __builtin_nontemporal_load((const f32x4*)(x + off + bj * 128 + n * 16));  MK_ROWS_END_NB
    }
    __device__ __forceinline__ void fused(f32x4 (&acc)[2][2][4][2], const Unit& u, int wr, int wc, int fr, int fq, PG8_LAS unsigned char* lds, int wid, int lane) const {
        PG8_LAS float* P = (PG8_LAS float*)lds;
        const int col0 = u.pn * 256 + wc * 32 + 4 * fq;
        MK_ROWS_BEGIN  const size_t off = ((size_t)u.pm * 256 + rl) * 2048 + col0; float q = 0.f;
#pragma unroll
            for (int bj = 0; bj < 2; ++bj)
#pragma unroll
                for (int n = 0; n < 2; ++n) { const f32x4 v = acc[ai][bj][m][n];
                    *(f32x4*)(x1 + off + bj * 128 + n * 16) = v; pg8::store4(x1b + off + bj * 128 + n * 16, v * *(const f32x4*)(gffn + col0 + bj * 128 + n * 16)); q += (v[0] * v[0] + v[1] * v[1]) + (v[2] * v[2] + v[3] * v[3]); }
            q = red_fq(q); if (fq == 0) P[rl * 4 + wc] = q;  MK_ROWS_END_NB
        asm volatile("s_waitcnt lgkmcnt(0)" ::: "memory"); __builtin_amdgcn_s_barrier(); asm volatile("" ::: "memory");
        if (threadIdx.x < 256) { const int r = threadIdx.x; const f32x4 p = *(const PG8_LAS f32x4*)(P + r * 4); ssq[((size_t)u.pm * 256 + r) * 8 + u.pn] = (p[0] + p[1]) + (p[2] + p[3]); }
        asm volatile("s_waitcnt lgkmcnt(0)" ::: "memory"); __builtin_amdgcn_s_barrier(); asm volatile("" ::: "memory");
    }
};
struct EpiFF1 {
    static constexpr bool PERM = true, AFTER_DRAIN = false, INIT_C = false;
    bf16_t* hff; const float* ssq;
    __device__ __forceinline__ void operator()(const f32x4 (&acc)[2][2][4][2], const Unit& u, int wr, int wc, int fr, int fq) const {
        const int cw = wc * 32 + 8 * fq;
        float ra[2][4];
#pragma unroll
        for (int ai = 0; ai < 2; ++ai)
#pragma unroll
            for (int m = 0; m < 4; ++m) { const size_t row = (size_t)u.pm * 256 + MK_RL(ai, m); const f32x4 p0 = *(const f32x4*)(ssq + row * 8), p1 = *(const f32x4*)(ssq + row * 8 + 4);
                ra[ai][m] = rsqrtf((((p0[0] + p0[1]) + (p0[2] + p0[3])) + ((p1[0] + p1[1]) + (p1[2] + p1[3]))) * (1.0f / 2048.0f) + EPS); }
        MK_ROWS_BEGIN  const size_t row = (size_t)u.pm * 256 + rl; const float r = ra[ai][m];
#pragma unroll
            for (int bj = 0; bj < 2; ++bj) { f32x4 v0 = acc[ai][bj][m][0] * r, v1 = acc[ai][bj][m][1] * r;
#pragma unroll
                for (int e = 0; e < 4; ++e) { const float a = fmaxf(v0[e], 0.f), b = fmaxf(v1[e], 0.f); v0[e] = a * a; v1[e] = b * b; }
                pg8::store8(hff + row * LDH + u.pn * 256 + bj * 128 + cw, v0, v1); }  MK_ROWS_END
    }
};
struct EpiFF2 {
    static constexpr bool PERM = false, AFTER_DRAIN = false, INIT_C = true;
    const float* src; float* out;
    __device__ __forceinline__ void init_c(f32x4 (&acc)[2][2][4][2], const Unit& u, int wr, int wc, int fr, int fq) const {
        const int col0 = u.pn * 256 + wc * 32 + 4 * fq;
        MK_ROWS_BEGIN  const size_t off = ((size_t)u.pm * 256 + rl) * 2048 + col0;
#pragma unroll
            for (int bj = 0; bj < 2; ++bj)
#pragma unroll
                for (int n = 0; n < 2; ++n) acc[ai][bj][m][n] = *(const f32x4*)(src + off + bj * 128 + n * 16);  MK_ROWS_END_NB
    }
    __device__ __forceinline__ void operator()(const f32x4 (&acc)[2][2][4][2], const Unit& u, int wr, int wc, int fr, int fq) const {
        const int col0 = u.pn * 256 + wc * 32 + 4 * fq;
        MK_ROWS_BEGIN  const size_t off = ((size_t)u.pm * 256 + rl) * 2048 + col0;
#pragma unroll
            for (int bj = 0; bj < 2; ++bj)
#pragma unroll
                for (int n = 0; n < 2; ++n) { const size_t o2 = off + bj * 128 + n * 16; *(f32x4*)(out + o2) = acc[ai][bj][m][n]; }  MK_ROWS_END_NB
    }
};

struct SchedList3 {
    pg8::UnitG u0, u1, u2; int n;
    __device__ __forceinline__ bool next(int i, pg8::UnitG& u) const { if (i >= n) return false;
        u.a = (i == 0) ? u0.a : ((i == 1) ? u1.a : u2.a); u.b = (i == 0) ? u0.b : ((i == 1) ? u1.b : u2.b);
        u.lda = (i == 0) ? u0.lda : ((i == 1) ? u1.lda : u2.lda); u.ldb = (i == 0) ? u0.ldb : ((i == 1) ? u1.ldb : u2.ldb);
        u.nt = (i == 0) ? u0.nt : ((i == 1) ? u1.nt : u2.nt); u.kind = (i == 0) ? u0.kind : ((i == 1) ? u1.kind : u2.kind); u.perm = (i == 0) ? u0.perm : ((i == 1) ? u1.perm : u2.perm);
        return true; }
};
struct EpiM1 {
    EpiF32 e0; EpiP e1; EpiXS e2;
    __device__ __forceinline__ bool after_drain(const pg8::UnitG&) const { return false; }
    __device__ __forceinline__ void operator()(const f32x4 (&acc)[2][2][4][2], const pg8::UnitG& u, int wr, int wc, int fr, int fq) const {
        Unit d; d.pm = 0; d.pn = 0; d.sub = 0;
        if (u.kind == 0) e0(acc, d, wr, wc, fr, fq); else if (u.kind == 1) e1(acc, d, wr, wc, fr, fq); else e2(acc, d, wr, wc, fr, fq); }
    __device__ __forceinline__ void fused(f32x4 (&)[2][2][4][2], const pg8::UnitG&, int, int, int, int, PG8_LAS unsigned char*, int, int) const {}
};
struct EpiM3 {
    EpiXO e0; EpiGN e1;
    __device__ __forceinline__ bool after_drain(const pg8::UnitG& u) const { return u.kind == 1; }
    __device__ __forceinline__ void operator()(const f32x4 (&acc)[2][2][4][2], const pg8::UnitG& u, int wr, int wc, int fr, int fq) const { Unit d; d.pm = 0; d.pn = 0; d.sub = 0; e0(acc, d, wr, wc, fr, fq); }
    __device__ __forceinline__ void fused(f32x4 (&acc)[2][2][4][2], const pg8::UnitG&, int wr, int wc, int fr, int fq, PG8_LAS unsigned char* lds, int wid, int lane) const {
        Unit d; d.pm = 0; d.pn = 0; d.sub = 0; e1.fused(acc, d, wr, wc, fr, fq, lds, wid, lane); }
};
#undef MK_ROWS_BEGIN
#undef MK_ROWS_END
#undef MK_ROWS_END_NB
#undef MK_ROWS_END2
#undef MK_RL
}

namespace na {
using bf16 = unsigned short;
using bf16x8 = __attribute__((ext_vector_type(8))) short;
using s16x4  = __attribute__((ext_vector_type(4))) short;
using f32x16 = __attribute__((ext_vector_type(16))) float;
using f32x4  = __attribute__((ext_vector_type(4))) float;
using u32x4  = __attribute__((ext_vector_type(4))) unsigned;
constexpr int DH = 128, NW = 8, QBLK = 32, KVBLK = 64, LDQ = 3072;
constexpr size_t SHM_V = KVBLK * DH * 2, SHM_K = KVBLK * DH * 2;
constexpr int NBUF = 3;
constexpr int OFF_RK = NBUF * SHM_V + NBUF * SHM_K;
constexpr int OFF_BIAS = OFF_RK + 768 * 4;
constexpr int BIAS_PAD = 64, BIAS_N = 64 + 15 * 31 + 79;
constexpr int OFF_LI = OFF_BIAS + ((BIAS_N * 4 + 15) / 16) * 16;
constexpr int NA_LDS_BYTES = OFF_LI + NW * 64 * 4;
#define KSWZ(row, colB) ((row) * 256 + ((colB) ^ (((row) & 7) << 4)))
#define SBAR() __builtin_amdgcn_sched_barrier(0)
__device__ __forceinline__ int crow(int r, int hi) { return (r & 3) + 8 * (r >> 2) + 4 * hi; }
__device__ __forceinline__ unsigned cvtpk(float lo, float hi) { return pg8::cvt_pk_bf16(lo, hi); }

__device__ __forceinline__ void procP(f32x16& p0, f32x16& p1, float& lsum, bool inwin, const float* rk_t  , const float* bias_l  ,
                                      float rqs, int cs, int hi) {
  if (!inwin) { p0 = f32x16{}; p1 = f32x16{}; return; }
#pragma unroll
  for (int g = 0; g < 4; ++g) {
    const f32x4 k0 = *(const f32x4*)(rk_t + 8 * g + 4 * hi), k1 = *(const f32x4*)(rk_t + 32 + 8 * g + 4 * hi);
#pragma unroll
    for (int e = 0; e < 4; ++e) { const int r = 4 * g + e; const int w0 = e + 8 * g + 4 * hi, w1 = w0 + 32;
      const float x0 = fmaf(p0[r], rqs * k0[e], bias_l[w0]), x1 = fmaf(p1[r], rqs * k1[e], bias_l[w1]);
      const float e0 = __builtin_amdgcn_exp2f(x0), e1 = __builtin_amdgcn_exp2f(x1);
      const float v0 = ((unsigned)(w0 - cs) < 16u) ? e0 : 0.f, v1 = ((unsigned)(w1 - cs) < 16u) ? e1 : 0.f;
      p0[r] = v0; p1[r] = v1; lsum += v0 + v1; }
  }
}
__device__ __forceinline__ void packP(const f32x16& p0, const f32x16& p1, bf16x8& pa0, bf16x8& pa1, bf16x8& pa2, bf16x8& pa3) {
#define PK4(P, BASE, OUT) do { unsigned a0 = cvtpk(P[BASE + 0], P[BASE + 1]), a1 = cvtpk(P[BASE + 2], P[BASE + 3]);   \
    unsigned b0 = cvtpk(P[BASE + 4], P[BASE + 5]), b1 = cvtpk(P[BASE + 6], P[BASE + 7]);                              \
    auto r0 = __builtin_amdgcn_permlane32_swap(a0, b0, false, false); auto r1 = __builtin_amdgcn_permlane32_swap(a1, b1, false, false); \
    u32x4 w = {r0[0], r1[0], r0[1], r1[1]}; OUT = *reinterpret_cast<bf16x8*>(&w); } while (0)
  PK4(p0, 0, pa0); PK4(p0, 8, pa1); PK4(p1, 0, pa2); PK4(p1, 8, pa3);
#undef PK4
}
__device__ __forceinline__ void qkt(f32x16& p0, f32x16& p1, const bf16* Ks, const bf16x8* qr, int r32, int hi) {
  p0 = f32x16{}; p1 = f32x16{};
#pragma unroll
  for (int d0 = 0; d0 < 8; ++d0) { int cb = (d0 * 16 + hi * 8) * 2;
    bf16x8 b0 = *reinterpret_cast<const bf16x8*>((const char*)Ks + KSWZ(r32, cb));
    bf16x8 b1 = *reinterpret_cast<const bf16x8*>((const char*)Ks + KSWZ(32 + r32, cb));
    p0 = __builtin_amdgcn_mfma_f32_32x32x16_bf16(b0, qr[d0], p0, 0, 0, 0);
    p1 = __builtin_amdgcn_mfma_f32_32x32x16_bf16(b1, qr[d0], p1, 0, 0, 0); }
}
__device__ __forceinline__ int v_st(int k, int c) { const int kk = (k & ~0xC) | ((k & 4) << 1) | ((k & 8) >> 1); return ((kk >> 3) * 4 + (c >> 5)) * 512 + ((kk & 7) * 32 + (c & 31)) * 2; }
__device__ __forceinline__ int v_rd_base(int lane) { return ((lane & 3) << 3) | (((lane >> 2) & 3) << 6) | (((lane >> 4) & 1) << 5) | (((lane >> 5) & 1) << 8); }
constexpr int v_rd_off(int d0, int ks, int half) { return d0 * 512 + ks * 4096 + half * 2048; }
template <int OFF> __device__ __forceinline__ s16x4 tr_read(int vb) {
  s16x4 r; asm volatile("ds_read_b64_tr_b16 %0, %1 offset:%2" : "=&v"(r) : "v"(vb), "i"(OFF) : "memory"); return r;
}
template <int D0> __device__ __forceinline__ void pv_one(f32x16& od, int vb, bf16x8 pa0, bf16x8 pa1, bf16x8 pa2, bf16x8 pa3) {
  const s16x4 l0 = tr_read<v_rd_off(D0, 0, 0)>(vb), h0 = tr_read<v_rd_off(D0, 0, 1)>(vb), l1 = tr_read<v_rd_off(D0, 1, 0)>(vb), h1 = tr_read<v_rd_off(D0, 1, 1)>(vb);
  const s16x4 l2 = tr_read<v_rd_off(D0, 2, 0)>(vb), h2 = tr_read<v_rd_off(D0, 2, 1)>(vb), l3 = tr_read<v_rd_off(D0, 3, 0)>(vb), h3 = tr_read<v_rd_off(D0, 3, 1)>(vb);
  asm volatile("s_waitcnt lgkmcnt(0)" ::: "memory"); SBAR();
#define PK(L, H) (bf16x8){L[0], L[1], L[2], L[3], H[0], H[1], H[2], H[3]}
  od = __builtin_amdgcn_mfma_f32_32x32x16_bf16(pa0, PK(l0, h0), od, 0, 0, 0);
  od = __builtin_amdgcn_mfma_f32_32x32x16_bf16(pa1, PK(l1, h1), od, 0, 0, 0);
  od = __builtin_amdgcn_mfma_f32_32x32x16_bf16(pa2, PK(l2, h2), od, 0, 0, 0);
  od = __builtin_amdgcn_mfma_f32_32x32x16_bf16(pa3, PK(l3, h3), od, 0, 0, 0);
#undef PK
}
__device__ __forceinline__ void pv_d0(f32x16* o, int vb, bf16x8 pa0, bf16x8 pa1, bf16x8 pa2, bf16x8 pa3) {
  pv_one<0>(o[0], vb, pa0, pa1, pa2, pa3); pv_one<1>(o[1], vb, pa0, pa1, pa2, pa3); pv_one<2>(o[2], vb, pa0, pa1, pa2, pa3); pv_one<3>(o[3], vb, pa0, pa1, pa2, pa3);
}

__device__ __forceinline__ void na_unit(int b, int h, int i4, const bf16* __restrict__ qkv, const float* __restrict__ ssq_q, const float* __restrict__ ssq_k,
                                        const float* __restrict__ rpb, bf16* __restrict__ ona, char* lds) {
  int tid_ = threadIdx.x; asm volatile("" : "+v"(tid_));
  const int tid = tid_, wid = __builtin_amdgcn_readfirstlane(tid >> 6), lane = tid & 63, r32 = lane & 31, hi = lane >> 5;
  bf16* V_lds = (bf16*)lds; bf16* K_lds = (bf16*)(lds + NBUF * SHM_V);
  float* rkL = (float*)(lds + OFF_RK); float* biasL = (float*)(lds + OFF_BIAS); float* li_l = (float*)(lds + OFF_LI) + wid * 64;
  const int NT = (i4 == 0 || i4 == 15) ? 8 : 11, rbase = (i4 == 0) ? 0 : ((i4 == 15) ? 56 : 4 * i4 - 4);
  const int qrow = 4 * i4 + (wid >> 1), qc = 32 * (wid & 1) + r32;
  int rs = qrow - 4; rs = rs < 0 ? 0 : (rs > 56 ? 56 : rs);
  int cs = qc - 8; cs = cs < 0 ? 0 : (cs > 48 ? 48 : cs);
  const size_t tok_q = (size_t)b * 4096 + qrow * 64 + qc, tok_k0 = (size_t)b * 4096 + rbase * 64;
  for (int i = tid; i < NT * 64; i += 512) { const f32x4 p = *(const f32x4*)(ssq_k + (tok_k0 + i) * 32 + h * 4); rkL[i] = rsqrtf(((p[0] + p[1]) + (p[2] + p[3])) * (1.0f / 128.0f) + 1e-6f); }
  for (int i = tid; i < BIAS_N; i += 512) { const int j = i - BIAS_PAD; biasL[i] = (j >= 0 && j < 15 * 31) ? rpb[h * 465 + j] * 1.4426950408889634f : 0.f; }
  float rqs; { const f32x4 p = *(const f32x4*)(ssq_q + tok_q * 32 + h * 4); rqs = rsqrtf(((p[0] + p[1]) + (p[2] + p[3])) * (1.0f / 128.0f) + 1e-6f) * 1.4426950408889634f; }
  float l_reg = 0; f32x16 o[4] = {}; bf16x8 qr[8];
  const bf16* Qw = qkv + tok_q * LDQ + h * 128 + hi * 8;
#pragma unroll
  for (int d0 = 0; d0 < 8; ++d0) qr[d0] = *reinterpret_cast<const bf16x8*>(Qw + d0 * 16);
  const bf16* Kh = qkv + tok_k0 * LDQ + 1024 + h * 128; const bf16* Vh = qkv + tok_k0 * LDQ + 2048 + h * 128;
  const int sr = tid >> 4, sc = (tid & 15) * 8, vst0 = v_st(sr, sc), vst1 = v_st(32 + sr, sc);
  const int vb0 = (int)(uintptr_t)V_lds + v_rd_base(lane);
  struct { bf16x8 vs0, vs1, ks0, ks1; } sr_[2];
#define SLOAD(i, k0) do { sr_[i].vs0 = *(const bf16x8*)(&Vh[(long)((k0) + sr) * LDQ + sc]); sr_[i].vs1 = *(const bf16x8*)(&Vh[(long)((k0) + 32 + sr) * LDQ + sc]); \
    sr_[i].ks0 = *(const bf16x8*)(&Kh[(long)((k0) + sr) * LDQ + sc]); sr_[i].ks1 = *(const bf16x8*)(&Kh[(long)((k0) + 32 + sr) * LDQ + sc]); } while (0)
#define SWRITE(bb, i) do { *(bf16x8*)((char*)V_lds + (bb) * SHM_V + vst0) = sr_[i].vs0;          \
    *(bf16x8*)((char*)V_lds + (bb) * SHM_V + vst1) = sr_[i].vs1; int kc = sc * 2;               \
    *(bf16x8*)((char*)K_lds + (bb) * SHM_K + KSWZ(sr, kc)) = sr_[i].ks0;                       \
    *(bf16x8*)((char*)K_lds + (bb) * SHM_K + KSWZ(32 + sr, kc)) = sr_[i].ks1; } while (0)
#define SWAIT() asm volatile("s_waitcnt vmcnt(0)" ::: "memory")
#define TILE_ARGS(j) ((unsigned)(rbase + (j) - rs) < 8u), rkL + (j) * 64, biasL + BIAS_PAD + (rbase + (j) - qrow + 7) * 31 + 15 - qc, rqs, cs, hi
  f32x16 p0, p1; bf16x8 pa0, pa1, pa2, pa3;
#define NA_TILE(j, bo) do { if ((unsigned)(rbase + (j) - rs) < 8u) {     \
      SBAR(); qkt(p0, p1, (const bf16*)((const char*)K_lds + (bo) * SHM_K), qr, r32, hi); \
      procP(p0, p1, l_reg, TILE_ARGS(j)); \
      packP(p0, p1, pa0, pa1, pa2, pa3); SBAR(); \
      pv_d0(o, vb0 + (bo) * (int)SHM_V, pa0, pa1, pa2, pa3); } } while (0)
  SLOAD(0, 0); SLOAD(1, KVBLK); SWRITE(0, 0); SLOAD(0, 2 * KVBLK); SWRITE(1, 1); SLOAD(1, 3 * KVBLK); __syncthreads();
  int b0 = 0;
  for (int j = 0; j < NT; j += 2) {
    const int b1 = (b0 == 2) ? 0 : b0 + 1, b2 = (b1 == 2) ? 0 : b1 + 1;
    NA_TILE(j, b0);
    if (j + 2 < NT) { SWRITE(b2, 0); if (j + 4 < NT) SLOAD(0, (j + 4) * KVBLK); }
    __syncthreads();
    if (j + 1 < NT) NA_TILE(j + 1, b1);
    if (j + 3 < NT) { SWRITE(b0, 1); if (j + 5 < NT) SLOAD(1, (j + 5) * KVBLK); }
    __syncthreads();
    b0 = b2;
  }
#undef NA_TILE
  { auto rr = __builtin_amdgcn_permlane32_swap(__float_as_uint(l_reg), __float_as_uint(l_reg), false, false); l_reg = __uint_as_float(rr[0]) + __uint_as_float(rr[1]); }
  if (hi == 0) li_l[r32] = l_reg; asm volatile("s_waitcnt lgkmcnt(0)" ::: "memory");
  float rli[16];
#pragma unroll
  for (int r = 0; r < 16; ++r) rli[r] = __builtin_amdgcn_rcpf(li_l[crow(r, hi)]);
  bf16* Ow = ona + ((size_t)b * 4096 + qrow * 64 + 32 * (wid & 1)) * 2048 + h * 128;
#pragma unroll
  for (int r = 0; r < 16; ++r) { const int orow = crow(r, hi);
#pragma unroll
    for (int d0 = 0; d0 < 4; ++d0) { const float v = o[d0][r] * rli[r]; unsigned u = __float_as_uint(v); u += 0x7fffu + ((u >> 16) & 1u); Ow[(size_t)orow * 2048 + d0 * 32 + r32] = (bf16)(u >> 16); } }
  __syncthreads();
#undef SLOAD
#undef SWRITE
#undef SWAIT
#undef TILE_ARGS
}
#undef KSWZ
#undef SBAR
}

constexpr int NWAVES = 8;
constexpr int RING_OFF = 0, RING_BYTES = 131072;
constexpr int LDSCTL_OFF = RING_BYTES, MISC_OFF = LDSCTL_OFF + 320;
constexpr int LDS_BYTES = 147456;
static_assert(MISC_OFF + 128 <= LDS_BYTES && na::NA_LDS_BYTES <= RING_BYTES, "LDS map");
constexpr int CW_TMO = 0, CW_P0A = 64, CW_BAR = 4096;
static_assert((CW_BAR + 3456) * 4 <= (int)mk::CTL_ZERO_BYTES, "control words inside the per-call memset");

#define GAS __attribute__((address_space(1)))
#define LAS __attribute__((address_space(3)))
typedef unsigned short bf16;
typedef unsigned v4u __attribute__((ext_vector_type(4)));
typedef float f32x4 __attribute__((ext_vector_type(4)));
typedef GAS unsigned gu32;
#define LDS_WAIT() asm volatile("s_waitcnt lgkmcnt(0)" ::: "memory")
#define VM_WAIT() asm volatile("s_waitcnt vmcnt(0)" ::: "memory")
__device__ __forceinline__ unsigned f2bf(float f) { unsigned u = __builtin_bit_cast(unsigned, f); return (u + 0x7fffu + ((u >> 16) & 1u)) >> 16; }
__device__ __forceinline__ unsigned pk2(float lo, float hi) { return f2bf(lo) | (f2bf(hi) << 16); }
__device__ __forceinline__ float bf2f_(unsigned h) { return __uint_as_float(h << 16); }

#define XB_TMO      128
#define XB_XCNT(j)  (256  + 64 * (j))
#define XB_XSUB(j)  (1280 + 64 * (j))
#define XB_XGEN(j)  (2304 + 64 * (j))
#define XB_TOP      3328
#define XB_TOPGEN   3392
#define XCD_BAR_WORDS 3456
#define XB_SPIN_CAP (1u << 18)
__device__ __forceinline__ unsigned xb_ld(unsigned* p)              { return __hip_atomic_load(p, __ATOMIC_RELAXED, __HIP_MEMORY_SCOPE_AGENT); }
__device__ __forceinline__ unsigned xb_add(unsigned* p, unsigned v) { return __hip_atomic_fetch_add(p, v, __ATOMIC_RELAXED, __HIP_MEMORY_SCOPE_AGENT); }
__device__ __forceinline__ unsigned xb_xcc_id() { return (unsigned)__builtin_amdgcn_s_getreg((3 << 11) | 20) & 0xFu; }
#define XB_SPIN(cond, bar) do { unsigned _sp = 0; while (cond) { __builtin_amdgcn_s_sleep(1); \
    if ((++_sp & 255u) == 0u) { if (xb_ld(&(bar)[XB_TMO])) break; if (_sp > XB_SPIN_CAP) { atomicAdd(&(bar)[XB_TMO], 1u); break; } } } } while (0)
struct XcdBarrier { unsigned* bar; unsigned x; volatile LAS unsigned* st; };
__device__ __forceinline__ XcdBarrier xcd_barrier_post(unsigned* bar, volatile LAS unsigned* st) {
    XcdBarrier b; b.bar = bar; b.x = xb_xcc_id(); b.st = st;
    if (threadIdx.x == 0) (void)xb_add(&bar[XB_XCNT(b.x)], 1u);
    return b;
}
__device__ __forceinline__ void xcd_barrier_complete(unsigned* bar, unsigned x, unsigned& nloc, unsigned& nx) {
    const unsigned G = gridDim.x * gridDim.y * gridDim.z;
    unsigned sum, cnt, mine, sp = 0u;
    for (;;) {
        sum = 0u; cnt = 0u; mine = 0u;
#pragma unroll
        for (unsigned j = 0; j < 16; ++j) { const unsigned c = xb_ld(&bar[XB_XCNT(j)]); sum += c; cnt += (c > 0u) ? 1u : 0u; mine = (j == x) ? c : mine; }
        if (sum == G) break;
        __builtin_amdgcn_s_sleep(1);
        if ((++sp & 255u) == 0u) { if (xb_ld(&bar[XB_TMO])) break; if (sp > XB_SPIN_CAP) { atomicAdd(&bar[XB_TMO], 1u); break; } }
    }
    nloc = mine > 0u ? mine : 1u; nx = cnt > 0u ? cnt : 1u;
}
__device__ __forceinline__ void xcd_barrier(const XcdBarrier& b) {
    asm volatile("s_waitcnt vmcnt(0)" ::: "memory");
    __syncthreads();
    if (threadIdx.x == 0) {
        unsigned* bar = b.bar;
        __builtin_amdgcn_s_waitcnt(0);
        unsigned nloc = b.st[0], nx = b.st[1];
        if (nloc == 0u) { xcd_barrier_complete(bar, b.x, nloc, nx); b.st[0] = nloc; b.st[1] = nx; }
        const unsigned old = xb_add(&bar[XB_XSUB(b.x)], 1u);
        const unsigned gen = old / nloc;
        if (old + 1u == (gen + 1u) * nloc) {
            __builtin_amdgcn_fence(__ATOMIC_RELEASE, "agent");
            asm volatile("s_waitcnt vmcnt(0)" ::: "memory");
            const unsigned og = xb_add(&bar[XB_TOP], 1u);
            const unsigned tg = og / nx;
            if (og + 1u == (tg + 1u) * nx) xb_add(&bar[XB_TOPGEN], 1u);
            else XB_SPIN(xb_ld(&bar[XB_TOPGEN]) == tg, bar);
            __builtin_amdgcn_fence(__ATOMIC_ACQUIRE, "agent");
            xb_add(&bar[XB_XGEN(b.x)], 1u);
            asm volatile("s_waitcnt vmcnt(0)" ::: "memory");
        } else {
            XB_SPIN(xb_ld(&bar[XB_XGEN(b.x)]) == gen, bar);
            __builtin_amdgcn_fence(__ATOMIC_ACQUIRE, "agent");
            asm volatile("s_waitcnt vmcnt(0)" ::: "memory");
        }
    }
    __syncthreads();
}

__device__ __forceinline__ float wave_sum(float v) {
#pragma unroll
    for (int o = 1; o < 64; o <<= 1) v += __shfl_xor(v, o);
    return v;
}
__device__ __forceinline__ void p0_item(const float* __restrict__ W, int ldw, int k0, int n0, bf16* __restrict__ WT, int ldt, int dA, int dB, const float* __restrict__ kscale, LAS float* scr, int lane) {
    const int c16 = lane & 15, kr = lane >> 4;
#pragma unroll
    for (int it = 0; it < 16; ++it) { const int k = 4 * it + kr;
        f32x4 v = __builtin_nontemporal_load((const f32x4*)(W + (size_t)(k0 + k) * ldw + n0 + 4 * c16));
        if (kscale) v = v * kscale[k0 + k];
        *(LAS f32x4*)(scr + k * 64 + ((4 * c16) ^ (8 * ((k >> 3) & 7)))) = v; }
    LDS_WAIT(); asm volatile("" ::: "memory");
    const int c = lane & 7;
#pragma unroll
    for (int j = 0; j < 8; ++j) { const int n = (lane >> 3) + 8 * j; const LAS float* s = scr + (8 * c) * 64 + (n ^ (8 * c));
        v4u o; o.x = pk2(s[0 * 64], s[1 * 64]); o.y = pk2(s[2 * 64], s[3 * 64]); o.z = pk2(s[4 * 64], s[5 * 64]); o.w = pk2(s[6 * 64], s[7 * 64]);
        const int drow = (n < 32) ? dA + n : dB + n - 32;
        *(GAS v4u*)(WT + (size_t)drow * ldt + k0 + 8 * c) = o; }
    LDS_WAIT(); asm volatile("" ::: "memory");
}
struct P0Desc { const float* src; bf16* dst; int ldw, ldt, dA, dB, nt; };
__device__ __forceinline__ void p0_load(const P0Desc& d, f32x4 (&R)[16], int lane) {
    const int c16 = lane & 15, kr = lane >> 4;
#pragma unroll
    for (int it = 0; it < 16; ++it) R[it] = __builtin_nontemporal_load((const f32x4*)(d.src + (size_t)(4 * it + kr) * d.ldw + 4 * c16));
}
__device__ __forceinline__ void p0_to_lds(const f32x4 (&R)[16], LAS float* scr, int lane) {
    const int c16 = lane & 15, kr = lane >> 4;
#pragma unroll
    for (int it = 0; it < 16; ++it) { const int k = 4 * it + kr; *(LAS f32x4*)(scr + k * 64 + ((4 * c16) ^ (8 * ((k >> 3) & 7)))) = R[it]; }
}
__device__ __forceinline__ void p0_store(const P0Desc& d, LAS float* scr, int lane) {
    const int c = lane & 7;
#pragma unroll
    for (int j = 0; j < 8; ++j) { const int n = (lane >> 3) + 8 * j; const LAS float* s = scr + (8 * c) * 64 + (n ^ (8 * c));
        v4u o; o.x = pk2(s[0 * 64], s[1 * 64]); o.y = pk2(s[2 * 64], s[3 * 64]); o.z = pk2(s[4 * 64], s[5 * 64]); o.w = pk2(s[6 * 64], s[7 * 64]);
        const int drow = (n < 32) ? d.dA + n : d.dB + n - 32;
        GAS v4u* q = (GAS v4u*)(d.dst + (size_t)drow * d.ldt + 8 * c); if (d.nt) __builtin_nontemporal_store(o, q); else *q = o; }
}
__device__ __forceinline__ void rms_row_to_bf16(const float* __restrict__ xrow, const float* __restrict__ g, bf16* __restrict__ orow, int lane) {
    const f32x4* xr = (const f32x4*)xrow + lane; const f32x4* gr = (const f32x4*)g + lane;
    f32x4 v[8]; float s = 0.f;
#pragma unroll
    for (int j = 0; j < 8; ++j) { v[j] = __builtin_nontemporal_load(xr + 64 * j); s += (v[j].x * v[j].x + v[j].y * v[j].y) + (v[j].z * v[j].z + v[j].w * v[j].w); }
    const float r = rsqrtf(wave_sum(s) * (1.f / 2048.f) + mk::EPS);
    unsigned long long* o8 = (unsigned long long*)orow + lane;
#pragma unroll
    for (int j = 0; j < 8; ++j) { const f32x4 gg = gr[64 * j]; o8[64 * j] = (unsigned long long)pk2(v[j].x * r * gg.x, v[j].y * r * gg.y) | ((unsigned long long)pk2(v[j].z * r * gg.z, v[j].w * r * gg.w) << 32); }
}
__device__ __forceinline__ int win_dest_row(int n32  ) {
    const int pn = n32 >> 3, ga = n32 & 7;
    if (pn < 12 || pn >= 20) return n32 * 32;
    const int gs = 4 * ((ga >> 1) & 1) + 2 * (ga >> 2) + (ga & 1);
    return (pn * 8 + gs) * 32;
}

#ifndef MK_TS
#define MK_TS_ -1
#else
#define MK_TS_ MK_TS
#endif
struct Args { const float* in[21]; float* out; unsigned char* ws; };

__global__ void __launch_bounds__(NWAVES * 64, 2) mk_fwd(Args args) {
    extern __shared__ __attribute__((aligned(16))) unsigned char lds[];
    LAS unsigned char* ldsl = (LAS unsigned char*)lds;
    volatile LAS unsigned* MISC = (volatile LAS unsigned*)(ldsl + MISC_OFF);
    const int tid = threadIdx.x, lane = tid & 63, wave = __builtin_amdgcn_readfirstlane(tid >> 6);
    const int G = gridDim.x, bx = blockIdx.x;
    const int vcu = (G % 8 == 0) ? (bx % 8) * (G / 8) + bx / 8 : bx;
    unsigned char* ws = args.ws; unsigned char* dob = (unsigned char*)args.out;
    gu32* ctl = (gu32*)(ws + mk::WS_CTL);
#define I_x args.in[0]
#define I_mem args.in[1]
#define I_g_mix args.in[2]
#define I_w_in args.in[3]
#define I_gq args.in[4]
#define I_gk args.in[5]
#define I_rpb args.in[6]
#define I_lgf_in args.in[7]
#define I_lgb_in args.in[8]
#define I_gn args.in[9]
#define I_g_mem args.in[10]
#define I_w_mkv args.in[11]
#define I_gxq args.in[12]
#define I_gxk args.in[13]
#define I_w_na args.in[14]
#define I_w_ret args.in[15]
#define I_w_memb args.in[16]
#define I_w_out args.in[17]
#define I_g_ffn args.in[18]
#define I_w_ff1 args.in[19]
#define I_w_ff2 args.in[20]
#define I_out args.out
#define cosT ((float*)(ws + mk::WS_COS))
#define sinT ((float*)(ws + mk::WS_SIN))
#define ssq_naq ((float*)(ws + mk::WS_SSQ_NAQ))
#define ssq_nak ((float*)(ws + mk::WS_SSQ_NAK))
#define ssq_xq ((float*)(ws + mk::WS_SSQ_XQ))
#define xl ((float*)(ws + mk::WS_XL))
#define ssq_x1 ((float*)(ws + mk::WS_SSQ_X1))
#define tab ((float*)(ws + mk::WS_TAB))
#define MEMN ((bf16*)(ws + mk::WS_MEMN))
#define MKb ((bf16*)(ws + mk::WS_MK))
#define MVT ((bf16*)(ws + mk::WS_MVT))
#define WinT ((bf16*)(ws + mk::WS_WIN))
#define Wff1T ((bf16*)(ws + mk::WS_WFF1))
#define Wff2T ((bf16*)(ws + mk::WS_WFF2))
#define WretT ((bf16*)(ws + mk::WS_WRET))
#define WoutT ((bf16*)(ws + mk::WS_WOUT))
#define WnmT ((bf16*)(ws + mk::WS_WNM))
#define WmkvT ((bf16*)(ws + mk::WS_WMKV))
#define NAQKV ((bf16*)(ws + mk::WS_NAQKV))
#define K0 ((bf16*)(ws + mk::WS_K0))
#define RG ((bf16*)(ws + mk::WS_RG))
#define XQ ((bf16*)(ws + mk::WS_XQ))
#define GATES ((bf16*)(ws + mk::WS_GATES))
#define AR ((bf16*)(ws + mk::WS_AR))
#define BR ((bf16*)(ws + mk::WS_BR))
#define KV ((bf16*)(ws + mk::WS_KV))
#define ORET ((bf16*)(ws + mk::WS_ORET))
#define MERGED ((bf16*)(ws + mk::WS_MERGED))
#define X1B ((bf16*)(ws + mk::WS_X1B))
#define HFF ((bf16*)(ws + mk::WS_HFF))
#define HN ((bf16*)(dob + mk::DO_HN))
#define KT ((bf16*)(dob + mk::DO_KT))
#define XP ((bf16*)(dob + mk::DO_XP))
#define ONM ((bf16*)(dob + mk::DO_ONM))
    for (int u = tid; u < (LDS_BYTES - LDSCTL_OFF) / 4; u += NWAVES * 64) ((LAS unsigned*)(ldsl + LDSCTL_OFF))[u] = 0u;
    __syncthreads();
    XcdBarrier bar = xcd_barrier_post((unsigned*)(ctl + CW_BAR), MISC + 8);
#define GRID_BAR() do { xcd_barrier(bar); MK_STAMP(); } while (0)
#define MK_STAMP() PG8_DBG_STAMP()
    MK_STAMP();
    LAS float* scr = (LAS float*)(ldsl + RING_OFF + wave * 16384);
    const int gw = vcu * NWAVES + wave, NGW = G * NWAVES;

    {
    if (vcu < 16) {
        if (tid == 0) {
            unsigned sp = 0; while (__hip_atomic_load((unsigned*)(ctl + CW_P0A), __ATOMIC_RELAXED, __HIP_MEMORY_SCOPE_AGENT) < (unsigned)(G - 16)) { __builtin_amdgcn_s_sleep(2); if (++sp > (1u << 22)) break; }
            __builtin_amdgcn_fence(__ATOMIC_ACQUIRE, "agent"); asm volatile("s_waitcnt vmcnt(0)" ::: "memory");
        }
        __syncthreads();
        mk::SchedOne S; S.has = true; const pg8::Gemm g{2048, 2048, 2048};
        mk::EpiMKV E{MKb, MVT, tab, tab, 0};
        if (vcu < 8) { S.u.pm = vcu >> 2; S.u.pn = vcu & 3; S.a = (const char*)(MEMN + (size_t)S.u.pm * 256 * 2048); S.b = (const char*)(WmkvT + (size_t)S.u.pn * 256 * 2048); E.mode = 0; }
        else { const int c = vcu - 8; S.u.pm = c >> 1; S.u.pn = c & 1; S.a = (const char*)(WmkvT + (size_t)(1024 + S.u.pm * 256) * 2048); S.b = (const char*)(MEMN + (size_t)S.u.pn * 256 * 2048); E.mode = 1; }
        pg8::gemm_phase<mk::EpiMKV, mk::SchedOne, false>(ldsl + RING_OFF, g, S, E);
    } else {
        const int gw2 = (vcu - 16) * NWAVES + wave, NGW2 = (G - 16) * NWAVES;
        {
            for (int i = gw2 * 64 + lane; i < 4096 * 64; i += NGW2 * 64) { const int s = i >> 6, f = i & 63;
                const float inv = powf(10000.0f, -(float)f / 64.0f), ang = (float)s * inv; cosT[i] = cosf(ang); sinT[i] = sinf(ang); }
            if (vcu == 16) {
                if (tid < 128) tab[mk::TAB_CS_NAQ + tid] = I_gq[tid] * I_gk[tid] * 0.08838834764831845f;
                if (tid < 256) tab[mk::TAB_CS_MK + tid] = I_gxq[tid] * I_gxk[tid] * 0.0625f;
                if (tid < 8) { tab[mk::TAB_L2F + tid] = -log1pf(expf(-I_lgf_in[tid])) * mk::LOG2E; tab[mk::TAB_L2B + tid] = -log1pf(expf(-I_lgb_in[tid])) * mk::LOG2E; }
            }
            for (int m = gw2; m < 512; m += NGW2) rms_row_to_bf16(I_mem + (size_t)m * 2048, I_g_mem, MEMN + (size_t)m * 2048, lane);
            for (int it = gw2; it < 32 * 32; it += NGW2) { const int kb = it >> 5, nb = it & 31; p0_item(I_w_mkv, 2048, 64 * kb, 64 * nb, WmkvT, 2048, 64 * nb, 64 * nb + 32, nullptr, scr, lane); }
            VM_WAIT(); __syncthreads();
            if (tid == 0) { __builtin_amdgcn_fence(__ATOMIC_RELEASE, "agent"); asm volatile("s_waitcnt vmcnt(0)" ::: "memory");
                (void)__hip_atomic_fetch_add((unsigned*)(ctl + CW_P0A), 1u, __ATOMIC_RELAXED, __HIP_MEMORY_SCOPE_AGENT); }
        }
        constexpr int I_IN = 32 * 256, I_FF1 = 32 * 128, I_FF2 = 128 * 32, I_RET = 32 * 32, I_OUT = 32 * 32, I_NA = 16 * 32, I_MEM = 16 * 32;
        constexpr int NITEMS = I_IN + I_FF1 + I_FF2 + I_RET + I_OUT + I_NA + I_MEM;
#define P0_DECODE(d, item) do { int r = (item); \
            if (r < I_IN) { const int kb = r >> 8, nb = r & 255; d.src = I_w_in + (size_t)(64 * kb) * 16384 + 64 * nb; d.ldw = 16384; d.dst = WinT + 64 * kb; d.ldt = 2048; d.dA = win_dest_row(2 * nb); d.dB = win_dest_row(2 * nb + 1); d.nt = 0; break; } r -= I_IN; \
            if (r < I_FF1) { const int kb = r >> 7, nb = r & 127; d.src = I_w_ff1 + (size_t)(64 * kb) * 8192 + 64 * nb; d.ldw = 8192; d.dst = Wff1T + 64 * kb; d.ldt = 2048; d.dA = 64 * nb; d.dB = 64 * nb + 32; d.nt = 1; break; } r -= I_FF1; \
            if (r < I_FF2) { const int kb = r >> 5, nb = r & 31; d.src = I_w_ff2 + (size_t)(64 * kb) * 2048 + 64 * nb; d.ldw = 2048; d.dst = Wff2T + 64 * kb; d.ldt = 8192; d.dA = 64 * nb; d.dB = 64 * nb + 32; d.nt = 1; break; } r -= I_FF2; \
            if (r < I_RET) { const int kb = r >> 5, nb = r & 31; d.src = I_w_ret + (size_t)(64 * kb) * 2048 + 64 * nb; d.ldw = 2048; d.dst = WretT + 64 * kb; d.ldt = 2048; d.dA = 64 * nb; d.dB = 64 * nb + 32; d.nt = 1; break; } r -= I_RET; \
            if (r < I_OUT) { const int kb = r >> 5, nb = r & 31; d.src = I_w_out + (size_t)(64 * kb) * 2048 + 64 * nb; d.ldw = 2048; d.dst = WoutT + 64 * kb; d.ldt = 2048; d.dA = 64 * nb; d.dB = 64 * nb + 32; d.nt = 1; break; } r -= I_OUT; \
            if (r < I_NA) { const int kb = r >> 5, nb = r & 31; d.src = I_w_na + (size_t)(64 * kb) * 2048 + 64 * nb; d.ldw = 2048; d.dst = WnmT + 64 * kb; d.ldt = 2048; d.dA = 64 * nb; d.dB = 64 * nb + 32; d.nt = 1; break; } r -= I_NA; \
            { const int kb = r >> 5, nb = r & 31; d.src = I_w_memb + (size_t)(64 * kb) * 2048 + 64 * nb; d.ldw = 2048; d.dst = WnmT + 1024 + 64 * kb; d.ldt = 2048; d.dA = 64 * nb; d.dB = 64 * nb + 32; d.nt = 1; } } while (0)
        {
            f32x4 R0[16], R1[16]; P0Desc d0, d1; int it = gw2;
            if (it < NITEMS) { P0_DECODE(d0, it); p0_load(d0, R0, lane); }
            if (it + NGW2 < NITEMS) { P0_DECODE(d1, it + NGW2); p0_load(d1, R1, lane); }
            for (; it < NITEMS; it += 2 * NGW2) {
                p0_to_lds(R0, scr, lane); const P0Desc c0 = d0;
                if (it + 2 * NGW2 < NITEMS) { P0_DECODE(d0, it + 2 * NGW2); p0_load(d0, R0, lane); }
                LDS_WAIT(); asm volatile("" ::: "memory"); p0_store(c0, scr, lane); LDS_WAIT(); asm volatile("" ::: "memory");
                if (it + NGW2 < NITEMS) {
                    p0_to_lds(R1, scr, lane); const P0Desc c1 = d1;
                    if (it + 3 * NGW2 < NITEMS) { P0_DECODE(d1, it + 3 * NGW2); p0_load(d1, R1, lane); }
                    LDS_WAIT(); asm volatile("" ::: "memory"); p0_store(c1, scr, lane); LDS_WAIT(); asm volatile("" ::: "memory");
                }
            }
        }
#undef P0_DECODE
        for (int m = gw2; m < mk::M; m += NGW2) rms_row_to_bf16(I_x + (size_t)m * 2048, I_g_mix, HN + (size_t)m * 2048, lane);
    }
    GRID_BAR();
    }
    {
    {
        mk::SchedProj S; S.o.init(mk::M, mk::D_IN, G, bx); S.hn_ = (const char*)HN; S.wt_ = (const char*)WinT;
        const pg8::Gemm g{2048, 2048, 2048};
        mk::EpiProj E{ws};
        pg8::gemm_phase<mk::EpiProj, mk::SchedProj, true>(ldsl + RING_OFF, g, S, E);
    }
    GRID_BAR();
    }
    {
    {
        const int c = bx, bh = c >> 4, nc = c & 15, b = bh >> 3, h = bh & 7;
        const float l2f = tab[mk::TAB_L2F + h], l2b = tab[mk::TAB_L2B + h];
        {
            bf16* kt = KT + (size_t)c * 65536; const bf16* ksrc = K0 + ((size_t)b * 4096 + nc * 256) * 1024 + h * 128;
            LAS float* t = scr;
            const int tok0 = wave * 32;
#pragma unroll
            for (int it = 0; it < 8; ++it) { const int tr = 4 * it + (lane >> 4), c8 = (lane & 15) * 8; const v4u w = *(const v4u*)(ksrc + (size_t)(tok0 + tr) * 1024 + c8);
                LAS float* d = t + tr * 128 + (c8 ^ (8 * (tr >> 3))); d[0] = bf2f_(w.x & 0xffffu); d[1] = bf2f_(w.x >> 16); d[2] = bf2f_(w.y & 0xffffu); d[3] = bf2f_(w.y >> 16);
                d[4] = bf2f_(w.z & 0xffffu); d[5] = bf2f_(w.z >> 16); d[6] = bf2f_(w.w & 0xffffu); d[7] = bf2f_(w.w >> 16); }
            LDS_WAIT(); asm volatile("" ::: "memory");
            const int q = lane & 3;
            float df[8], db[8];
#pragma unroll
            for (int i = 0; i < 8; ++i) { const int tk = tok0 + 8 * q + i; df[i] = pg8::fexp2(l2f * (float)(255 - tk)); db[i] = pg8::fexp2(l2b * (float)tk); }
#pragma unroll
            for (int j = 0; j < 8; ++j) { const int dk = (lane >> 2) + 16 * j; const LAS float* s = t + (8 * q) * 128 + (dk ^ (8 * q));
                float v[8];
#pragma unroll
                for (int i = 0; i < 8; ++i) v[i] = s[i * 128];
                v4u o; o.x = pk2(v[0] * df[0], v[1] * df[1]); o.y = pk2(v[2] * df[2], v[3] * df[3]); o.z = pk2(v[4] * df[4], v[5] * df[5]); o.w = pk2(v[6] * df[6], v[7] * df[7]);
                *(GAS v4u*)(kt + (size_t)dk * 256 + tok0 + 8 * q) = o;
                o.x = pk2(v[0] * db[0], v[1] * db[1]); o.y = pk2(v[2] * db[2], v[3] * db[3]); o.z = pk2(v[4] * db[4], v[5] * db[5]); o.w = pk2(v[6] * db[6], v[7] * db[7]);
                *(GAS v4u*)(kt + (size_t)(128 + dk) * 256 + tok0 + 8 * q) = o; }
            VM_WAIT(); LDS_WAIT(); __syncthreads();
        }
        MK_STAMP();
        {
            bf16* arc = AR + ((size_t)bh * 4096 + nc * 256) * 512;
            mk::SchedList3 S; S.n = (bx < 128) ? 3 : 2;
            S.u0.a = (const char*)(BR + (size_t)c * 256 * 512); S.u0.b = (const char*)(KT + (size_t)c * 65536); S.u0.lda = 512; S.u0.ldb = 256; S.u0.nt = 4; S.u0.kind = 0; S.u0.perm = 1;
            S.u1.a = (const char*)(arc + 256); S.u1.b = (const char*)(K0 + ((size_t)b * 4096 + nc * 256) * 1024 + h * 128); S.u1.lda = 512; S.u1.ldb = 1024; S.u1.nt = 2; S.u1.kind = 1; S.u1.perm = 1;
            const int xb = (bx >> 6) & 1, xh = (bx >> 4) & 3, qt = bx & 15; const size_t tok0 = (size_t)xb * 4096 + qt * 256;
            S.u2.a = (const char*)(XQ + tok0 * 1024 + xh * 256); S.u2.b = (const char*)(MKb + (size_t)xb * 256 * 1024 + xh * 256); S.u2.lda = 1024; S.u2.ldb = 1024; S.u2.nt = 4; S.u2.kind = 2; S.u2.perm = 1;
            mk::EpiM1 E{mk::EpiF32{KV + (size_t)c * 65536}, mk::EpiP{arc, l2f, l2b},
                        mk::EpiXS{XP + tok0 * 1024 + xh * 256, xl + tok0 * 16 + xh * 4, ssq_xq + tok0 * 16 + xh * 4, tab + mk::TAB_SSQ_MK + (size_t)xb * 256 * 16 + xh * 4}};
            pg8::gemm_stream<mk::EpiM1, mk::SchedList3, true>(ldsl + RING_OFF, S, E);
        }
        MK_STAMP();
    }
    GRID_BAR();
    }
    {
    {
        for (int e = (vcu * 512 + tid); e < 16 * 65536; e += G * 512) {
            const int bh = e >> 16, r = e & 65535, col = r & 255, h = bh & 7;
            const bool fwd = col < 128; const float dec = pg8::fexp2((fwd ? tab[mk::TAB_L2F + h] : tab[mk::TAB_L2B + h]) * 256.0f);
            const bf16* kvp = KV + (size_t)bh * 16 * 65536 + r; bf16* brp = BR + ((size_t)bh * 16 * 256 + (r >> 8)) * 512 + 256 + col;
            float kvv[16];
#pragma unroll
            for (int n = 0; n < 16; ++n) kvv[n] = bf2f_(__builtin_nontemporal_load(kvp + (size_t)n * 65536));
            float s = 0.f;
            if (fwd) {
#pragma unroll
                for (int n = 0; n < 16; ++n) { brp[(size_t)n * 256 * 512] = (bf16)f2bf(s); s = dec * s + kvv[n]; }
            } else {
#pragma unroll
                for (int n = 15; n >= 0; --n) { brp[(size_t)n * 256 * 512] = (bf16)f2bf(s); s = dec * s + kvv[n]; }
            }
        }
        __syncthreads();
        MK_STAMP();
        { const int b = bx >> 7, h = (bx >> 4) & 7, i4 = bx & 15;
        na::na_unit(b, h, i4, NAQKV, ssq_naq, ssq_nak, I_rpb, ONM, (char*)lds); }
        MK_STAMP();
    }
    GRID_BAR();
    }
    {
    {
        const int c = bx, bh = c >> 4, nc = c & 15, b = bh >> 3, h = bh & 7;
        {
            const int xb = (bx >> 6) & 1, xh = (bx >> 4) & 3, qt = bx & 15; const size_t tok0 = (size_t)xb * 4096 + qt * 256;
            const size_t o0 = ((size_t)b * 4096 + nc * 256) * 2048 + h * 256;
            const bool hx = bx < 128;
            mk::SchedList3 S; S.n = hx ? 2 : 1;
            const char* const ra = (const char*)(AR + ((size_t)bh * 4096 + nc * 256) * 512); const char* const rb = (const char*)(BR + (size_t)c * 256 * 512);
            S.u0.a = hx ? (const char*)(XP + tok0 * 1024 + xh * 256) : ra; S.u0.b = hx ? (const char*)(MVT + (size_t)xh * 256 * 512 + xb * 256) : rb;
            S.u0.lda = hx ? 1024 : 512; S.u0.ldb = 512; S.u0.nt = hx ? 4 : 8; S.u0.kind = hx ? 0 : 1; S.u0.perm = 1;
            S.u1.a = ra; S.u1.b = rb; S.u1.lda = 512; S.u1.ldb = 512; S.u1.nt = 8; S.u1.kind = 1; S.u1.perm = 1;
            S.u2.a = ra; S.u2.b = rb; S.u2.lda = 512; S.u2.ldb = 512; S.u2.nt = 8; S.u2.kind = 1; S.u2.perm = 1;
            mk::EpiM3 E{mk::EpiXO{ONM + tok0 * 2048 + 1024 + xh * 256, xl + tok0 * 16 + xh * 4}, mk::EpiGN{ORET + o0, RG + o0, I_gn + h * 256}};
            pg8::gemm_stream<mk::EpiM3, mk::SchedList3, true>(ldsl + RING_OFF, S, E);
        }
        MK_STAMP();
    }
    GRID_BAR();
    }
    {
    {
        mk::SchedBR S; S.o.init(mk::M, 2048, G, bx); S.onm = (const char*)ONM; S.oret = (const char*)ORET; S.wnm = (const char*)WnmT; S.wret = (const char*)WretT;
        const pg8::Gemm g{2048, 2048, 1024}; mk::EpiGate4 E{MERGED, GATES};
        pg8::gemm_phase<mk::EpiGate4, mk::SchedBR, true>(ldsl + RING_OFF, g, S, E);
    }
    GRID_BAR();
    }
    {
    {
        mk::SchedGrid S; S.o.init(mk::M, 2048, G, bx); S.A = (const char*)MERGED; S.B = (const char*)WoutT; S.ta = 256u * 2048u * 2u; S.tb = 256u * 2048u * 2u;
        const pg8::Gemm g{2048, 2048, 2048}; mk::EpiWout E{I_x, I_out, X1B, ssq_x1, I_g_ffn};
        pg8::gemm_phase<mk::EpiWout, mk::SchedGrid, false>(ldsl + RING_OFF, g, S, E);
    }
    GRID_BAR();
    }
    {
    {
        mk::SchedGrid S; S.o.init(mk::M, 8192, G, bx); S.A = (const char*)X1B; S.B = (const char*)Wff1T; S.ta = 256u * 2048u * 2u; S.tb = 256u * 2048u * 2u;
        const pg8::Gemm g{2048, 2048, 2048}; mk::EpiFF1 E{HFF, ssq_x1};
        pg8::gemm_phase<mk::EpiFF1, mk::SchedGrid, true>(ldsl + RING_OFF, g, S, E);
    }
    GRID_BAR();
    }
    if (false) {
        mk::SchedGrid S; S.o.init(mk::M, 2048, G, bx); S.A = (const char*)HFF; S.B = (const char*)Wff2T; S.ta = 256u * (unsigned)mk::LDH * 2u; S.tb = 256u * 8192u * 2u;
        const pg8::Gemm g{mk::LDH, 8192, 8192}; mk::EpiFF2 E{I_out, (float*)AR};
        pg8::gemm_phase<mk::EpiFF2, mk::SchedGrid, false>(ldsl + RING_OFF, g, S, E);
        GRID_BAR();
    }
    {
        mk::SchedGrid S; S.o.init(mk::M, 2048, G, bx); S.A = (const char*)HFF; S.B = (const char*)Wff2T; S.ta = 256u * (unsigned)mk::LDH * 2u; S.tb = 256u * 8192u * 2u;
        const pg8::Gemm g{mk::LDH, 8192, 8192}; mk::EpiFF2 E{I_out, I_out};
        pg8::gemm_phase<mk::EpiFF2, mk::SchedGrid, false>(ldsl + RING_OFF, g, S, E);
    }
    MK_STAMP();
    if (MK_TS_ >= 0 && bx == 0 && tid == 0) {
        const unsigned dt = MISC[16 + MK_TS_ + 1] - MISC[16 + MK_TS_]; const unsigned long long t0 = __builtin_amdgcn_s_memrealtime();
        while (__builtin_amdgcn_s_memrealtime() - t0 < 8ull * dt) __builtin_amdgcn_s_sleep(8);
    }
}

extern "C" void kernel_launch(void* const* d_in, const int* in_sizes, int n_in, void* d_out, int out_size, void* d_ws, size_t ws_size, hipStream_t stream) {
    static int grid = 0;
    if (grid == 0) {
        if (n_in != 21 || out_size != mk::M * mk::D || ws_size < mk::WS_END) { fprintf(stderr, "kernel_launch: unexpected shapes (n_in %d out %d ws %zu); nothing launched\n", n_in, out_size, ws_size); grid = -1; return; }
        int dev = 0, cus = 0;
        if (hipGetDevice(&dev) != hipSuccess || hipDeviceGetAttribute(&cus, hipDeviceAttributeMultiprocessorCount, dev) != hipSuccess) { grid = -1; return; }
        if (hipFuncSetAttribute((const void*)mk_fwd, hipFuncAttributeMaxDynamicSharedMemorySize, LDS_BYTES) != hipSuccess) { fprintf(stderr, "kernel_launch: hipFuncSetAttribute failed\n"); grid = -1; return; }
        (void)hipGetLastError();
        grid = cus;
        if (grid != 256) fprintf(stderr, "kernel_launch: %d CUs; this kernel's unit maps assume 256\n", grid);
    }
    if (grid < 0) return;
    if (hipMemsetAsync((char*)d_ws + mk::WS_CTL, 0, mk::CTL_ZERO_BYTES, stream) != hipSuccess) return;
    Args a{};
    for (int i = 0; i < 21; ++i) a.in[i] = (const float*)d_in[i];
    a.out = (float*)d_out; a.ws = (unsigned char*)d_ws;
    hipLaunchKernelGGL(mk_fwd, dim3(grid), dim3(NWAVES * 64), LDS_BYTES, stream, a);
}
```

```cpp
#include <hip/hip_runtime.h>
#include <cstdio>
#include <cstdint>

#if defined(MK_TS)
#define PG8_DBG_STAMP() do { if (blockIdx.x == 0 && threadIdx.x == 0) { volatile __attribute__((address_space(3))) unsigned* M_ = (volatile __attribute__((address_space(3))) unsigned*)131392; const unsigned n_ = M_[15]; M_[16 + n_] = (unsigned)__builtin_amdgcn_s_memrealtime(); M_[15] = n_ + 1u; } } while (0)
#else
#define PG8_DBG_STAMP() do {} while (0)
#endif
namespace pg8 {
#define PG8_LAS __attribute__((address_space(3)))
typedef unsigned short bf16_t;
typedef short bf16x8 __attribute__((ext_vector_type(8)));
typedef float f32x4 __attribute__((ext_vector_type(4)));
typedef float f32x2 __attribute__((ext_vector_type(2)));
typedef unsigned u32x4 __attribute__((ext_vector_type(4)));
typedef unsigned u32x2 __attribute__((ext_vector_type(2)));
constexpr int BM = 256, BK = 64, HALF = 128, HTB = HALF * BK * 2, STAGE_BYTES = 8 * HTB, NXCD = 8, WGM = 4;

__host__ __device__ __forceinline__ int lds_byte(int r, int c) { const int st = (r >> 4) * 2 + (c >> 5), rr = r & 15, cc = c & 31, ob = rr * 64 + cc * 2; return st * 1024 + (ob ^ (((ob >> 9) & 1) << 5)); }
__host__ __device__ __forceinline__ void stage_rc(int b, int& R, int& C) { const int st = b / 1024, sb = b % 1024, swz = sb ^ (((sb >> 9) & 1) << 5); R = (st >> 1) * 16 + swz / 64; C = (st & 1) * 32 + (swz % 64) / 2; }
__host__ __device__ __forceinline__ int perm32(int rho) { const int n = rho >> 4, i = rho & 15; return 8 * (i >> 2) + 4 * n + (i & 3); }

struct Unit { int pm, pn, sub; };
struct Gemm { int lda, ldb, K; };

struct GridOrder {
    int nM, nN, nwg, G, c;
    __device__ void init(int M, int N, int G_, int c_) { nM = M / BM; nN = N / BM; nwg = nM * nN; G = G_; c = c_; }
    __device__ bool next(int i, Unit& u) const {
        const long L = (long)i * G + c; if (L >= nwg) return false;
        int wgid = (int)L; { const int q = nwg / NXCD, r = nwg % NXCD, xcd = wgid % NXCD, off = wgid / NXCD; wgid = (xcd < r ? xcd * (q + 1) : r * (q + 1) + (xcd - r) * q) + off; }
        const int nig = WGM * nN, gid = wgid / nig, fm = gid * WGM, gsz = (nM - fm) < WGM ? (nM - fm) : WGM;
        u.pm = fm + ((wgid % nig) % gsz); u.pn = (wgid % nig) / gsz; u.sub = 0; return true;
    }
};

typedef float f32x2_cv __attribute__((ext_vector_type(2))); typedef __bf16 bf16x2_cv __attribute__((ext_vector_type(2)));
__device__ __forceinline__ unsigned cvt_pk_bf16(float lo, float hi) { const f32x2_cv v = {lo, hi}; const bf16x2_cv b = __builtin_convertvector(v, bf16x2_cv); return __builtin_bit_cast(unsigned, b); }
__device__ __forceinline__ void store8(bf16_t* p, f32x4 v0, f32x4 v1) { u32x4 w; w.x = cvt_pk_bf16(v0[0], v0[1]); w.y = cvt_pk_bf16(v0[2], v0[3]); w.z = cvt_pk_bf16(v1[0], v1[1]); w.w = cvt_pk_bf16(v1[2], v1[3]); *(u32x4*)p = w; }
__device__ __forceinline__ void store4(bf16_t* p, f32x4 v0) { u32x2 w; w.x = cvt_pk_bf16(v0[0], v0[1]); w.y = cvt_pk_bf16(v0[2], v0[3]); *(u32x2*)p = w; }
__device__ __forceinline__ float bf2f(unsigned short h) { return __uint_as_float((unsigned)h << 16); }
__device__ __forceinline__ void load8(const bf16_t* p, f32x4& v0, f32x4& v1) { const u32x4 w = *(const u32x4*)p;
    v0[0] = __uint_as_float(w.x << 16); v0[1] = __uint_as_float(w.x & 0xffff0000u); v0[2] = __uint_as_float(w.y << 16); v0[3] = __uint_as_float(w.y & 0xffff0000u);
    v1[0] = __uint_as_float(w.z << 16); v1[1] = __uint_as_float(w.z & 0xffff0000u); v1[2] = __uint_as_float(w.w << 16); v1[3] = __uint_as_float(w.w & 0xffff0000u); }
__device__ __forceinline__ void load8_nt(const bf16_t* p, f32x4& v0, f32x4& v1) { const u32x4 w = __builtin_nontemporal_load((const u32x4*)p);
    v0[0] = __uint_as_float(w.x << 16); v0[1] = __uint_as_float(w.x & 0xffff0000u); v0[2] = __uint_as_float(w.y << 16); v0[3] = __uint_as_float(w.y & 0xffff0000u);
    v1[0] = __uint_as_float(w.z << 16); v1[1] = __uint_as_float(w.z & 0xffff0000u); v1[2] = __uint_as_float(w.w << 16); v1[3] = __uint_as_float(w.w & 0xffff0000u); }
__device__ __forceinline__ void load8_l2(const bf16_t* p, f32x4& v0, f32x4& v1) { u32x4 w; const unsigned long long a = __hip_atomic_load((const unsigned long long*)p, __ATOMIC_RELAXED, __HIP_MEMORY_SCOPE_AGENT), b = __hip_atomic_load((const unsigned long long*)p + 1, __ATOMIC_RELAXED, __HIP_MEMORY_SCOPE_AGENT);
    w.x = (unsigned)a; w.y = (unsigned)(a >> 32); w.z = (unsigned)b; w.w = (unsigned)(b >> 32);
    v0[0] = __uint_as_float(w.x << 16); v0[1] = __uint_as_float(w.x & 0xffff0000u); v0[2] = __uint_as_float(w.y << 16); v0[3] = __uint_as_float(w.y & 0xffff0000u);
    v1[0] = __uint_as_float(w.z << 16); v1[1] = __uint_as_float(w.z & 0xffff0000u); v1[2] = __uint_as_float(w.w << 16); v1[3] = __uint_as_float(w.w & 0xffff0000u); }
__device__ __forceinline__ float fexp2(float x) { return __builtin_amdgcn_exp2f(x); }
__device__ __forceinline__ float frcp(float x) { return __builtin_amdgcn_rcpf(x); }
__device__ __forceinline__ float sigmoidf_(float x) { return frcp(1.f + fexp2(-1.4426950408889634f * x)); }

template <class Epi, class Sched, bool ALIGN_EPI>
__device__ __forceinline__ void gemm_phase(PG8_LAS unsigned char* lds, const Gemm g, const Sched& S, const Epi& E) {
    int tid_ = threadIdx.x; asm volatile("" : "+v"(tid_));
    const int tid = tid_, wid = __builtin_amdgcn_readfirstlane(tid >> 6), lane = tid & 63, wr = wid >> 2, wc = wid & 3, fr = lane & 15, fq = lane >> 4;
    unsigned voffA[2], voffB[2];
#pragma unroll
    for (int i = 0; i < 2; ++i) { int R, C; stage_rc(tid * 16 + i * 8192, R, C); const int Rb = Epi::PERM ? ((R & ~31) + perm32(R & 31)) : R;
        voffA[i] = (unsigned)(R * g.lda + C) * 2u; voffB[i] = (unsigned)(Rb * g.ldb + C) * 2u; }
    const size_t kstep = (size_t)(BK * 2);
    const size_t hstepA = (size_t)HALF * g.lda * 2, hstepB = (size_t)HALF * g.ldb * 2;
    const unsigned ldsw = (unsigned)wid * 1024u;
    const int aoff = lds_byte(wr * 64 + fr, fq * 8), boff = lds_byte(wc * 32 + fr, fq * 8);
#define PG8_SA(b, h) (((b) * 2 + (h)) * HTB)
#define PG8_SB(b, h) ((4 + (b) * 2 + (h)) * HTB)
#define PG8_STAGE(bufoff, gbase, voff) do { _Pragma("unroll") for (int _i = 0; _i < 2; ++_i) \
        __builtin_amdgcn_global_load_lds((const unsigned*)((const char*)(gbase) + (voff)[_i]), (PG8_LAS unsigned*)(lds + (bufoff) + ldsw + _i * 8192), 16, 0, 0); } while (0)
#define PG8_LDA(dst, b, h) do { _Pragma("unroll") for (int m = 0; m < 4; ++m) _Pragma("unroll") for (int k = 0; k < 2; ++k) dst[m][k] = *(const PG8_LAS bf16x8*)(lds + PG8_SA(b, h) + aoff + m * 2048 + k * 1024); } while (0)
#define PG8_LDB(dst, b, h) do { _Pragma("unroll") for (int n = 0; n < 2; ++n) _Pragma("unroll") for (int k = 0; k < 2; ++k) dst[n][k] = *(const PG8_LAS bf16x8*)(lds + PG8_SB(b, h) + boff + n * 2048 + k * 1024); } while (0)
#define PG8_MMA(ai, bj, At, Bt) do { __builtin_amdgcn_s_setprio(1); _Pragma("unroll") for (int m = 0; m < 4; ++m) _Pragma("unroll") for (int n = 0; n < 2; ++n) _Pragma("unroll") for (int k = 0; k < 2; ++k) \
        acc[ai][bj][m][n] = __builtin_amdgcn_mfma_f32_16x16x32_bf16(Bt[n][k], At[m][k], acc[ai][bj][m][n], 0, 0, 0); __builtin_amdgcn_s_setprio(0); } while (0)
#define PG8_WAIT_V(n) asm volatile("s_waitcnt vmcnt(" #n ")" ::: "memory")
#define PG8_WAIT_L(n) asm volatile("s_waitcnt lgkmcnt(" #n ")" ::: "memory")
#define PG8_BAR __builtin_amdgcn_s_barrier()
#define PG8_SCHED __builtin_amdgcn_sched_barrier(0)
    Unit cur, nxt; int ui = 0;
    if (!S.next(0, cur)) return;
    f32x4 acc[2][2][4][2];
    if constexpr (Epi::INIT_C) { int fr2 = fr, fq2 = fq; asm volatile("" : "+v"(fr2), "+v"(fq2)); E.init_c(acc, cur, wr, wc, fr2, fq2); }
    else {
#pragma unroll
    for (int a = 0; a < 2; ++a)
#pragma unroll
        for (int b = 0; b < 2; ++b)
#pragma unroll
            for (int m = 0; m < 4; ++m)
#pragma unroll
                for (int n = 0; n < 2; ++n) acc[a][b][m][n] = (f32x4){0.f, 0.f, 0.f, 0.f};
    }
    bf16x8 At[4][2], B0[2][2], B1[2][2];
    const char* cA; const char* cB; S.ptrs(cur, cA, cB);
    PG8_STAGE(PG8_SB(0, 0), cB, voffB); PG8_STAGE(PG8_SB(0, 1), cB + hstepB, voffB); PG8_STAGE(PG8_SA(0, 0), cA, voffA); PG8_STAGE(PG8_SA(0, 1), cA + hstepA, voffA);
    if (wr == 1) PG8_BAR;
    PG8_WAIT_V(2); PG8_BAR;
    PG8_STAGE(PG8_SB(1, 0), cB + kstep, voffB); PG8_STAGE(PG8_SA(1, 0), cA + kstep, voffA); PG8_STAGE(PG8_SB(1, 1), cB + hstepB + kstep, voffB);
    PG8_WAIT_V(6); PG8_BAR;
    for (;;) {
        const bool has_next = S.next(ui + 1, nxt); const int nt = S.nt(cur, g.K) ;
        const char* nA = cA; const char* nB = cB; if (has_next) S.ptrs(nxt, nA, nB);
        for (int t = 0; t < nt; t += 2) {
            const bool last = (t == nt - 2);
            const char* a1 = cA + (size_t)(t + 1) * kstep;
            const char* a2 = last ? nA : cA + (size_t)(t + 2) * kstep; const char* b2 = last ? nB : cB + (size_t)(t + 2) * kstep;
            const char* a3 = a2 + kstep; const char* b3 = b2 + kstep;
            PG8_LDB(B0, 0, 0); PG8_LDB(B1, 0, 1); PG8_SCHED; PG8_LDA(At, 0, 0); PG8_STAGE(PG8_SA(1, 1), a1 + hstepA, voffA);
            PG8_WAIT_V(8); PG8_WAIT_L(0); PG8_BAR; PG8_MMA(0, 0, At, B0); PG8_MMA(0, 1, At, B1); PG8_BAR; PG8_SCHED;
            PG8_LDA(At, 0, 1); PG8_STAGE(PG8_SB(0, 0), b2, voffB); PG8_STAGE(PG8_SB(0, 1), b2 + hstepB, voffB); PG8_STAGE(PG8_SA(0, 0), a2, voffA);
            PG8_WAIT_V(8); PG8_WAIT_L(0); PG8_BAR; PG8_MMA(1, 0, At, B0); PG8_MMA(1, 1, At, B1); PG8_BAR; PG8_SCHED;
            PG8_LDB(B0, 1, 0); PG8_LDB(B1, 1, 1); PG8_SCHED; PG8_LDA(At, 1, 0); PG8_STAGE(PG8_SA(0, 1), a2 + hstepA, voffA);
            PG8_WAIT_V(8); PG8_WAIT_L(0); PG8_BAR; PG8_MMA(0, 0, At, B0); PG8_MMA(0, 1, At, B1); PG8_BAR; PG8_SCHED;
            PG8_LDA(At, 1, 1); PG8_STAGE(PG8_SB(1, 0), b3, voffB); PG8_STAGE(PG8_SB(1, 1), b3 + hstepB, voffB); PG8_STAGE(PG8_SA(1, 0), a3, voffA);
            PG8_WAIT_V(8); PG8_WAIT_L(0); PG8_BAR; PG8_MMA(1, 0, At, B0); PG8_MMA(1, 1, At, B1); PG8_BAR; PG8_SCHED;
        }
        if constexpr (ALIGN_EPI) { if (wr == 0) PG8_BAR; }
        if constexpr (!Epi::AFTER_DRAIN) { int fr2 = fr, fq2 = fq; asm volatile("" : "+v"(fr2), "+v"(fq2)); E(acc, cur, wr, wc, fr2, fq2); }
        if (!has_next) break;
        if constexpr (Epi::INIT_C) { int fr2 = fr, fq2 = fq; asm volatile("" : "+v"(fr2), "+v"(fq2)); E.init_c(acc, nxt, wr, wc, fr2, fq2); }
        else {
#pragma unroll
        for (int a = 0; a < 2; ++a)
#pragma unroll
            for (int b = 0; b < 2; ++b)
#pragma unroll
                for (int m = 0; m < 4; ++m)
#pragma unroll
                    for (int n = 0; n < 2; ++n) acc[a][b][m][n] = (f32x4){0.f, 0.f, 0.f, 0.f};
        }
        cur = nxt; cA = nA; cB = nB; ++ui;
        if constexpr (ALIGN_EPI) { if (wr == 1) PG8_BAR; }
    }
    PG8_WAIT_V(0);
    if constexpr (!ALIGN_EPI) { if (wr == 0) PG8_BAR; }
    PG8_BAR;
    if constexpr (Epi::AFTER_DRAIN) { int fr2 = fr, fq2 = fq; asm volatile("" : "+v"(fr2), "+v"(fq2)); E.fused(acc, cur, wr, wc, fr2, fq2, lds, wid, lane); }
#undef PG8_SA
#undef PG8_SB
#undef PG8_STAGE
#undef PG8_LDA
#undef PG8_LDB
#undef PG8_MMA
#undef PG8_WAIT_V
#undef PG8_WAIT_L
#undef PG8_BAR
#undef PG8_SCHED
}
struct UnitG { const char* a; const char* b; int lda, ldb, nt, kind, perm; };
template <class Epi, class Sched, bool ALIGN_EPI>
__device__ __forceinline__ void gemm_stream(PG8_LAS unsigned char* lds, const Sched& S, const Epi& E) {
    int tid_ = threadIdx.x; asm volatile("" : "+v"(tid_));
    const int tid = tid_, wid = __builtin_amdgcn_readfirstlane(tid >> 6), lane = tid & 63, wr = wid >> 2, wc = wid & 3, fr = lane & 15, fq = lane >> 4;
#define PG8_VOFF(u, vA, vB) do { _Pragma("unroll") for (int i_ = 0; i_ < 2; ++i_) { int R_, C_; stage_rc(tid * 16 + i_ * 8192, R_, C_); const int Rb_ = (u).perm ? ((R_ & ~31) + perm32(R_ & 31)) : R_; \
        vA[i_] = (unsigned)(R_ * (u).lda + C_) * 2u; vB[i_] = (unsigned)(Rb_ * (u).ldb + C_) * 2u; } } while (0)
    const size_t kstep = (size_t)(BK * 2);
    const unsigned ldsw = (unsigned)wid * 1024u;
    const int aoff = lds_byte(wr * 64 + fr, fq * 8), boff = lds_byte(wc * 32 + fr, fq * 8);
#undef PG8_SA
#undef PG8_SB
#undef PG8_STAGE
#undef PG8_LDA
#undef PG8_LDB
#undef PG8_MMA
#undef PG8_WAIT_V
#undef PG8_WAIT_L
#undef PG8_BAR
#undef PG8_SCHED
#define PG8_SA(b, h) (((b) * 2 + (h)) * HTB)
#define PG8_SB(b, h) ((4 + (b) * 2 + (h)) * HTB)
#define PG8_STAGE(bufoff, gbase, voff) do { _Pragma("unroll") for (int _i = 0; _i < 2; ++_i) \
        __builtin_amdgcn_global_load_lds((const unsigned*)((const char*)(gbase) + (voff)[_i]), (PG8_LAS unsigned*)(lds + (bufoff) + ldsw + _i * 8192), 16, 0, 0); } while (0)
#define PG8_LDA(dst, b, h) do { _Pragma("unroll") for (int m = 0; m < 4; ++m) _Pragma("unroll") for (int k = 0; k < 2; ++k) dst[m][k] = *(const PG8_LAS bf16x8*)(lds + PG8_SA(b, h) + aoff + m * 2048 + k * 1024); } while (0)
#define PG8_LDB(dst, b, h) do { _Pragma("unroll") for (int n = 0; n < 2; ++n) _Pragma("unroll") for (int k = 0; k < 2; ++k) dst[n][k] = *(const PG8_LAS bf16x8*)(lds + PG8_SB(b, h) + boff + n * 2048 + k * 1024); } while (0)
#define PG8_MMA(ai, bj, At, Bt) do { __builtin_amdgcn_s_setprio(1); _Pragma("unroll") for (int m = 0; m < 4; ++m) _Pragma("unroll") for (int n = 0; n < 2; ++n) _Pragma("unroll") for (int k = 0; k < 2; ++k) \
        acc[ai][bj][m][n] = __builtin_amdgcn_mfma_f32_16x16x32_bf16(Bt[n][k], At[m][k], acc[ai][bj][m][n], 0, 0, 0); __builtin_amdgcn_s_setprio(0); } while (0)
#define PG8_WAIT_V(n) asm volatile("s_waitcnt vmcnt(" #n ")" ::: "memory")
#define PG8_WAIT_L(n) asm volatile("s_waitcnt lgkmcnt(" #n ")" ::: "memory")
#define PG8_BAR __builtin_amdgcn_s_barrier()
#define PG8_SCHED __builtin_amdgcn_sched_barrier(0)
    UnitG cur, nxt; int ui = 0;
    if (!S.next(0, cur)) return;
    unsigned voffA[2], voffB[2]; PG8_VOFF(cur, voffA, voffB);
    size_t hstepA = (size_t)HALF * cur.lda * 2, hstepB = (size_t)HALF * cur.ldb * 2;
    f32x4 acc[2][2][4][2];
#pragma unroll
    for (int a = 0; a < 2; ++a)
#pragma unroll
        for (int b = 0; b < 2; ++b)
#pragma unroll
            for (int m = 0; m < 4; ++m)
#pragma unroll
                for (int n = 0; n < 2; ++n) acc[a][b][m][n] = (f32x4){0.f, 0.f, 0.f, 0.f};
    bf16x8 At[4][2], B0[2][2], B1[2][2];
    const char* cA = cur.a; const char* cB = cur.b;
    PG8_STAGE(PG8_SB(0, 0), cB, voffB); PG8_STAGE(PG8_SB(0, 1), cB + hstepB, voffB); PG8_STAGE(PG8_SA(0, 0), cA, voffA); PG8_STAGE(PG8_SA(0, 1), cA + hstepA, voffA);
    if (wr == 1) PG8_BAR;
    PG8_WAIT_V(2); PG8_BAR;
    PG8_STAGE(PG8_SB(1, 0), cB + kstep, voffB); PG8_STAGE(PG8_SA(1, 0), cA + kstep, voffA); PG8_STAGE(PG8_SB(1, 1), cB + hstepB + kstep, voffB);
    PG8_WAIT_V(6); PG8_BAR; PG8_DBG_STAMP();
    for (;;) {
        const bool has_next = S.next(ui + 1, nxt); const int nt = cur.nt; if (!has_next) nxt = cur;
        const char* nA = nxt.a; const char* nB = nxt.b;
        const size_t nhA = (size_t)HALF * nxt.lda * 2, nhB = (size_t)HALF * nxt.ldb * 2;
        for (int t = 0; t < nt; t += 2) {
            const bool last = (t == nt - 2);
            const char* a1 = cA + (size_t)(t + 1) * kstep;
            const char* a2 = last ? nA : cA + (size_t)(t + 2) * kstep; const char* b2 = last ? nB : cB + (size_t)(t + 2) * kstep;
            const char* a3 = a2 + kstep; const char* b3 = b2 + kstep;
            unsigned xvA[2], xvB[2]; if (last) { PG8_VOFF(nxt, xvA, xvB); } else { xvA[0] = voffA[0]; xvA[1] = voffA[1]; xvB[0] = voffB[0]; xvB[1] = voffB[1]; }
            const size_t xhA = last ? nhA : hstepA, xhB = last ? nhB : hstepB;
            PG8_LDB(B0, 0, 0); PG8_LDB(B1, 0, 1); PG8_SCHED; PG8_LDA(At, 0, 0); PG8_STAGE(PG8_SA(1, 1), a1 + hstepA, voffA);
            PG8_WAIT_V(8); PG8_WAIT_L(0); PG8_BAR; PG8_MMA(0, 0, At, B0); PG8_MMA(0, 1, At, B1); PG8_BAR; PG8_SCHED;
            PG8_LDA(At, 0, 1); PG8_STAGE(PG8_SB(0, 0), b2, xvB); PG8_STAGE(PG8_SB(0, 1), b2 + xhB, xvB); PG8_STAGE(PG8_SA(0, 0), a2, xvA);
            PG8_WAIT_V(8); PG8_WAIT_L(0); PG8_BAR; PG8_MMA(1, 0, At, B0); PG8_MMA(1, 1, At, B1); PG8_BAR; PG8_SCHED;
            PG8_LDB(B0, 1, 0); PG8_LDB(B1, 1, 1); PG8_SCHED; PG8_LDA(At, 1, 0); PG8_STAGE(PG8_SA(0, 1), a2 + xhA, xvA);
            PG8_WAIT_V(8); PG8_WAIT_L(0); PG8_BAR; PG8_MMA(0, 0, At, B0); PG8_MMA(0, 1, At, B1); PG8_BAR; PG8_SCHED;
            PG8_LDA(At, 1, 1); PG8_STAGE(PG8_SB(1, 0), b3, xvB); PG8_STAGE(PG8_SB(1, 1), b3 + xhB, xvB); PG8_STAGE(PG8_SA(1, 0), a3, xvA);
            PG8_WAIT_V(8); PG8_WAIT_L(0); PG8_BAR; PG8_MMA(1, 0, At, B0); PG8_MMA(1, 1, At, B1); PG8_BAR; PG8_SCHED;
        }
        if constexpr (ALIGN_EPI) { if (wr == 0) PG8_BAR; } PG8_DBG_STAMP();
        if (!E.after_drain(cur)) { int fr2 = fr, fq2 = fq; asm volatile("" : "+v"(fr2), "+v"(fq2)); E(acc, cur, wr, wc, fr2, fq2); }
        PG8_DBG_STAMP();
        if (!has_next) break;
#pragma unroll
        for (int a = 0; a < 2; ++a)
#pragma unroll
            for (int b = 0; b < 2; ++b)
#pragma unroll
                for (int m = 0; m < 4; ++m)
#pragma unroll
                    for (int n = 0; n < 2; ++n) acc[a][b][m][n] = (f32x4){0.f, 0.f, 0.f, 0.f};
        cur = nxt; cA = nA; cB = nB; ++ui; PG8_VOFF(cur, voffA, voffB); hstepA = nhA; hstepB = nhB;
        if constexpr (ALIGN_EPI) { if (wr == 1) PG8_BAR; }
    }
    PG8_WAIT_V(0);
    if constexpr (!ALIGN_EPI) { if (wr == 0) PG8_BAR; }
    PG8_BAR;
    if (E.after_drain(cur)) { int fr2 = fr, fq2 = fq; asm volatile("" : "+v"(fr2), "+v"(fq2)); E.fused(acc, cur, wr, wc, fr2, fq2, lds, wid, lane); }
#undef PG8_SA
#undef PG8_SB
#undef PG8_STAGE
#undef PG8_LDA
#undef PG8_LDB
#undef PG8_MMA
#undef PG8_WAIT_V
#undef PG8_WAIT_L
#undef PG8_BAR
#undef PG8_SCHED
#undef PG8_VOFF
}
}

namespace mk {
using pg8::bf16_t; using pg8::f32x4; using pg8::f32x2; using pg8::u32x4; using pg8::u32x2; using pg8::Unit;
constexpr int D = 2048, BATCH = 2, SEQ = 4096, M = BATCH * SEQ, D_IN = 16384, D_FF = 8192, N_MEM = 256;
constexpr float EPS = 1e-6f, LOG2E = 1.4426950408889634f;
constexpr size_t MiB = 1u << 20;
constexpr size_t WS_CTL = 0, CTL_ZERO_BYTES = 32 * 1024;
constexpr size_t WS_COS = 1 * MiB, WS_SIN = 2 * MiB;
constexpr size_t WS_SSQ_NAQ = 3 * MiB, WS_SSQ_NAK = 4 * MiB;
constexpr size_t WS_SSQ_XQ = 5 * MiB, WS_XL = 5 * MiB + 512 * 1024;
constexpr size_t WS_SSQ_X1 = 6 * MiB;
constexpr size_t WS_TAB = 6 * MiB + 512 * 1024;
constexpr int TAB_CS_NAQ = 0, TAB_CS_MK = 128, TAB_L2F = 384, TAB_L2B = 392, TAB_SSQ_MK = 1024;
constexpr size_t WS_MEMN = 8 * MiB, WS_MK = 10 * MiB, WS_MVT = 11 * MiB;
constexpr size_t WS_WIN = 16 * MiB, WS_WFF1 = 80 * MiB, WS_WFF2 = 112 * MiB, WS_WRET = 144 * MiB, WS_WOUT = 152 * MiB, WS_WNM = 160 * MiB  , WS_WMKV = 168 * MiB;
constexpr size_t WS_NAQKV = 176 * MiB, WS_K0 = 224 * MiB, WS_RG = 240 * MiB, WS_XQ = 272 * MiB, WS_GATES = 288 * MiB;
constexpr size_t WS_AR = 384 * MiB, WS_BR = 448 * MiB, WS_END = 512 * MiB;
constexpr size_t WS_KV = WS_WIN;
constexpr size_t WS_ORET = 16 * MiB;
constexpr size_t WS_MERGED = WS_NAQKV;
constexpr size_t WS_X1B = WS_AR;
constexpr size_t WS_HFF = 176 * MiB;
constexpr int LDH = 8192;
constexpr size_t DO_HN = 0, DO_KT = 0, DO_XP = 32 * MiB, DO_ONM = 0;

struct SchedGrid {
    pg8::GridOrder o; const char* A; const char* B; size_t ta, tb;
    __device__ __forceinline__ bool next(int i, Unit& u) const { return o.next(i, u); }
    __device__ __forceinline__ void ptrs(const Unit& u, const char*& a, const char*& b) const { a = A + (size_t)u.pm * ta; b = B + (size_t)u.pn * tb; }
    __device__ __forceinline__ int nt(const Unit&, int K) const { return K / 64; }
};
struct SchedProj {
    pg8::GridOrder o; const char* hn_; const char* wt_;
    __device__ __forceinline__ bool next(int i, Unit& u) const { return o.next(i, u); }
    __device__ __forceinline__ void ptrs(const Unit& u, const char*& a, const char*& b) const {
        const char* h = hn_ + (size_t)u.pm * (256u * 2048u * 2u); const char* w = wt_ + (size_t)u.pn * (256u * 2048u * 2u);
        const bool sw = (u.pn >= 20 && u.pn < 28); a = sw ? w : h; b = sw ? h : w; }
    __device__ __forceinline__ int nt(const Unit&, int K) const { return K / 64; }
};
struct SchedOne { bool has; Unit u; const char* a; const char* b;
    __device__ __forceinline__ bool next(int i, Unit& uu) const { if (i != 0 || !has) return false; uu = u; return true; }
    __device__ __forceinline__ void ptrs(const Unit&, const char*& aa, const char*& bb) const { aa = a; bb = b; }
    __device__ __forceinline__ int nt(const Unit&, int K) const { return K / 64; }
};

#define MK_ROWS_BEGIN _Pragma("unroll") for (int ai = 0; ai < 2; ++ai) { _Pragma("unroll") for (int m = 0; m < 4; ++m) { const int rl = ai * 128 + wr * 64 + m * 16 + fr;
#define MK_ROWS_END __builtin_amdgcn_sched_barrier(0); } }
#define MK_ROWS_END_NB } }
#define MK_ROWS_END2 if (m & 1) __builtin_amdgcn_sched_barrier(0); } }
#define MK_RL(ai, m) ((ai) * 128 + wr * 64 + (m) * 16 + fr)
__device__ __forceinline__ float sq8(const f32x4& a, const f32x4& b) { return (a[0] * a[0] + a[1] * a[1]) + (a[2] * a[2] + a[3] * a[3]) + (b[0] * b[0] + b[1] * b[1]) + (b[2] * b[2] + b[3] * b[3]); }
__device__ __forceinline__ float red_fq(float s) {
    { auto r = __builtin_amdgcn_permlane16_swap(__float_as_uint(s), __float_as_uint(s), false, false); s = __uint_as_float(r[0]) + __uint_as_float(r[1]); }
    { auto r = __builtin_amdgcn_permlane32_swap(__float_as_uint(s), __float_as_uint(s), false, false); s = __uint_as_float(r[0]) + __uint_as_float(r[1]); }
    return s; }

struct EpiProj {
    static constexpr bool PERM = true, AFTER_DRAIN = false, INIT_C = false;
    unsigned char* ws;
    __device__ __forceinline__ void operator()(const f32x4 (&acc)[2][2][4][2], const Unit& u, int wr, int wc, int fr, int fq) const {
        bf16_t* const naqkv = (bf16_t*)(ws + WS_NAQKV); bf16_t* const k0 = (bf16_t*)(ws + WS_K0); bf16_t* const rg = (bf16_t*)(ws + WS_RG); bf16_t* const xq = (bf16_t*)(ws + WS_XQ);
        bf16_t* const gates = (bf16_t*)(ws + WS_GATES); bf16_t* const ar = (bf16_t*)(ws + WS_AR); bf16_t* const br = (bf16_t*)(ws + WS_BR);
        float* const ssq_naq = (float*)(ws + WS_SSQ_NAQ); float* const ssq_nak = (float*)(ws + WS_SSQ_NAK); float* const ssq_xq = (float*)(ws + WS_SSQ_XQ);
        const float* const cosT = (const float*)(ws + WS_COS); const float* const sinT = (const float*)(ws + WS_SIN); const float* const tab = (const float*)(ws + WS_TAB);
        const int pn = u.pn, row0 = u.pm * 256, cw = wc * 32 + 8 * fq;
        if (pn < 8) {
            const bool isq = pn < 4; float* ssq = isq ? ssq_naq : ssq_nak; const int hb = isq ? 2 * pn : 2 * (pn - 4);
            f32x4 c0 = (f32x4){1.f, 1.f, 1.f, 1.f}, c1 = c0; if (isq) { c0 = *(const f32x4*)(tab + TAB_CS_NAQ + cw); c1 = *(const f32x4*)(tab + TAB_CS_NAQ + cw + 4); }
            MK_ROWS_BEGIN  const int row = row0 + rl;
#pragma unroll
                for (int bj = 0; bj < 2; ++bj) { const f32x4 v0 = acc[ai][bj][m][0], v1 = acc[ai][bj][m][1]; const float q = red_fq(sq8(v0, v1));
                    if (fq == 0) ssq[(size_t)row * 32 + (hb + bj) * 4 + wc] = q;
                    pg8::store8(naqkv + (size_t)row * 3072 + pn * 256 + bj * 128 + cw, v0 * c0, v1 * c1); }  MK_ROWS_END
        } else if (pn < 12) {
            MK_ROWS_BEGIN  const int row = row0 + rl;
#pragma unroll
                for (int bj = 0; bj < 2; ++bj) pg8::store8(naqkv + (size_t)row * 3072 + pn * 256 + bj * 128 + cw, acc[ai][bj][m][0], acc[ai][bj][m][1]);  MK_ROWS_END
        } else if (pn < 20) {
            const bool isq = pn < 16; const int head = 2 * (pn & 3) + (wc >> 1), i0 = 32 * (wc & 1) + 8 * fq;
            const float l2f = tab[TAB_L2F + head], l2b = tab[TAB_L2B + head];
            MK_ROWS_BEGIN  const int row = row0 + rl, s = row & 4095, b = row >> 12;
                const f32x4 cs0 = *(const f32x4*)(cosT + s * 64 + i0), cs1 = *(const f32x4*)(cosT + s * 64 + i0 + 4), sn0 = *(const f32x4*)(sinT + s * 64 + i0), sn1 = *(const f32x4*)(sinT + s * 64 + i0 + 4);
                const f32x4 a0 = acc[ai][0][m][0], a1 = acc[ai][0][m][1], b0 = acc[ai][1][m][0], b1 = acc[ai][1][m][1];
                const f32x4 lo0 = a0 * cs0 - b0 * sn0, lo1 = a1 * cs1 - b1 * sn1, hi0 = a0 * sn0 + b0 * cs0, hi1 = a1 * sn1 + b1 * cs1;
                if (isq) { const int c = row & 255; const float df = pg8::fexp2(l2f * (float)(c + 1)), db = pg8::fexp2(l2b * (float)(256 - c));
                    bf16_t* d = ar + ((size_t)(b * 8 + head) * 4096 + s) * 512 + 256 + i0;
                    pg8::store8(d, lo0 * df, lo1 * df); pg8::store8(d + 64, hi0 * df, hi1 * df); pg8::store8(d + 128, lo0 * db, lo1 * db); pg8::store8(d + 192, hi0 * db, hi1 * db);
                } else { const float sc = 0.08838834764831845f; bf16_t* d = k0 + (size_t)row * 1024 + head * 128 + i0;
                    pg8::store8(d, lo0 * sc, lo1 * sc); pg8::store8(d + 64, hi0 * sc, hi1 * sc); }  MK_ROWS_END2
        } else if (pn < 28) {
            const int hv = pn - 20, b = u.pm >> 4, nc = u.pm & 15;
            bf16_t* base = br + ((size_t)((b * 8 + hv) * 16 + nc) * 256) * 512;
            MK_ROWS_BEGIN
#pragma unroll
                for (int bj = 0; bj < 2; ++bj) pg8::store8(base + (size_t)rl * 512 + bj * 128 + cw, acc[ai][bj][m][0], acc[ai][bj][m][1]);  MK_ROWS_END
        } else if (pn < 36) {
            MK_ROWS_BEGIN  const int row = row0 + rl;
#pragma unroll
                for (int bj = 0; bj < 2; ++bj) { f32x4 v0 = acc[ai][bj][m][0], v1 = acc[ai][bj][m][1];
#pragma unroll
                    for (int e = 0; e < 4; ++e) { v0[e] = v0[e] * pg8::sigmoidf_(v0[e]); v1[e] = v1[e] * pg8::sigmoidf_(v1[e]); }
                    pg8::store8(rg + (size_t)row * 2048 + (pn - 28) * 256 + bj * 128 + cw, v0, v1); }  MK_ROWS_END
        } else if (pn < 40) {
            MK_ROWS_BEGIN  const int row = row0 + rl;
                const float q = red_fq(sq8(acc[ai][0][m][0], acc[ai][0][m][1]) + sq8(acc[ai][1][m][0], acc[ai][1][m][1]));
                if (fq == 0) ssq_xq[(size_t)row * 16 + (pn - 36) * 4 + wc] = q;
#pragma unroll
                for (int bj = 0; bj < 2; ++bj) pg8::store8(xq + (size_t)row * 1024 + (pn - 36) * 256 + bj * 128 + cw, acc[ai][bj][m][0], acc[ai][bj][m][1]);  MK_ROWS_END
        } else {
            MK_ROWS_BEGIN  const int row = row0 + rl;
#pragma unroll
                for (int bj = 0; bj < 2; ++bj) { f32x4 v0 = acc[ai][bj][m][0], v1 = acc[ai][bj][m][1];
#pragma unroll
                    for (int e = 0; e < 4; ++e) { v0[e] = pg8::sigmoidf_(v0[e]); v1[e] = pg8::sigmoidf_(v1[e]); }
                    u32x2 w; w.x = (unsigned)(v0[0] * 255.f + 0.5f) | ((unsigned)(v0[1] * 255.f + 0.5f) << 8) | ((unsigned)(v0[2] * 255.f + 0.5f) << 16) | ((unsigned)(v0[3] * 255.f + 0.5f) << 24);
                    w.y = (unsigned)(v1[0] * 255.f + 0.5f) | ((unsigned)(v1[1] * 255.f + 0.5f) << 8) | ((unsigned)(v1[2] * 255.f + 0.5f) << 16) | ((unsigned)(v1[3] * 255.f + 0.5f) << 24);
                    *(u32x2*)((unsigned char*)gates + (size_t)row * 6144 + (pn - 40) * 256 + bj * 128 + cw) = w; }  MK_ROWS_END
        }
    }
};
struct EpiMKV {
    static constexpr bool PERM = true, AFTER_DRAIN = false, INIT_C = false;
    bf16_t *mk, *mvt; float* tabw; const float* tab; int mode;
    __device__ __forceinline__ void operator()(const f32x4 (&acc)[2][2][4][2], const Unit& u, int wr, int wc, int fr, int fq) const {
        const int cw = wc * 32 + 8 * fq, row0 = u.pm * 256;
        if (mode == 0) {
            MK_ROWS_BEGIN  const int row = row0 + rl;
                const float q = red_fq(sq8(acc[ai][0][m][0], acc[ai][0][m][1]) + sq8(acc[ai][1][m][0], acc[ai][1][m][1]));
                if (fq == 0) tabw[TAB_SSQ_MK + row * 16 + u.pn * 4 + wc] = q;
#pragma unroll
                for (int bj = 0; bj < 2; ++bj) { const f32x4 c0 = *(const f32x4*)(tab + TAB_CS_MK + bj * 128 + cw), c1 = *(const f32x4*)(tab + TAB_CS_MK + bj * 128 + cw + 4);
                    pg8::store8(mk + (size_t)row * 1024 + u.pn * 256 + bj * 128 + cw, acc[ai][bj][m][0] * c0, acc[ai][bj][m][1] * c1); }  MK_ROWS_END
        } else {
            MK_ROWS_BEGIN  const int row = row0 + rl;
#pragma unroll
                for (int bj = 0; bj < 2; ++bj) pg8::store8(mvt + (size_t)row * 512 + u.pn * 256 + bj * 128 + cw, acc[ai][bj][m][0], acc[ai][bj][m][1]);  MK_ROWS_END
        }
    }
};
struct EpiF32 {
    static constexpr bool PERM = true, AFTER_DRAIN = false, INIT_C = false;
    bf16_t* C;
    __device__ __forceinline__ void operator()(const f32x4 (&acc)[2][2][4][2], const Unit&, int wr, int wc, int fr, int fq) const {
        const int cw = wc * 32 + 8 * fq;
        MK_ROWS_BEGIN
#pragma unroll
            for (int bj = 0; bj < 2; ++bj) pg8::store8(C + (size_t)rl * 256 + bj * 128 + cw, acc[ai][bj][m][0], acc[ai][bj][m][1]);  MK_ROWS_END
    }
};
struct EpiP {
    static constexpr bool PERM = true, AFTER_DRAIN = false, INIT_C = false;
    bf16_t* P; float l2f, l2b;
    __device__ __forceinline__ void operator()(const f32x4 (&acc)[2][2][4][2], const Unit&, int wr, int wc, int fr, int fq) const {
        const int cw = wc * 32 + 8 * fq;
        MK_ROWS_BEGIN  const int c = rl; const float rowf = -l2f * (float)(c + 1);
#pragma unroll
            for (int bj = 0; bj < 2; ++bj) { f32x4 v[2] = {acc[ai][bj][m][0], acc[ai][bj][m][1]};
#pragma unroll
                for (int n = 0; n < 2; ++n)
#pragma unroll
                    for (int e = 0; e < 4; ++e) { const int cp = bj * 128 + cw + 4 * n + e;
                        const float ex = (c >= cp) ? (-l2f * (float)(cp + 1)) : (l2b * (float)(cp - c) + rowf);
                        v[n][e] *= pg8::fexp2(ex); }
                pg8::store8(P + (size_t)c * 512 + bj * 128 + cw, v[0], v[1]); }  MK_ROWS_END
    }
};
struct EpiGN {
    static constexpr bool PERM = true, AFTER_DRAIN = true, INIT_C = false;
    bf16_t* oret; const bf16_t* rgv; const float* gn;
    __device__ __forceinline__ void fused(f32x4 (&acc)[2][2][4][2], const Unit&, int wr, int wc, int fr, int fq, PG8_LAS unsigned char* lds, int wid, int lane) const {
        PG8_LAS f32x2* P = (PG8_LAS f32x2*)lds;
        const int cw = wc * 32 + 8 * fq;
        MK_ROWS_BEGIN  float s = 0.f;
#pragma unroll
            for (int bj = 0; bj < 2; ++bj)
#pragma unroll
                for (int n = 0; n < 2; ++n) { const f32x4 x = acc[ai][bj][m][n]; s += (x[0] + x[1]) + (x[2] + x[3]); }
            s = red_fq(s); const float mw = s * (1.0f / 64.0f); float q = 0.f;
#pragma unroll
            for (int bj = 0; bj < 2; ++bj)
#pragma unroll
                for (int n = 0; n < 2; ++n) { const f32x4 d = acc[ai][bj][m][n] - mw; q += (d[0] * d[0] + d[1] * d[1]) + (d[2] * d[2] + d[3] * d[3]); }
            q = red_fq(q);
            if (fq == 0) P[rl * 4 + wc] = (f32x2){mw, q};  MK_ROWS_END
        asm volatile("s_waitcnt lgkmcnt(0)" ::: "memory"); __builtin_amdgcn_s_barrier(); asm volatile("" ::: "memory");
        f32x4 g0[2], g1[2];
#pragma unroll
        for (int bj = 0; bj < 2; ++bj) { g0[bj] = *(const f32x4*)(gn + bj * 128 + cw); g1[bj] = *(const f32x4*)(gn + bj * 128 + cw + 4); }
        MK_ROWS_BEGIN  const f32x2 a = P[rl * 4 + 0], b = P[rl * 4 + 1], c = P[rl * 4 + 2], d = P[rl * 4 + 3];
            const float mt = (a.x + b.x + c.x + d.x) * 0.25f;
            const float da = a.x - mt, db = b.x - mt, dc = c.x - mt, dd = d.x - mt;
            const float m2 = (a.y + b.y) + (c.y + d.y) + 64.0f * ((da * da + db * db) + (dc * dc + dd * dd));
            const float rstd = 1.0f / sqrtf(m2 * (1.0f / 256.0f) + EPS);
#pragma unroll
            for (int bj = 0; bj < 2; ++bj) { f32x4 r0, r1; pg8::load8(rgv + (size_t)rl * 2048 + bj * 128 + cw, r0, r1);
                const f32x4 o0 = (acc[ai][bj][m][0] - mt) * rstd * g0[bj] * r0, o1 = (acc[ai][bj][m][1] - mt) * rstd * g1[bj] * r1;
                pg8::store8(oret + (size_t)rl * 2048 + bj * 128 + cw, o0, o1); }  MK_ROWS_END_NB
        asm volatile("s_waitcnt lgkmcnt(0)" ::: "memory"); __builtin_amdgcn_s_barrier(); asm volatile("" ::: "memory");
    }
};
struct EpiXS {
    static constexpr bool PERM = true, AFTER_DRAIN = false, INIT_C = false;
    bf16_t* xp; float* xl; const float* ssq_q; const float* ssq_k;
    __device__ __forceinline__ void operator()(const f32x4 (&acc)[2][2][4][2], const Unit&, int wr, int wc, int fr, int fq) const {
        const int cw = wc * 32 + 8 * fq;
        float rk[2][8];
#pragma unroll
        for (int bj = 0; bj < 2; ++bj)
#pragma unroll
            for (int j = 0; j < 8; ++j) { const f32x4 p = *(const f32x4*)(ssq_k + (size_t)(bj * 128 + cw + j) * 16); rk[bj][j] = rsqrtf(((p[0] + p[1]) + (p[2] + p[3])) * (1.0f / 256.0f) + EPS) * LOG2E; }
#pragma unroll
        for (int ai = 0; ai < 2; ++ai) {
            float rqa[4];
#pragma unroll
            for (int m = 0; m < 4; ++m) { const f32x4 pq = *(const f32x4*)(ssq_q + (size_t)MK_RL(ai, m) * 16); rqa[m] = rsqrtf(((pq[0] + pq[1]) + (pq[2] + pq[3])) * (1.0f / 256.0f) + EPS); }
#pragma unroll
            for (int m = 0; m < 4; ++m) { const int rl = MK_RL(ai, m); const float rq = rqa[m];
                float s = 0.f;
#pragma unroll
                for (int bj = 0; bj < 2; ++bj) { f32x4 v[2] = {acc[ai][bj][m][0], acc[ai][bj][m][1]};
#pragma unroll
                    for (int n = 0; n < 2; ++n)
#pragma unroll
                        for (int e = 0; e < 4; ++e) { v[n][e] = pg8::fexp2(v[n][e] * rq * rk[bj][4 * n + e]); s += v[n][e]; }
                    pg8::store8(xp + (size_t)rl * 1024 + bj * 128 + cw, v[0], v[1]); }
                s = red_fq(s); if (fq == 0) xl[(size_t)rl * 16 + wc] = s;
                __builtin_amdgcn_sched_barrier(0); }
        }
    }
};
struct EpiXO {
    static constexpr bool PERM = true, AFTER_DRAIN = false, INIT_C = false;
    bf16_t* omem; const float* xl;
    __device__ __forceinline__ void operator()(const f32x4 (&acc)[2][2][4][2], const Unit&, int wr, int wc, int fr, int fq) const {
        const int cw = wc * 32 + 8 * fq;
        float ila[2][4];
#pragma unroll
        for (int ai = 0; ai < 2; ++ai)
#pragma unroll
            for (int m = 0; m < 4; ++m) { const f32x4 p = *(const f32x4*)(xl + (size_t)MK_RL(ai, m) * 16); ila[ai][m] = pg8::frcp((p[0] + p[1]) + (p[2] + p[3])); }
        MK_ROWS_BEGIN  const float il = ila[ai][m];
#pragma unroll
            for (int bj = 0; bj < 2; ++bj) pg8::store8(omem + (size_t)rl * 2048 + bj * 128 + cw, acc[ai][bj][m][0] * il, acc[ai][bj][m][1] * il);  MK_ROWS_END
    }
};
struct EpiGate4 {
    static constexpr bool PERM = true, AFTER_DRAIN = false, INIT_C = false;
    bf16_t* merged; const bf16_t* gates;
    __device__ __forceinline__ void operator()(const f32x4 (&acc)[2][2][4][2], const Unit& u, int wr, int wc, int fr, int fq) const {
        const int cw = wc * 32 + 8 * fq; const unsigned char* gate = (const unsigned char*)gates + u.sub * 2048; const bool first = u.sub == 0;
        MK_ROWS_BEGIN  const size_t row = (size_t)u.pm * 256 + rl;
#pragma unroll
            for (int bj = 0; bj < 2; ++bj) { const int col = u.pn * 256 + bj * 128 + cw; const u32x2 gw = *(const u32x2*)(gate + row * 6144 + col); const float q8 = 1.0f / 255.0f;
                const f32x4 g0 = (f32x4){(float)(gw.x & 255u), (float)((gw.x >> 8) & 255u), (float)((gw.x >> 16) & 255u), (float)(gw.x >> 24)} * q8;
                const f32x4 g1 = (f32x4){(float)(gw.y & 255u), (float)((gw.y >> 8) & 255u), (float)((gw.y >> 16) & 255u), (float)(gw.y >> 24)} * q8;
                f32x4 v0 = acc[ai][bj][m][0] * g0, v1 = acc[ai][bj][m][1] * g1;
                if (!first) { f32x4 t0, t1; pg8::load8(merged + row * 2048 + col, t0, t1); v0 += t0; v1 += t1; }
                pg8::store8(merged + row * 2048 + col, v0, v1); }  MK_ROWS_END_NB
    }
};
struct SchedBR {
    pg8::GridOrder o; const char* onm; const char* oret; const char* wnm; const char* wret;
    __device__ __forceinline__ bool next(int i, Unit& u) const { if (i >= 3) return false; const bool ok = o.next(0, u); u.sub = i; return ok; }
    __device__ __forceinline__ void ptrs(const Unit& u, const char*& a, const char*& b) const {
        const size_t ra = (size_t)u.pm * (256u * 2048u * 2u), rb = (size_t)u.pn * (256u * 2048u * 2u);
        const bool nm = (u.sub != 1); const size_t co = (u.sub == 2) ? 2048u : 0u;
        a = (nm ? onm : oret) + ra + co; b = (nm ? wnm : wret) + rb + co; }
    __device__ __forceinline__ int nt(const Unit& u, int) const { return u.sub == 1 ? 32 : 16; }
};
struct EpiWout {
    static constexpr bool PERM = false, AFTER_DRAIN = true, INIT_C = true;
    const float* x; float* x1; bf16_t* x1b; float* ssq; const float* gffn;
    __device__ __forceinline__ void init_c(f32x4 (&acc)[2][2][4][2], const Unit& u, int wr, int wc, int fr, int fq) const {
        const int col0 = u.pn * 256 + wc * 32 + 4 * fq;
        MK_ROWS_BEGIN  const size_t off = ((size_t)u.pm * 256 + rl) * 2048 + col0;
#pragma unroll
            for (int bj = 0; bj < 2; ++bj)
#pragma unroll
                for (int n = 0; n < 2; ++n) acc[ai][bj][m][n] = __builtin_nontemporal_load((const f32x4*)(x + off + bj * 128 + n * 16));  MK_ROWS_END_NB
    }
    __device__ __forceinline__ void fused(f32x4 (&acc)[2][2][4][2], const Unit& u, int wr, int wc, int fr, int fq, PG8_LAS unsigned char* lds, int wid, int lane) const {
        PG8_LAS float* P = (PG8_LAS float*)lds;
        const int col0 = u.pn * 256 + wc * 32 + 4 * fq;
        MK_ROWS_BEGIN  const size_t off = ((size_t)u.pm * 256 + rl) * 2048 + col0; float q = 0.f;
#pragma unroll
            for (int bj = 0; bj < 2; ++bj)
#pragma unroll
                for (int n = 0; n < 2; ++n) { const f32x4 v = acc[ai][bj][m][n];
                    *(f32x4*)(x1 + off + bj * 128 + n * 16) = v; pg8::store4(x1b + off + bj * 128 + n * 16, v * *(const f32x4*)(gffn + col0 + bj * 128 + n * 16)); q += (v[0] * v[0] + v[1] * v[1]) + (v[2] * v[2] + v[3] * v[3]); }
            q = red_fq(q); if (fq == 0) P[rl * 4 + wc] = q;  MK_ROWS_END_NB
        asm volatile("s_waitcnt lgkmcnt(0)" ::: "memory"); __builtin_amdgcn_s_barrier(); asm volatile("" ::: "memory");
        if (threadIdx.x < 256) { const int r = threadIdx.x; const f32x4 p = *(const PG8_LAS f32x4*)(P + r * 4); ssq[((size_t)u.pm * 256 + r) * 8 + u.pn] = (p[0] + p[1]) + (p[2] + p[3]); }
        asm volatile("s_waitcnt lgkmcnt(0)" ::: "memory"); __builtin_amdgcn_s_barrier(); asm volatile("" ::: "memory");
    }
};
struct EpiFF1 {
    static constexpr bool PERM = true, AFTER_DRAIN = false, INIT_C = false;
    bf16_t* hff; const float* ssq;
    __device__ __forceinline__ void operator()(const f32x4 (&acc)[2][2][4][2], const Unit& u, int wr, int wc, int fr, int fq) const {
        const int cw = wc * 32 + 8 * fq;
        float ra[2][4];
#pragma unroll
        for (int ai = 0; ai < 2; ++ai)
#pragma unroll
            for (int m = 0; m < 4; ++m) { const size_t row = (size_t)u.pm * 256 + MK_RL(ai, m); const f32x4 p0 = *(const f32x4*)(ssq + row * 8), p1 = *(const f32x4*)(ssq + row * 8 + 4);
                ra[ai][m] = rsqrtf((((p0[0] + p0[1]) + (p0[2] + p0[3])) + ((p1[0] + p1[1]) + (p1[2] + p1[3]))) * (1.0f / 2048.0f) + EPS); }
        MK_ROWS_BEGIN  const size_t row = (size_t)u.pm * 256 + rl; const float r = ra[ai][m];
#pragma unroll
            for (int bj = 0; bj < 2; ++bj) { f32x4 v0 = acc[ai][bj][m][0] * r, v1 = acc[ai][bj][m][1] * r;
#pragma unroll
                for (int e = 0; e < 4; ++e) { const float a = fmaxf(v0[e], 0.f), b = fmaxf(v1[e], 0.f); v0[e] = a * a; v1[e] = b * b; }
                pg8::store8(hff + row * LDH + u.pn * 256 + bj * 128 + cw, v0, v1); }  MK_ROWS_END
    }
};
struct EpiFF2 {
    static constexpr bool PERM = false, AFTER_DRAIN = false, INIT_C = true;
    const float* src; float* out;
    __device__ __forceinline__ void init_c(f32x4 (&acc)[2][2][4][2], const Unit& u, int wr, int wc, int fr, int fq) const {
        const int col0 = u.pn * 256 + wc * 32 + 4 * fq;
        MK_ROWS_BEGIN  const size_t off = ((size_t)u.pm * 256 + rl) * 2048 + col0;
#pragma unroll
            for (int bj = 0; bj < 2; ++bj)
#pragma unroll
                for (int n = 0; n < 2; ++n) acc[ai][bj][m][n] = *(const f32x4*)(src + off + bj * 128 + n * 16);  MK_ROWS_END_NB
    }
    __device__ __forceinline__ void operator()(const f32x4 (&acc)[2][2][4][2], const Unit& u, int wr, int wc, int fr, int fq) const {
        const int col0 = u.pn * 256 + wc * 32 + 4 * fq;
        MK_ROWS_BEGIN  const size_t off = ((size_t)u.pm * 256 + rl) * 2048 + col0;
#pragma unroll
            for (int bj = 0; bj < 2; ++bj)
#pragma unroll
                for (int n = 0; n < 2; ++n) { const size_t o2 = off + bj * 128 + n * 16; *(f32x4*)(out + o2) = acc[ai][bj][m][n]; }  MK_ROWS_END_NB
    }
};

struct SchedList3 {
    pg8::UnitG u0, u1, u2; int n;
    __device__ __forceinline__ bool next(int i, pg8::UnitG& u) const { if (i >= n) return false;
        u.a = (i == 0) ? u0.a : ((i == 1) ? u1.a : u2.a); u.b = (i == 0) ? u0.b : ((i == 1) ? u1.b : u2.b);
        u.lda = (i == 0) ? u0.lda : ((i == 1) ? u1.lda : u2.lda); u.ldb = (i == 0) ? u0.ldb : ((i == 1) ? u1.ldb : u2.ldb);
        u.nt = (i == 0) ? u0.nt : ((i == 1) ? u1.nt : u2.nt); u.kind = (i == 0) ? u0.kind : ((i == 1) ? u1.kind : u2.kind); u.perm = (i == 0) ? u0.perm : ((i == 1) ? u1.perm : u2.perm);
        return true; }
};
struct EpiM1 {
    EpiF32 e0; EpiP e1; EpiXS e2;
    __device__ __forceinline__ bool after_drain(const pg8::UnitG&) const { return false; }
    __device__ __forceinline__ void operator()(const f32x4 (&acc)[2][2][4][2], const pg8::UnitG& u, int wr, int wc, int fr, int fq) const {
        Unit d; d.pm = 0; d.pn = 0; d.sub = 0;
        if (u.kind == 0) e0(acc, d, wr, wc, fr, fq); else if (u.kind == 1) e1(acc, d, wr, wc, fr, fq); else e2(acc, d, wr, wc, fr, fq); }
    __device__ __forceinline__ void fused(f32x4 (&)[2][2][4][2], const pg8::UnitG&, int, int, int, int, PG8_LAS unsigned char*, int, int) const {}
};
struct EpiM3 {
    EpiXO e0; EpiGN e1;
    __device__ __forceinline__ bool after_drain(const pg8::UnitG& u) const { return u.kind == 1; }
    __device__ __forceinline__ void operator()(const f32x4 (&acc)[2][2][4][2], const pg8::UnitG& u, int wr, int wc, int fr, int fq) const { Unit d; d.pm = 0; d.pn = 0; d.sub = 0; e0(acc, d, wr, wc, fr, fq); }
    __device__ __forceinline__ void fused(f32x4 (&acc)[2][2][4][2], const pg8::UnitG&, int wr, int wc, int fr, int fq, PG8_LAS unsigned char* lds, int wid, int lane) const {
        Unit d; d.pm = 0; d.pn = 0; d.sub = 0; e1.fused(acc, d, wr, wc, fr, fq, lds, wid, lane); }
};
#undef MK_ROWS_BEGIN
#undef MK_ROWS_END
#undef MK_ROWS_END_NB
#undef MK_ROWS_END2
#undef MK_RL
}

namespace na {
using bf16 = unsigned short;
using bf16x8 = __attribute__((ext_vector_type(8))) short;
using s16x4  = __attribute__((ext_vector_type(4))) short;
using f32x16 = __attribute__((ext_vector_type(16))) float;
using f32x4  = __attribute__((ext_vector_type(4))) float;
using u32x4  = __attribute__((ext_vector_type(4))) unsigned;
constexpr int DH = 128, NW = 8, QBLK = 32, KVBLK = 64, LDQ = 3072;
constexpr size_t SHM_V = KVBLK * DH * 2, SHM_K = KVBLK * DH * 2;
constexpr int NBUF = 3;
constexpr int OFF_RK = NBUF * SHM_V + NBUF * SHM_K;
constexpr int OFF_BIAS = OFF_RK + 768 * 4;
constexpr int BIAS_PAD = 64, BIAS_N = 64 + 15 * 31 + 79;
constexpr int OFF_LI = OFF_BIAS + ((BIAS_N * 4 + 15) / 16) * 16;
constexpr int NA_LDS_BYTES = OFF_LI + NW * 64 * 4;
#define KSWZ(row, colB) ((row) * 256 + ((colB) ^ (((row) & 7) << 4)))
#define SBAR() __builtin_amdgcn_sched_barrier(0)
__device__ __forceinline__ int crow(int r, int hi) { return (r & 3) + 8 * (r >> 2) + 4 * hi; }
__device__ __forceinline__ unsigned cvtpk(float lo, float hi) { return pg8::cvt_pk_bf16(lo, hi); }

__device__ __forceinline__ void procP(f32x16& p0, f32x16& p1, float& lsum, bool inwin, const float* rk_t  , const float* bias_l  ,
                                      float rqs, int cs, int hi) {
  if (!inwin) { p0 = f32x16{}; p1 = f32x16{}; return; }
#pragma unroll
  for (int g = 0; g < 4; ++g) {
    const f32x4 k0 = *(const f32x4*)(rk_t + 8 * g + 4 * hi), k1 = *(const f32x4*)(rk_t + 32 + 8 * g + 4 * hi);
#pragma unroll
    for (int e = 0; e < 4; ++e) { const int r = 4 * g + e; const int w0 = e + 8 * g + 4 * hi, w1 = w0 + 32;
      const float x0 = fmaf(p0[r], rqs * k0[e], bias_l[w0]), x1 = fmaf(p1[r], rqs * k1[e], bias_l[w1]);
      const float e0 = __builtin_amdgcn_exp2f(x0), e1 = __builtin_amdgcn_exp2f(x1);
      const float v0 = ((unsigned)(w0 - cs) < 16u) ? e0 : 0.f, v1 = ((unsigned)(w1 - cs) < 16u) ? e1 : 0.f;
      p0[r] = v0; p1[r] = v1; lsum += v0 + v1; }
  }
}
__device__ __forceinline__ void packP(const f32x16& p0, const f32x16& p1, bf16x8& pa0, bf16x8& pa1, bf16x8& pa2, bf16x8& pa3) {
#define PK4(P, BASE, OUT) do { unsigned a0 = cvtpk(P[BASE + 0], P[BASE + 1]), a1 = cvtpk(P[BASE + 2], P[BASE + 3]);   \
    unsigned b0 = cvtpk(P[BASE + 4], P[BASE + 5]), b1 = cvtpk(P[BASE + 6], P[BASE + 7]);                              \
    auto r0 = __builtin_amdgcn_permlane32_swap(a0, b0, false, false); auto r1 = __builtin_amdgcn_permlane32_swap(a1, b1, false, false); \
    u32x4 w = {r0[0], r1[0], r0[1], r1[1]}; OUT = *reinterpret_cast<bf16x8*>(&w); } while (0)
  PK4(p0, 0, pa0); PK4(p0, 8, pa1); PK4(p1, 0, pa2); PK4(p1, 8, pa3);
#undef PK4
}
__device__ __forceinline__ void qkt(f32x16& p0, f32x16& p1, const bf16* Ks, const bf16x8* qr, int r32, int hi) {
  p0 = f32x16{}; p1 = f32x16{};
#pragma unroll
  for (int d0 = 0; d0 < 8; ++d0) { int cb = (d0 * 16 + hi * 8) * 2;
    bf16x8 b0 = *reinterpret_cast<const bf16x8*>((const char*)Ks + KSWZ(r32, cb));
    bf16x8 b1 = *reinterpret_cast<const bf16x8*>((const char*)Ks + KSWZ(32 + r32, cb));
    p0 = __builtin_amdgcn_mfma_f32_32x32x16_bf16(b0, qr[d0], p0, 0, 0, 0);
    p1 = __builtin_amdgcn_mfma_f32_32x32x16_bf16(b1, qr[d0], p1, 0, 0, 0); }
}
__device__ __forceinline__ int v_st(int k, int c) { const int kk = (k & ~0xC) | ((k & 4) << 1) | ((k & 8) >> 1); return ((kk >> 3) * 4 + (c >> 5)) * 512 + ((kk & 7) * 32 + (c & 31)) * 2; }
__device__ __forceinline__ int v_rd_base(int lane) { return ((lane & 3) << 3) | (((lane >> 2) & 3) << 6) | (((lane >> 4) & 1) << 5) | (((lane >> 5) & 1) << 8); }
constexpr int v_rd_off(int d0, int ks, int half) { return d0 * 512 + ks * 4096 + half * 2048; }
template <int OFF> __device__ __forceinline__ s16x4 tr_read(int vb) {
  s16x4 r; asm volatile("ds_read_b64_tr_b16 %0, %1 offset:%2" : "=&v"(r) : "v"(vb), "i"(OFF) : "memory"); return r;
}
template <int D0> __device__ __forceinline__ void pv_one(f32x16& od, int vb, bf16x8 pa0, bf16x8 pa1, bf16x8 pa2, bf16x8 pa3) {
  const s16x4 l0 = tr_read<v_rd_off(D0, 0, 0)>(vb), h0 = tr_read<v_rd_off(D0, 0, 1)>(vb), l1 = tr_read<v_rd_off(D0, 1, 0)>(vb), h1 = tr_read<v_rd_off(D0, 1, 1)>(vb);
  const s16x4 l2 = tr_read<v_rd_off(D0, 2, 0)>(vb), h2 = tr_read<v_rd_off(D0, 2, 1)>(vb), l3 = tr_read<v_rd_off(D0, 3, 0)>(vb), h3 = tr_read<v_rd_off(D0, 3, 1)>(vb);
  asm volatile("s_waitcnt lgkmcnt(0)" ::: "memory"); SBAR();
#define PK(L, H) (bf16x8){L[0], L[1], L[2], L[3], H[0], H[1], H[2], H[3]}
  od = __builtin_amdgcn_mfma_f32_32x32x16_bf16(pa0, PK(l0, h0), od, 0, 0, 0);
  od = __builtin_amdgcn_mfma_f32_32x32x16_bf16(pa1, PK(l1, h1), od, 0, 0, 0);
  od = __builtin_amdgcn_mfma_f32_32x32x16_bf16(pa2, PK(l2, h2), od, 0, 0, 0);
  od = __builtin_amdgcn_mfma_f32_32x32x16_bf16(pa3, PK(l3, h3), od, 0, 0, 0);
#undef PK
}
__device__ __forceinline__ void pv_d0(f32x16* o, int vb, bf16x8 pa0, bf16x8 pa1, bf16x8 pa2, bf16x8 pa3) {
  pv_one<0>(o[0], vb, pa0, pa1, pa2, pa3); pv_one<1>(o[1], vb, pa0, pa1, pa2, pa3); pv_one<2>(o[2], vb, pa0, pa1, pa2, pa3); pv_one<3>(o[3], vb, pa0, pa1, pa2, pa3);
}

__device__ __forceinline__ void na_unit(int b, int h, int i4, const bf16* __restrict__ qkv, const float* __restrict__ ssq_q, const float* __restrict__ ssq_k,
                                        const float* __restrict__ rpb, bf16* __restrict__ ona, char* lds) {
  int tid_ = threadIdx.x; asm volatile("" : "+v"(tid_));
  const int tid = tid_, wid = __builtin_amdgcn_readfirstlane(tid >> 6), lane = tid & 63, r32 = lane & 31, hi = lane >> 5;
  bf16* V_lds = (bf16*)lds; bf16* K_lds = (bf16*)(lds + NBUF * SHM_V);
  float* rkL = (float*)(lds + OFF_RK); float* biasL = (float*)(lds + OFF_BIAS); float* li_l = (float*)(lds + OFF_LI) + wid * 64;
  const int NT = (i4 == 0 || i4 == 15) ? 8 : 11, rbase = (i4 == 0) ? 0 : ((i4 == 15) ? 56 : 4 * i4 - 4);
  const int qrow = 4 * i4 + (wid >> 1), qc = 32 * (wid & 1) + r32;
  int rs = qrow - 4; rs = rs < 0 ? 0 : (rs > 56 ? 56 : rs);
  int cs = qc - 8; cs = cs < 0 ? 0 : (cs > 48 ? 48 : cs);
  const size_t tok_q = (size_t)b * 4096 + qrow * 64 + qc, tok_k0 = (size_t)b * 4096 + rbase * 64;
  for (int i = tid; i < NT * 64; i += 512) { const f32x4 p = *(const f32x4*)(ssq_k + (tok_k0 + i) * 32 + h * 4); rkL[i] = rsqrtf(((p[0] + p[1]) + (p[2] + p[3])) * (1.0f / 128.0f) + 1e-6f); }
  for (int i = tid; i < BIAS_N; i += 512) { const int j = i - BIAS_PAD; biasL[i] = (j >= 0 && j < 15 * 31) ? rpb[h * 465 + j] * 1.4426950408889634f : 0.f; }
  float rqs; { const f32x4 p = *(const f32x4*)(ssq_q + tok_q * 32 + h * 4); rqs = rsqrtf(((p[0] + p[1]) + (p[2] + p[3])) * (1.0f / 128.0f) + 1e-6f) * 1.4426950408889634f; }
  float l_reg = 0; f32x16 o[4] = {}; bf16x8 qr[8];
  const bf16* Qw = qkv + tok_q * LDQ + h * 128 + hi * 8;
#pragma unroll
  for (int d0 = 0; d0 < 8; ++d0) qr[d0] = *reinterpret_cast<const bf16x8*>(Qw + d0 * 16);
  const bf16* Kh = qkv + tok_k0 * LDQ + 1024 + h * 128; const bf16* Vh = qkv + tok_k0 * LDQ + 2048 + h * 128;
  const int sr = tid >> 4, sc = (tid & 15) * 8, vst0 = v_st(sr, sc), vst1 = v_st(32 + sr, sc);
  const int vb0 = (int)(uintptr_t)V_lds + v_rd_base(lane);
  struct { bf16x8 vs0, vs1, ks0, ks1; } sr_[2];
#define SLOAD(i, k0) do { sr_[i].vs0 = *(const bf16x8*)(&Vh[(long)((k0) + sr) * LDQ + sc]); sr_[i].vs1 = *(const bf16x8*)(&Vh[(long)((k0) + 32 + sr) * LDQ + sc]); \
    sr_[i].ks0 = *(const bf16x8*)(&Kh[(long)((k0) + sr) * LDQ + sc]); sr_[i].ks1 = *(const bf16x8*)(&Kh[(long)((k0) + 32 + sr) * LDQ + sc]); } while (0)
#define SWRITE(bb, i) do { *(bf16x8*)((char*)V_lds + (bb) * SHM_V + vst0) = sr_[i].vs0;          \
    *(bf16x8*)((char*)V_lds + (bb) * SHM_V + vst1) = sr_[i].vs1; int kc = sc * 2;               \
    *(bf16x8*)((char*)K_lds + (bb) * SHM_K + KSWZ(sr, kc)) = sr_[i].ks0;                       \
    *(bf16x8*)((char*)K_lds + (bb) * SHM_K + KSWZ(32 + sr, kc)) = sr_[i].ks1; } while (0)
#define SWAIT() asm volatile("s_waitcnt vmcnt(0)" ::: "memory")
#define TILE_ARGS(j) ((unsigned)(rbase + (j) - rs) < 8u), rkL + (j) * 64, biasL + BIAS_PAD + (rbase + (j) - qrow + 7) * 31 + 15 - qc, rqs, cs, hi
  f32x16 p0, p1; bf16x8 pa0, pa1, pa2, pa3;
#define NA_TILE(j, bo) do { if ((unsigned)(rbase + (j) - rs) < 8u) {     \
      SBAR(); qkt(p0, p1, (const bf16*)((const char*)K_lds + (bo) * SHM_K), qr, r32, hi); \
      procP(p0, p1, l_reg, TILE_ARGS(j)); \
      packP(p0, p1, pa0, pa1, pa2, pa3); SBAR(); \
      pv_d0(o, vb0 + (bo) * (int)SHM_V, pa0, pa1, pa2, pa3); } } while (0)
  SLOAD(0, 0); SLOAD(1, KVBLK); SWRITE(0, 0); SLOAD(0, 2 * KVBLK); SWRITE(1, 1); SLOAD(1, 3 * KVBLK); __syncthreads();
  int b0 = 0;
  for (int j = 0; j < NT; j += 2) {
    const int b1 = (b0 == 2) ? 0 : b0 + 1, b2 = (b1 == 2) ? 0 : b1 + 1;
    NA_TILE(j, b0);
    if (j + 2 < NT) { SWRITE(b2, 0); if (j + 4 < NT) SLOAD(0, (j + 4) * KVBLK); }
    __syncthreads();
    if (j + 1 < NT) NA_TILE(j + 1, b1);
    if (j + 3 < NT) { SWRITE(b0, 1); if (j + 5 < NT) SLOAD(1, (j + 5) * KVBLK); }
    __syncthreads();
    b0 = b2;
  }
#undef NA_TILE
  { auto rr = __builtin_amdgcn_permlane32_swap(__float_as_uint(l_reg), __float_as_uint(l_reg), false, false); l_reg = __uint_as_float(rr[0]) + __uint_as_float(rr[1]); }
  if (hi == 0) li_l[r32] = l_reg; asm volatile("s_waitcnt lgkmcnt(0)" ::: "memory");
  float rli[16];
#pragma unroll
  for (int r = 0; r < 16; ++r) rli[r] = __builtin_amdgcn_rcpf(li_l[crow(r, hi)]);
  bf16* Ow = ona + ((size_t)b * 4096 + qrow * 64 + 32 * (wid & 1)) * 2048 + h * 128;
#pragma unroll
  for (int r = 0; r < 16; ++r) { const int orow = crow(r, hi);
#pragma unroll
    for (int d0 = 0; d0 < 4; ++d0) { const float v = o[d0][r] * rli[r]; unsigned u = __float_as_uint(v); u += 0x7fffu + ((u >> 16) & 1u); Ow[(size_t)orow * 2048 + d0 * 32 + r32] = (bf16)(u >> 16); } }
  __syncthreads();
#undef SLOAD
#undef SWRITE
#undef SWAIT
#undef TILE_ARGS
}
#undef KSWZ
#undef SBAR
}

constexpr int NWAVES = 8;
constexpr int RING_OFF = 0, RING_BYTES = 131072;
constexpr int LDSCTL_OFF = RING_BYTES, MISC_OFF = LDSCTL_OFF + 320;
constexpr int LDS_BYTES = 147456;
static_assert(MISC_OFF + 128 <= LDS_BYTES && na::NA_LDS_BYTES <= RING_BYTES, "LDS map");
constexpr int CW_TMO = 0, CW_P0A = 64, CW_BAR = 4096;
static_assert((CW_BAR + 3456) * 4 <= (int)mk::CTL_ZERO_BYTES, "control words inside the per-call memset");

#define GAS __attribute__((address_space(1)))
#define LAS __attribute__((address_space(3)))
typedef unsigned short bf16;
typedef unsigned v4u __attribute__((ext_vector_type(4)));
typedef float f32x4 __attribute__((ext_vector_type(4)));
typedef GAS unsigned gu32;
#define LDS_WAIT() asm volatile("s_waitcnt lgkmcnt(0)" ::: "memory")
#define VM_WAIT() asm volatile("s_waitcnt vmcnt(0)" ::: "memory")
__device__ __forceinline__ unsigned f2bf(float f) { unsigned u = __builtin_bit_cast(unsigned, f); return (u + 0x7fffu + ((u >> 16) & 1u)) >> 16; }
__device__ __forceinline__ unsigned pk2(float lo, float hi) { return f2bf(lo) | (f2bf(hi) << 16); }
__device__ __forceinline__ float bf2f_(unsigned h) { return __uint_as_float(h << 16); }

#define XB_TMO      128
#define XB_XCNT(j)  (256  + 64 * (j))
#define XB_XSUB(j)  (1280 + 64 * (j))
#define XB_XGEN(j)  (2304 + 64 * (j))
#define XB_TOP      3328
#define XB_TOPGEN   3392
#define XCD_BAR_WORDS 3456
#define XB_SPIN_CAP (1u << 18)
__device__ __forceinline__ unsigned xb_ld(unsigned* p)              { return __hip_atomic_load(p, __ATOMIC_RELAXED, __HIP_MEMORY_SCOPE_AGENT); }
__device__ __forceinline__ unsigned xb_add(unsigned* p, unsigned v) { return __hip_atomic_fetch_add(p, v, __ATOMIC_RELAXED, __HIP_MEMORY_SCOPE_AGENT); }
__device__ __forceinline__ unsigned xb_xcc_id() { return (unsigned)__builtin_amdgcn_s_getreg((3 << 11) | 20) & 0xFu; }
#define XB_SPIN(cond, bar) do { unsigned _sp = 0; while (cond) { __builtin_amdgcn_s_sleep(1); \
    if ((++_sp & 255u) == 0u) { if (xb_ld(&(bar)[XB_TMO])) break; if (_sp > XB_SPIN_CAP) { atomicAdd(&(bar)[XB_TMO], 1u); break; } } } } while (0)
struct XcdBarrier { unsigned* bar; unsigned x; volatile LAS unsigned* st; };
__device__ __forceinline__ XcdBarrier xcd_barrier_post(unsigned* bar, volatile LAS unsigned* st) {
    XcdBarrier b; b.bar = bar; b.x = xb_xcc_id(); b.st = st;
    if (threadIdx.x == 0) (void)xb_add(&bar[XB_XCNT(b.x)], 1u);
    return b;
}
__device__ __forceinline__ void xcd_barrier_complete(unsigned* bar, unsigned x, unsigned& nloc, unsigned& nx) {
    const unsigned G = gridDim.x * gridDim.y * gridDim.z;
    unsigned sum, cnt, mine, sp = 0u;
    for (;;) {
        sum = 0u; cnt = 0u; mine = 0u;
#pragma unroll
        for (unsigned j = 0; j < 16; ++j) { const unsigned c = xb_ld(&bar[XB_XCNT(j)]); sum += c; cnt += (c > 0u) ? 1u : 0u; mine = (j == x) ? c : mine; }
        if (sum == G) break;
        __builtin_amdgcn_s_sleep(1);
        if ((++sp & 255u) == 0u) { if (xb_ld(&bar[XB_TMO])) break; if (sp > XB_SPIN_CAP) { atomicAdd(&bar[XB_TMO], 1u); break; } }
    }
    nloc = mine > 0u ? mine : 1u; nx = cnt > 0u ? cnt : 1u;
}
__device__ __forceinline__ void xcd_barrier(const XcdBarrier& b) {
    asm volatile("s_waitcnt vmcnt(0)" ::: "memory");
    __syncthreads();
    if (threadIdx.x == 0) {
        unsigned* bar = b.bar;
        __builtin_amdgcn_s_waitcnt(0);
        unsigned nloc = b.st[0], nx = b.st[1];
        if (nloc == 0u) { xcd_barrier_complete(bar, b.x, nloc, nx); b.st[0] = nloc; b.st[1] = nx; }
        const unsigned old = xb_add(&bar[XB_XSUB(b.x)], 1u);
        const unsigned gen = old / nloc;
        if (old + 1u == (gen + 1u) * nloc) {
            __builtin_amdgcn_fence(__ATOMIC_RELEASE, "agent");
            asm volatile("s_waitcnt vmcnt(0)" ::: "memory");
            const unsigned og = xb_add(&bar[XB_TOP], 1u);
            const unsigned tg = og / nx;
            if (og + 1u == (tg + 1u) * nx) xb_add(&bar[XB_TOPGEN], 1u);
            else XB_SPIN(xb_ld(&bar[XB_TOPGEN]) == tg, bar);
            __builtin_amdgcn_fence(__ATOMIC_ACQUIRE, "agent");
            xb_add(&bar[XB_XGEN(b.x)], 1u);
            asm volatile("s_waitcnt vmcnt(0)" ::: "memory");
        } else {
            XB_SPIN(xb_ld(&bar[XB_XGEN(b.x)]) == gen, bar);
            __builtin_amdgcn_fence(__ATOMIC_ACQUIRE, "agent");
            asm volatile("s_waitcnt vmcnt(0)" ::: "memory");
        }
    }
    __syncthreads();
}

__device__ __forceinline__ float wave_sum(float v) {
#pragma unroll
    for (int o = 1; o < 64; o <<= 1) v += __shfl_xor(v, o);
    return v;
}
__device__ __forceinline__ void p0_item(const float* __restrict__ W, int ldw, int k0, int n0, bf16* __restrict__ WT, int ldt, int dA, int dB, const float* __restrict__ kscale, LAS float* scr, int lane) {
    const int c16 = lane & 15, kr = lane >> 4;
#pragma unroll
    for (int it = 0; it < 16; ++it) { const int k = 4 * it + kr;
        f32x4 v = __builtin_nontemporal_load((const f32x4*)(W + (size_t)(k0 + k) * ldw + n0 + 4 * c16));
        if (kscale) v = v * kscale[k0 + k];
        *(LAS f32x4*)(scr + k * 64 + ((4 * c16) ^ (8 * ((k >> 3) & 7)))) = v; }
    LDS_WAIT(); asm volatile("" ::: "memory");
    const int c = lane & 7;
#pragma unroll
    for (int j = 0; j < 8; ++j) { const int n = (lane >> 3) + 8 * j; const LAS float* s = scr + (8 * c) * 64 + (n ^ (8 * c));
        v4u o; o.x = pk2(s[0 * 64], s[1 * 64]); o.y = pk2(s[2 * 64], s[3 * 64]); o.z = pk2(s[4 * 64], s[5 * 64]); o.w = pk2(s[6 * 64], s[7 * 64]);
        const int drow = (n < 32) ? dA + n : dB + n - 32;
        *(GAS v4u*)(WT + (size_t)drow * ldt + k0 + 8 * c) = o; }
    LDS_WAIT(); asm volatile("" ::: "memory");
}
struct P0Desc { const float* src; bf16* dst; int ldw, ldt, dA, dB, nt; };
__device__ __forceinline__ void p0_load(const P0Desc& d, f32x4 (&R)[16], int lane) {
    const int c16 = lane & 15, kr = lane >> 4;
#pragma unroll
    for (int it = 0; it < 16; ++it) R[it] = __builtin_nontemporal_load((const f32x4*)(d.src + (size_t)(4 * it + kr) * d.ldw + 4 * c16));
}
__device__ __forceinline__ void p0_to_lds(const f32x4 (&R)[16], LAS float* scr, int lane) {
    const int c16 = lane & 15, kr = lane >> 4;
#pragma unroll
    for (int it = 0; it < 16; ++it) { const int k = 4 * it + kr; *(LAS f32x4*)(scr + k * 64 + ((4 * c16) ^ (8 * ((k >> 3) & 7)))) = R[it]; }
}
__device__ __forceinline__ void p0_store(const P0Desc& d, LAS float* scr, int lane) {
    const int c = lane & 7;
#pragma unroll
    for (int j = 0; j < 8; ++j) { const int n = (lane >> 3) + 8 * j; const LAS float* s = scr + (8 * c) * 64 + (n ^ (8 * c));
        v4u o; o.x = pk2(s[0 * 64], s[1 * 64]); o.y = pk2(s[2 * 64], s[3 * 64]); o.z = pk2(s[4 * 64], s[5 * 64]); o.w = pk2(s[6 * 64], s[7 * 64]);
        const int drow = (n < 32) ? d.dA + n : d.dB + n - 32;
        GAS v4u* q = (GAS v4u*)(d.dst + (size_t)drow * d.ldt + 8 * c); if (d.nt) __builtin_nontemporal_store(o, q); else *q = o; }
}
__device__ __forceinline__ void rms_row_to_bf16(const float* __restrict__ xrow, const float* __restrict__ g, bf16* __restrict__ orow, int lane) {
    const f32x4* xr = (const f32x4*)xrow + lane; const f32x4* gr = (const f32x4*)g + lane;
    f32x4 v[8]; float s = 0.f;
#pragma unroll
    for (int j = 0; j < 8; ++j) { v[j] = __builtin_nontemporal_load(xr + 64 * j); s += (v[j].x * v[j].x + v[j].y * v[j].y) + (v[j].z * v[j].z + v[j].w * v[j].w); }
    const float r = rsqrtf(wave_sum(s) * (1.f / 2048.f) + mk::EPS);
    unsigned long long* o8 = (unsigned long long*)orow + lane;
#pragma unroll
    for (int j = 0; j < 8; ++j) { const f32x4 gg = gr[64 * j]; o8[64 * j] = (unsigned long long)pk2(v[j].x * r * gg.x, v[j].y * r * gg.y) | ((unsigned long long)pk2(v[j].z * r * gg.z, v[j].w * r * gg.w) << 32); }
}
__device__ __forceinline__ int win_dest_row(int n32  ) {
    const int pn = n32 >> 3, ga = n32 & 7;
    if (pn < 12 || pn >= 20) return n32 * 32;
    const int gs = 4 * ((ga >> 1) & 1) + 2 * (ga >> 2) + (ga & 1);
    return (pn * 8 + gs) * 32;
}

#ifndef MK_TS
#define MK_TS_ -1
#else
#define MK_TS_ MK_TS
#endif
struct Args { const float* in[21]; float* out; unsigned char* ws; };

__global__ void __launch_bounds__(NWAVES * 64, 2) mk_fwd(Args args) {
    extern __shared__ __attribute__((aligned(16))) unsigned char lds[];
    LAS unsigned char* ldsl = (LAS unsigned char*)lds;
    volatile LAS unsigned* MISC = (volatile LAS unsigned*)(ldsl + MISC_OFF);
    const int tid = threadIdx.x, lane = tid & 63, wave = __builtin_amdgcn_readfirstlane(tid >> 6);
    const int G = gridDim.x, bx = blockIdx.x;
    const int vcu = (G % 8 == 0) ? (bx % 8) * (G / 8) + bx / 8 : bx;
    unsigned char* ws = args.ws; unsigned char* dob = (unsigned char*)args.out;
    gu32* ctl = (gu32*)(ws + mk::WS_CTL);
#define I_x args.in[0]
#define I_mem args.in[1]
#define I_g_mix args.in[2]
#define I_w_in args.in[3]
#define I_gq args.in[4]
#define I_gk args.in[5]
#define I_rpb args.in[6]
#define I_lgf_in args.in[7]
#define I_lgb_in args.in[8]
#define I_gn args.in[9]
#define I_g_mem args.in[10]
#define I_w_mkv args.in[11]
#define I_gxq args.in[12]
#define I_gxk args.in[13]
#define I_w_na args.in[14]
#define I_w_ret args.in[15]
#define I_w_memb args.in[16]
#define I_w_out args.in[17]
#define I_g_ffn args.in[18]
#define I_w_ff1 args.in[19]
#define I_w_ff2 args.in[20]
#define I_out args.out
#define cosT ((float*)(ws + mk::WS_COS))
#define sinT ((float*)(ws + mk::WS_SIN))
#define ssq_naq ((float*)(ws + mk::WS_SSQ_NAQ))
#define ssq_nak ((float*)(ws + mk::WS_SSQ_NAK))
#define ssq_xq ((float*)(ws + mk::WS_SSQ_XQ))
#define xl ((float*)(ws + mk::WS_XL))
#define ssq_x1 ((float*)(ws + mk::WS_SSQ_X1))
#define tab ((float*)(ws + mk::WS_TAB))
#define MEMN ((bf16*)(ws + mk::WS_MEMN))
#define MKb ((bf16*)(ws + mk::WS_MK))
#define MVT ((bf16*)(ws + mk::WS_MVT))
#define WinT ((bf16*)(ws + mk::WS_WIN))
#define Wff1T ((bf16*)(ws + mk::WS_WFF1))
#define Wff2T ((bf16*)(ws + mk::WS_WFF2))
#define WretT ((bf16*)(ws + mk::WS_WRET))
#define WoutT ((bf16*)(ws + mk::WS_WOUT))
#define WnmT ((bf16*)(ws + mk::WS_WNM))
#define WmkvT ((bf16*)(ws + mk::WS_WMKV))
#define NAQKV ((bf16*)(ws + mk::WS_NAQKV))
#define K0 ((bf16*)(ws + mk::WS_K0))
#define RG ((bf16*)(ws + mk::WS_RG))
#define XQ ((bf16*)(ws + mk::WS_XQ))
#define GATES ((bf16*)(ws + mk::WS_GATES))
#define AR ((bf16*)(ws + mk::WS_AR))
#define BR ((bf16*)(ws + mk::WS_BR))
#define KV ((bf16*)(ws + mk::WS_KV))
#define ORET ((bf16*)(ws + mk::WS_ORET))
#define MERGED ((bf16*)(ws + mk::WS_MERGED))
#define X1B ((bf16*)(ws + mk::WS_X1B))
#define HFF ((bf16*)(ws + mk::WS_HFF))
#define HN ((bf16*)(dob + mk::DO_HN))
#define KT ((bf16*)(dob + mk::DO_KT))
#define XP ((bf16*)(dob + mk::DO_XP))
#define ONM ((bf16*)(dob + mk::DO_ONM))
    for (int u = tid; u < (LDS_BYTES - LDSCTL_OFF) / 4; u += NWAVES * 64) ((LAS unsigned*)(ldsl + LDSCTL_OFF))[u] = 0u;
    __syncthreads();
    XcdBarrier bar = xcd_barrier_post((unsigned*)(ctl + CW_BAR), MISC + 8);
#define GRID_BAR() do { xcd_barrier(bar); MK_STAMP(); } while (0)
#define MK_STAMP() PG8_DBG_STAMP()
    MK_STAMP();
    LAS float* scr = (LAS float*)(ldsl + RING_OFF + wave * 16384);
    const int gw = vcu * NWAVES + wave, NGW = G * NWAVES;

    {
    if (vcu < 16) {
        if (tid == 0) {
            unsigned sp = 0; while (__hip_atomic_load((unsigned*)(ctl + CW_P0A), __ATOMIC_RELAXED, __HIP_MEMORY_SCOPE_AGENT) < (unsigned)(G - 16)) { __builtin_amdgcn_s_sleep(2); if (++sp > (1u << 22)) break; }
            __builtin_amdgcn_fence(__ATOMIC_ACQUIRE, "agent"); asm volatile("s_waitcnt vmcnt(0)" ::: "memory");
        }
        __syncthreads();
        mk::SchedOne S; S.has = true; const pg8::Gemm g{2048, 2048, 2048};
        mk::EpiMKV E{MKb, MVT, tab, tab, 0};
        if (vcu < 8) { S.u.pm = vcu >> 2; S.u.pn = vcu & 3; S.a = (const char*)(MEMN + (size_t)S.u.pm * 256 * 2048); S.b = (const char*)(WmkvT + (size_t)S.u.pn * 256 * 2048); E.mode = 0; }
        else { const int c = vcu - 8; S.u.pm = c >> 1; S.u.pn = c & 1; S.a = (const char*)(WmkvT + (size_t)(1024 + S.u.pm * 256) * 2048); S.b = (const char*)(MEMN + (size_t)S.u.pn * 256 * 2048); E.mode = 1; }
        pg8::gemm_phase<mk::EpiMKV, mk::SchedOne, false>(ldsl + RING_OFF, g, S, E);
    } else {
        const int gw2 = (vcu - 16) * NWAVES + wave, NGW2 = (G - 16) * NWAVES;
        {
            for (int i = gw2 * 64 + lane; i < 4096 * 64; i += NGW2 * 64) { const int s = i >> 6, f = i & 63;
                const float inv = powf(10000.0f, -(float)f / 64.0f), ang = (float)s * inv; cosT[i] = cosf(ang); sinT[i] = sinf(ang); }
            if (vcu == 16) {
                if (tid < 128) tab[mk::TAB_CS_NAQ + tid] = I_gq[tid] * I_gk[tid] * 0.08838834764831845f;
                if (tid < 256) tab[mk::TAB_CS_MK + tid] = I_gxq[tid] * I_gxk[tid] * 0.0625f;
                if (tid < 8) { tab[mk::TAB_L2F + tid] = -log1pf(expf(-I_lgf_in[tid])) * mk::LOG2E; tab[mk::TAB_L2B + tid] = -log1pf(expf(-I_lgb_in[tid])) * mk::LOG2E; }
            }
            for (int m = gw2; m < 512; m += NGW2) rms_row_to_bf16(I_mem + (size_t)m * 2048, I_g_mem, MEMN + (size_t)m * 2048, lane);
            for (int it = gw2; it < 32 * 32; it += NGW2) { const int kb = it >> 5, nb = it & 31; p0_item(I_w_mkv, 2048, 64 * kb, 64 * nb, WmkvT, 2048, 64 * nb, 64 * nb + 32, nullptr, scr, lane); }
            VM_WAIT(); __syncthreads();
            if (tid == 0) { __builtin_amdgcn_fence(__ATOMIC_RELEASE, "agent"); asm volatile("s_waitcnt vmcnt(0)" ::: "memory");
                (void)__hip_atomic_fetch_add((unsigned*)(ctl + CW_P0A), 1u, __ATOMIC_RELAXED, __HIP_MEMORY_SCOPE_AGENT); }
        }
        constexpr int I_IN = 32 * 256, I_FF1 = 32 * 128, I_FF2 = 128 * 32, I_RET = 32 * 32, I_OUT = 32 * 32, I_NA = 16 * 32, I_MEM = 16 * 32;
        constexpr int NITEMS = I_IN + I_FF1 + I_FF2 + I_RET + I_OUT + I_NA + I_MEM;
#define P0_DECODE(d, item) do { int r = (item); \
            if (r < I_IN) { const int kb = r >> 8, nb = r & 255; d.src = I_w_in + (size_t)(64 * kb) * 16384 + 64 * nb; d.ldw = 16384; d.dst = WinT + 64 * kb; d.ldt = 2048; d.dA = win_dest_row(2 * nb); d.dB = win_dest_row(2 * nb + 1); d.nt = 0; break; } r -= I_IN; \
            if (r < I_FF1) { const int kb = r >> 7, nb = r & 127; d.src = I_w_ff1 + (size_t)(64 * kb) * 8192 + 64 * nb; d.ldw = 8192; d.dst = Wff1T + 64 * kb; d.ldt = 2048; d.dA = 64 * nb; d.dB = 64 * nb + 32; d.nt = 1; break; } r -= I_FF1; \
            if (r < I_FF2) { const int kb = r >> 5, nb = r & 31; d.src = I_w_ff2 + (size_t)(64 * kb) * 2048 + 64 * nb; d.ldw = 2048; d.dst = Wff2T + 64 * kb; d.ldt = 8192; d.dA = 64 * nb; d.dB = 64 * nb + 32; d.nt = 1; break; } r -= I_FF2; \
            if (r < I_RET) { const int kb = r >> 5, nb = r & 31; d.src = I_w_ret + (size_t)(64 * kb) * 2048 + 64 * nb; d.ldw = 2048; d.dst = WretT + 64 * kb; d.ldt = 2048; d.dA = 64 * nb; d.dB = 64 * nb + 32; d.nt = 1; break; } r -= I_RET; \
            if (r < I_OUT) { const int kb = r >> 5, nb = r & 31; d.src = I_w_out + (size_t)(64 * kb) * 2048 + 64 * nb; d.ldw = 2048; d.dst = WoutT + 64 * kb; d.ldt = 2048; d.dA = 64 * nb; d.dB = 64 * nb + 32; d.nt = 1; break; } r -= I_OUT; \
            if (r < I_NA) { const int kb = r >> 5, nb = r & 31; d.src = I_w_na + (size_t)(64 * kb) * 2048 + 64 * nb; d.ldw = 2048; d.dst = WnmT + 64 * kb; d.ldt = 2048; d.dA = 64 * nb; d.dB = 64 * nb + 32; d.nt = 1; break; } r -= I_NA; \
            { const int kb = r >> 5, nb = r & 31; d.src = I_w_memb + (size_t)(64 * kb) * 2048 + 64 * nb; d.ldw = 2048; d.dst = WnmT + 1024 + 64 * kb; d.ldt = 2048; d.dA = 64 * nb; d.dB = 64 * nb + 32; d.nt = 1; } } while (0)
        {
            f32x4 R0[16], R1[16]; P0Desc d0, d1; int it = gw2;
            if (it < NITEMS) { P0_DECODE(d0, it); p0_load(d0, R0, lane); }
            if (it + NGW2 < NITEMS) { P0_DECODE(d1, it + NGW2); p0_load(d1, R1, lane); }
            for (; it < NITEMS; it += 2 * NGW2) {
                p0_to_lds(R0, scr, lane); const P0Desc c0 = d0;
                if (it + 2 * NGW2 < NITEMS) { P0_DECODE(d0, it + 2 * NGW2); p0_load(d0, R0, lane); }
                LDS_WAIT(); asm volatile("" ::: "memory"); p0_store(c0, scr, lane); LDS_WAIT(); asm volatile("" ::: "memory");
                if (it + NGW2 < NITEMS) {
                    p0_to_lds(R1, scr, lane); const P0Desc c1 = d1;
                    if (it + 3 * NGW2 < NITEMS) { P0_DECODE(d1, it + 3 * NGW2); p0_load(d1, R1, lane); }
                    LDS_WAIT(); asm volatile("" ::: "memory"); p0_store(c1, scr, lane); LDS_WAIT(); asm volatile("" ::: "memory");
                }
            }
        }
#undef P0_DECODE
        for (int m = gw2; m < mk::M; m += NGW2) rms_row_to_bf16(I_x + (size_t)m * 2048, I_g_mix, HN + (size_t)m * 2048, lane);
    }
    GRID_BAR();
    }
    {
    {
        mk::SchedProj S; S.o.init(mk::M, mk::D_IN, G, bx); S.hn_ = (const char*)HN; S.wt_ = (const char*)WinT;
        const pg8::Gemm g{2048, 2048, 2048};
        mk::EpiProj E{ws};
        pg8::gemm_phase<mk::EpiProj, mk::SchedProj, true>(ldsl + RING_OFF, g, S, E);
    }
    GRID_BAR();
    }
    {
    {
        const int c = bx, bh = c >> 4, nc = c & 15, b = bh >> 3, h = bh & 7;
        const float l2f = tab[mk::TAB_L2F + h], l2b = tab[mk::TAB_L2B + h];
        {
            bf16* kt = KT + (size_t)c * 65536; const bf16* ksrc = K0 + ((size_t)b * 4096 + nc * 256) * 1024 + h * 128;
            LAS float* t = scr;
            const int tok0 = wave * 32;
#pragma unroll
            for (int it = 0; it < 8; ++it) { const int tr = 4 * it + (lane >> 4), c8 = (lane & 15) * 8; const v4u w = *(const v4u*)(ksrc + (size_t)(tok0 + tr) * 1024 + c8);
                LAS float* d = t + tr * 128 + (c8 ^ (8 * (tr >> 3))); d[0] = bf2f_(w.x & 0xffffu); d[1] = bf2f_(w.x >> 16); d[2] = bf2f_(w.y & 0xffffu); d[3] = bf2f_(w.y >> 16);
                d[4] = bf2f_(w.z & 0xffffu); d[5] = bf2f_(w.z >> 16); d[6] = bf2f_(w.w & 0xffffu); d[7] = bf2f_(w.w >> 16); }
            LDS_WAIT(); asm volatile("" ::: "memory");
            const int q = lane & 3;
            float df[8], db[8];
#pragma unroll
            for (int i = 0; i < 8; ++i) { const int tk = tok0 + 8 * q + i; df[i] = pg8::fexp2(l2f * (float)(255 - tk)); db[i] = pg8::fexp2(l2b * (float)tk); }
#pragma unroll
            for (int j = 0; j < 8; ++j) { const int dk = (lane >> 2) + 16 * j; const LAS float* s = t + (8 * q) * 128 + (dk ^ (8 * q));
                float v[8];
#pragma unroll
                for (int i = 0; i < 8; ++i) v[i] = s[i * 128];
                v4u o; o.x = pk2(v[0] * df[0], v[1] * df[1]); o.y = pk2(v[2] * df[2], v[3] * df[3]); o.z = pk2(v[4] * df[4], v[5] * df[5]); o.w = pk2(v[6] * df[6], v[7] * df[7]);
                *(GAS v4u*)(kt + (size_t)dk * 256 + tok0 + 8 * q) = o;
                o.x = pk2(v[0] * db[0], v[1] * db[1]); o.y = pk2(v[2] * db[2], v[3] * db[3]); o.z = pk2(v[4] * db[4], v[5] * db[5]); o.w = pk2(v[6] * db[6], v[7] * db[7]);
                *(GAS v4u*)(kt + (size_t)(128 + dk) * 256 + tok0 + 8 * q) = o; }
            VM_WAIT(); LDS_WAIT(); __syncthreads();
        }
        MK_STAMP();
        {
            bf16* arc = AR + ((size_t)bh * 4096 + nc * 256) * 512;
            mk::SchedList3 S; S.n = (bx < 128) ? 3 : 2;
            S.u0.a = (const char*)(BR + (size_t)c * 256 * 512); S.u0.b = (const char*)(KT + (size_t)c * 65536); S.u0.lda = 512; S.u0.ldb = 256; S.u0.nt = 4; S.u0.kind = 0; S.u0.perm = 1;
            S.u1.a = (const char*)(arc + 256); S.u1.b = (const char*)(K0 + ((size_t)b * 4096 + nc * 256) * 1024 + h * 128); S.u1.lda = 512; S.u1.ldb = 1024; S.u1.nt = 2; S.u1.kind = 1; S.u1.perm = 1;
            const int xb = (bx >> 6) & 1, xh = (bx >> 4) & 3, qt = bx & 15; const size_t tok0 = (size_t)xb * 4096 + qt * 256;
            S.u2.a = (const char*)(XQ + tok0 * 1024 + xh * 256); S.u2.b = (const char*)(MKb + (size_t)xb * 256 * 1024 + xh * 256); S.u2.lda = 1024; S.u2.ldb = 1024; S.u2.nt = 4; S.u2.kind = 2; S.u2.perm = 1;
            mk::EpiM1 E{mk::EpiF32{KV + (size_t)c * 65536}, mk::EpiP{arc, l2f, l2b},
                        mk::EpiXS{XP + tok0 * 1024 + xh * 256, xl + tok0 * 16 + xh * 4, ssq_xq + tok0 * 16 + xh * 4, tab + mk::TAB_SSQ_MK + (size_t)xb * 256 * 16 + xh * 4}};
            pg8::gemm_stream<mk::EpiM1, mk::SchedList3, true>(ldsl + RING_OFF, S, E);
        }
        MK_STAMP();
    }
    GRID_BAR();
    }
    {
    {
        for (int e = (vcu * 512 + tid); e < 16 * 65536; e += G * 512) {
            const int bh = e >> 16, r = e & 65535, col = r & 255, h = bh & 7;
            const bool fwd = col < 128; const float dec = pg8::fexp2((fwd ? tab[mk::TAB_L2F + h] : tab[mk::TAB_L2B + h]) * 256.0f);
            const bf16* kvp = KV + (size_t)bh * 16 * 65536 + r; bf16* brp = BR + ((size_t)bh * 16 * 256 + (r >> 8)) * 512 + 256 + col;
            float kvv[16];
#pragma unroll
            for (int n = 0; n < 16; ++n) kvv[n] = bf2f_(__builtin_nontemporal_load(kvp + (size_t)n * 65536));
            float s = 0.f;
            if (fwd) {
#pragma unroll
                for (int n = 0; n < 16; ++n) { brp[(size_t)n * 256 * 512] = (bf16)f2bf(s); s = dec * s + kvv[n]; }
            } else {
#pragma unroll
                for (int n = 15; n >= 0; --n) { brp[(size_t)n * 256 * 512] = (bf16)f2bf(s); s = dec * s + kvv[n]; }
            }
        }
        __syncthreads();
        MK_STAMP();
        { const int b = bx >> 7, h = (bx >> 4) & 7, i4 = bx & 15;
        na::na_unit(b, h, i4, NAQKV, ssq_naq, ssq_nak, I_rpb, ONM, (char*)lds); }
        MK_STAMP();
    }
    GRID_BAR();
    }
    {
    {
        const int c = bx, bh = c >> 4, nc = c & 15, b = bh >> 3, h = bh & 7;
        {
            const int xb = (bx >> 6) & 1, xh = (bx >> 4) & 3, qt = bx & 15; const size_t tok0 = (size_t)xb * 4096 + qt * 256;
            const size_t o0 = ((size_t)b * 4096 + nc * 256) * 2048 + h * 256;
            const bool hx = bx < 128;
            mk::SchedList3 S; S.n = hx ? 2 : 1;
            const char* const ra = (const char*)(AR + ((size_t)bh * 4096 + nc * 256) * 512); const char* const rb = (const char*)(BR + (size_t)c * 256 * 512);
            S.u0.a = hx ? (const char*)(XP + tok0 * 1024 + xh * 256) : ra; S.u0.b = hx ? (const char*)(MVT + (size_t)xh * 256 * 512 + xb * 256) : rb;
            S.u0.lda = hx ? 1024 : 512; S.u0.ldb = 512; S.u0.nt = hx ? 4 : 8; S.u0.kind = hx ? 0 : 1; S.u0.perm = 1;
            S.u1.a = ra; S.u1.b = rb; S.u1.lda = 512; S.u1.ldb = 512; S.u1.nt = 8; S.u1.kind = 1; S.u1.perm = 1;
            S.u2.a = ra; S.u2.b = rb; S.u2.lda = 512; S.u2.ldb = 512; S.u2.nt = 8; S.u2.kind = 1; S.u2.perm = 1;
            mk::EpiM3 E{mk::EpiXO{ONM + tok0 * 2048 + 1024 + xh * 256, xl + tok0 * 16 + xh * 4}, mk::EpiGN{ORET + o0, RG + o0, I_gn + h * 256}};
            pg8::gemm_stream<mk::EpiM3, mk::SchedList3, true>(ldsl + RING_OFF, S, E);
        }
        MK_STAMP();
    }
    GRID_BAR();
    }
    {
    {
        mk::SchedBR S; S.o.init(mk::M, 2048, G, bx); S.onm = (const char*)ONM; S.oret = (const char*)ORET; S.wnm = (const char*)WnmT; S.wret = (const char*)WretT;
        const pg8::Gemm g{2048, 2048, 1024}; mk::EpiGate4 E{MERGED, GATES};
        pg8::gemm_phase<mk::EpiGate4, mk::SchedBR, true>(ldsl + RING_OFF, g, S, E);
    }
    GRID_BAR();
    }
    {
    {
        mk::SchedGrid S; S.o.init(mk::M, 2048, G, bx); S.A = (const char*)MERGED; S.B = (const char*)WoutT; S.ta = 256u * 2048u * 2u; S.tb = 256u * 2048u * 2u;
        const pg8::Gemm g{2048, 2048, 2048}; mk::EpiWout E{I_x, I_out, X1B, ssq_x1, I_g_ffn};
        pg8::gemm_phase<mk::EpiWout, mk::SchedGrid, false>(ldsl + RING_OFF, g, S, E);
    }
    GRID_BAR();
    }
    {
    {
        mk::SchedGrid S; S.o.init(mk::M, 8192, G, bx); S.A = (const char*)X1B; S.B = (const char*)Wff1T; S.ta = 256u * 2048u * 2u; S.tb = 256u * 2048u * 2u;
        const pg8::Gemm g{2048, 2048, 2048}; mk::EpiFF1 E{HFF, ssq_x1};
        pg8::gemm_phase<mk::EpiFF1, mk::SchedGrid, true>(ldsl + RING_OFF, g, S, E);
    }
    GRID_BAR();
    }
    if (false) {
        mk::SchedGrid S; S.o.init(mk::M, 2048, G, bx); S.A = (const char*)HFF; S.B = (const char*)Wff2T; S.ta = 256u * (unsigned)mk::LDH * 2u; S.tb = 256u * 8192u * 2u;
        const pg8::Gemm g{mk::LDH, 8192, 8192}; mk::EpiFF2 E{I_out, (float*)AR};
        pg8::gemm_phase<mk::EpiFF2, mk::SchedGrid, false>(ldsl + RING_OFF, g, S, E);
        GRID_BAR();
    }
    {
        mk::SchedGrid S; S.o.init(mk::M, 2048, G, bx); S.A = (const char*)HFF; S.B = (const char*)Wff2T; S.ta = 256u * (unsigned)mk::LDH * 2u; S.tb = 256u * 8192u * 2u;
        const pg8::Gemm g{mk::LDH, 8192, 8192}; mk::EpiFF2 E{I_out, I_out};
        pg8::gemm_phase<mk::EpiFF2, mk::SchedGrid, false>(ldsl + RING_OFF, g, S, E);
    }
    MK_STAMP();
    if (MK_TS_ >= 0 && bx == 0 && tid == 0) {
        const unsigned dt = MISC[16 + MK_TS_ + 1] - MISC[16 + MK_TS_]; const unsigned long long t0 = __builtin_amdgcn_s_memrealtime();
        while (__builtin_amdgcn_s_memrealtime() - t0 < 8ull * dt) __builtin_amdgcn_s_sleep(8);
    }
}

extern "C" void kernel_launch(void* const* d_in, const int* in_sizes, int n_in, void* d_out, int out_size, void* d_ws, size_t ws_size, hipStream_t stream) {
    static int grid = 0;
    if (grid == 0) {
        if (n_in != 21 || out_size != mk::M * mk::D || ws_size < mk::WS_END) { fprintf(stderr, "kernel_launch: unexpected shapes (n_in %d out %d ws %zu); nothing launched\n", n_in, out_size, ws_size); grid = -1; return; }
        int dev = 0, cus = 0;
        if (hipGetDevice(&dev) != hipSuccess || hipDeviceGetAttribute(&cus, hipDeviceAttributeMultiprocessorCount, dev) != hipSuccess) { grid = -1; return; }
        if (hipFuncSetAttribute((const void*)mk_fwd, hipFuncAttributeMaxDynamicSharedMemorySize, LDS_BYTES) != hipSuccess) { fprintf(stderr, "kernel_launch: hipFuncSetAttribute failed\n"); grid = -1; return; }
        (void)hipGetLastError();
        grid = cus;
        if (grid != 256) fprintf(stderr, "kernel_launch: %d CUs; this kernel's unit maps assume 256\n", grid);
    }
    if (grid < 0) return;
    if (hipMemsetAsync((char*)d_ws + mk::WS_CTL, 0, mk::CTL_ZERO_BYTES, stream) != hipSuccess) return;
    Args a{};
    for (int i = 0; i < 21; ++i) a.in[i] = (const float*)d_in[i];
    a.out = (float*)d_out; a.ws = (unsigned char*)d_ws;
    hipLaunchKernelGGL(mk_fwd, dim3(grid), dim3(NWAVES * 64), LDS_BYTES, stream, a);
}
```

```cpp
#include <hip/hip_runtime.h>
#include <cstdio>
#include <cstdint>

#if defined(MK_TS)
#define PG8_DBG_STAMP() do { if (blockIdx.x == 0 && threadIdx.x == 0) { volatile __attribute__((address_space(3))) unsigned* M_ = (volatile __attribute__((address_space(3))) unsigned*)131392; const unsigned n_ = M_[15]; M_[16 + n_] = (unsigned)__builtin_amdgcn_s_memrealtime(); M_[15] = n_ + 1u; } } while (0)
#else
#define PG8_DBG_STAMP() do {} while (0)
#endif
namespace pg8 {
#define PG8_LAS __attribute__((address_space(3)))
typedef unsigned short bf16_t;
typedef short bf16x8 __attribute__((ext_vector_type(8)));
typedef float f32x4 __attribute__((ext_vector_type(4)));
typedef float f32x2 __attribute__((ext_vector_type(2)));
typedef unsigned u32x4 __attribute__((ext_vector_type(4)));
typedef unsigned u32x2 __attribute__((ext_vector_type(2)));
constexpr int BM = 256, BK = 64, HALF = 128, HTB = HALF * BK * 2, STAGE_BYTES = 8 * HTB, NXCD = 8, WGM = 4;

__host__ __device__ __forceinline__ int lds_byte(int r, int c) { const int st = (r >> 4) * 2 + (c >> 5), rr = r & 15, cc = c & 31, ob = rr * 64 + cc * 2; return st * 1024 + (ob ^ (((ob >> 9) & 1) << 5)); }
__host__ __device__ __forceinline__ void stage_rc(int b, int& R, int& C) { const int st = b / 1024, sb = b % 1024, swz = sb ^ (((sb >> 9) & 1) << 5); R = (st >> 1) * 16 + swz / 64; C = (st & 1) * 32 + (swz % 64) / 2; }
__host__ __device__ __forceinline__ int perm32(int rho) { const int n = rho >> 4, i = rho & 15; return 8 * (i >> 2) + 4 * n + (i & 3); }

struct Unit { int pm, pn, sub; };
struct Gemm { int lda, ldb, K; };

struct GridOrder {
    int nM, nN, nwg, G, c;
    __device__ void init(int M, int N, int G_, int c_) { nM = M / BM; nN = N / BM; nwg = nM * nN; G = G_; c = c_; }
    __device__ bool next(int i, Unit& u) const {
        const long L = (long)i * G + c; if (L >= nwg) return false;
        int wgid = (int)L; { const int q = nwg / NXCD, r = nwg % NXCD, xcd = wgid % NXCD, off = wgid / NXCD; wgid = (xcd < r ? xcd * (q + 1) : r * (q + 1) + (xcd - r) * q) + off; }
        const int nig = WGM * nN, gid = wgid / nig, fm = gid * WGM, gsz = (nM - fm) < WGM ? (nM - fm) : WGM;
        u.pm = fm + ((wgid % nig) % gsz); u.pn = (wgid % nig) / gsz; u.sub = 0; return true;
    }
};

typedef float f32x2_cv __attribute__((ext_vector_type(2))); typedef __bf16 bf16x2_cv __attribute__((ext_vector_type(2)));
__device__ __forceinline__ unsigned cvt_pk_bf16(float lo, float hi) { const f32x2_cv v = {lo, hi}; const bf16x2_cv b = __builtin_convertvector(v, bf16x2_cv); return __builtin_bit_cast(unsigned, b); }
__device__ __forceinline__ void store8(bf16_t* p, f32x4 v0, f32x4 v1) { u32x4 w; w.x = cvt_pk_bf16(v0[0], v0[1]); w.y = cvt_pk_bf16(v0[2], v0[3]); w.z = cvt_pk_bf16(v1[0], v1[1]); w.w = cvt_pk_bf16(v1[2], v1[3]); *(u32x4*)p = w; }
__device__ __forceinline__ void store4(bf16_t* p, f32x4 v0) { u32x2 w; w.x = cvt_pk_bf16(v0[0], v0[1]); w.y = cvt_pk_bf16(v0[2], v0[3]); *(u32x2*)p = w; }
__device__ __forceinline__ float bf2f(unsigned short h) { return __uint_as_float((unsigned)h << 16); }
__device__ __forceinline__ void load8(const bf16_t* p, f32x4& v0, f32x4& v1) { const u32x4 w = *(const u32x4*)p;
    v0[0] = __uint_as_float(w.x << 16); v0[1] = __uint_as_float(w.x & 0xffff0000u); v0[2] = __uint_as_float(w.y << 16); v0[3] = __uint_as_float(w.y & 0xffff0000u);
    v1[0] = __uint_as_float(w.z << 16); v1[1] = __uint_as_float(w.z & 0xffff0000u); v1[2] = __uint_as_float(w.w << 16); v1[3] = __uint_as_float(w.w & 0xffff0000u); }
__device__ __forceinline__ void load8_nt(const bf16_t* p, f32x4& v0, f32x4& v1) { const u32x4 w = __builtin_nontemporal_load((const u32x4*)p);
    v0[0] = __uint_as_float(w.x << 16); v0[1] = __uint_as_float(w.x & 0xffff0000u); v0[2] = __uint_as_float(w.y << 16); v0[3] = __uint_as_float(w.y & 0xffff0000u);
    v1[0] = __uint_as_float(w.z << 16); v1[1] = __uint_as_float(w.z & 0xffff0000u); v1[2] = __uint_as_float(w.w << 16); v1[3] = __uint_as_float(w.w & 0xffff0000u); }
__device__ __forceinline__ void load8_l2(const bf16_t* p, f32x4& v0, f32x4& v1) { u32x4 w; const unsigned long long a = __hip_atomic_load((const unsigned long long*)p, __ATOMIC_RELAXED, __HIP_MEMORY_SCOPE_AGENT), b = __hip_atomic_load((const unsigned long long*)p + 1, __ATOMIC_RELAXED, __HIP_MEMORY_SCOPE_AGENT);
    w.x = (unsigned)a; w.y = (unsigned)(a >> 32); w.z = (unsigned)b; w.w = (unsigned)(b >> 32);
    v0[0] = __uint_as_float(w.x << 16); v0[1] = __uint_as_float(w.x & 0xffff0000u); v0[2] = __uint_as_float(w.y << 16); v0[3] = __uint_as_float(w.y & 0xffff0000u);
    v1[0] = __uint_as_float(w.z << 16); v1[1] = __uint_as_float(w.z & 0xffff0000u); v1[2] = __uint_as_float(w.w << 16); v1[3] = __uint_as_float(w.w & 0xffff0000u); }
__device__ __forceinline__ float fexp2(float x) { return __builtin_amdgcn_exp2f(x); }
__device__ __forceinline__ float frcp(float x) { return __builtin_amdgcn_rcpf(x); }
__device__ __forceinline__ float sigmoidf_(float x) { return frcp(1.f + fexp2(-1.4426950408889634f * x)); }

template <class Epi, class Sched, bool ALIGN_EPI>
__device__ __forceinline__ void gemm_phase(PG8_LAS unsigned char* lds, const Gemm g, const Sched& S, const Epi& E) {
    int tid_ = threadIdx.x; asm volatile("" : "+v"(tid_));
    const int tid = tid_, wid = __builtin_amdgcn_readfirstlane(tid >> 6), lane = tid & 63, wr = wid >> 2, wc = wid & 3, fr = lane & 15, fq = lane >> 4;
    unsigned voffA[2], voffB[2];
#pragma unroll
    for (int i = 0; i < 2; ++i) { int R, C; stage_rc(tid * 16 + i * 8192, R, C); const int Rb = Epi::PERM ? ((R & ~31) + perm32(R & 31)) : R;
        voffA[i] = (unsigned)(R * g.lda + C) * 2u; voffB[i] = (unsigned)(Rb * g.ldb + C) * 2u; }
    const size_t kstep = (size_t)(BK * 2);
    const size_t hstepA = (size_t)HALF * g.lda * 2, hstepB = (size_t)HALF * g.ldb * 2;
    const unsigned ldsw = (unsigned)wid * 1024u;
    const int aoff = lds_byte(wr * 64 + fr, fq * 8), boff = lds_byte(wc * 32 + fr, fq * 8);
#define PG8_SA(b, h) (((b) * 2 + (h)) * HTB)
#define PG8_SB(b, h) ((4 + (b) * 2 + (h)) * HTB)
#define PG8_STAGE(bufoff, gbase, voff) do { _Pragma("unroll") for (int _i = 0; _i < 2; ++_i) \
        __builtin_amdgcn_global_load_lds((const unsigned*)((const char*)(gbase) + (voff)[_i]), (PG8_LAS unsigned*)(lds + (bufoff) + ldsw + _i * 8192), 16, 0, 0); } while (0)
#define PG8_LDA(dst, b, h) do { _Pragma("unroll") for (int m = 0; m < 4; ++m) _Pragma("unroll") for (int k = 0; k < 2; ++k) dst[m][k] = *(const PG8_LAS bf16x8*)(lds + PG8_SA(b, h) + aoff + m * 2048 + k * 1024); } while (0)
#define PG8_LDB(dst, b, h) do { _Pragma("unroll") for (int n = 0; n < 2; ++n) _Pragma("unroll") for (int k = 0; k < 2; ++k) dst[n][k] = *(const PG8_LAS bf16x8*)(lds + PG8_SB(b, h) + boff + n * 2048 + k * 1024); } while (0)
#define PG8_MMA(ai, bj, At, Bt) do { __builtin_amdgcn_s_setprio(1); _Pragma("unroll") for (int m = 0; m < 4; ++m) _Pragma("unroll") for (int n = 0; n < 2; ++n) _Pragma("unroll") for (int k = 0; k < 2; ++k) \
        acc[ai][bj][m][n] = __builtin_amdgcn_mfma_f32_16x16x32_bf16(Bt[n][k], At[m][k], acc[ai][bj][m][n], 0, 0, 0); __builtin_amdgcn_s_setprio(0); } while (0)
#define PG8_WAIT_V(n) asm volatile("s_waitcnt vmcnt(" #n ")" ::: "memory")
#define PG8_WAIT_L(n) asm volatile("s_waitcnt lgkmcnt(" #n ")" ::: "memory")
#define PG8_BAR __builtin_amdgcn_s_barrier()
#define PG8_SCHED __builtin_amdgcn_sched_barrier(0)
    Unit cur, nxt; int ui = 0;
    if (!S.next(0, cur)) return;
    f32x4 acc[2][2][4][2];
    if constexpr (Epi::INIT_C) { int fr2 = fr, fq2 = fq; asm volatile("" : "+v"(fr2), "+v"(fq2)); E.init_c(acc, cur, wr, wc, fr2, fq2); }
    else {
#pragma unroll
    for (int a = 0; a < 2; ++a)
#pragma unroll
        for (int b = 0; b < 2; ++b)
#pragma unroll
            for (int m = 0; m < 4; ++m)
#pragma unroll
                for (int n = 0; n < 2; ++n) acc[a][b][m][n] = (f32x4){0.f, 0.f, 0.f, 0.f};
    }
    bf16x8 At[4][2], B0[2][2], B1[2][2];
    const char* cA; const char* cB; S.ptrs(cur, cA, cB);
    PG8_STAGE(PG8_SB(0, 0), cB, voffB); PG8_STAGE(PG8_SB(0, 1), cB + hstepB, voffB); PG8_STAGE(PG8_SA(0, 0), cA, voffA); PG8_STAGE(PG8_SA(0, 1), cA + hstepA, voffA);
    if (wr == 1) PG8_BAR;
    PG8_WAIT_V(2); PG8_BAR;
    PG8_STAGE(PG8_SB(1, 0), cB + kstep, voffB); PG8_STAGE(PG8_SA(1, 0), cA + kstep, voffA); PG8_STAGE(PG8_SB(1, 1), cB + hstepB + kstep, voffB);
    PG8_WAIT_V(6); PG8_BAR; if constexpr (Epi::DBG) PG8_DBG_STAMP();
    for (;;) {
        const bool has_next = S.next(ui + 1, nxt); const int nt = S.nt(cur, g.K) ;
        const char* nA = cA; const char* nB = cB; if (has_next) S.ptrs(nxt, nA, nB);
        for (int t = 0; t < nt; t += 2) {
            const bool last = (t == nt - 2);
            const char* a1 = cA + (size_t)(t + 1) * kstep;
            const char* a2 = last ? nA : cA + (size_t)(t + 2) * kstep; const char* b2 = last ? nB : cB + (size_t)(t + 2) * kstep;
            const char* a3 = a2 + kstep; const char* b3 = b2 + kstep;
            PG8_LDB(B0, 0, 0); PG8_LDB(B1, 0, 1); PG8_SCHED; PG8_LDA(At, 0, 0); PG8_STAGE(PG8_SA(1, 1), a1 + hstepA, voffA);
            PG8_WAIT_V(8); PG8_WAIT_L(0); PG8_BAR; PG8_MMA(0, 0, At, B0); PG8_MMA(0, 1, At, B1); PG8_BAR; PG8_SCHED;
            PG8_LDA(At, 0, 1); PG8_STAGE(PG8_SB(0, 0), b2, voffB); PG8_STAGE(PG8_SB(0, 1), b2 + hstepB, voffB); PG8_STAGE(PG8_SA(0, 0), a2, voffA);
            PG8_WAIT_V(8); PG8_WAIT_L(0); PG8_BAR; PG8_MMA(1, 0, At, B0); PG8_MMA(1, 1, At, B1); PG8_BAR; PG8_SCHED;
            PG8_LDB(B0, 1, 0); PG8_LDB(B1, 1, 1); PG8_SCHED; PG8_LDA(At, 1, 0); PG8_STAGE(PG8_SA(0, 1), a2 + hstepA, voffA);
            PG8_WAIT_V(8); PG8_WAIT_L(0); PG8_BAR; PG8_MMA(0, 0, At, B0); PG8_MMA(0, 1, At, B1); PG8_BAR; PG8_SCHED;
            PG8_LDA(At, 1, 1); PG8_STAGE(PG8_SB(1, 0), b3, voffB); PG8_STAGE(PG8_SB(1, 1), b3 + hstepB, voffB); PG8_STAGE(PG8_SA(1, 0), a3, voffA);
            PG8_WAIT_V(8); PG8_WAIT_L(0); PG8_BAR; PG8_MMA(1, 0, At, B0); PG8_MMA(1, 1, At, B1); PG8_BAR; PG8_SCHED;
        }
        if constexpr (ALIGN_EPI) { if (wr == 0) PG8_BAR; } if constexpr (Epi::DBG) PG8_DBG_STAMP();
        if constexpr (!Epi::AFTER_DRAIN) { int fr2 = fr, fq2 = fq; asm volatile("" : "+v"(fr2), "+v"(fq2)); E(acc, cur, wr, wc, fr2, fq2); }
        if constexpr (Epi::DBG) PG8_DBG_STAMP();
        if (!has_next) break;
        if constexpr (Epi::KEEP_ACC) { }
        else if constexpr (Epi::INIT_C) { int fr2 = fr, fq2 = fq; asm volatile("" : "+v"(fr2), "+v"(fq2)); E.init_c(acc, nxt, wr, wc, fr2, fq2); }
        else {
#pragma unroll
        for (int a = 0; a < 2; ++a)
#pragma unroll
            for (int b = 0; b < 2; ++b)
#pragma unroll
                for (int m = 0; m < 4; ++m)
#pragma unroll
                    for (int n = 0; n < 2; ++n) acc[a][b][m][n] = (f32x4){0.f, 0.f, 0.f, 0.f};
        }
        cur = nxt; cA = nA; cB = nB; ++ui;
        if constexpr (ALIGN_EPI) { if (wr == 1) PG8_BAR; }
    }
    PG8_WAIT_V(0);
    if constexpr (!ALIGN_EPI) { if (wr == 0) PG8_BAR; }
    PG8_BAR;
    if constexpr (Epi::AFTER_DRAIN) { int fr2 = fr, fq2 = fq; asm volatile("" : "+v"(fr2), "+v"(fq2)); E.fused(acc, cur, wr, wc, fr2, fq2, lds, wid, lane); }
#undef PG8_SA
#undef PG8_SB
#undef PG8_STAGE
#undef PG8_LDA
#undef PG8_LDB
#undef PG8_MMA
#undef PG8_WAIT_V
#undef PG8_WAIT_L
#undef PG8_BAR
#undef PG8_SCHED
}
struct UnitG { const char* a; const char* b; int lda, ldb, nt, kind, perm; };
template <class Epi, class Sched, bool ALIGN_EPI>
__device__ __forceinline__ void gemm_stream(PG8_LAS unsigned char* lds, const Sched& S, const Epi& E) {
    int tid_ = threadIdx.x; asm volatile("" : "+v"(tid_));
    const int tid = tid_, wid = __builtin_amdgcn_readfirstlane(tid >> 6), lane = tid & 63, wr = wid >> 2, wc = wid & 3, fr = lane & 15, fq = lane >> 4;
#define PG8_VOFF(u, vA, vB) do { _Pragma("unroll") for (int i_ = 0; i_ < 2; ++i_) { int R_, C_; stage_rc(tid * 16 + i_ * 8192, R_, C_); const int Rb_ = (u).perm ? ((R_ & ~31) + perm32(R_ & 31)) : R_; \
        vA[i_] = (unsigned)(R_ * (u).lda + C_) * 2u; vB[i_] = (unsigned)(Rb_ * (u).ldb + C_) * 2u; } } while (0)
    const size_t kstep = (size_t)(BK * 2);
    const unsigned ldsw = (unsigned)wid * 1024u;
    const int aoff = lds_byte(wr * 64 + fr, fq * 8), boff = lds_byte(wc * 32 + fr, fq * 8);
#undef PG8_SA
#undef PG8_SB
#undef PG8_STAGE
#undef PG8_LDA
#undef PG8_LDB
#undef PG8_MMA
#undef PG8_WAIT_V
#undef PG8_WAIT_L
#undef PG8_BAR
#undef PG8_SCHED
#define PG8_SA(b, h) (((b) * 2 + (h)) * HTB)
#define PG8_SB(b, h) ((4 + (b) * 2 + (h)) * HTB)
#define PG8_STAGE(bufoff, gbase, voff) do { _Pragma("unroll") for (int _i = 0; _i < 2; ++_i) \
        __builtin_amdgcn_global_load_lds((const unsigned*)((const char*)(gbase) + (voff)[_i]), (PG8_LAS unsigned*)(lds + (bufoff) + ldsw + _i * 8192), 16, 0, 0); } while (0)
#define PG8_LDA(dst, b, h) do { _Pragma("unroll") for (int m = 0; m < 4; ++m) _Pragma("unroll") for (int k = 0; k < 2; ++k) dst[m][k] = *(const PG8_LAS bf16x8*)(lds + PG8_SA(b, h) + aoff + m * 2048 + k * 1024); } while (0)
#define PG8_LDB(dst, b, h) do { _Pragma("unroll") for (int n = 0; n < 2; ++n) _Pragma("unroll") for (int k = 0; k < 2; ++k) dst[n][k] = *(const PG8_LAS bf16x8*)(lds + PG8_SB(b, h) + boff + n * 2048 + k * 1024); } while (0)
#define PG8_MMA(ai, bj, At, Bt) do { __builtin_amdgcn_s_setprio(1); _Pragma("unroll") for (int m = 0; m < 4; ++m) _Pragma("unroll") for (int n = 0; n < 2; ++n) _Pragma("unroll") for (int k = 0; k < 2; ++k) \
        acc[ai][bj][m][n] = __builtin_amdgcn_mfma_f32_16x16x32_bf16(Bt[n][k], At[m][k], acc[ai][bj][m][n], 0, 0, 0); __builtin_amdgcn_s_setprio(0); } while (0)
#define PG8_WAIT_V(n) asm volatile("s_waitcnt vmcnt(" #n ")" ::: "memory")
#define PG8_WAIT_L(n) asm volatile("s_waitcnt lgkmcnt(" #n ")" ::: "memory")
#define PG8_BAR __builtin_amdgcn_s_barrier()
#define PG8_SCHED __builtin_amdgcn_sched_barrier(0)
    UnitG cur, nxt; int ui = 0;
    if (!S.next(0, cur)) return;
    unsigned voffA[2], voffB[2]; PG8_VOFF(cur, voffA, voffB);
    size_t hstepA = (size_t)HALF * cur.lda * 2, hstepB = (size_t)HALF * cur.ldb * 2;
    f32x4 acc[2][2][4][2];
#pragma unroll
    for (int a = 0; a < 2; ++a)
#pragma unroll
        for (int b = 0; b < 2; ++b)
#pragma unroll
            for (int m = 0; m < 4; ++m)
#pragma unroll
                for (int n = 0; n < 2; ++n) acc[a][b][m][n] = (f32x4){0.f, 0.f, 0.f, 0.f};
    bf16x8 At[4][2], B0[2][2], B1[2][2];
    const char* cA = cur.a; const char* cB = cur.b;
    PG8_STAGE(PG8_SB(0, 0), cB, voffB); PG8_STAGE(PG8_SB(0, 1), cB + hstepB, voffB); PG8_STAGE(PG8_SA(0, 0), cA, voffA); PG8_STAGE(PG8_SA(0, 1), cA + hstepA, voffA);
    if (wr == 1) PG8_BAR;
    PG8_WAIT_V(2); PG8_BAR;
    PG8_STAGE(PG8_SB(1, 0), cB + kstep, voffB); PG8_STAGE(PG8_SA(1, 0), cA + kstep, voffA); PG8_STAGE(PG8_SB(1, 1), cB + hstepB + kstep, voffB);
    PG8_WAIT_V(6); PG8_BAR; PG8_DBG_STAMP();
    for (;;) {
        const bool has_next = S.next(ui + 1, nxt); const int nt = cur.nt; if (!has_next) nxt = cur;
        const char* nA = nxt.a; const char* nB = nxt.b;
        const size_t nhA = (size_t)HALF * nxt.lda * 2, nhB = (size_t)HALF * nxt.ldb * 2;
        for (int t = 0; t < nt; t += 2) {
            const bool last = (t == nt - 2);
            const char* a1 = cA + (size_t)(t + 1) * kstep;
            const char* a2 = last ? nA : cA + (size_t)(t + 2) * kstep; const char* b2 = last ? nB : cB + (size_t)(t + 2) * kstep;
            const char* a3 = a2 + kstep; const char* b3 = b2 + kstep;
            unsigned xvA[2], xvB[2]; if (last) { PG8_VOFF(nxt, xvA, xvB); } else { xvA[0] = voffA[0]; xvA[1] = voffA[1]; xvB[0] = voffB[0]; xvB[1] = voffB[1]; }
            const size_t xhA = last ? nhA : hstepA, xhB = last ? nhB : hstepB;
            PG8_LDB(B0, 0, 0); PG8_LDB(B1, 0, 1); PG8_SCHED; PG8_LDA(At, 0, 0); PG8_STAGE(PG8_SA(1, 1), a1 + hstepA, voffA);
            PG8_WAIT_V(8); PG8_WAIT_L(0); PG8_BAR; PG8_MMA(0, 0, At, B0); PG8_MMA(0, 1, At, B1); PG8_BAR; PG8_SCHED;
            PG8_LDA(At, 0, 1); PG8_STAGE(PG8_SB(0, 0), b2, xvB); PG8_STAGE(PG8_SB(0, 1), b2 + xhB, xvB); PG8_STAGE(PG8_SA(0, 0), a2, xvA);
            PG8_WAIT_V(8); PG8_WAIT_L(0); PG8_BAR; PG8_MMA(1, 0, At, B0); PG8_MMA(1, 1, At, B1); PG8_BAR; PG8_SCHED;
            PG8_LDB(B0, 1, 0); PG8_LDB(B1, 1, 1); PG8_SCHED; PG8_LDA(At, 1, 0); PG8_STAGE(PG8_SA(0, 1), a2 + xhA, xvA);
            PG8_WAIT_V(8); PG8_WAIT_L(0); PG8_BAR; PG8_MMA(0, 0, At, B0); PG8_MMA(0, 1, At, B1); PG8_BAR; PG8_SCHED;
            PG8_LDA(At, 1, 1); PG8_STAGE(PG8_SB(1, 0), b3, xvB); PG8_STAGE(PG8_SB(1, 1), b3 + xhB, xvB); PG8_STAGE(PG8_SA(1, 0), a3, xvA);
            PG8_WAIT_V(8); PG8_WAIT_L(0); PG8_BAR; PG8_MMA(1, 0, At, B0); PG8_MMA(1, 1, At, B1); PG8_BAR; PG8_SCHED;
        }
        if constexpr (ALIGN_EPI) { if (wr == 0) PG8_BAR; } PG8_DBG_STAMP();
        if (!E.after_drain(cur)) { int fr2 = fr, fq2 = fq; asm volatile("" : "+v"(fr2), "+v"(fq2)); E(acc, cur, wr, wc, fr2, fq2); }
        PG8_DBG_STAMP();
        if (!has_next) break;
#pragma unroll
        for (int a = 0; a < 2; ++a)
#pragma unroll
            for (int b = 0; b < 2; ++b)
#pragma unroll
                for (int m = 0; m < 4; ++m)
#pragma unroll
                    for (int n = 0; n < 2; ++n) acc[a][b][m][n] = (f32x4){0.f, 0.f, 0.f, 0.f};
        cur = nxt; cA = nA; cB = nB; ++ui; PG8_VOFF(cur, voffA, voffB); hstepA = nhA; hstepB = nhB;
        if constexpr (ALIGN_EPI) { if (wr == 1) PG8_BAR; }
    }
    PG8_WAIT_V(0);
    if constexpr (!ALIGN_EPI) { if (wr == 0) PG8_BAR; }
    PG8_BAR;
    if (E.after_drain(cur)) { int fr2 = fr, fq2 = fq; asm volatile("" : "+v"(fr2), "+v"(fq2)); E.fused(acc, cur, wr, wc, fr2, fq2, lds, wid, lane); }
#undef PG8_SA
#undef PG8_SB
#undef PG8_STAGE
#undef PG8_LDA
#undef PG8_LDB
#undef PG8_MMA
#undef PG8_WAIT_V
#undef PG8_WAIT_L
#undef PG8_BAR
#undef PG8_SCHED
#undef PG8_VOFF
}
}

namespace mk {
using pg8::bf16_t; using pg8::f32x4; using pg8::f32x2; using pg8::u32x4; using pg8::u32x2; using pg8::Unit;
constexpr int D = 2048, BATCH = 2, SEQ = 4096, M = BATCH * SEQ, D_IN = 16384, D_FF = 8192, N_MEM = 256;
constexpr float EPS = 1e-6f, LOG2E = 1.4426950408889634f;
constexpr size_t MiB = 1u << 20;
constexpr size_t WS_CTL = 0, CTL_ZERO_BYTES = 32 * 1024;
constexpr size_t WS_COS = 1 * MiB, WS_SIN = 2 * MiB;
constexpr size_t WS_SSQ_NAQ = 3 * MiB, WS_SSQ_NAK = 4 * MiB;
constexpr size_t WS_SSQ_XQ = 5 * MiB, WS_XL = 5 * MiB + 512 * 1024;
constexpr size_t WS_SSQ_X1 = 6 * MiB;
constexpr size_t WS_TAB = 6 * MiB + 512 * 1024;
constexpr int TAB_CS_NAQ = 0, TAB_CS_MK = 128, TAB_L2F = 384, TAB_L2B = 392, TAB_SSQ_MK = 1024;
constexpr size_t WS_MEMN = 8 * MiB, WS_MK = 10 * MiB, WS_MVT = 11 * MiB;
constexpr size_t WS_WIN = 16 * MiB, WS_WFF1 = 80 * MiB, WS_WFF2 = 112 * MiB, WS_WRET = 144 * MiB, WS_WOUT = 152 * MiB, WS_WNM = 160 * MiB  , WS_WMKV = 168 * MiB;
constexpr size_t WS_NAQKV = 176 * MiB, WS_K0 = 224 * MiB, WS_RG = 240 * MiB, WS_XQ = 272 * MiB, WS_GATES = 288 * MiB;
constexpr size_t WS_AR = 384 * MiB, WS_BR = 448 * MiB, WS_END = 512 * MiB;
constexpr size_t WS_KV = WS_WIN;
constexpr size_t WS_ORET = 16 * MiB;
constexpr size_t WS_MERGED = WS_NAQKV;
constexpr size_t WS_X1B = WS_AR;
constexpr size_t WS_HFF = 176 * MiB;
constexpr int LDH = 8192;
constexpr size_t DO_HN = 0, DO_KT = 0, DO_XP = 32 * MiB, DO_ONM = 0;

struct SchedGrid {
    pg8::GridOrder o; const char* A; const char* B; size_t ta, tb;
    __device__ __forceinline__ bool next(int i, Unit& u) const { return o.next(i, u); }
    __device__ __forceinline__ void ptrs(const Unit& u, const char*& a, const char*& b) const { a = A + (size_t)u.pm * ta; b = B + (size_t)u.pn * tb; }
    __device__ __forceinline__ int nt(const Unit&, int K) const { return K / 64; }
};
struct SchedProj {
    pg8::GridOrder o; const char* hn_; const char* wt_;
    __device__ __forceinline__ bool next(int i, Unit& u) const { return o.next(i, u); }
    __device__ __forceinline__ void ptrs(const Unit& u, const char*& a, const char*& b) const {
        const char* h = hn_ + (size_t)u.pm * (256u * 2048u * 2u); const char* w = wt_ + (size_t)u.pn * (256u * 2048u * 2u);
        const bool sw = (u.pn >= 20 && u.pn < 28); a = sw ? w : h; b = sw ? h : w; }
    __device__ __forceinline__ int nt(const Unit&, int K) const { return K / 64; }
};
struct SchedOne { bool has; Unit u; const char* a; const char* b;
    __device__ __forceinline__ bool next(int i, Unit& uu) const { if (i != 0 || !has) return false; uu = u; return true; }
    __device__ __forceinline__ void ptrs(const Unit&, const char*& aa, const char*& bb) const { aa = a; bb = b; }
    __device__ __forceinline__ int nt(const Unit&, int K) const { return K / 64; }
};

#define MK_ROWS_BEGIN _Pragma("unroll") for (int ai = 0; ai < 2; ++ai) { _Pragma("unroll") for (int m = 0; m < 4; ++m) { const int rl = ai * 128 + wr * 64 + m * 16 + fr;
#define MK_ROWS_END __builtin_amdgcn_sched_barrier(0); } }
#define MK_ROWS_END_NB } }
#define MK_ROWS_END2 if (m & 1) __builtin_amdgcn_sched_barrier(0); } }
#define MK_RL(ai, m) ((ai) * 128 + wr * 64 + (m) * 16 + fr)
__device__ __forceinline__ float sq8(const f32x4& a, const f32x4& b) { return (a[0] * a[0] + a[1] * a[1]) + (a[2] * a[2] + a[3] * a[3]) + (b[0] * b[0] + b[1] * b[1]) + (b[2] * b[2] + b[3] * b[3]); }
__device__ __forceinline__ float red_fq(float s) {
    { auto r = __builtin_amdgcn_permlane16_swap(__float_as_uint(s), __float_as_uint(s), false, false); s = __uint_as_float(r[0]) + __uint_as_float(r[1]); }
    { auto r = __builtin_amdgcn_permlane32_swap(__float_as_uint(s), __float_as_uint(s), false, false); s = __uint_as_float(r[0]) + __uint_as_float(r[1]); }
    return s; }

struct EpiProj {
    static constexpr bool PERM = true, AFTER_DRAIN = false, INIT_C = false, DBG = false, KEEP_ACC = false;
    unsigned char* ws;
    __device__ __forceinline__ void operator()(const f32x4 (&acc)[2][2][4][2], const Unit& u, int wr, int wc, int fr, int fq) const {
        bf16_t* const naqkv = (bf16_t*)(ws + WS_NAQKV); bf16_t* const k0 = (bf16_t*)(ws + WS_K0); bf16_t* const rg = (bf16_t*)(ws + WS_RG); bf16_t* const xq = (bf16_t*)(ws + WS_XQ);
        bf16_t* const gates = (bf16_t*)(ws + WS_GATES); bf16_t* const ar = (bf16_t*)(ws + WS_AR); bf16_t* const br = (bf16_t*)(ws + WS_BR);
        float* const ssq_naq = (float*)(ws + WS_SSQ_NAQ); float* const ssq_nak = (float*)(ws + WS_SSQ_NAK); float* const ssq_xq = (float*)(ws + WS_SSQ_XQ);
        const float* const cosT = (const float*)(ws + WS_COS); const float* const sinT = (const float*)(ws + WS_SIN); const float* const tab = (const float*)(ws + WS_TAB);
        const int pn = u.pn, row0 = u.pm * 256, cw = wc * 32 + 8 * fq;
        if (pn < 8) {
            const bool isq = pn < 4; float* ssq = isq ? ssq_naq : ssq_nak; const int hb = isq ? 2 * pn : 2 * (pn - 4);
            f32x4 c0 = (f32x4){1.f, 1.f, 1.f, 1.f}, c1 = c0; if (isq) { c0 = *(const f32x4*)(tab + TAB_CS_NAQ + cw); c1 = *(const f32x4*)(tab + TAB_CS_NAQ + cw + 4); }
            MK_ROWS_BEGIN  const int row = row0 + rl;
#pragma unroll
                for (int bj = 0; bj < 2; ++bj) { const f32x4 v0 = acc[ai][bj][m][0], v1 = acc[ai][bj][m][1]; const float q = red_fq(sq8(v0, v1));
                    if (fq == 0) ssq[(size_t)row * 32 + (hb + bj) * 4 + wc] = q;
                    pg8::store8(naqkv + (size_t)row * 3072 + pn * 256 + bj * 128 + cw, v0 * c0, v1 * c1); }  MK_ROWS_END
        } else if (pn < 12) {
            MK_ROWS_BEGIN  const int row = row0 + rl;
#pragma unroll
                for (int bj = 0; bj < 2; ++bj) pg8::store8(naqkv + (size_t)row * 3072 + pn * 256 + bj * 128 + cw, acc[ai][bj][m][0], acc[ai][bj][m][1]);  MK_ROWS_END
        } else if (pn < 20) {
            const bool isq = pn < 16; const int head = 2 * (pn & 3) + (wc >> 1), i0 = 32 * (wc & 1) + 8 * fq;
            const float l2f = tab[TAB_L2F + head], l2b = tab[TAB_L2B + head];
            MK_ROWS_BEGIN  const int row = row0 + rl, s = row & 4095, b = row >> 12;
                const f32x4 cs0 = *(const f32x4*)(cosT + s * 64 + i0), cs1 = *(const f32x4*)(cosT + s * 64 + i0 + 4), sn0 = *(const f32x4*)(sinT + s * 64 + i0), sn1 = *(const f32x4*)(sinT + s * 64 + i0 + 4);
                const f32x4 a0 = acc[ai][0][m][0], a1 = acc[ai][0][m][1], b0 = acc[ai][1][m][0], b1 = acc[ai][1][m][1];
                const f32x4 lo0 = a0 * cs0 - b0 * sn0, lo1 = a1 * cs1 - b1 * sn1, hi0 = a0 * sn0 + b0 * cs0, hi1 = a1 * sn1 + b1 * cs1;
                if (isq) { const int c = row & 255; const float df = pg8::fexp2(l2f * (float)(c + 1)), db = pg8::fexp2(l2b * (float)(256 - c));
                    bf16_t* d = ar + ((size_t)(b * 8 + head) * 4096 + s) * 512 + 256 + i0;
                    pg8::store8(d, lo0 * df, lo1 * df); pg8::store8(d + 64, hi0 * df, hi1 * df); pg8::store8(d + 128, lo0 * db, lo1 * db); pg8::store8(d + 192, hi0 * db, hi1 * db);
                } else { const float sc = 0.08838834764831845f; bf16_t* d = k0 + (size_t)row * 1024 + head * 128 + i0;
                    pg8::store8(d, lo0 * sc, lo1 * sc); pg8::store8(d + 64, hi0 * sc, hi1 * sc); }  MK_ROWS_END2
        } else if (pn < 28) {
            const int hv = pn - 20, b = u.pm >> 4, nc = u.pm & 15;
            bf16_t* base = br + ((size_t)((b * 8 + hv) * 16 + nc) * 256) * 512;
            MK_ROWS_BEGIN
#pragma unroll
                for (int bj = 0; bj < 2; ++bj) pg8::store8(base + (size_t)rl * 512 + bj * 128 + cw, acc[ai][bj][m][0], acc[ai][bj][m][1]);  MK_ROWS_END
        } else if (pn < 36) {
            MK_ROWS_BEGIN  const int row = row0 + rl;
#pragma unroll
                for (int bj = 0; bj < 2; ++bj) { f32x4 v0 = acc[ai][bj][m][0], v1 = acc[ai][bj][m][1];
#pragma unroll
                    for (int e = 0; e < 4; ++e) { v0[e] = v0[e] * pg8::sigmoidf_(v0[e]); v1[e] = v1[e] * pg8::sigmoidf_(v1[e]); }
                    pg8::store8(rg + (size_t)row * 2048 + (pn - 28) * 256 + bj * 128 + cw, v0, v1); }  MK_ROWS_END
        } else if (pn < 40) {
            MK_ROWS_BEGIN  const int row = row0 + rl;
                const float q = red_fq(sq8(acc[ai][0][m][0], acc[ai][0][m][1]) + sq8(acc[ai][1][m][0], acc[ai][1][m][1]));
                if (fq == 0) ssq_xq[(size_t)row * 16 + (pn - 36) * 4 + wc] = q;
#pragma unroll
                for (int bj = 0; bj < 2; ++bj) pg8::store8(xq + (size_t)row * 1024 + (pn - 36) * 256 + bj * 128 + cw, acc[ai][bj][m][0], acc[ai][bj][m][1]);  MK_ROWS_END
        } else {
            MK_ROWS_BEGIN  const int row = row0 + rl;
#pragma unroll
                for (int bj = 0; bj < 2; ++bj) { f32x4 v0 = acc[ai][bj][m][0], v1 = acc[ai][bj][m][1];
#pragma unroll
                    for (int e = 0; e < 4; ++e) { v0[e] = pg8::sigmoidf_(v0[e]); v1[e] = pg8::sigmoidf_(v1[e]); }
                    u32x2 w; w.x = (unsigned)fmaxf(v0[0] * 255.f + 0.5f, 1.f) | ((unsigned)fmaxf(v0[1] * 255.f + 0.5f, 1.f) << 8) | ((unsigned)fmaxf(v0[2] * 255.f + 0.5f, 1.f) << 16) | ((unsigned)fmaxf(v0[3] * 255.f + 0.5f, 1.f) << 24);
                    w.y = (unsigned)fmaxf(v1[0] * 255.f + 0.5f, 1.f) | ((unsigned)fmaxf(v1[1] * 255.f + 0.5f, 1.f) << 8) | ((unsigned)fmaxf(v1[2] * 255.f + 0.5f, 1.f) << 16) | ((unsigned)fmaxf(v1[3] * 255.f + 0.5f, 1.f) << 24);
                    *(u32x2*)((unsigned char*)gates + (size_t)row * 6144 + (pn - 40) * 256 + bj * 128 + cw) = w; }  MK_ROWS_END
        }
    }
};
struct EpiMKV {
    static constexpr bool PERM = true, AFTER_DRAIN = false, INIT_C = false, DBG = false, KEEP_ACC = false;
    bf16_t *mk, *mvt; float* tabw; const float* tab; int mode;
    __device__ __forceinline__ void operator()(const f32x4 (&acc)[2][2][4][2], const Unit& u, int wr, int wc, int fr, int fq) const {
        const int cw = wc * 32 + 8 * fq, row0 = u.pm * 256;
        if (mode == 0) {
            MK_ROWS_BEGIN  const int row = row0 + rl;
                const float q = red_fq(sq8(acc[ai][0][m][0], acc[ai][0][m][1]) + sq8(acc[ai][1][m][0], acc[ai][1][m][1]));
                if (fq == 0) tabw[TAB_SSQ_MK + row * 16 + u.pn * 4 + wc] = q;
#pragma unroll
                for (int bj = 0; bj < 2; ++bj) { const f32x4 c0 = *(const f32x4*)(tab + TAB_CS_MK + bj * 128 + cw), c1 = *(const f32x4*)(tab + TAB_CS_MK + bj * 128 + cw + 4);
                    pg8::store8(mk + (size_t)row * 1024 + u.pn * 256 + bj * 128 + cw, acc[ai][bj][m][0] * c0, acc[ai][bj][m][1] * c1); }  MK_ROWS_END
        } else {
            MK_ROWS_BEGIN  const int row = row0 + rl;
#pragma unroll
                for (int bj = 0; bj < 2; ++bj) pg8::store8(mvt + (size_t)row * 512 + u.pn * 256 + bj * 128 + cw, acc[ai][bj][m][0], acc[ai][bj][m][1]);  MK_ROWS_END
        }
    }
};
struct EpiF32 {
    static constexpr bool PERM = true, AFTER_DRAIN = false, INIT_C = false, DBG = false, KEEP_ACC = false;
    bf16_t* C;
    __device__ __forceinline__ void operator()(const f32x4 (&acc)[2][2][4][2], const Unit&, int wr, int wc, int fr, int fq) const {
        const int cw = wc * 32 + 8 * fq;
        MK_ROWS_BEGIN
#pragma unroll
            for (int bj = 0; bj < 2; ++bj) pg8::store8(C + (size_t)rl * 256 + bj * 128 + cw, acc[ai][bj][m][0], acc[ai][bj][m][1]);  MK_ROWS_END
    }
};
struct EpiP {
    static constexpr bool PERM = true, AFTER_DRAIN = false, INIT_C = false, DBG = false, KEEP_ACC = false;
    bf16_t* P; float l2f, l2b;
    __device__ __forceinline__ void operator()(const f32x4 (&acc)[2][2][4][2], const Unit&, int wr, int wc, int fr, int fq) const {
        const int cw = wc * 32 + 8 * fq;
        MK_ROWS_BEGIN  const int c = rl; const float rowf = -l2f * (float)(c + 1);
#pragma unroll
            for (int bj = 0; bj < 2; ++bj) { f32x4 v[2] = {acc[ai][bj][m][0], acc[ai][bj][m][1]};
#pragma unroll
                for (int n = 0; n < 2; ++n)
#pragma unroll
                    for (int e = 0; e < 4; ++e) { const int cp = bj * 128 + cw + 4 * n + e;
                        const float ex = (c >= cp) ? (-l2f * (float)(cp + 1)) : (l2b * (float)(cp - c) + rowf);
                        v[n][e] *= pg8::fexp2(ex); }
                pg8::store8(P + (size_t)c * 512 + bj * 128 + cw, v[0], v[1]); }  MK_ROWS_END
    }
};
struct EpiGN {
    static constexpr bool PERM = true, AFTER_DRAIN = true, INIT_C = false, DBG = false, KEEP_ACC = false;
    bf16_t* oret; const bf16_t* rgv; const float* gn;
    __device__ __forceinline__ void fused(f32x4 (&acc)[2][2][4][2], const Unit&, int wr, int wc, int fr, int fq, PG8_LAS unsigned char* lds, int wid, int lane) const {
        PG8_LAS f32x2* P = (PG8_LAS f32x2*)lds;
        const int cw = wc * 32 + 8 * fq;
        MK_ROWS_BEGIN  float s = 0.f;
#pragma unroll
            for (int bj = 0; bj < 2; ++bj)
#pragma unroll
                for (int n = 0; n < 2; ++n) { const f32x4 x = acc[ai][bj][m][n]; s += (x[0] + x[1]) + (x[2] + x[3]); }
            s = red_fq(s); const float mw = s * (1.0f / 64.0f); float q = 0.f;
#pragma unroll
            for (int bj = 0; bj < 2; ++bj)
#pragma unroll
                for (int n = 0; n < 2; ++n) { const f32x4 d = acc[ai][bj][m][n] - mw; q += (d[0] * d[0] + d[1] * d[1]) + (d[2] * d[2] + d[3] * d[3]); }
            q = red_fq(q);
            if (fq == 0) P[rl * 4 + wc] = (f32x2){mw, q};  MK_ROWS_END
        asm volatile("s_waitcnt lgkmcnt(0)" ::: "memory"); __builtin_amdgcn_s_barrier(); asm volatile("" ::: "memory");
        f32x4 g0[2], g1[2];
#pragma unroll
        for (int bj = 0; bj < 2; ++bj) { g0[bj] = *(const f32x4*)(gn + bj * 128 + cw); g1[bj] = *(const f32x4*)(gn + bj * 128 + cw + 4); }
        MK_ROWS_BEGIN  const f32x2 a = P[rl * 4 + 0], b = P[rl * 4 + 1], c = P[rl * 4 + 2], d = P[rl * 4 + 3];
            const float mt = (a.x + b.x + c.x + d.x) * 0.25f;
            const float da = a.x - mt, db = b.x - mt, dc = c.x - mt, dd = d.x - mt;
            const float m2 = (a.y + b.y) + (c.y + d.y) + 64.0f * ((da * da + db * db) + (dc * dc + dd * dd));
            const float rstd = 1.0f / sqrtf(m2 * (1.0f / 256.0f) + EPS);
#pragma unroll
            for (int bj = 0; bj < 2; ++bj) { f32x4 r0, r1; pg8::load8(rgv + (size_t)rl * 2048 + bj * 128 + cw, r0, r1);
                const f32x4 o0 = (acc[ai][bj][m][0] - mt) * rstd * g0[bj] * r0, o1 = (acc[ai][bj][m][1] - mt) * rstd * g1[bj] * r1;
                pg8::store8(oret + (size_t)rl * 2048 + bj * 128 + cw, o0, o1); }  MK_ROWS_END_NB
        asm volatile("s_waitcnt lgkmcnt(0)" ::: "memory"); __builtin_amdgcn_s_barrier(); asm volatile("" ::: "memory");
    }
};
struct EpiXS {
    static constexpr bool PERM = true, AFTER_DRAIN = false, INIT_C = false, DBG = false, KEEP_ACC = false;
    bf16_t* xp; float* xl; const float* ssq_q; const float* ssq_k;
    __device__ __forceinline__ void operator()(const f32x4 (&acc)[2][2][4][2], const Unit&, int wr, int wc, int fr, int fq) const {
        const int cw = wc * 32 + 8 * fq;
        float rk[2][8];
#pragma unroll
        for (int bj = 0; bj < 2; ++bj)
#pragma unroll
            for (int j = 0; j < 8; ++j) { const f32x4 p = *(const f32x4*)(ssq_k + (size_t)(bj * 128 + cw + j) * 16); rk[bj][j] = rsqrtf(((p[0] + p[1]) + (p[2] + p[3])) * (1.0f / 256.0f) + EPS) * LOG2E; }
#pragma unroll
        for (int ai = 0; ai < 2; ++ai) {
            float rqa[4];
#pragma unroll
            for (int m = 0; m < 4; ++m) { const f32x4 pq = *(const f32x4*)(ssq_q + (size_t)MK_RL(ai, m) * 16); rqa[m] = rsqrtf(((pq[0] + pq[1]) + (pq[2] + pq[3])) * (1.0f / 256.0f) + EPS); }
#pragma unroll
            for (int m = 0; m < 4; ++m) { const int rl = MK_RL(ai, m); const float rq = rqa[m];
                float s = 0.f;
#pragma unroll
                for (int bj = 0; bj < 2; ++bj) { f32x4 v[2] = {acc[ai][bj][m][0], acc[ai][bj][m][1]};
#pragma unroll
                    for (int n = 0; n < 2; ++n)
#pragma unroll
                        for (int e = 0; e < 4; ++e) { v[n][e] = pg8::fexp2(v[n][e] * rq * rk[bj][4 * n + e]); s += v[n][e]; }
                    pg8::store8(xp + (size_t)rl * 1024 + bj * 128 + cw, v[0], v[1]); }
                s = red_fq(s); if (fq == 0) xl[(size_t)rl * 16 + wc] = s;
                __builtin_amdgcn_sched_barrier(0); }
        }
    }
};
struct EpiXO {
    static constexpr bool PERM = true, AFTER_DRAIN = false, INIT_C = false, DBG = false, KEEP_ACC = false;
    bf16_t* omem; const float* xl;
    __device__ __forceinline__ void operator()(const f32x4 (&acc)[2][2][4][2], const Unit&, int wr, int wc, int fr, int fq) const {
        const int cw = wc * 32 + 8 * fq;
        float ila[2][4];
#pragma unroll
        for (int ai = 0; ai < 2; ++ai)
#pragma unroll
            for (int m = 0; m < 4; ++m) { const f32x4 p = *(const f32x4*)(xl + (size_t)MK_RL(ai, m) * 16); ila[ai][m] = pg8::frcp((p[0] + p[1]) + (p[2] + p[3])); }
        MK_ROWS_BEGIN  const float il = ila[ai][m];
#pragma unroll
            for (int bj = 0; bj < 2; ++bj) pg8::store8(omem + (size_t)rl * 2048 + bj * 128 + cw, acc[ai][bj][m][0] * il, acc[ai][bj][m][1] * il);  MK_ROWS_END
    }
};
struct EpiGate4 {
    static constexpr bool PERM = true, AFTER_DRAIN = false, INIT_C = false, DBG = true, KEEP_ACC = true;
    bf16_t* merged; const bf16_t* gates;
    __device__ __forceinline__ static void g8(const unsigned char* p, f32x4& a, f32x4& b) { const u32x2 w = *(const u32x2*)p;
        a = (f32x4){(float)(w.x & 255u), (float)((w.x >> 8) & 255u), (float)((w.x >> 16) & 255u), (float)(w.x >> 24)};
        b = (f32x4){(float)(w.y & 255u), (float)((w.y >> 8) & 255u), (float)((w.y >> 16) & 255u), (float)(w.y >> 24)}; }
    __device__ __forceinline__ void operator()(f32x4 (&acc)[2][2][4][2], const Unit& u, int wr, int wc, int fr, int fq) const {
        const int cw = wc * 32 + 8 * fq; const unsigned char* gate = (const unsigned char*)gates + u.sub * 2048;
        if (u.sub < 2) {
            MK_ROWS_BEGIN  const size_t row = (size_t)u.pm * 256 + rl;
#pragma unroll
                for (int bj = 0; bj < 2; ++bj) { const int col = u.pn * 256 + bj * 128 + cw; f32x4 a0, a1, b0, b1; g8(gate + row * 6144 + col, a0, a1); g8(gate + 2048 + row * 6144 + col, b0, b1);
#pragma unroll
                    for (int e = 0; e < 4; ++e) { acc[ai][bj][m][0][e] *= a0[e] * pg8::frcp(b0[e]); acc[ai][bj][m][1][e] *= a1[e] * pg8::frcp(b1[e]); } }  MK_ROWS_END_NB
        } else {
            MK_ROWS_BEGIN  const size_t row = (size_t)u.pm * 256 + rl;
#pragma unroll
                for (int bj = 0; bj < 2; ++bj) { const int col = u.pn * 256 + bj * 128 + cw; f32x4 g0, g1; g8(gate + row * 6144 + col, g0, g1);
                    pg8::store8(merged + row * 2048 + col, acc[ai][bj][m][0] * g0 * (1.0f / 255.0f), acc[ai][bj][m][1] * g1 * (1.0f / 255.0f)); }  MK_ROWS_END_NB
        }
    }
};
struct SchedBR {
    pg8::GridOrder o; const char* onm; const char* oret; const char* wnm; const char* wret;
    __device__ __forceinline__ bool next(int i, Unit& u) const { if (i >= 3) return false; const bool ok = o.next(0, u); u.sub = i; return ok; }
    __device__ __forceinline__ void ptrs(const Unit& u, const char*& a, const char*& b) const {
        const size_t ra = (size_t)u.pm * (256u * 2048u * 2u), rb = (size_t)u.pn * (256u * 2048u * 2u);
        const bool nm = (u.sub != 1); const size_t co = (u.sub == 2) ? 2048u : 0u;
        a = (nm ? onm : oret) + ra + co; b = (nm ? wnm : wret) + rb + co; }
    __device__ __forceinline__ int nt(const Unit& u, int) const { return u.sub == 1 ? 32 : 16; }
};
struct EpiWout {
    static constexpr bool PERM = false, AFTER_DRAIN = true, INIT_C = true, DBG = false, KEEP_ACC = false;
    const float* x; float* x1; bf16_t* x1b; float* ssq; const float* gffn;
    __device__ __forceinline__ void init_c(f32x4 (&acc)[2][2][4][2], const Unit& u, int wr, int wc, int fr, int fq) const {
        const int col0 = u.pn * 256 + wc * 32 + 4 * fq;
        MK_ROWS_BEGIN  const size_t off = ((size_t)u.pm * 256 + rl) * 2048 + col0;
#pragma unroll
            for (int bj = 0; bj < 2; ++bj)
#pragma unroll
                for (int n = 0; n < 2; ++n) acc[ai][bj][m][n] = __builtin_nontemporal_load((const f32x4*)(x + off + bj * 128 + n * 16));  MK_ROWS_END_NB
    }
    __device__ __forceinline__ void fused(f32x4 (&acc)[2][2][4][2], const Unit& u, int wr, int wc, int fr, int fq, PG8_LAS unsigned char* lds, int wid, int lane) const {
        PG8_LAS float* P = (PG8_LAS float*)lds;
        const int col0 = u.pn * 256 + wc * 32 + 4 * fq;
        MK_ROWS_BEGIN  const size_t off = ((size_t)u.pm * 256 + rl) * 2048 + col0; float q = 0.f;
#pragma unroll
            for (int bj = 0; bj < 2; ++bj)
#pragma unroll
                for (int n = 0; n < 2; ++n) { const f32x4 v = acc[ai][bj][m][n];
                    *(f32x4*)(x1 + off + bj * 128 + n * 16) = v; pg8::store4(x1b + off + bj * 128 + n * 16, v * *(const f32x4*)(gffn + col0 + bj * 128 + n * 16)); q += (v[0] * v[0] + v[1] * v[1]) + (v[2] * v[2] + v[3] * v[3]); }
            q = red_fq(q); if (fq == 0) P[rl * 4 + wc] = q;  MK_ROWS_END_NB
        asm volatile("s_waitcnt lgkmcnt(0)" ::: "memory"); __builtin_amdgcn_s_barrier(); asm volatile("" ::: "memory");
        if (threadIdx.x < 256) { const int r = threadIdx.x; const f32x4 p = *(const PG8_LAS f32x4*)(P + r * 4); ssq[((size_t)u.pm * 256 + r) * 8 + u.pn] = (p[0] + p[1]) + (p[2] + p[3]); }
        asm volatile("s_waitcnt lgkmcnt(0)" ::: "memory"); __builtin_amdgcn_s_barrier(); asm volatile("" ::: "memory");
    }
};
struct EpiFF1 {
    static constexpr bool PERM = true, AFTER_DRAIN = false, INIT_C = false, DBG = false, KEEP_ACC = false;
    bf16_t* hff; const float* ssq;
    __device__ __forceinline__ void operator()(const f32x4 (&acc)[2][2][4][2], const Unit& u, int wr, int wc, int fr, int fq) const {
        const int cw = wc * 32 + 8 * fq;
        float ra[2][4];
#pragma unroll
        for (int ai = 0; ai < 2; ++ai)
#pragma unroll
            for (int m = 0; m < 4; ++m) { const size_t row = (size_t)u.pm * 256 + MK_RL(ai, m); const f32x4 p0 = *(const f32x4*)(ssq + row * 8), p1 = *(const f32x4*)(ssq + row * 8 + 4);
                ra[ai][m] = rsqrtf((((p0[0] + p0[1]) + (p0[2] + p0[3])) + ((p1[0] + p1[1]) + (p1[2] + p1[3]))) * (1.0f / 2048.0f) + EPS); }
        MK_ROWS_BEGIN  const size_t row = (size_t)u.pm * 256 + rl; const float r = ra[ai][m];
#pragma unroll
            for (int bj = 0; bj < 2; ++bj) { f32x4 v0 = acc[ai][bj][m][0] * r, v1 = acc[ai][bj][m][1] * r;
#pragma unroll
                for (int e = 0; e < 4; ++e) { const float a = fmaxf(v0[e], 0.f), b = fmaxf(v1[e], 0.f); v0[e] = a * a; v1[e] = b * b; }
                pg8::store8(hff + row * LDH + u.pn * 256 + bj * 128 + cw, v0, v1); }  MK_ROWS_END
    }
};
struct EpiFF2 {
    static constexpr bool PERM = false, AFTER_DRAIN = false, INIT_C = true, DBG = false, KEEP_ACC = false;
    const float* src; float* out;
    __device__ __forceinline__ void init_c(f32x4 (&acc)[2][2][4][2], const Unit& u, int wr, int wc, int fr, int fq) const {
        const int col0 = u.pn * 256 + wc * 32 + 4 * fq;
        MK_ROWS_BEGIN  const size_t off = ((size_t)u.pm * 256 + rl) * 2048 + col0;
#pragma unroll
            for (int bj = 0; bj < 2; ++bj)
#pragma unroll
                for (int n = 0; n < 2; ++n) acc[ai][bj][m][n] = *(const f32x4*)(src + off + bj * 128 + n * 16);  MK_ROWS_END_NB
    }
    __device__ __forceinline__ void operator()(const f32x4 (&acc)[2][2][4][2], const Unit& u, int wr, int wc, int fr, int fq) const {
        const int col0 = u.pn * 256 + wc * 32 + 4 * fq;
        MK_ROWS_BEGIN  const size_t off = ((size_t)u.pm * 256 + rl) * 2048 + col0;
#pragma unroll
            for (int bj = 0; bj < 2; ++bj)
#pragma unroll
                for (int n = 0; n < 2; ++n) { const size_t o2 = off + bj * 128 + n * 16; *(f32x4*)(out + o2) = acc[ai][bj][m][n]; }  MK_ROWS_END_NB
    }
};

struct SchedList3 {
    pg8::UnitG u0, u1, u2; int n;
    __device__ __forceinline__ bool next(int i, pg8::UnitG& u) const { if (i >= n) return false;
        u.a = (i == 0) ? u0.a : ((i == 1) ? u1.a : u2.a); u.b = (i == 0) ? u0.b : ((i == 1) ? u1.b : u2.b);
        u.lda = (i == 0) ? u0.lda : ((i == 1) ? u1.lda : u2.lda); u.ldb = (i == 0) ? u0.ldb : ((i == 1) ? u1.ldb : u2.ldb);
        u.nt = (i == 0) ? u0.nt : ((i == 1) ? u1.nt : u2.nt); u.kind = (i == 0) ? u0.kind : ((i == 1) ? u1.kind : u2.kind); u.perm = (i == 0) ? u0.perm : ((i == 1) ? u1.perm : u2.perm);
        return true; }
};
struct EpiM1 {
    EpiF32 e0; EpiP e1; EpiXS e2;
    __device__ __forceinline__ bool after_drain(const pg8::UnitG&) const { return false; }
    __device__ __forceinline__ void operator()(const f32x4 (&acc)[2][2][4][2], const pg8::UnitG& u, int wr, int wc, int fr, int fq) const {
        Unit d; d.pm = 0; d.pn = 0; d.sub = 0;
        if (u.kind == 0) e0(acc, d, wr, wc, fr, fq); else if (u.kind == 1) e1(acc, d, wr, wc, fr, fq); else e2(acc, d, wr, wc, fr, fq); }
    __device__ __forceinline__ void fused(f32x4 (&)[2][2][4][2], const pg8::UnitG&, int, int, int, int, PG8_LAS unsigned char*, int, int) const {}
};
struct EpiM3 {
    EpiXO e0; EpiGN e1;
    __device__ __forceinline__ bool after_drain(const pg8::UnitG& u) const { return u.kind == 1; }
    __device__ __forceinline__ void operator()(const f32x4 (&acc)[2][2][4][2], const pg8::UnitG& u, int wr, int wc, int fr, int fq) const { Unit d; d.pm = 0; d.pn = 0; d.sub = 0; e0(acc, d, wr, wc, fr, fq); }
    __device__ __forceinline__ void fused(f32x4 (&acc)[2][2][4][2], const pg8::UnitG&, int wr, int wc, int fr, int fq, PG8_LAS unsigned char* lds, int wid, int lane) const {
        Unit d; d.pm = 0; d.pn = 0; d.sub = 0; e1.fused(acc, d, wr, wc, fr, fq, lds, wid, lane); }
};
#undef MK_ROWS_BEGIN
#undef MK_ROWS_END
#undef MK_ROWS_END_NB
#undef MK_ROWS_END2
#undef MK_RL
}

namespace na {
using bf16 = unsigned short;
using bf16x8 = __attribute__((ext_vector_type(8))) short;
using s16x4  = __attribute__((ext_vector_type(4))) short;
using f32x16 = __attribute__((ext_vector_type(16))) float;
using f32x4  = __attribute__((ext_vector_type(4))) float;
using u32x4  = __attribute__((ext_vector_type(4))) unsigned;
constexpr int DH = 128, NW = 8, QBLK = 32, KVBLK = 64, LDQ = 3072;
constexpr size_t SHM_V = KVBLK * DH * 2, SHM_K = KVBLK * DH * 2;
constexpr int NBUF = 3;
constexpr int OFF_RK = NBUF * SHM_V + NBUF * SHM_K;
constexpr int OFF_BIAS = OFF_RK + 768 * 4;
constexpr int BIAS_PAD = 64, BIAS_N = 64 + 15 * 31 + 79;
constexpr int OFF_LI = OFF_BIAS + ((BIAS_N * 4 + 15) / 16) * 16;
constexpr int NA_LDS_BYTES = OFF_LI + NW * 64 * 4;
#define KSWZ(row, colB) ((row) * 256 + ((colB) ^ (((row) & 7) << 4)))
#define SBAR() __builtin_amdgcn_sched_barrier(0)
__device__ __forceinline__ int crow(int r, int hi) { return (r & 3) + 8 * (r >> 2) + 4 * hi; }
__device__ __forceinline__ unsigned cvtpk(float lo, float hi) { return pg8::cvt_pk_bf16(lo, hi); }

__device__ __forceinline__ void procP(f32x16& p0, f32x16& p1, float& lsum, bool inwin, const float* rk_t  , const float* bias_l  ,
                                      float rqs, int cs, int hi) {
  if (!inwin) { p0 = f32x16{}; p1 = f32x16{}; return; }
#pragma unroll
  for (int g = 0; g < 4; ++g) {
    const f32x4 k0 = *(const f32x4*)(rk_t + 8 * g + 4 * hi), k1 = *(const f32x4*)(rk_t + 32 + 8 * g + 4 * hi);
#pragma unroll
    for (int e = 0; e < 4; ++e) { const int r = 4 * g + e; const int w0 = e + 8 * g + 4 * hi, w1 = w0 + 32;
      const float x0 = fmaf(p0[r], rqs * k0[e], bias_l[w0]), x1 = fmaf(p1[r], rqs * k1[e], bias_l[w1]);
      const float e0 = __builtin_amdgcn_exp2f(x0), e1 = __builtin_amdgcn_exp2f(x1);
      const float v0 = ((unsigned)(w0 - cs) < 16u) ? e0 : 0.f, v1 = ((unsigned)(w1 - cs) < 16u) ? e1 : 0.f;
      p0[r] = v0; p1[r] = v1; lsum += v0 + v1; }
  }
}
__device__ __forceinline__ void packP(const f32x16& p0, const f32x16& p1, bf16x8& pa0, bf16x8& pa1, bf16x8& pa2, bf16x8& pa3) {
#define PK4(P, BASE, OUT) do { unsigned a0 = cvtpk(P[BASE + 0], P[BASE + 1]), a1 = cvtpk(P[BASE + 2], P[BASE + 3]);   \
    unsigned b0 = cvtpk(P[BASE + 4], P[BASE + 5]), b1 = cvtpk(P[BASE + 6], P[BASE + 7]);                              \
    auto r0 = __builtin_amdgcn_permlane32_swap(a0, b0, false, false); auto r1 = __builtin_amdgcn_permlane32_swap(a1, b1, false, false); \
    u32x4 w = {r0[0], r1[0], r0[1], r1[1]}; OUT = *reinterpret_cast<bf16x8*>(&w); } while (0)
  PK4(p0, 0, pa0); PK4(p0, 8, pa1); PK4(p1, 0, pa2); PK4(p1, 8, pa3);
#undef PK4
}
__device__ __forceinline__ void qkt(f32x16& p0, f32x16& p1, const bf16* Ks, const bf16x8* qr, int r32, int hi) {
  p0 = f32x16{}; p1 = f32x16{};
#pragma unroll
  for (int d0 = 0; d0 < 8; ++d0) { int cb = (d0 * 16 + hi * 8) * 2;
    bf16x8 b0 = *reinterpret_cast<const bf16x8*>((const char*)Ks + KSWZ(r32, cb));
    bf16x8 b1 = *reinterpret_cast<const bf16x8*>((const char*)Ks + KSWZ(32 + r32, cb));
    p0 = __builtin_amdgcn_mfma_f32_32x32x16_bf16(b0, qr[d0], p0, 0, 0, 0);
    p1 = __builtin_amdgcn_mfma_f32_32x32x16_bf16(b1, qr[d0], p1, 0, 0, 0); }
}
__device__ __forceinline__ int v_st(int k, int c) { const int kk = (k & ~0xC) | ((k & 4) << 1) | ((k & 8) >> 1); return ((kk >> 3) * 4 + (c >> 5)) * 512 + ((kk & 7) * 32 + (c & 31)) * 2; }
__device__ __forceinline__ int v_rd_base(int lane) { return ((lane & 3) << 3) | (((lane >> 2) & 3) << 6) | (((lane >> 4) & 1) << 5) | (((lane >> 5) & 1) << 8); }
constexpr int v_rd_off(int d0, int ks, int half) { return d0 * 512 + ks * 4096 + half * 2048; }
template <int OFF> __device__ __forceinline__ s16x4 tr_read(int vb) {
  s16x4 r; asm volatile("ds_read_b64_tr_b16 %0, %1 offset:%2" : "=&v"(r) : "v"(vb), "i"(OFF) : "memory"); return r;
}
template <int D0> __device__ __forceinline__ void pv_one(f32x16& od, int vb, bf16x8 pa0, bf16x8 pa1, bf16x8 pa2, bf16x8 pa3) {
  const s16x4 l0 = tr_read<v_rd_off(D0, 0, 0)>(vb), h0 = tr_read<v_rd_off(D0, 0, 1)>(vb), l1 = tr_read<v_rd_off(D0, 1, 0)>(vb), h1 = tr_read<v_rd_off(D0, 1, 1)>(vb);
  const s16x4 l2 = tr_read<v_rd_off(D0, 2, 0)>(vb), h2 = tr_read<v_rd_off(D0, 2, 1)>(vb), l3 = tr_read<v_rd_off(D0, 3, 0)>(vb), h3 = tr_read<v_rd_off(D0, 3, 1)>(vb);
  asm volatile("s_waitcnt lgkmcnt(0)" ::: "memory"); SBAR();
#define PK(L, H) (bf16x8){L[0], L[1], L[2], L[3], H[0], H[1], H[2], H[3]}
  od = __builtin_amdgcn_mfma_f32_32x32x16_bf16(pa0, PK(l0, h0), od, 0, 0, 0);
  od = __builtin_amdgcn_mfma_f32_32x32x16_bf16(pa1, PK(l1, h1), od, 0, 0, 0);
  od = __builtin_amdgcn_mfma_f32_32x32x16_bf16(pa2, PK(l2, h2), od, 0, 0, 0);
  od = __builtin_amdgcn_mfma_f32_32x32x16_bf16(pa3, PK(l3, h3), od, 0, 0, 0);
#undef PK
}
__device__ __forceinline__ void pv_d0(f32x16* o, int vb, bf16x8 pa0, bf16x8 pa1, bf16x8 pa2, bf16x8 pa3) {
  pv_one<0>(o[0], vb, pa0, pa1, pa2, pa3); pv_one<1>(o[1], vb, pa0, pa1, pa2, pa3); pv_one<2>(o[2], vb, pa0, pa1, pa2, pa3); pv_one<3>(o[3], vb, pa0, pa1, pa2, pa3);
}

__device__ __forceinline__ void na_unit(int b, int h, int i4, const bf16* __restrict__ qkv, const float* __restrict__ ssq_q, const float* __restrict__ ssq_k,
                                        const float* __restrict__ rpb, bf16* __restrict__ ona, char* lds) {
  int tid_ = threadIdx.x; asm volatile("" : "+v"(tid_));
  const int tid = tid_, wid = __builtin_amdgcn_readfirstlane(tid >> 6), lane = tid & 63, r32 = lane & 31, hi = lane >> 5;
  bf16* V_lds = (bf16*)lds; bf16* K_lds = (bf16*)(lds + NBUF * SHM_V);
  float* rkL = (float*)(lds + OFF_RK); float* biasL = (float*)(lds + OFF_BIAS); float* li_l = (float*)(lds + OFF_LI) + wid * 64;
  const int NT = (i4 == 0 || i4 == 15) ? 8 : 11, rbase = (i4 == 0) ? 0 : ((i4 == 15) ? 56 : 4 * i4 - 4);
  const int qrow = 4 * i4 + (wid >> 1), qc = 32 * (wid & 1) + r32;
  int rs = qrow - 4; rs = rs < 0 ? 0 : (rs > 56 ? 56 : rs);
  int cs = qc - 8; cs = cs < 0 ? 0 : (cs > 48 ? 48 : cs);
  const size_t tok_q = (size_t)b * 4096 + qrow * 64 + qc, tok_k0 = (size_t)b * 4096 + rbase * 64;
  for (int i = tid; i < NT * 64; i += 512) { const f32x4 p = *(const f32x4*)(ssq_k + (tok_k0 + i) * 32 + h * 4); rkL[i] = rsqrtf(((p[0] + p[1]) + (p[2] + p[3])) * (1.0f / 128.0f) + 1e-6f); }
  for (int i = tid; i < BIAS_N; i += 512) { const int j = i - BIAS_PAD; biasL[i] = (j >= 0 && j < 15 * 31) ? rpb[h * 465 + j] * 1.4426950408889634f : 0.f; }
  float rqs; { const f32x4 p = *(const f32x4*)(ssq_q + tok_q * 32 + h * 4); rqs = rsqrtf(((p[0] + p[1]) + (p[2] + p[3])) * (1.0f / 128.0f) + 1e-6f) * 1.4426950408889634f; }
  float l_reg = 0; f32x16 o[4] = {}; bf16x8 qr[8];
  const bf16* Qw = qkv + tok_q * LDQ + h * 128 + hi * 8;
#pragma unroll
  for (int d0 = 0; d0 < 8; ++d0) qr[d0] = *reinterpret_cast<const bf16x8*>(Qw + d0 * 16);
  const bf16* Kh = qkv + tok_k0 * LDQ + 1024 + h * 128; const bf16* Vh = qkv + tok_k0 * LDQ + 2048 + h * 128;
  const int sr = tid >> 4, sc = (tid & 15) * 8, vst0 = v_st(sr, sc), vst1 = v_st(32 + sr, sc);
  const int vb0 = (int)(uintptr_t)V_lds + v_rd_base(lane);
  struct { bf16x8 vs0, vs1, ks0, ks1; } sr_[2];
#define SLOAD(i, k0) do { sr_[i].vs0 = *(const bf16x8*)(&Vh[(long)((k0) + sr) * LDQ + sc]); sr_[i].vs1 = *(const bf16x8*)(&Vh[(long)((k0) + 32 + sr) * LDQ + sc]); \
    sr_[i].ks0 = *(const bf16x8*)(&Kh[(long)((k0) + sr) * LDQ + sc]); sr_[i].ks1 = *(const bf16x8*)(&Kh[(long)((k0) + 32 + sr) * LDQ + sc]); } while (0)
#define SWRITE(bb, i) do { *(bf16x8*)((char*)V_lds + (bb) * SHM_V + vst0) = sr_[i].vs0;          \
    *(bf16x8*)((char*)V_lds + (bb) * SHM_V + vst1) = sr_[i].vs1; int kc = sc * 2;               \
    *(bf16x8*)((char*)K_lds + (bb) * SHM_K + KSWZ(sr, kc)) = sr_[i].ks0;                       \
    *(bf16x8*)((char*)K_lds + (bb) * SHM_K + KSWZ(32 + sr, kc)) = sr_[i].ks1; } while (0)
#define SWAIT() asm volatile("s_waitcnt vmcnt(0)" ::: "memory")
#define TILE_ARGS(j) ((unsigned)(rbase + (j) - rs) < 8u), rkL + (j) * 64, biasL + BIAS_PAD + (rbase + (j) - qrow + 7) * 31 + 15 - qc, rqs, cs, hi
  f32x16 p0, p1; bf16x8 pa0, pa1, pa2, pa3;
#define NA_TILE(j, bo) do { if ((unsigned)(rbase + (j) - rs) < 8u) {     \
      SBAR(); qkt(p0, p1, (const bf16*)((const char*)K_lds + (bo) * SHM_K), qr, r32, hi); \
      procP(p0, p1, l_reg, TILE_ARGS(j)); \
      packP(p0, p1, pa0, pa1, pa2, pa3); SBAR(); \
      pv_d0(o, vb0 + (bo) * (int)SHM_V, pa0, pa1, pa2, pa3); } } while (0)
  SLOAD(0, 0); SLOAD(1, KVBLK); SWRITE(0, 0); SLOAD(0, 2 * KVBLK); SWRITE(1, 1); SLOAD(1, 3 * KVBLK); __syncthreads();
  int b0 = 0;
  for (int j = 0; j < NT; j += 2) {
    const int b1 = (b0 == 2) ? 0 : b0 + 1, b2 = (b1 == 2) ? 0 : b1 + 1;
    NA_TILE(j, b0);
    if (j + 2 < NT) { SWRITE(b2, 0); if (j + 4 < NT) SLOAD(0, (j + 4) * KVBLK); }
    __syncthreads();
    if (j + 1 < NT) NA_TILE(j + 1, b1);
    if (j + 3 < NT) { SWRITE(b0, 1); if (j + 5 < NT) SLOAD(1, (j + 5) * KVBLK); }
    __syncthreads();
    b0 = b2;
  }
#undef NA_TILE
  { auto rr = __builtin_amdgcn_permlane32_swap(__float_as_uint(l_reg), __float_as_uint(l_reg), false, false); l_reg = __uint_as_float(rr[0]) + __uint_as_float(rr[1]); }
  if (hi == 0) li_l[r32] = l_reg; asm volatile("s_waitcnt lgkmcnt(0)" ::: "memory");
  float rli[16];
#pragma unroll
  for (int r = 0; r < 16; ++r) rli[r] = __builtin_amdgcn_rcpf(li_l[crow(r, hi)]);
  bf16* Ow = ona + ((size_t)b * 4096 + qrow * 64 + 32 * (wid & 1)) * 2048 + h * 128;
#pragma unroll
  for (int r = 0; r < 16; ++r) { const int orow = crow(r, hi);
#pragma unroll
    for (int d0 = 0; d0 < 4; ++d0) { const float v = o[d0][r] * rli[r]; unsigned u = __float_as_uint(v); u += 0x7fffu + ((u >> 16) & 1u); Ow[(size_t)orow * 2048 + d0 * 32 + r32] = (bf16)(u >> 16); } }
  __syncthreads();
#undef SLOAD
#undef SWRITE
#undef SWAIT
#undef TILE_ARGS
}
#undef KSWZ
#undef SBAR
}

constexpr int NWAVES = 8;
constexpr int RING_OFF = 0, RING_BYTES = 131072;
constexpr int LDSCTL_OFF = RING_BYTES, MISC_OFF = LDSCTL_OFF + 320;
constexpr int LDS_BYTES = 147456;
static_assert(MISC_OFF + 128 <= LDS_BYTES && na::NA_LDS_BYTES <= RING_BYTES, "LDS map");
constexpr int CW_TMO = 0, CW_P0A = 64, CW_BAR = 4096;
static_assert((CW_BAR + 3456) * 4 <= (int)mk::CTL_ZERO_BYTES, "control words inside the per-call memset");

#define GAS __attribute__((address_space(1)))
#define LAS __attribute__((address_space(3)))
typedef unsigned short bf16;
typedef unsigned v4u __attribute__((ext_vector_type(4)));
typedef float f32x4 __attribute__((ext_vector_type(4)));
typedef GAS unsigned gu32;
#define LDS_WAIT() asm volatile("s_waitcnt lgkmcnt(0)" ::: "memory")
#define VM_WAIT() asm volatile("s_waitcnt vmcnt(0)" ::: "memory")
__device__ __forceinline__ unsigned f2bf(float f) { unsigned u = __builtin_bit_cast(unsigned, f); return (u + 0x7fffu + ((u >> 16) & 1u)) >> 16; }
__device__ __forceinline__ unsigned pk2(float lo, float hi) { return f2bf(lo) | (f2bf(hi) << 16); }
__device__ __forceinline__ float bf2f_(unsigned h) { return __uint_as_float(h << 16); }

#define XB_TMO      128
#define XB_XCNT(j)  (256  + 64 * (j))
#define XB_XSUB(j)  (1280 + 64 * (j))
#define XB_XGEN(j)  (2304 + 64 * (j))
#define XB_TOP      3328
#define XB_TOPGEN   3392
#define XCD_BAR_WORDS 3456
#define XB_SPIN_CAP (1u << 18)
__device__ __forceinline__ unsigned xb_ld(unsigned* p)              { return __hip_atomic_load(p, __ATOMIC_RELAXED, __HIP_MEMORY_SCOPE_AGENT); }
__device__ __forceinline__ unsigned xb_add(unsigned* p, unsigned v) { return __hip_atomic_fetch_add(p, v, __ATOMIC_RELAXED, __HIP_MEMORY_SCOPE_AGENT); }
__device__ __forceinline__ unsigned xb_xcc_id() { return (unsigned)__builtin_amdgcn_s_getreg((3 << 11) | 20) & 0xFu; }
#define XB_SPIN(cond, bar) do { unsigned _sp = 0; while (cond) { __builtin_amdgcn_s_sleep(1); \
    if ((++_sp & 255u) == 0u) { if (xb_ld(&(bar)[XB_TMO])) break; if (_sp > XB_SPIN_CAP) { atomicAdd(&(bar)[XB_TMO], 1u); break; } } } } while (0)
struct XcdBarrier { unsigned* bar; unsigned x; volatile LAS unsigned* st; };
__device__ __forceinline__ XcdBarrier xcd_barrier_post(unsigned* bar, volatile LAS unsigned* st) {
    XcdBarrier b; b.bar = bar; b.x = xb_xcc_id(); b.st = st;
    if (threadIdx.x == 0) (void)xb_add(&bar[XB_XCNT(b.x)], 1u);
    return b;
}
__device__ __forceinline__ void xcd_barrier_complete(unsigned* bar, unsigned x, unsigned& nloc, unsigned& nx) {
    const unsigned G = gridDim.x * gridDim.y * gridDim.z;
    unsigned sum, cnt, mine, sp = 0u;
    for (;;) {
        sum = 0u; cnt = 0u; mine = 0u;
#pragma unroll
        for (unsigned j = 0; j < 16; ++j) { const unsigned c = xb_ld(&bar[XB_XCNT(j)]); sum += c; cnt += (c > 0u) ? 1u : 0u; mine = (j == x) ? c : mine; }
        if (sum == G) break;
        __builtin_amdgcn_s_sleep(1);
        if ((++sp & 255u) == 0u) { if (xb_ld(&bar[XB_TMO])) break; if (sp > XB_SPIN_CAP) { atomicAdd(&bar[XB_TMO], 1u); break; } }
    }
    nloc = mine > 0u ? mine : 1u; nx = cnt > 0u ? cnt : 1u;
}
__device__ __forceinline__ void xcd_barrier(const XcdBarrier& b) {
    asm volatile("s_waitcnt vmcnt(0)" ::: "memory");
    __syncthreads();
    if (threadIdx.x == 0) {
        unsigned* bar = b.bar;
        __builtin_amdgcn_s_waitcnt(0);
        unsigned nloc = b.st[0], nx = b.st[1];
        if (nloc == 0u) { xcd_barrier_complete(bar, b.x, nloc, nx); b.st[0] = nloc; b.st[1] = nx; }
        const unsigned old = xb_add(&bar[XB_XSUB(b.x)], 1u);
        const unsigned gen = old / nloc;
        if (old + 1u == (gen + 1u) * nloc) {
            __builtin_amdgcn_fence(__ATOMIC_RELEASE, "agent");
            asm volatile("s_waitcnt vmcnt(0)" ::: "memory");
            const unsigned og = xb_add(&bar[XB_TOP], 1u);
            const unsigned tg = og / nx;
            if (og + 1u == (tg + 1u) * nx) xb_add(&bar[XB_TOPGEN], 1u);
            else XB_SPIN(xb_ld(&bar[XB_TOPGEN]) == tg, bar);
            __builtin_amdgcn_fence(__ATOMIC_ACQUIRE, "agent");
            xb_add(&bar[XB_XGEN(b.x)], 1u);
            asm volatile("s_waitcnt vmcnt(0)" ::: "memory");
        } else {
            XB_SPIN(xb_ld(&bar[XB_XGEN(b.x)]) == gen, bar);
            __builtin_amdgcn_fence(__ATOMIC_ACQUIRE, "agent");
            asm volatile("s_waitcnt vmcnt(0)" ::: "memory");
        }
    }
    __syncthreads();
}

__device__ __forceinline__ float wave_sum(float v) {
#pragma unroll
    for (int o = 1; o < 64; o <<= 1) v += __shfl_xor(v, o);
    return v;
}
__device__ __forceinline__ void p0_item(const float* __restrict__ W, int ldw, int k0, int n0, bf16* __restrict__ WT, int ldt, int dA, int dB, const float* __restrict__ kscale, LAS float* scr, int lane) {
    const int c16 = lane & 15, kr = lane >> 4;
#pragma unroll
    for (int it = 0; it < 16; ++it) { const int k = 4 * it + kr;
        f32x4 v = __builtin_nontemporal_load((const f32x4*)(W + (size_t)(k0 + k) * ldw + n0 + 4 * c16));
        if (kscale) v = v * kscale[k0 + k];
        *(LAS f32x4*)(scr + k * 64 + ((4 * c16) ^ (8 * ((k >> 3) & 7)))) = v; }
    LDS_WAIT(); asm volatile("" ::: "memory");
    const int c = lane & 7;
#pragma unroll
    for (int j = 0; j < 8; ++j) { const int n = (lane >> 3) + 8 * j; const LAS float* s = scr + (8 * c) * 64 + (n ^ (8 * c));
        v4u o; o.x = pk2(s[0 * 64], s[1 * 64]); o.y = pk2(s[2 * 64], s[3 * 64]); o.z = pk2(s[4 * 64], s[5 * 64]); o.w = pk2(s[6 * 64], s[7 * 64]);
        const int drow = (n < 32) ? dA + n : dB + n - 32;
        *(GAS v4u*)(WT + (size_t)drow * ldt + k0 + 8 * c) = o; }
    LDS_WAIT(); asm volatile("" ::: "memory");
}
struct P0Desc { const float* src; bf16* dst; int ldw, ldt, dA, dB, nt; };
__device__ __forceinline__ void p0_load(const P0Desc& d, f32x4 (&R)[16], int lane) {
    const int c16 = lane & 15, kr = lane >> 4;
#pragma unroll
    for (int it = 0; it < 16; ++it) R[it] = __builtin_nontemporal_load((const f32x4*)(d.src + (size_t)(4 * it + kr) * d.ldw + 4 * c16));
}
__device__ __forceinline__ void p0_to_lds(const f32x4 (&R)[16], LAS float* scr, int lane) {
    const int c16 = lane & 15, kr = lane >> 4;
#pragma unroll
    for (int it = 0; it < 16; ++it) { const int k = 4 * it + kr; *(LAS f32x4*)(scr + k * 64 + ((4 * c16) ^ (8 * ((k >> 3) & 7)))) = R[it]; }
}
__device__ __forceinline__ void p0_store(const P0Desc& d, LAS float* scr, int lane) {
    const int c = lane & 7;
#pragma unroll
    for (int j = 0; j < 8; ++j) { const int n = (lane >> 3) + 8 * j; const LAS float* s = scr + (8 * c) * 64 + (n ^ (8 * c));
        v4u o; o.x = pk2(s[0 * 64], s[1 * 64]); o.y = pk2(s[2 * 64], s[3 * 64]); o.z = pk2(s[4 * 64], s[5 * 64]); o.w = pk2(s[6 * 64], s[7 * 64]);
        const int drow = (n < 32) ? d.dA + n : d.dB + n - 32;
        GAS v4u* q = (GAS v4u*)(d.dst + (size_t)drow * d.ldt + 8 * c); if (d.nt) __builtin_nontemporal_store(o, q); else *q = o; }
}
__device__ __forceinline__ void rms_row_to_bf16(const float* __restrict__ xrow, const float* __restrict__ g, bf16* __restrict__ orow, int lane) {
    const f32x4* xr = (const f32x4*)xrow + lane; const f32x4* gr = (const f32x4*)g + lane;
    f32x4 v[8]; float s = 0.f;
#pragma unroll
    for (int j = 0; j < 8; ++j) { v[j] = __builtin_nontemporal_load(xr + 64 * j); s += (v[j].x * v[j].x + v[j].y * v[j].y) + (v[j].z * v[j].z + v[j].w * v[j].w); }
    const float r = rsqrtf(wave_sum(s) * (1.f / 2048.f) + mk::EPS);
    unsigned long long* o8 = (unsigned long long*)orow + lane;
#pragma unroll
    for (int j = 0; j < 8; ++j) { const f32x4 gg = gr[64 * j]; o8[64 * j] = (unsigned long long)pk2(v[j].x * r * gg.x, v[j].y * r * gg.y) | ((unsigned long long)pk2(v[j].z * r * gg.z, v[j].w * r * gg.w) << 32); }
}
__device__ __forceinline__ int win_dest_row(int n32  ) {
    const int pn = n32 >> 3, ga = n32 & 7;
    if (pn < 12 || pn >= 20) return n32 * 32;
    const int gs = 4 * ((ga >> 1) & 1) + 2 * (ga >> 2) + (ga & 1);
    return (pn * 8 + gs) * 32;
}

#ifndef MK_TS
#define MK_TS_ -1
#else
#define MK_TS_ MK_TS
#endif
struct Args { const float* in[21]; float* out; unsigned char* ws; };

__global__ void __launch_bounds__(NWAVES * 64, 2) mk_fwd(Args args) {
    extern __shared__ __attribute__((aligned(16))) unsigned char lds[];
    LAS unsigned char* ldsl = (LAS unsigned char*)lds;
    volatile LAS unsigned* MISC = (volatile LAS unsigned*)(ldsl + MISC_OFF);
    const int tid = threadIdx.x, lane = tid & 63, wave = __builtin_amdgcn_readfirstlane(tid >> 6);
    const int G = gridDim.x, bx = blockIdx.x;
    const int vcu = (G % 8 == 0) ? (bx % 8) * (G / 8) + bx / 8 : bx;
    unsigned char* ws = args.ws; unsigned char* dob = (unsigned char*)args.out;
    gu32* ctl = (gu32*)(ws + mk::WS_CTL);
#define I_x args.in[0]
#define I_mem args.in[1]
#define I_g_mix args.in[2]
#define I_w_in args.in[3]
#define I_gq args.in[4]
#define I_gk args.in[5]
#define I_rpb args.in[6]
#define I_lgf_in args.in[7]
#define I_lgb_in args.in[8]
#define I_gn args.in[9]
#define I_g_mem args.in[10]
#define I_w_mkv args.in[11]
#define I_gxq args.in[12]
#define I_gxk args.in[13]
#define I_w_na args.in[14]
#define I_w_ret args.in[15]
#define I_w_memb args.in[16]
#define I_w_out args.in[17]
#define I_g_ffn args.in[18]
#define I_w_ff1 args.in[19]
#define I_w_ff2 args.in[20]
#define I_out args.out
#define cosT ((float*)(ws + mk::WS_COS))
#define sinT ((float*)(ws + mk::WS_SIN))
#define ssq_naq ((float*)(ws + mk::WS_SSQ_NAQ))
#define ssq_nak ((float*)(ws + mk::WS_SSQ_NAK))
#define ssq_xq ((float*)(ws + mk::WS_SSQ_XQ))
#define xl ((float*)(ws + mk::WS_XL))
#define ssq_x1 ((float*)(ws + mk::WS_SSQ_X1))
#define tab ((float*)(ws + mk::WS_TAB))
#define MEMN ((bf16*)(ws + mk::WS_MEMN))
#define MKb ((bf16*)(ws + mk::WS_MK))
#define MVT ((bf16*)(ws + mk::WS_MVT))
#define WinT ((bf16*)(ws + mk::WS_WIN))
#define Wff1T ((bf16*)(ws + mk::WS_WFF1))
#define Wff2T ((bf16*)(ws + mk::WS_WFF2))
#define WretT ((bf16*)(ws + mk::WS_WRET))
#define WoutT ((bf16*)(ws + mk::WS_WOUT))
#define WnmT ((bf16*)(ws + mk::WS_WNM))
#define WmkvT ((bf16*)(ws + mk::WS_WMKV))
#define NAQKV ((bf16*)(ws + mk::WS_NAQKV))
#define K0 ((bf16*)(ws + mk::WS_K0))
#define RG ((bf16*)(ws + mk::WS_RG))
#define XQ ((bf16*)(ws + mk::WS_XQ))
#define GATES ((bf16*)(ws + mk::WS_GATES))
#define AR ((bf16*)(ws + mk::WS_AR))
#define BR ((bf16*)(ws + mk::WS_BR))
#define KV ((bf16*)(ws + mk::WS_KV))
#define ORET ((bf16*)(ws + mk::WS_ORET))
#define MERGED ((bf16*)(ws + mk::WS_MERGED))
#define X1B ((bf16*)(ws + mk::WS_X1B))
#define HFF ((bf16*)(ws + mk::WS_HFF))
#define HN ((bf16*)(dob + mk::DO_HN))
#define KT ((bf16*)(dob + mk::DO_KT))
#define XP ((bf16*)(dob + mk::DO_XP))
#define ONM ((bf16*)(dob + mk::DO_ONM))
    for (int u = tid; u < (LDS_BYTES - LDSCTL_OFF) / 4; u += NWAVES * 64) ((LAS unsigned*)(ldsl + LDSCTL_OFF))[u] = 0u;
    __syncthreads();
    XcdBarrier bar = xcd_barrier_post((unsigned*)(ctl + CW_BAR), MISC + 8);
#define GRID_BAR() do { xcd_barrier(bar); MK_STAMP(); } while (0)
#define MK_STAMP() PG8_DBG_STAMP()
    MK_STAMP();
    LAS float* scr = (LAS float*)(ldsl + RING_OFF + wave * 16384);
    const int gw = vcu * NWAVES + wave, NGW = G * NWAVES;

    {
    if (vcu < 16) {
        if (tid == 0) {
            unsigned sp = 0; while (__hip_atomic_load((unsigned*)(ctl + CW_P0A), __ATOMIC_RELAXED, __HIP_MEMORY_SCOPE_AGENT) < (unsigned)(G - 16)) { __builtin_amdgcn_s_sleep(2); if (++sp > (1u << 22)) break; }
            __builtin_amdgcn_fence(__ATOMIC_ACQUIRE, "agent"); asm volatile("s_waitcnt vmcnt(0)" ::: "memory");
        }
        __syncthreads();
        mk::SchedOne S; S.has = true; const pg8::Gemm g{2048, 2048, 2048};
        mk::EpiMKV E{MKb, MVT, tab, tab, 0};
        if (vcu < 8) { S.u.pm = vcu >> 2; S.u.pn = vcu & 3; S.a = (const char*)(MEMN + (size_t)S.u.pm * 256 * 2048); S.b = (const char*)(WmkvT + (size_t)S.u.pn * 256 * 2048); E.mode = 0; }
        else { const int c = vcu - 8; S.u.pm = c >> 1; S.u.pn = c & 1; S.a = (const char*)(WmkvT + (size_t)(1024 + S.u.pm * 256) * 2048); S.b = (const char*)(MEMN + (size_t)S.u.pn * 256 * 2048); E.mode = 1; }
        pg8::gemm_phase<mk::EpiMKV, mk::SchedOne, false>(ldsl + RING_OFF, g, S, E);
    } else {
        const int gw2 = (vcu - 16) * NWAVES + wave, NGW2 = (G - 16) * NWAVES;
        {
            for (int i = gw2 * 64 + lane; i < 4096 * 64; i += NGW2 * 64) { const int s = i >> 6, f = i & 63;
                const float inv = powf(10000.0f, -(float)f / 64.0f), ang = (float)s * inv; cosT[i] = cosf(ang); sinT[i] = sinf(ang); }
            if (vcu == 16) {
                if (tid < 128) tab[mk::TAB_CS_NAQ + tid] = I_gq[tid] * I_gk[tid] * 0.08838834764831845f;
                if (tid < 256) tab[mk::TAB_CS_MK + tid] = I_gxq[tid] * I_gxk[tid] * 0.0625f;
                if (tid < 8) { tab[mk::TAB_L2F + tid] = -log1pf(expf(-I_lgf_in[tid])) * mk::LOG2E; tab[mk::TAB_L2B + tid] = -log1pf(expf(-I_lgb_in[tid])) * mk::LOG2E; }
            }
            for (int m = gw2; m < 512; m += NGW2) rms_row_to_bf16(I_mem + (size_t)m * 2048, I_g_mem, MEMN + (size_t)m * 2048, lane);
            for (int it = gw2; it < 32 * 32; it += NGW2) { const int kb = it >> 5, nb = it & 31; p0_item(I_w_mkv, 2048, 64 * kb, 64 * nb, WmkvT, 2048, 64 * nb, 64 * nb + 32, nullptr, scr, lane); }
            VM_WAIT(); __syncthreads();
            if (tid == 0) { __builtin_amdgcn_fence(__ATOMIC_RELEASE, "agent"); asm volatile("s_waitcnt vmcnt(0)" ::: "memory");
                (void)__hip_atomic_fetch_add((unsigned*)(ctl + CW_P0A), 1u, __ATOMIC_RELAXED, __HIP_MEMORY_SCOPE_AGENT); }
        }
        constexpr int I_IN = 32 * 256, I_FF1 = 32 * 128, I_FF2 = 128 * 32, I_RET = 32 * 32, I_OUT = 32 * 32, I_NA = 16 * 32, I_MEM = 16 * 32;
        constexpr int NITEMS = I_IN + I_FF1 + I_FF2 + I_RET + I_OUT + I_NA + I_MEM;
#define P0_DECODE(d, item) do { int r = (item); \
            if (r < I_IN) { const int kb = r >> 8, nb = r & 255; d.src = I_w_in + (size_t)(64 * kb) * 16384 + 64 * nb; d.ldw = 16384; d.dst = WinT + 64 * kb; d.ldt = 2048; d.dA = win_dest_row(2 * nb); d.dB = win_dest_row(2 * nb + 1); d.nt = 0; break; } r -= I_IN; \
            if (r < I_FF1) { const int kb = r >> 7, nb = r & 127; d.src = I_w_ff1 + (size_t)(64 * kb) * 8192 + 64 * nb; d.ldw = 8192; d.dst = Wff1T + 64 * kb; d.ldt = 2048; d.dA = 64 * nb; d.dB = 64 * nb + 32; d.nt = 1; break; } r -= I_FF1; \
            if (r < I_FF2) { const int kb = r >> 5, nb = r & 31; d.src = I_w_ff2 + (size_t)(64 * kb) * 2048 + 64 * nb; d.ldw = 2048; d.dst = Wff2T + 64 * kb; d.ldt = 8192; d.dA = 64 * nb; d.dB = 64 * nb + 32; d.nt = 1; break; } r -= I_FF2; \
            if (r < I_RET) { const int kb = r >> 5, nb = r & 31; d.src = I_w_ret + (size_t)(64 * kb) * 2048 + 64 * nb; d.ldw = 2048; d.dst = WretT + 64 * kb; d.ldt = 2048; d.dA = 64 * nb; d.dB = 64 * nb + 32; d.nt = 1; break; } r -= I_RET; \
            if (r < I_OUT) { const int kb = r >> 5, nb = r & 31; d.src = I_w_out + (size_t)(64 * kb) * 2048 + 64 * nb; d.ldw = 2048; d.dst = WoutT + 64 * kb; d.ldt = 2048; d.dA = 64 * nb; d.dB = 64 * nb + 32; d.nt = 1; break; } r -= I_OUT; \
            if (r < I_NA) { const int kb = r >> 5, nb = r & 31; d.src = I_w_na + (size_t)(64 * kb) * 2048 + 64 * nb; d.ldw = 2048; d.dst = WnmT + 64 * kb; d.ldt = 2048; d.dA = 64 * nb; d.dB = 64 * nb + 32; d.nt = 1; break; } r -= I_NA; \
            { const int kb = r >> 5, nb = r & 31; d.src = I_w_memb + (size_t)(64 * kb) * 2048 + 64 * nb; d.ldw = 2048; d.dst = WnmT + 1024 + 64 * kb; d.ldt = 2048; d.dA = 64 * nb; d.dB = 64 * nb + 32; d.nt = 1; } } while (0)
        {
            f32x4 R0[16], R1[16]; P0Desc d0, d1; int it = gw2;
            if (it < NITEMS) { P0_DECODE(d0, it); p0_load(d0, R0, lane); }
            if (it + NGW2 < NITEMS) { P0_DECODE(d1, it + NGW2); p0_load(d1, R1, lane); }
            for (; it < NITEMS; it += 2 * NGW2) {
                p0_to_lds(R0, scr, lane); const P0Desc c0 = d0;
                if (it + 2 * NGW2 < NITEMS) { P0_DECODE(d0, it + 2 * NGW2); p0_load(d0, R0, lane); }
                LDS_WAIT(); asm volatile("" ::: "memory"); p0_store(c0, scr, lane); LDS_WAIT(); asm volatile("" ::: "memory");
                if (it + NGW2 < NITEMS) {
                    p0_to_lds(R1, scr, lane); const P0Desc c1 = d1;
                    if (it + 3 * NGW2 < NITEMS) { P0_DECODE(d1, it + 3 * NGW2); p0_load(d1, R1, lane); }
                    LDS_WAIT(); asm volatile("" ::: "memory"); p0_store(c1, scr, lane); LDS_WAIT(); asm volatile("" ::: "memory");
                }
            }
        }
#undef P0_DECODE
        for (int m = gw2; m < mk::M; m += NGW2) rms_row_to_bf16(I_x + (size_t)m * 2048, I_g_mix, HN + (size_t)m * 2048, lane);
    }
    GRID_BAR();
    }
    {
    {
        mk::SchedProj S; S.o.init(mk::M, mk::D_IN, G, bx); S.hn_ = (const char*)HN; S.wt_ = (const char*)WinT;
        const pg8::Gemm g{2048, 2048, 2048};
        mk::EpiProj E{ws};
        pg8::gemm_phase<mk::EpiProj, mk::SchedProj, true>(ldsl + RING_OFF, g, S, E);
    }
    GRID_BAR();
    }
    {
    {
        const int c = bx, bh = c >> 4, nc = c & 15, b = bh >> 3, h = bh & 7;
        const float l2f = tab[mk::TAB_L2F + h], l2b = tab[mk::TAB_L2B + h];
        {
            bf16* kt = KT + (size_t)c * 65536; const bf16* ksrc = K0 + ((size_t)b * 4096 + nc * 256) * 1024 + h * 128;
            LAS float* t = scr;
            const int tok0 = wave * 32;
#pragma unroll
            for (int it = 0; it < 8; ++it) { const int tr = 4 * it + (lane >> 4), c8 = (lane & 15) * 8; const v4u w = *(const v4u*)(ksrc + (size_t)(tok0 + tr) * 1024 + c8);
                LAS float* d = t + tr * 128 + (c8 ^ (8 * (tr >> 3))); d[0] = bf2f_(w.x & 0xffffu); d[1] = bf2f_(w.x >> 16); d[2] = bf2f_(w.y & 0xffffu); d[3] = bf2f_(w.y >> 16);
                d[4] = bf2f_(w.z & 0xffffu); d[5] = bf2f_(w.z >> 16); d[6] = bf2f_(w.w & 0xffffu); d[7] = bf2f_(w.w >> 16); }
            LDS_WAIT(); asm volatile("" ::: "memory");
            const int q = lane & 3;
            float df[8], db[8];
#pragma unroll
            for (int i = 0; i < 8; ++i) { const int tk = tok0 + 8 * q + i; df[i] = pg8::fexp2(l2f * (float)(255 - tk)); db[i] = pg8::fexp2(l2b * (float)tk); }
#pragma unroll
            for (int j = 0; j < 8; ++j) { const int dk = (lane >> 2) + 16 * j; const LAS float* s = t + (8 * q) * 128 + (dk ^ (8 * q));
                float v[8];
#pragma unroll
                for (int i = 0; i < 8; ++i) v[i] = s[i * 128];
                v4u o; o.x = pk2(v[0] * df[0], v[1] * df[1]); o.y = pk2(v[2] * df[2], v[3] * df[3]); o.z = pk2(v[4] * df[4], v[5] * df[5]); o.w = pk2(v[6] * df[6], v[7] * df[7]);
                *(GAS v4u*)(kt + (size_t)dk * 256 + tok0 + 8 * q) = o;
                o.x = pk2(v[0] * db[0], v[1] * db[1]); o.y = pk2(v[2] * db[2], v[3] * db[3]); o.z = pk2(v[4] * db[4], v[5] * db[5]); o.w = pk2(v[6] * db[6], v[7] * db[7]);
                *(GAS v4u*)(kt + (size_t)(128 + dk) * 256 + tok0 + 8 * q) = o; }
            VM_WAIT(); LDS_WAIT(); __syncthreads();
        }
        MK_STAMP();
        {
            bf16* arc = AR + ((size_t)bh * 4096 + nc * 256) * 512;
            mk::SchedList3 S; S.n = (bx < 128) ? 3 : 2;
            S.u0.a = (const char*)(BR + (size_t)c * 256 * 512); S.u0.b = (const char*)(KT + (size_t)c * 65536); S.u0.lda = 512; S.u0.ldb = 256; S.u0.nt = 4; S.u0.kind = 0; S.u0.perm = 1;
            S.u1.a = (const char*)(arc + 256); S.u1.b = (const char*)(K0 + ((size_t)b * 4096 + nc * 256) * 1024 + h * 128); S.u1.lda = 512; S.u1.ldb = 1024; S.u1.nt = 2; S.u1.kind = 1; S.u1.perm = 1;
            const int xb = (bx >> 6) & 1, xh = (bx >> 4) & 3, qt = bx & 15; const size_t tok0 = (size_t)xb * 4096 + qt * 256;
            S.u2.a = (const char*)(XQ + tok0 * 1024 + xh * 256); S.u2.b = (const char*)(MKb + (size_t)xb * 256 * 1024 + xh * 256); S.u2.lda = 1024; S.u2.ldb = 1024; S.u2.nt = 4; S.u2.kind = 2; S.u2.perm = 1;
            mk::EpiM1 E{mk::EpiF32{KV + (size_t)c * 65536}, mk::EpiP{arc, l2f, l2b},
                        mk::EpiXS{XP + tok0 * 1024 + xh * 256, xl + tok0 * 16 + xh * 4, ssq_xq + tok0 * 16 + xh * 4, tab + mk::TAB_SSQ_MK + (size_t)xb * 256 * 16 + xh * 4}};
            pg8::gemm_stream<mk::EpiM1, mk::SchedList3, true>(ldsl + RING_OFF, S, E);
        }
        MK_STAMP();
    }
    GRID_BAR();
    }
    {
    {
        for (int e = (vcu * 512 + tid); e < 16 * 65536; e += G * 512) {
            const int bh = e >> 16, r = e & 65535, col = r & 255, h = bh & 7;
            const bool fwd = col < 128; const float dec = pg8::fexp2((fwd ? tab[mk::TAB_L2F + h] : tab[mk::TAB_L2B + h]) * 256.0f);
            const bf16* kvp = KV + (size_t)bh * 16 * 65536 + r; bf16* brp = BR + ((size_t)bh * 16 * 256 + (r >> 8)) * 512 + 256 + col;
            float kvv[16];
#pragma unroll
            for (int n = 0; n < 16; ++n) kvv[n] = bf2f_(__builtin_nontemporal_load(kvp + (size_t)n * 65536));
            float s = 0.f;
            if (fwd) {
#pragma unroll
                for (int n = 0; n < 16; ++n) { brp[(size_t)n * 256 * 512] = (bf16)f2bf(s); s = dec * s + kvv[n]; }
            } else {
#pragma unroll
                for (int n = 15; n >= 0; --n) { brp[(size_t)n * 256 * 512] = (bf16)f2bf(s); s = dec * s + kvv[n]; }
            }
        }
        __syncthreads();
        MK_STAMP();
        { const int b = bx >> 7, h = (bx >> 4) & 7, i4 = bx & 15;
        na::na_unit(b, h, i4, NAQKV, ssq_naq, ssq_nak, I_rpb, ONM, (char*)lds); }
        MK_STAMP();
    }
    GRID_BAR();
    }
    {
    {
        const int c = bx, bh = c >> 4, nc = c & 15, b = bh >> 3, h = bh & 7;
        {
            const int xb = (bx >> 6) & 1, xh = (bx >> 4) & 3, qt = bx & 15; const size_t tok0 = (size_t)xb * 4096 + qt * 256;
            const size_t o0 = ((size_t)b * 4096 + nc * 256) * 2048 + h * 256;
            const bool hx = bx < 128;
            mk::SchedList3 S; S.n = hx ? 2 : 1;
            const char* const ra = (const char*)(AR + ((size_t)bh * 4096 + nc * 256) * 512); const char* const rb = (const char*)(BR + (size_t)c * 256 * 512);
            S.u0.a = hx ? (const char*)(XP + tok0 * 1024 + xh * 256) : ra; S.u0.b = hx ? (const char*)(MVT + (size_t)xh * 256 * 512 + xb * 256) : rb;
            S.u0.lda = hx ? 1024 : 512; S.u0.ldb = 512; S.u0.nt = hx ? 4 : 8; S.u0.kind = hx ? 0 : 1; S.u0.perm = 1;
            S.u1.a = ra; S.u1.b = rb; S.u1.lda = 512; S.u1.ldb = 512; S.u1.nt = 8; S.u1.kind = 1; S.u1.perm = 1;
            S.u2.a = ra; S.u2.b = rb; S.u2.lda = 512; S.u2.ldb = 512; S.u2.nt = 8; S.u2.kind = 1; S.u2.perm = 1;
            mk::EpiM3 E{mk::EpiXO{ONM + tok0 * 2048 + 1024 + xh * 256, xl + tok0 * 16 + xh * 4}, mk::EpiGN{ORET + o0, RG + o0, I_gn + h * 256}};
            pg8::gemm_stream<mk::EpiM3, mk::SchedList3, true>(ldsl + RING_OFF, S, E);
        }
        MK_STAMP();
    }
    GRID_BAR();
    }
    {
    {
        mk::SchedBR S; S.o.init(mk::M, 2048, G, bx); S.onm = (const char*)ONM; S.oret = (const char*)ORET; S.wnm = (const char*)WnmT; S.wret = (const char*)WretT;
        const pg8::Gemm g{2048, 2048, 1024}; mk::EpiGate4 E{MERGED, GATES};
        pg8::gemm_phase<mk::EpiGate4, mk::SchedBR, true>(ldsl + RING_OFF, g, S, E);
    }
    GRID_BAR();
    }
    {
    {
        mk::SchedGrid S; S.o.init(mk::M, 2048, G, bx); S.A = (const char*)MERGED; S.B = (const char*)WoutT; S.ta = 256u * 2048u * 2u; S.tb = 256u * 2048u * 2u;
        const pg8::Gemm g{2048, 2048, 2048}; mk::EpiWout E{I_x, I_out, X1B, ssq_x1, I_g_ffn};
        pg8::gemm_phase<mk::EpiWout, mk::SchedGrid, false>(ldsl + RING_OFF, g, S, E);
    }
    GRID_BAR();
    }
    {
    {
        mk::SchedGrid S; S.o.init(mk::M, 8192, G, bx); S.A = (const char*)X1B; S.B = (const char*)Wff1T; S.ta = 256u * 2048u * 2u; S.tb = 256u * 2048u * 2u;
        const pg8::Gemm g{2048, 2048, 2048}; mk::EpiFF1 E{HFF, ssq_x1};
        pg8::gemm_phase<mk::EpiFF1, mk::SchedGrid, true>(ldsl + RING_OFF, g, S, E);
    }
    GRID_BAR();
    }
    if (false) {
        mk::SchedGrid S; S.o.init(mk::M, 2048, G, bx); S.A = (const char*)HFF; S.B = (const char*)Wff2T; S.ta = 256u * (unsigned)mk::LDH * 2u; S.tb = 256u * 8192u * 2u;
        const pg8::Gemm g{mk::LDH, 8192, 8192}; mk::EpiFF2 E{I_out, (float*)AR};
        pg8::gemm_phase<mk::EpiFF2, mk::SchedGrid, false>(ldsl + RING_OFF, g, S, E);
        GRID_BAR();
    }
    {
        mk::SchedGrid S; S.o.init(mk::M, 2048, G, bx); S.A = (const char*)HFF; S.B = (const char*)Wff2T; S.ta = 256u * (unsigned)mk::LDH * 2u; S.tb = 256u * 8192u * 2u;
        const pg8::Gemm g{mk::LDH, 8192, 8192}; mk::EpiFF2 E{I_out, I_out};
        pg8::gemm_phase<mk::EpiFF2, mk::SchedGrid, false>(ldsl + RING_OFF, g, S, E);
    }
    MK_STAMP();
    if (MK_TS_ >= 0 && bx == 0 && tid == 0) {
        const unsigned dt = MISC[16 + MK_TS_ + 1] - MISC[16 + MK_TS_]; const unsigned long long t0 = __builtin_amdgcn_s_memrealtime();
        while (__builtin_amdgcn_s_memrealtime() - t0 < 8ull * dt) __builtin_amdgcn_s_sleep(8);
    }
}

extern "C" void kernel_launch(void* const* d_in, const int* in_sizes, int n_in, void* d_out, int out_size, void* d_ws, size_t ws_size, hipStream_t stream) {
    static int grid = 0;
    if (grid == 0) {
        if (n_in != 21 || out_size != mk::M * mk::D || ws_size < mk::WS_END) { fprintf(stderr, "kernel_launch: unexpected shapes (n_in %d out %d ws %zu); nothing launched\n", n_in, out_size, ws_size); grid = -1; return; }
        int dev = 0, cus = 0;
        if (hipGetDevice(&dev) != hipSuccess || hipDeviceGetAttribute(&cus, hipDeviceAttributeMultiprocessorCount, dev) != hipSuccess) { grid = -1; return; }
        if (hipFuncSetAttribute((const void*)mk_fwd, hipFuncAttributeMaxDynamicSharedMemorySize, LDS_BYTES) != hipSuccess) { fprintf(stderr, "kernel_launch: hipFuncSetAttribute failed\n"); grid = -1; return; }
        (void)hipGetLastError();
        grid = cus;
        if (grid != 256) fprintf(stderr, "kernel_launch: %d CUs; this kernel's unit maps assume 256\n", grid);
    }
    if (grid < 0) return;
    if (hipMemsetAsync((char*)d_ws + mk::WS_CTL, 0, mk::CTL_ZERO_BYTES, stream) != hipSuccess) return;
    Args a{};
    for (int i = 0; i < 21; ++i) a.in[i] = (const float*)d_in[i];
    a.out = (float*)d_out; a.ws = (unsigned char*)d_ws;
    hipLaunchKernelGGL(mk_fwd, dim3(grid), dim3(NWAVES * 64), LDS_BYTES, stream, a);
}
```
